# Optimizing an MI355X kernel written in HIP

```python
import jax, jax.numpy as jnp
from jax import lax
import numpy as np

D_MODEL = 1024
BATCH = 8
SEQ = 2048
DEPTH = 1

N_HEADS_MLA = 8
QK_NOPE_DIM = 64
QK_ROPE_DIM = 32
V_HEAD_DIM = 64
Q_LORA_RANK = 256
KV_LORA_RANK = 128
QK_HEAD_DIM = QK_NOPE_DIM + QK_ROPE_DIM
ROPE_THETA = 10000.0
Q_BLOCK = 128
MLA_WIDTH = N_HEADS_MLA * V_HEAD_DIM

N_FOURIER_GROUPS = 8
FOURIER_GROUP_DIM = 64
FOURIER_WIDTH = N_FOURIER_GROUPS * FOURIER_GROUP_DIM

N_EXPERTS = 256
TOP_K = 8
EXPERT_DIM = 256
SHARED_DIM = 256
ROUTED_SCALE = 2.5
EXPERT_BLOCK = 128

EPS = 1e-6
N_ADA = 6

IN_SPLITS = (Q_LORA_RANK, KV_LORA_RANK, QK_ROPE_DIM, FOURIER_WIDTH, D_MODEL, D_MODEL)
IN_WIDTH = sum(IN_SPLITS)
IN_OFFSETS = tuple(int(o) for o in np.cumsum(IN_SPLITS)[:-1])

kernel_name = "hybrid_mla_fnet_moe_adaln_block"


def rms_norm(x, g):
    xf = x.astype(jnp.float32)
    y = xf * lax.rsqrt(jnp.mean(xf * xf, axis=-1, keepdims=True) + EPS)
    return (y * g.astype(jnp.float32)).astype(x.dtype)


def rope_tables(seq_len):
    pos = jnp.arange(seq_len, dtype=jnp.float32)
    inv_freq = ROPE_THETA ** (-jnp.arange(0, QK_ROPE_DIM, 2, dtype=jnp.float32) / QK_ROPE_DIM)
    ang = pos[:, None] * inv_freq[None, :]
    return jnp.cos(ang)[None, :, None, :], jnp.sin(ang)[None, :, None, :]


def apply_rope_tail(t, cos, sin):
    nope, rot = t[..., :QK_NOPE_DIM], t[..., QK_NOPE_DIM:]
    r1, r2 = jnp.split(rot, 2, axis=-1)
    cos = cos.astype(t.dtype)
    sin = sin.astype(t.dtype)
    rot = jnp.concatenate([r1 * cos - r2 * sin, r2 * cos + r1 * sin], axis=-1)
    return jnp.concatenate([nope, rot], axis=-1)


def mla_mixer(z_q, z_kv, z_kr, q_a_norm_g, w_uq, kv_a_norm_g, w_ukv, q_norm_g, k_norm_g):
    B, S, _ = z_q.shape
    H = N_HEADS_MLA
    cq = rms_norm(z_q, q_a_norm_g)
    q = (cq @ w_uq).reshape(B, S, H, QK_HEAD_DIM)
    ckv = rms_norm(z_kv, kv_a_norm_g)
    kv = (ckv @ w_ukv).reshape(B, S, H, QK_NOPE_DIM + V_HEAD_DIM)
    k_nope, v = kv[..., :QK_NOPE_DIM], kv[..., QK_NOPE_DIM:]
    k_rope = jnp.broadcast_to(z_kr[:, :, None, :], (B, S, H, QK_ROPE_DIM))
    k = jnp.concatenate([k_nope, k_rope], axis=-1)
    q = rms_norm(q, q_norm_g)
    k = rms_norm(k, k_norm_g)
    cos, sin = rope_tables(S)
    q = apply_rope_tail(q, cos, sin)
    k = apply_rope_tail(k, cos, sin)
    q = q * jnp.asarray(QK_HEAD_DIM ** -0.5, dtype=q.dtype)
    n_blocks = S // Q_BLOCK
    qb = q.reshape(B, n_blocks, Q_BLOCK, H, QK_HEAD_DIM).transpose(1, 0, 2, 3, 4)

    def attend(q_blk):
        s = jnp.einsum('bqhd,bkhd->bhqk', q_blk, k, preferred_element_type=jnp.float32)
        p = jax.nn.softmax(s, axis=-1).astype(v.dtype)
        return jnp.einsum('bhqk,bkhd->bqhd', p, v)

    o = lax.map(attend, qb)
    return o.transpose(1, 0, 2, 3, 4).reshape(B, S, MLA_WIDTH)


def fourier_mixer(z_f):
    B, S, _ = z_f.shape
    zg = z_f.astype(jnp.float32).reshape(B, S, N_FOURIER_GROUPS, FOURIER_GROUP_DIM)
    zf = jnp.fft.fft2(zg, axes=(1, 3), norm='ortho')
    return jnp.real(zf).astype(z_f.dtype).reshape(B, S, FOURIER_WIDTH)


def swiglu(x, w_gate, w_up, w_down):
    return (jax.nn.silu(x @ w_gate) * (x @ w_up)) @ w_down


def moe_ffn(h, w_router, router_bias, w_exp_gate, w_exp_up, w_exp_down,
            w_sh_gate, w_sh_up, w_sh_down):
    B, S, D = h.shape
    T = B * S
    P = T * TOP_K
    n_blk = -(-P // EXPERT_BLOCK) + N_EXPERTS
    hf = h.reshape(T, D)
    scores = jax.nn.sigmoid(hf.astype(jnp.float32) @ w_router.astype(jnp.float32))
    _, idx = lax.top_k(scores + router_bias.astype(jnp.float32)[None, :], TOP_K)
    w_sel = jnp.take_along_axis(scores, idx, axis=-1)
    w_sel = w_sel / jnp.sum(w_sel, axis=-1, keepdims=True) * ROUTED_SCALE

    e_flat = idx.reshape(P).astype(jnp.int32)
    tok_flat = jnp.repeat(jnp.arange(T, dtype=jnp.int32), TOP_K)
    w_flat = w_sel.reshape(P).astype(h.dtype)
    order = jnp.argsort(e_flat, stable=True)
    e_sorted = e_flat[order]
    counts = jnp.bincount(e_flat, length=N_EXPERTS)
    starts = jnp.cumsum(counts) - counts
    padded = ((counts + EXPERT_BLOCK - 1) // EXPERT_BLOCK) * EXPERT_BLOCK
    p_ends = jnp.cumsum(padded)
    p_starts = p_ends - padded
    rank = jnp.arange(P, dtype=jnp.int32) - starts[e_sorted]
    slot = p_starts[e_sorted] + rank
    n_slots = n_blk * EXPERT_BLOCK
    slot_tok = jnp.zeros((n_slots,), jnp.int32).at[slot].set(tok_flat[order])
    slot_w = jnp.zeros((n_slots,), h.dtype).at[slot].set(w_flat[order])
    blk_start = jnp.arange(n_blk, dtype=p_ends.dtype) * EXPERT_BLOCK
    blk_expert = jnp.clip(jnp.searchsorted(p_ends, blk_start, side='right'), 0, N_EXPERTS - 1)

    def run_block(args):
        e, tok, wt = args
        xb = hf[tok]
        yb = swiglu(xb, w_exp_gate[e], w_exp_up[e], w_exp_down[e])
        return yb * wt[:, None]

    ys = lax.map(run_block, (blk_expert, slot_tok.reshape(n_blk, EXPERT_BLOCK),
                             slot_w.reshape(n_blk, EXPERT_BLOCK)))
    routed = jnp.zeros((T, D), h.dtype).at[slot_tok].add(ys.reshape(n_slots, D))
    shared = swiglu(hf, w_sh_gate, w_sh_up, w_sh_down)
    return (routed + shared).reshape(B, S, D)


def setup_inputs(seed: int = 0) -> dict:
    key = jax.random.key(seed)
    ks = iter(jax.random.split(key, 32))
    L, D = DEPTH, D_MODEL

    def dense(shape, fan_in, gain=1.0):
        return jax.random.normal(next(ks), shape, jnp.float32) * (gain * fan_in ** -0.5)

    def norm_gain(shape):
        return 1.0 + 0.1 * jax.random.normal(next(ks), shape, jnp.float32)

    return {
        'x': jax.random.normal(next(ks), (BATCH, SEQ, D), jnp.float32),
        'c': jax.random.normal(next(ks), (BATCH, D), jnp.float32),
        'w_ada': dense((L, D, N_ADA * D), D, 0.5),
        'b_ada': 0.02 * jax.random.normal(next(ks), (L, N_ADA * D), jnp.float32),
        'norm1_g': norm_gain((L, D)),
        'w_in': dense((L, D, IN_WIDTH), D),
        'q_a_norm_g': norm_gain((L, Q_LORA_RANK)),
        'w_uq': dense((L, Q_LORA_RANK, N_HEADS_MLA * QK_HEAD_DIM), Q_LORA_RANK),
        'kv_a_norm_g': norm_gain((L, KV_LORA_RANK)),
        'w_ukv': dense((L, KV_LORA_RANK, N_HEADS_MLA * (QK_NOPE_DIM + V_HEAD_DIM)), KV_LORA_RANK),
        'q_norm_g': norm_gain((L, QK_HEAD_DIM)),
        'k_norm_g': norm_gain((L, QK_HEAD_DIM)),
        'w_proj_attn': dense((L, MLA_WIDTH, D), MLA_WIDTH),
        'w_proj_fourier': dense((L, FOURIER_WIDTH, D), FOURIER_WIDTH),
        'w_out': dense((L, D, D), D),
        'norm2_g': norm_gain((L, D)),
        'w_router': dense((L, D, N_EXPERTS), D),
        'router_bias': 0.01 * jax.random.normal(next(ks), (L, N_EXPERTS), jnp.float32),
        'w_exp_gate': dense((L, N_EXPERTS, D, EXPERT_DIM), D),
        'w_exp_up': dense((L, N_EXPERTS, D, EXPERT_DIM), D),
        'w_exp_down': dense((L, N_EXPERTS, EXPERT_DIM, D), EXPERT_DIM),
        'w_sh_gate': dense((L, D, SHARED_DIM), D),
        'w_sh_up': dense((L, D, SHARED_DIM), D),
        'w_sh_down': dense((L, SHARED_DIM, D), SHARED_DIM),
    }


def reference(x, c, w_ada, b_ada, norm1_g, w_in, q_a_norm_g, w_uq, kv_a_norm_g, w_ukv,
              q_norm_g, k_norm_g, w_proj_attn, w_proj_fourier, w_out, norm2_g,
              w_router, router_bias, w_exp_gate, w_exp_up, w_exp_down,
              w_sh_gate, w_sh_up, w_sh_down):
    for l in range(DEPTH):
        ada = jax.nn.silu(c) @ w_ada[l] + b_ada[l]
        sh1, sc1, g1, sh2, sc2, g2 = jnp.split(ada[:, None, :], N_ADA, axis=-1)

        h = rms_norm(x, norm1_g[l]) * (1 + sc1) + sh1
        z = h @ w_in[l]
        z_q, z_kv, z_kr, z_f, gate_a, gate_f = jnp.split(z, IN_OFFSETS, axis=-1)
        y_a = mla_mixer(z_q, z_kv, z_kr, q_a_norm_g[l], w_uq[l], kv_a_norm_g[l], w_ukv[l],
                        q_norm_g[l], k_norm_g[l]) @ w_proj_attn[l]
        y_f = fourier_mixer(z_f) @ w_proj_fourier[l]
        merged = jax.nn.sigmoid(gate_a) * y_a + jax.nn.sigmoid(gate_f) * y_f
        x = x + g1 * (merged @ w_out[l])

        h2 = rms_norm(x, norm2_g[l]) * (1 + sc2) + sh2
        x = x + g2 * moe_ffn(h2, w_router[l], router_bias[l], w_exp_gate[l], w_exp_up[l],
                             w_exp_down[l], w_sh_gate[l], w_sh_up[l], w_sh_down[l])
    return x
```

```cpp
#include <hip/hip_runtime.h>
#include <cstdio>
#include <cstdint>

typedef unsigned short bf16_t;
typedef short bf16x8 __attribute__((ext_vector_type(8)));
typedef float f32x16 __attribute__((ext_vector_type(16)));
typedef float f32x4 __attribute__((ext_vector_type(4)));
typedef unsigned u32x4 __attribute__((ext_vector_type(4)));
typedef unsigned u32x2 __attribute__((ext_vector_type(2)));

#ifndef N_LAUNCH_MODE
#define N_LAUNCH_MODE 0
#endif
#ifndef NAIVE_MMA
#define NAIVE_MMA 0
#endif

constexpr int T = 16384, DM = 1024, NB = 8, SEQ = 2048;
constexpr int INW = 2976, NH = 8, DQK = 96, DV = 64;
constexpr int NE = 256, TOPK = 8, EH = 256;
constexpr float EPS = 1e-6f;
constexpr int NTHREADS = 512;
constexpr int LCAP = 16384;

constexpr size_t al256(size_t x) { return (x + 255) & ~(size_t)255; }
constexpr size_t WS_CTL   = 0;
constexpr size_t CTL_BYTES = 65536;
constexpr size_t WS_ADAP  = WS_CTL + CTL_BYTES;
constexpr size_t WS_ADAF  = WS_ADAP + al256((size_t)16 * 8 * 6144 * 4);
constexpr size_t WS_ROPE  = WS_ADAF + al256((size_t)8 * 6144 * 4);
constexpr size_t WS_WDFT  = WS_ROPE + al256((size_t)2 * 2048 * 16 * 4);
constexpr size_t WS_D64T  = WS_WDFT + al256((size_t)2048 * 4096 * 2);
constexpr size_t WS_WR3   = WS_D64T + al256((size_t)128 * 64 * 2);
constexpr size_t WS_WUQ   = WS_WR3 + al256((size_t)3072 * 256 * 4);
constexpr size_t WS_WUKV  = WS_WUQ + al256((size_t)256 * 768 * 4);
constexpr size_t WS_H     = WS_WUKV + al256((size_t)128 * 1024 * 4);
constexpr size_t WS_H2LO  = WS_H + al256((size_t)T * 1024 * 2);
constexpr size_t WS_ZQKV  = WS_H2LO + al256((size_t)T * 1024 * 2);
constexpr size_t WS_ZF    = WS_ZQKV + al256((size_t)T * 416 * 2);
constexpr size_t WS_SIG   = WS_ZF + al256((size_t)T * 512 * 2);
constexpr size_t WS_RSTD  = WS_SIG + al256((size_t)T * 2048 * 2);
constexpr size_t WS_XT    = WS_RSTD + al256((size_t)2 * T * 4);
constexpr size_t WS_QRAW  = WS_XT + al256((size_t)4096 * 4096 * 2);
constexpr size_t WS_KNRAW = WS_QRAW + al256((size_t)T * 768 * 4);
constexpr size_t WS_Q     = WS_KNRAW + al256((size_t)T * 512 * 4);
constexpr size_t WS_K     = WS_Q + al256((size_t)T * 768 * 2);
constexpr size_t WS_VT    = WS_K + al256((size_t)T * 768 * 2);
constexpr size_t WS_O     = WS_VT + al256((size_t)T * 512 * 2);
constexpr size_t WS_F     = WS_O + al256((size_t)T * 512 * 2);
constexpr size_t WS_MERGED= WS_F + al256((size_t)T * 512 * 2);
constexpr size_t WS_X1    = WS_MERGED + al256((size_t)T * 1024 * 2);
constexpr size_t WS_LOGIT = WS_X1 + al256((size_t)T * 1024 * 4);
constexpr size_t WS_ACTS  = WS_LOGIT + al256((size_t)T * 256 * 4);
constexpr size_t WS_LTOK  = WS_ACTS + al256((size_t)T * 256 * 2);
constexpr size_t WS_LW    = WS_LTOK + al256((size_t)NE * LCAP * 4);
constexpr size_t WS_ACT   = WS_LW + al256((size_t)NE * LCAP * 4);
constexpr size_t WS_YBUF  = WS_ACT + al256((size_t)T * 8 * 256 * 2);
constexpr size_t WS_END   = WS_YBUF + al256((size_t)T * 8 * 1024 * 2);

constexpr int CW_CNT = 4096;
constexpr int CW_QUEUE = 4400;
constexpr int CW_BAR = 0;

constexpr int LDS_GEMM = 2 * 65536;
constexpr int LDS_MISC = LDS_GEMM;
constexpr int LDS_BYTES = LDS_GEMM + 8192;

typedef __bf16 bf16x2_t __attribute__((ext_vector_type(2)));
typedef float f32x2_t __attribute__((ext_vector_type(2)));
__device__ __forceinline__ unsigned cvt_pk_bf16(float lo, float hi) { f32x2_t f = {lo, hi}; bf16x2_t h = __builtin_convertvector(f, bf16x2_t); return __builtin_bit_cast(unsigned, h); }
__device__ __forceinline__ bf16_t f2bf(float v) { __bf16 h = (__bf16)v; return __builtin_bit_cast(unsigned short, h); }
__device__ __forceinline__ float bf2f(bf16_t b) { return __uint_as_float(((unsigned)b) << 16); }
__device__ __forceinline__ float sigmoidf_(float v) { return 1.f / (1.f + __expf(-v)); }
__device__ __forceinline__ float siluf_(float v) { return v / (1.f + __expf(-v)); }
__device__ __forceinline__ float wave_sum(float v) {
#pragma unroll
    for (int o = 32; o > 0; o >>= 1) v += __shfl_xor(v, o);
    return v;
}
__device__ __forceinline__ int swz(int row) { return ((row >> 1) & 7) ^ ((row >> 4) & 1); }

#define XB_TMO      128
#define XB_XCNT(j)  (256  + 64 * (j))
#define XB_XSUB(j)  (1280 + 64 * (j))
#define XB_XGEN(j)  (2304 + 64 * (j))
#define XB_TOP      3328
#define XB_TOPGEN   3392
#define XCD_BAR_WORDS 3456
#define XB_SPIN_CAP (1u << 22)
#define LAS __attribute__((address_space(3)))
__device__ __forceinline__ unsigned xb_ld(unsigned* p)              { return __hip_atomic_load(p, __ATOMIC_RELAXED, __HIP_MEMORY_SCOPE_AGENT); }
__device__ __forceinline__ unsigned xb_add(unsigned* p, unsigned v) { return __hip_atomic_fetch_add(p, v, __ATOMIC_RELAXED, __HIP_MEMORY_SCOPE_AGENT); }
__device__ __forceinline__ unsigned xb_xcc_id() { return (unsigned)__builtin_amdgcn_s_getreg((3 << 11) | 20) & 0xFu; }
#define XB_SPIN(cond, bar) do { unsigned _sp = 0; while (cond) { __builtin_amdgcn_s_sleep(1); \
    if ((++_sp & 255u) == 0u) { if (xb_ld(&(bar)[XB_TMO])) break; if (_sp > XB_SPIN_CAP) { atomicAdd(&(bar)[XB_TMO], 1u); break; } } } } while (0)
struct XcdBarrier { unsigned* bar; unsigned x; volatile LAS unsigned* st; };
__device__ __forceinline__ XcdBarrier xcd_barrier_post(unsigned* bar, volatile LAS unsigned* st) {
    XcdBarrier b; b.bar = bar; b.x = xb_xcc_id(); b.st = st;
    if (threadIdx.x == 0) (void)xb_add(&bar[XB_XCNT(b.x)], 1u);
    return b;
}
__device__ __forceinline__ void xcd_barrier_complete(unsigned* bar, unsigned x, unsigned& nloc, unsigned& nx) {
    const unsigned G = gridDim.x * gridDim.y * gridDim.z;
    unsigned sum, cnt, mine, sp = 0u;
    for (;;) {
        sum = 0u; cnt = 0u; mine = 0u;
#pragma unroll
        for (unsigned j = 0; j < 16; ++j) { const unsigned c = xb_ld(&bar[XB_XCNT(j)]); sum += c; cnt += (c > 0u) ? 1u : 0u; mine = (j == x) ? c : mine; }
        if (sum == G) break;
        __builtin_amdgcn_s_sleep(1);
        if ((++sp & 255u) == 0u) { if (xb_ld(&bar[XB_TMO])) break; if (sp > XB_SPIN_CAP) { atomicAdd(&bar[XB_TMO], 1u); break; } }
    }
    nloc = mine > 0u ? mine : 1u; nx = cnt > 0u ? cnt : 1u;
}
__device__ __forceinline__ void xcd_barrier(const XcdBarrier& b) {
    asm volatile("s_waitcnt vmcnt(0)" ::: "memory");
    __syncthreads();
    if (threadIdx.x == 0) {
        unsigned* bar = b.bar;
        __builtin_amdgcn_s_waitcnt(0);
        unsigned nloc = b.st[0], nx = b.st[1];
        if (nloc == 0u) { xcd_barrier_complete(bar, b.x, nloc, nx); b.st[0] = nloc; b.st[1] = nx; }
        const unsigned old = xb_add(&bar[XB_XSUB(b.x)], 1u);
        const unsigned gen = old / nloc;
        if (old + 1u == (gen + 1u) * nloc) {
            __builtin_amdgcn_fence(__ATOMIC_RELEASE, "agent");
            asm volatile("s_waitcnt vmcnt(0)" ::: "memory");
            const unsigned og = xb_add(&bar[XB_TOP], 1u);
            const unsigned tg = og / nx;
            if (og + 1u == (tg + 1u) * nx) xb_add(&bar[XB_TOPGEN], 1u);
            else XB_SPIN(xb_ld(&bar[XB_TOPGEN]) == tg, bar);
            __builtin_amdgcn_fence(__ATOMIC_ACQUIRE, "agent");
            xb_add(&bar[XB_XGEN(b.x)], 1u);
            asm volatile("s_waitcnt vmcnt(0)" ::: "memory");
        } else {
            XB_SPIN(xb_ld(&bar[XB_XGEN(b.x)]) == gen, bar);
            __builtin_amdgcn_fence(__ATOMIC_ACQUIRE, "agent");
            asm volatile("s_waitcnt vmcnt(0)" ::: "memory");
        }
    }
    __syncthreads();
}

template <int MI, class AF, class BF>
__device__ __forceinline__ void gemm_core(f32x16 (&acc)[MI][2], const AF& af, const BF& bf, const int nk, unsigned char* lds) {
    constexpr int BM = 64 * MI;
    constexpr int A_BYTES = BM * 128, STAGE = A_BYTES + 256 * 128;
    const int t = threadIdx.x, lane = t & 63, w = t >> 6, wm = w >> 2, wn = w & 3;
    const int l31 = lane & 31, hh = lane >> 5;
    const int ch = t & 7, r0 = t >> 3;
    const bf16_t* abase = af.base();
    unsigned aoff[MI];
#pragma unroll
    for (int i = 0; i < MI; ++i) aoff[i] = af.off(r0 + 64 * i);
    const int a_lds = r0 * 128 + ((ch ^ swz(r0)) << 4);
    u32x4 areg[MI];
    f32x4 bregf[8]; u32x4 bregh[4];
    unsigned boff[4];
    const float* bcolf = nullptr;
    if constexpr (BF::KN) { bcolf = bf.col(4 * lane); }
    else {
#pragma unroll
        for (int i = 0; i < 4; ++i) boff[i] = bf.off(r0 + 64 * i);
    }
    auto gload = [&](int kt) {
        const long ko = af.koff(kt) + ch * 8;
#pragma unroll
        for (int i = 0; i < MI; ++i) areg[i] = *(const u32x4*)(abase + aoff[i] + ko);
        if constexpr (BF::KN) {
            const float* bp = bcolf + (long)(kt * 64 + w * 8) * bf.ldb;
#pragma unroll
            for (int i = 0; i < 8; ++i) bregf[i] = *(const f32x4*)(bp + (long)i * bf.ldb);
        } else {
            const bf16_t* bp = bf.base() + bf.koff(kt) + ch * 8;
#pragma unroll
            for (int i = 0; i < 4; ++i) bregh[i] = *(const u32x4*)(bp + boff[i]);
        }
    };
    auto lstore = [&](int st) {
        unsigned char* base = lds + st * STAGE;
#pragma unroll
        for (int i = 0; i < MI; ++i) *(u32x4*)(base + a_lds + i * 64 * 128) = areg[i];
        unsigned char* bb = base + A_BYTES;
        if constexpr (BF::KN) {
#pragma unroll
            for (int cc = 0; cc < 4; ++cc) {
                const int col = 4 * lane + cc;
                u32x4 v; v.x = cvt_pk_bf16(bregf[0][cc], bregf[1][cc]); v.y = cvt_pk_bf16(bregf[2][cc], bregf[3][cc]);
                v.z = cvt_pk_bf16(bregf[4][cc], bregf[5][cc]); v.w = cvt_pk_bf16(bregf[6][cc], bregf[7][cc]);
                *(u32x4*)(bb + col * 128 + ((w ^ swz(col)) << 4)) = v;
            }
        } else {
#pragma unroll
            for (int i = 0; i < 4; ++i) *(u32x4*)(bb + a_lds + i * 64 * 128) = bregh[i];
        }
    };
    const int fsw = swz(l31);
    const int a_frag = (wm * 32 * MI + l31) * 128, b_frag = (wn * 64 + l31) * 128;
    auto compute = [&](int st) {
        const unsigned char* base = lds + st * STAGE;
        const unsigned char* bb = base + A_BYTES;
#if NAIVE_MMA
#pragma unroll
        for (int mi = 0; mi < MI; ++mi)
#pragma unroll
            for (int ni = 0; ni < 2; ++ni)
#pragma unroll
                for (int rg = 0; rg < 16; ++rg) {
                    const int row = wm * 32 * MI + mi * 32 + (rg & 3) + 8 * (rg >> 2) + 4 * hh, col = wn * 64 + ni * 32 + l31;
                    float s = 0.f;
                    for (int k = 0; k < 64; ++k) {
                        const bf16_t av = *(const bf16_t*)(base + row * 128 + (((k >> 3) ^ swz(row)) << 4) + (k & 7) * 2);
                        const bf16_t bv = *(const bf16_t*)(bb + col * 128 + (((k >> 3) ^ swz(col)) << 4) + (k & 7) * 2);
                        s += bf2f(av) * bf2f(bv);
                    }
                    acc[mi][ni][rg] += s;
                }
#else
#pragma unroll 2
        for (int s = 0; s < 4; ++s) {
            const int pos = ((2 * s + hh) ^ fsw) << 4;
            bf16x8 bfr[2];
#pragma unroll
            for (int ni = 0; ni < 2; ++ni) bfr[ni] = *(const bf16x8*)(bb + b_frag + ni * 32 * 128 + pos);
#pragma unroll
            for (int mi = 0; mi < MI; ++mi) {
                const bf16x8 afr = *(const bf16x8*)(base + a_frag + mi * 32 * 128 + pos);
#pragma unroll
                for (int ni = 0; ni < 2; ++ni) acc[mi][ni] = __builtin_amdgcn_mfma_f32_32x32x16_bf16(afr, bfr[ni], acc[mi][ni], 0, 0, 0);
            }
        }
#endif
    };
    __syncthreads();
    gload(0);
    lstore(0);
    __syncthreads();
    for (int kt = 0; kt < nk; ++kt) {
        const bool more = (kt + 1 < nk);
        if (more) gload(kt + 1);
        compute(kt & 1);
        if (more) lstore((kt + 1) & 1);
        __syncthreads();
    }
}

template <int MI> __device__ __forceinline__ void zero_acc(f32x16 (&acc)[MI][2]) {
#pragma unroll
    for (int mi = 0; mi < MI; ++mi)
#pragma unroll
        for (int ni = 0; ni < 2; ++ni)
#pragma unroll
            for (int r = 0; r < 16; ++r) acc[mi][ni][r] = 0.f;
}
template <int MI, class EPI>
__device__ __forceinline__ void run_epilogue(const f32x16 (&acc)[MI][2], const EPI& epi) {
    const int t = threadIdx.x, lane = t & 63, w = t >> 6, wm = w >> 2, wn = w & 3, l31 = lane & 31, hh = lane >> 5;
#pragma unroll
    for (int mi = 0; mi < MI; ++mi)
#pragma unroll
        for (int rg = 0; rg < 16; ++rg) {
            const int r = wm * 32 * MI + mi * 32 + (rg & 3) + 8 * (rg >> 2) + 4 * hh;
            epi(r, wn * 64 + l31, acc[mi][0][rg], acc[mi][1][rg]);
            if ((rg & 7) == 7) __builtin_amdgcn_sched_barrier(0);
        }
}

struct ARows { const bf16_t* b; unsigned lda; int m0;
    __device__ __forceinline__ const bf16_t* base() const { return b; }
    __device__ __forceinline__ unsigned off(int r) const { return (unsigned)(m0 + r) * lda; }
    __device__ __forceinline__ long koff(int kt) const { return (long)kt * 64; } };
struct BKN { const float* b; int ldb; int n0; int nvalid; static constexpr bool KN = true;
    __device__ __forceinline__ const float* col(int c) const { int cc = n0 + c; cc = (cc < nvalid) ? cc : (nvalid - 4); return b + cc; } };
struct BKNPair { const float* g; long u_minus_g; int ldb; static constexpr bool KN = true;
    __device__ __forceinline__ const float* col(int c) const { return g + (long)((c >> 5) & 1) * u_minus_g + (c >> 6) * 32 + (c & 31); } };
struct BNK { const bf16_t* b; unsigned ldb; int n0; static constexpr bool KN = false;
    __device__ __forceinline__ const bf16_t* base() const { return b; }
    __device__ __forceinline__ unsigned off(int c) const { return (unsigned)(n0 + c) * ldb; }
    __device__ __forceinline__ long koff(int kt) const { return (long)kt * 64; } };

struct Args { const float* in[24]; float* out; unsigned char* ws; int ph_lo, ph_hi; };

struct Ctx {
    const Args& a; float* out; unsigned char* ws; unsigned char* lds; unsigned* ctl;
    int tid, lane, wave, G, vcu;
};

__device__ __forceinline__ void p0_prep(const Ctx& F) {
    const float* c = F.a.in[1]; const float* w_ada = F.a.in[2];
    float* adap = (float*)(F.ws + WS_ADAP);
    float* sc = (float*)F.lds;
    for (int it = F.vcu; it < 16 * 24; it += F.G) {
        const int ks = it / 24, chunk = it % 24;
        __syncthreads();
        { const int b = F.tid >> 6, k = F.tid & 63; sc[b * 64 + k] = siluf_(c[b * 1024 + ks * 64 + k]); }
        __syncthreads();
        const int col = chunk * 256 + (F.tid & 255), b0 = (F.tid >> 8) * 4;
        float a0 = 0.f, a1 = 0.f, a2 = 0.f, a3 = 0.f;
        for (int k = 0; k < 64; ++k) {
            const float wv = w_ada[(long)(ks * 64 + k) * 6144 + col];
            a0 += sc[(b0 + 0) * 64 + k] * wv; a1 += sc[(b0 + 1) * 64 + k] * wv; a2 += sc[(b0 + 2) * 64 + k] * wv; a3 += sc[(b0 + 3) * 64 + k] * wv;
        }
        adap[((long)ks * 8 + b0 + 0) * 6144 + col] = a0; adap[((long)ks * 8 + b0 + 1) * 6144 + col] = a1;
        adap[((long)ks * 8 + b0 + 2) * 6144 + col] = a2; adap[((long)ks * 8 + b0 + 3) * 6144 + col] = a3;
    }
    const long gt = (long)F.vcu * NTHREADS + F.tid, gs = (long)F.G * NTHREADS;
    { float* rc = (float*)(F.ws + WS_ROPE); float* rs = rc + 2048 * 16;
      for (long i = gt; i < 2048 * 16; i += gs) { const int pos = (int)(i >> 4), j = (int)(i & 15);
          const float inv = powf(10000.0f, -(float)(2 * j) / 32.0f); const float ang = (float)pos * inv; rc[i] = cosf(ang); rs[i] = sinf(ang); } }
    { bf16_t* wd = (bf16_t*)(F.ws + WS_WDFT); const float nrm = 0.02209708691207961f;
      for (long i = gt; i < (long)2048 * 4096; i += gs) { const int k = (int)(i >> 12), kk = (int)(i & 4095), s = kk & 2047; const int idx = (k * s) & 2047;
          const float a = (float)idx * (1.0f / 1024.0f); const float v = (kk < 2048) ? cospif(a) : sinpif(a); wd[i] = f2bf(v * nrm); } }
    { bf16_t* d6 = (bf16_t*)(F.ws + WS_D64T);
      for (long i = gt; i < 128 * 64; i += gs) { const int n = (int)(i >> 6), cc = (int)(i & 63), part = n >> 6, m = n & 63; const int idx = (m * cc) & 63;
          const float a = (float)idx * (1.0f / 32.0f); const float v = part ? -sinpif(a) : cospif(a); d6[i] = f2bf(v * 0.125f); } }
    { float* w3 = (float*)(F.ws + WS_WR3); const float* wr = F.a.in[16];
      for (long i = gt; i < (long)3072 * 256; i += gs) { const int k3 = (int)(i >> 8), n = (int)(i & 255), rg = k3 >> 10, k = k3 & 1023;
          const float wv = wr[k * 256 + n]; const float hi = bf2f(f2bf(wv)); w3[i] = (rg == 2) ? (wv - hi) : hi; } }
    { float* o = (float*)(F.ws + WS_WUQ); const float* g = F.a.in[6]; const float* wq = F.a.in[7];
      for (long i = gt; i < 256 * 768; i += gs) o[i] = wq[i] * g[i / 768]; }
    { float* o = (float*)(F.ws + WS_WUKV); const float* g = F.a.in[8]; const float* wk = F.a.in[9];
      for (long i = gt; i < 128 * 1024; i += gs) o[i] = wk[i] * g[i >> 10]; }
}

__device__ __forceinline__ void p_norm_rows(const Ctx& F, int which) {
    const float* src = which ? (const float*)(F.ws + WS_X1) : F.a.in[0];
    const float* gain = which ? F.a.in[15] : F.a.in[4];
    const float* adap = (const float*)(F.ws + WS_ADAP); const float* b_ada = F.a.in[3];
    float* adaf = (float*)(F.ws + WS_ADAF);
    bf16_t* dhi = (bf16_t*)(F.ws + WS_H); bf16_t* dlo = (bf16_t*)(F.ws + WS_H2LO);
    float* smod = (float*)F.lds; float* sshift = smod + 1024;
    const int nitems = 256 + (which ? 0 : 8);
    for (int it = F.vcu; it < nitems; it += F.G) {
        if (it >= 256) {
            const int b = it - 256;
            for (int j = F.tid; j < 6144; j += NTHREADS) { float s = b_ada[j];
                for (int ks = 0; ks < 16; ++ks) s += adap[((long)ks * 8 + b) * 6144 + j];
                adaf[b * 6144 + j] = s; }
            continue;
        }
        const int b = it >> 5;
        __syncthreads();
        for (int cidx = F.tid; cidx < 1024; cidx += NTHREADS) {
            float sh, scv;
            if (which == 0) { sh = b_ada[cidx]; scv = b_ada[1024 + cidx];
                for (int ks = 0; ks < 16; ++ks) { sh += adap[((long)ks * 8 + b) * 6144 + cidx]; scv += adap[((long)ks * 8 + b) * 6144 + 1024 + cidx]; } }
            else { sh = adaf[b * 6144 + 3 * 1024 + cidx]; scv = adaf[b * 6144 + 4 * 1024 + cidx]; }
            smod[cidx] = gain[cidx] * (1.f + scv); sshift[cidx] = sh;
        }
        __syncthreads();
        for (int j = 0; j < 8; ++j) {
            const long row = (long)it * 64 + F.wave * 8 + j;
            f32x4 v[4]; float ss = 0.f;
#pragma unroll
            for (int i = 0; i < 4; ++i) { v[i] = *(const f32x4*)(src + row * 1024 + i * 256 + F.lane * 4); ss += v[i][0] * v[i][0] + v[i][1] * v[i][1] + v[i][2] * v[i][2] + v[i][3] * v[i][3]; }
            ss = wave_sum(ss);
            const float rstd = rsqrtf(ss * (1.0f / 1024.0f) + EPS);
#pragma unroll
            for (int i = 0; i < 4; ++i) {
                const int c0 = i * 256 + F.lane * 4; float hv[4];
#pragma unroll
                for (int e = 0; e < 4; ++e) hv[e] = v[i][e] * rstd * smod[c0 + e] + sshift[c0 + e];
                u32x2 pk; pk.x = cvt_pk_bf16(hv[0], hv[1]); pk.y = cvt_pk_bf16(hv[2], hv[3]);
                *(u32x2*)(dhi + row * 1024 + c0) = pk;
                if (which) {
                    float lo[4];
                    lo[0] = hv[0] - __uint_as_float(pk.x << 16); lo[1] = hv[1] - __uint_as_float(pk.x & 0xffff0000u);
                    lo[2] = hv[2] - __uint_as_float(pk.y << 16); lo[3] = hv[3] - __uint_as_float(pk.y & 0xffff0000u);
                    u32x2 pl; pl.x = cvt_pk_bf16(lo[0], lo[1]); pl.y = cvt_pk_bf16(lo[2], lo[3]);
                    *(u32x2*)(dlo + row * 1024 + c0) = pl;
                }
            }
        }
    }
}

__device__ __forceinline__ void p2_win(const Ctx& F) {
    const bf16_t* h = (const bf16_t*)(F.ws + WS_H);
    bf16_t* zqkv = (bf16_t*)(F.ws + WS_ZQKV); bf16_t* zf = (bf16_t*)(F.ws + WS_ZF); bf16_t* sig = (bf16_t*)(F.ws + WS_SIG);
    for (int it = F.vcu; it < 64 * 12; it += F.G) {
        const int ct = it % 12, rt = it / 12; const int m0 = rt * 256, n0 = ct * 256;
        f32x16 acc[4][2]; zero_acc<4>(acc);
        ARows af{h, 1024, m0}; BKN bf{F.a.in[5], INW, n0, INW};
        gemm_core<4>(acc, af, bf, 16, F.lds);
        run_epilogue<4>(acc, [&](int r, int c, float v0, float v1) {
            const long row = m0 + r;
#pragma unroll
            for (int q = 0; q < 2; ++q) { const int col = n0 + c + 32 * q; const float v = q ? v1 : v0;
                if (col < 416) zqkv[row * 416 + col] = f2bf(v);
                else if (col < 928) zf[row * 512 + (col - 416)] = f2bf(v);
                else if (col < INW) sig[row * 2048 + (col - 928)] = f2bf(sigmoidf_(v)); }
        });
    }
}

__device__ __forceinline__ void p3_stats_chdft(const Ctx& F) {
    const bf16_t* zqkv = (const bf16_t*)(F.ws + WS_ZQKV); float* rstd = (float*)(F.ws + WS_RSTD);
    for (int row = F.vcu * 8 + F.wave; row < T; row += F.G * 8) {
        const bf16_t* p = zqkv + (long)row * 416;
        const u32x2 a = *(const u32x2*)(p + F.lane * 4); const unsigned bq = *(const unsigned*)(p + 256 + F.lane * 2);
        float s1 = 0.f, s2 = 0.f; float f;
        f = __uint_as_float(a.x << 16); s1 += f * f; f = __uint_as_float(a.x & 0xffff0000u); s1 += f * f;
        f = __uint_as_float(a.y << 16); s1 += f * f; f = __uint_as_float(a.y & 0xffff0000u); s1 += f * f;
        f = __uint_as_float(bq << 16); s2 += f * f; f = __uint_as_float(bq & 0xffff0000u); s2 += f * f;
        s1 = wave_sum(s1); s2 = wave_sum(s2);
        if (F.lane == 0) { rstd[row] = rsqrtf(s1 * (1.0f / 256.0f) + EPS); rstd[T + row] = rsqrtf(s2 * (1.0f / 128.0f) + EPS); }
    }
    const bf16_t* zf = (const bf16_t*)(F.ws + WS_ZF); const bf16_t* d6 = (const bf16_t*)(F.ws + WS_D64T); bf16_t* xt = (bf16_t*)(F.ws + WS_XT);
    for (int it = F.vcu; it < 8 * 64; it += F.G) {
        const int g = it & 7, tt = it >> 3; const int tok0 = tt * 256;
        f32x16 acc[2][2]; zero_acc<2>(acc);
        ARows af{d6, 64, 0}; BNK bf{zf + g * 64, 512, tok0};
        gemm_core<2>(acc, af, bf, 1, F.lds);
        run_epilogue<2>(acc, [&](int r, int c, float v0, float v1) {
            const int part = r >> 6, m = r & 63;
#pragma unroll
            for (int q = 0; q < 2; ++q) { const int tok = tok0 + c + 32 * q; const int b = tok >> 11, s = tok & 2047;
                xt[((long)(b * 512 + g * 64 + m)) * 4096 + part * 2048 + s] = f2bf(q ? v1 : v0); }
        });
    }
}

__device__ __forceinline__ void p4_qkv_up(const Ctx& F) {
    const bf16_t* zqkv = (const bf16_t*)(F.ws + WS_ZQKV); const float* rstd = (const float*)(F.ws + WS_RSTD);
    float* qraw = (float*)(F.ws + WS_QRAW); float* knraw = (float*)(F.ws + WS_KNRAW); bf16_t* vt = (bf16_t*)(F.ws + WS_VT);
    for (int it = F.vcu; it < 64 * 3; it += F.G) {
        const int rt = it / 3, ct = it % 3; const int m0 = rt * 256, n0 = ct * 256;
        f32x16 acc[4][2]; zero_acc<4>(acc);
        ARows af{zqkv, 416, m0}; BKN bf{(const float*)(F.ws + WS_WUQ), 768, n0, 768};
        gemm_core<4>(acc, af, bf, 4, F.lds);
        run_epilogue<4>(acc, [&](int r, int c, float v0, float v1) {
            const long row = m0 + r; const float rs = rstd[row];
            qraw[row * 768 + n0 + c] = v0 * rs; qraw[row * 768 + n0 + c + 32] = v1 * rs; });
    }
    for (int it = F.vcu; it < 64 * 4; it += F.G) {
        const int rt = it >> 2, ct = it & 3; const int m0 = rt * 256, n0 = ct * 256;
        f32x16 acc[4][2]; zero_acc<4>(acc);
        ARows af{zqkv + 256, 416, m0}; BKN bf{(const float*)(F.ws + WS_WUKV), 1024, n0, 1024};
        gemm_core<4>(acc, af, bf, 2, F.lds);
        run_epilogue<4>(acc, [&](int r, int c, float v0, float v1) {
            const long row = m0 + r; const float rs = rstd[T + row]; const int b = (int)(row >> 11), s = (int)(row & 2047);
#pragma unroll
            for (int q = 0; q < 2; ++q) { const int col = n0 + c + 32 * q; const float v = (q ? v1 : v0) * rs; const int hd = col >> 7, d = col & 127;
                if (d < 64) knraw[row * 512 + hd * 64 + d] = v;
                else vt[((long)((b * 8 + hd) * 64 + (d - 64))) * 2048 + s] = f2bf(v); }
        });
    }
}

__device__ __forceinline__ void p5_qk_final(const Ctx& F) {
    const float* qraw = (const float*)(F.ws + WS_QRAW); const float* knraw = (const float*)(F.ws + WS_KNRAW); const bf16_t* zqkv = (const bf16_t*)(F.ws + WS_ZQKV);
    const float* rc = (const float*)(F.ws + WS_ROPE); const float* rs = rc + 2048 * 16;
    bf16_t* Q = (bf16_t*)(F.ws + WS_Q); bf16_t* K = (bf16_t*)(F.ws + WS_K);
    const float qscale = 0.10206207261596577f * 1.4426950408889634f;
    const long gt = (long)F.vcu * NTHREADS + F.tid, gs = (long)F.G * NTHREADS;
    for (long i = gt; i < (long)T * 16; i += gs) {
        const int which = (int)(i & 1), hd = (int)((i >> 1) & 7); const long tok = i >> 4; const int b = (int)(tok >> 11), s = (int)(tok & 2047);
        const float* g = which ? F.a.in[11] : F.a.in[10];
        const float* p0 = which ? (knraw + tok * 512 + hd * 64) : (qraw + tok * 768 + hd * 96);
        const bf16_t* pr = zqkv + tok * 416 + 384;
        float ss = 0.f;
        for (int d = 0; d < 64; ++d) { const float v = p0[d]; ss += v * v; }
        for (int d = 0; d < 32; ++d) { const float v = which ? bf2f(pr[d]) : p0[64 + d]; ss += v * v; }
        const float rstd = rsqrtf(ss * (1.0f / 96.0f) + EPS) * (which ? 1.f : qscale);
        bf16_t* o = (which ? K : Q) + ((long)(b * 8 + hd) * 2048 + s) * 96;
        for (int d = 0; d < 64; d += 2) { *(unsigned*)(o + d) = cvt_pk_bf16(p0[d] * rstd * g[d], p0[d + 1] * rstd * g[d + 1]); }
        for (int j = 0; j < 16; j += 2) {
            float o1[2], o2[2];
#pragma unroll
            for (int e = 0; e < 2; ++e) { const int jj = j + e;
                const float r1 = (which ? bf2f(pr[jj]) : p0[64 + jj]) * rstd * g[64 + jj];
                const float r2 = (which ? bf2f(pr[16 + jj]) : p0[80 + jj]) * rstd * g[80 + jj];
                const float cs = rc[s * 16 + jj], sn = rs[s * 16 + jj];
                o1[e] = r1 * cs - r2 * sn; o2[e] = r2 * cs + r1 * sn; }
            *(unsigned*)(o + 64 + j) = cvt_pk_bf16(o1[0], o1[1]); *(unsigned*)(o + 80 + j) = cvt_pk_bf16(o2[0], o2[1]);
        }
    }
}

constexpr int KROW = 208, VROW = 136, K_TILE = 64 * KROW, V_TILE = 64 * VROW, AT_STAGE = K_TILE + V_TILE;
__device__ __forceinline__ void attn_item(const Ctx& F, int item) {
    const int qb = item & 7, bh = item >> 3, b = bh >> 3, hd = bh & 7;
    const bf16_t* Q = (const bf16_t*)(F.ws + WS_Q) + (long)bh * 2048 * 96;
    const bf16_t* K = (const bf16_t*)(F.ws + WS_K) + (long)bh * 2048 * 96;
    const bf16_t* Vt = (const bf16_t*)(F.ws + WS_VT) + (long)bh * 64 * 2048;
    bf16_t* O = (bf16_t*)(F.ws + WS_O);
    const int t = F.tid, lane = F.lane, w = F.wave, l31 = lane & 31, hh = lane >> 5;
    bf16x8 qf[6];
    { const bf16_t* qp = Q + (long)(qb * 256 + w * 32 + l31) * 96 + hh * 8;
#pragma unroll
      for (int s = 0; s < 6; ++s) qf[s] = *(const bf16x8*)(qp + s * 16); }
    f32x16 oacc[2];
#pragma unroll
    for (int d = 0; d < 2; ++d)
#pragma unroll
        for (int r = 0; r < 16; ++r) oacc[d][r] = 0.f;
    float m_run = -1e30f, l_run = 0.f;
    const int kq0 = t, kq1 = t + 512;
    const int k_l0 = (kq0 / 12) * KROW + (kq0 % 12) * 16, k_l1 = (kq1 / 12) * KROW + (kq1 % 12) * 16;
    const int v_dv = t >> 3, v_c = t & 7; const int v_l = v_dv * VROW + v_c * 16;
    u32x4 kr0, kr1, vr;
    auto gload = [&](int j) {
        const bf16_t* kp = K + (long)j * 64 * 96;
        kr0 = *(const u32x4*)(kp + kq0 * 8);
        if (t < 256) kr1 = *(const u32x4*)(kp + kq1 * 8);
        vr = *(const u32x4*)(Vt + (long)v_dv * 2048 + j * 64 + v_c * 8);
    };
    auto lstore = [&](int st) {
        unsigned char* base = F.lds + st * AT_STAGE;
        *(u32x4*)(base + k_l0) = kr0;
        if (t < 256) *(u32x4*)(base + k_l1) = kr1;
        *(u32x2*)(base + K_TILE + v_l) = (u32x2){vr.x, vr.y}; *(u32x2*)(base + K_TILE + v_l + 8) = (u32x2){vr.z, vr.w};
    };
    __syncthreads();
    gload(0); lstore(0);
    __syncthreads();
    for (int j = 0; j < 32; ++j) {
        const bool more = (j + 1 < 32);
        if (more) gload(j + 1);
        const unsigned char* kb = F.lds + (j & 1) * AT_STAGE; const unsigned char* vb = kb + K_TILE;
        f32x16 st[2];
#pragma unroll
        for (int f = 0; f < 2; ++f) {
#pragma unroll
            for (int r = 0; r < 16; ++r) st[f][r] = 0.f;
#pragma unroll
            for (int s = 0; s < 6; ++s) {
                const bf16x8 kf = *(const bf16x8*)(kb + (32 * f + l31) * KROW + (16 * s + 8 * hh) * 2);
                st[f] = __builtin_amdgcn_mfma_f32_32x32x16_bf16(kf, qf[s], st[f], 0, 0, 0);
            }
        }
        float mx = st[0][0];
#pragma unroll
        for (int r = 1; r < 16; ++r) mx = fmaxf(mx, st[0][r]);
#pragma unroll
        for (int r = 0; r < 16; ++r) mx = fmaxf(mx, st[1][r]);
        mx = fmaxf(mx, __shfl_xor(mx, 32));
        const float m_new = fmaxf(m_run, mx);
        const float alpha = __builtin_amdgcn_exp2f(m_run - m_new);
        m_run = m_new;
        float ps = 0.f;
#pragma unroll
        for (int f = 0; f < 2; ++f)
#pragma unroll
            for (int r = 0; r < 16; ++r) { const float p = __builtin_amdgcn_exp2f(st[f][r] - m_new); st[f][r] = p; ps += p; }
        l_run = l_run * alpha + ps;
#pragma unroll
        for (int d = 0; d < 2; ++d)
#pragma unroll
            for (int r = 0; r < 16; ++r) oacc[d][r] *= alpha;
#pragma unroll
        for (int f = 0; f < 2; ++f)
#pragma unroll
            for (int s2 = 0; s2 < 2; ++s2) {
                u32x4 pw; pw.x = cvt_pk_bf16(st[f][8 * s2 + 0], st[f][8 * s2 + 1]); pw.y = cvt_pk_bf16(st[f][8 * s2 + 2], st[f][8 * s2 + 3]);
                pw.z = cvt_pk_bf16(st[f][8 * s2 + 4], st[f][8 * s2 + 5]); pw.w = cvt_pk_bf16(st[f][8 * s2 + 6], st[f][8 * s2 + 7]);
                const bf16x8 pf = *(const bf16x8*)&pw;
                const int key0 = 32 * f + 16 * s2 + 4 * hh;
#pragma unroll
                for (int d = 0; d < 2; ++d) {
                    const unsigned char* vp = vb + (32 * d + l31) * VROW + key0 * 2;
                    const u32x2 lo = *(const u32x2*)vp, hi = *(const u32x2*)(vp + 16);
                    u32x4 vw = {lo.x, lo.y, hi.x, hi.y};
                    oacc[d] = __builtin_amdgcn_mfma_f32_32x32x16_bf16(*(const bf16x8*)&vw, pf, oacc[d], 0, 0, 0);
                }
            }
        if (more) lstore((j + 1) & 1);
        __syncthreads();
    }
    l_run += __shfl_xor(l_run, 32);
    const float inv = 1.0f / l_run;
    const long tok = (long)b * 2048 + qb * 256 + w * 32 + l31;
#pragma unroll
    for (int d = 0; d < 2; ++d)
#pragma unroll
        for (int q4 = 0; q4 < 4; ++q4) {
            const int dv = 32 * d + 8 * q4 + 4 * hh;
            u32x2 pk; pk.x = cvt_pk_bf16(oacc[d][4 * q4 + 0] * inv, oacc[d][4 * q4 + 1] * inv); pk.y = cvt_pk_bf16(oacc[d][4 * q4 + 2] * inv, oacc[d][4 * q4 + 3] * inv);
            *(u32x2*)(O + tok * 512 + hd * 64 + dv) = pk;
        }
}

__device__ __forceinline__ void dft_item(const Ctx& F, int item) {
    const int rt = item & 7, ctile = item >> 3;
    const int m0 = rt * 256, n0 = ctile * 256;
    f32x16 acc[4][2]; zero_acc<4>(acc);
    ARows af{(const bf16_t*)(F.ws + WS_WDFT), 4096, m0}; BNK bf{(const bf16_t*)(F.ws + WS_XT), 4096, n0};
    gemm_core<4>(acc, af, bf, 64, F.lds);
    bf16_t* Fo = (bf16_t*)(F.ws + WS_F);
    const int b = n0 >> 9, c0 = n0 & 511;
    run_epilogue<4>(acc, [&](int r, int c, float v0, float v1) {
        const long row = (long)b * 2048 + m0 + r;
        Fo[row * 512 + c0 + c] = f2bf(v0); Fo[row * 512 + c0 + c + 32] = f2bf(v1); });
}

__device__ __forceinline__ void p6_attn_dft(const Ctx& F) {
    volatile LAS int* sitem = (volatile LAS int*)(F.lds + LDS_MISC);
    auto next_item = [&]() -> int {
        __syncthreads();
        if (F.tid == 0) sitem[0] = (int)xb_add(F.ctl + CW_QUEUE, 1u);
        __syncthreads();
        return sitem[0];
    };
    int it = next_item();
    while (it < 128) { dft_item(F, it); it = next_item(); }
    while (it < 128 + 512) { attn_item(F, it - 128); it = next_item(); }
}

__device__ __forceinline__ void p7_merge(const Ctx& F) {
    const bf16_t* O = (const bf16_t*)(F.ws + WS_O); const bf16_t* Fo = (const bf16_t*)(F.ws + WS_F); const bf16_t* sig = (const bf16_t*)(F.ws + WS_SIG);
    bf16_t* mg = (bf16_t*)(F.ws + WS_MERGED);
    for (int it = F.vcu; it < 128 * 4; it += F.G) {
        const int ct = it & 3, rt = it >> 2; const int m0 = rt * 128, n0 = ct * 256;
        f32x16 acc[2][2]; zero_acc<2>(acc);
        ARows af{O, 512, m0}; BKN bf{F.a.in[12], 1024, n0, 1024}; gemm_core<2>(acc, af, bf, 8, F.lds);
        run_epilogue<2>(acc, [&](int r, int c, float v0, float v1) { const unsigned row = m0 + r; const unsigned col = n0 + c;
            mg[row * 1024u + col] = f2bf(bf2f(sig[row * 2048u + col]) * v0); mg[row * 1024u + col + 32] = f2bf(bf2f(sig[row * 2048u + col + 32]) * v1); });
    }
    for (int it = F.vcu; it < 128 * 4; it += F.G) {
        const int ct = it & 3, rt = it >> 2; const int m0 = rt * 128, n0 = ct * 256;
        f32x16 acc[2][2]; zero_acc<2>(acc);
        ARows af{Fo, 512, m0}; BKN bf{F.a.in[13], 1024, n0, 1024}; gemm_core<2>(acc, af, bf, 8, F.lds);
        run_epilogue<2>(acc, [&](int r, int c, float v0, float v1) { const unsigned row = m0 + r; const unsigned col = n0 + c;
            mg[row * 1024u + col] = f2bf(bf2f(mg[row * 1024u + col]) + bf2f(sig[row * 2048u + 1024 + col]) * v0);
            mg[row * 1024u + col + 32] = f2bf(bf2f(mg[row * 1024u + col + 32]) + bf2f(sig[row * 2048u + 1024 + col + 32]) * v1); });
    }
}

__device__ __forceinline__ void p8_out(const Ctx& F) {
    const bf16_t* mg = (const bf16_t*)(F.ws + WS_MERGED); const float* x = F.a.in[0]; const float* adaf = (const float*)(F.ws + WS_ADAF);
    float* x1 = (float*)(F.ws + WS_X1);
    for (int it = F.vcu; it < 64 * 4; it += F.G) {
        const int ct = it & 3, rt = it >> 2; const int m0 = rt * 256, n0 = ct * 256; const int b = m0 >> 11;
        f32x16 acc[4][2]; zero_acc<4>(acc);
        ARows af{mg, 1024, m0}; BKN bf{F.a.in[14], 1024, n0, 1024};
        gemm_core<4>(acc, af, bf, 16, F.lds);
        const float* g1 = adaf + b * 6144 + 2 * 1024;
        run_epilogue<4>(acc, [&](int r, int c, float v0, float v1) {
            const long row = m0 + r; const int col = n0 + c;
            x1[row * 1024 + col] = x[row * 1024 + col] + g1[col] * v0;
            x1[row * 1024 + col + 32] = x[row * 1024 + col + 32] + g1[col + 32] * v1; });
    }
}

struct ARouter { const bf16_t* hi; long lo_minus_hi; int m0;
    __device__ __forceinline__ const bf16_t* base() const { return hi; }
    __device__ __forceinline__ unsigned off(int r) const { return (unsigned)(m0 + r) * 1024u; }
    __device__ __forceinline__ long koff(int kt) const { const int rg = kt >> 4; return (long)(kt & 15) * 64 + ((rg == 1) ? lo_minus_hi : 0L); } };
__device__ __forceinline__ void p10_router_shared(const Ctx& F) {
    const bf16_t* hhi = (const bf16_t*)(F.ws + WS_H); const bf16_t* hlo = (const bf16_t*)(F.ws + WS_H2LO);
    float* logit = (float*)(F.ws + WS_LOGIT); bf16_t* acts = (bf16_t*)(F.ws + WS_ACTS);
    for (int it = F.vcu; it < 128; it += F.G) {
        const int m0 = it * 128;
        f32x16 acc[2][2]; zero_acc<2>(acc);
        ARouter af{hhi, (long)(hlo - hhi), m0}; BKN bf{(const float*)(F.ws + WS_WR3), 256, 0, 256};
        gemm_core<2>(acc, af, bf, 48, F.lds);
        run_epilogue<2>(acc, [&](int r, int c, float v0, float v1) { const long row = m0 + r; logit[row * 256 + c] = v0; logit[row * 256 + c + 32] = v1; });
    }
    for (int i2 = (F.vcu + 128) % F.G; i2 < 128; i2 += F.G) {
        const int rt = i2 >> 1, ct = i2 & 1; const int m0 = rt * 256, j0 = ct * 128;
        f32x16 acc[4][2]; zero_acc<4>(acc);
        ARows af{hhi, 1024, m0}; BKNPair bf{F.a.in[21] + j0, (long)(F.a.in[22] - F.a.in[21]), 256};
        gemm_core<4>(acc, af, bf, 16, F.lds);
        run_epilogue<4>(acc, [&](int r, int c, float v0, float v1) { const long row = m0 + r; const int j = j0 + (c >> 6) * 32 + (c & 31);
            acts[row * 256 + j] = f2bf(siluf_(v0) * v1); });
    }
}

__device__ __forceinline__ void p11_topk(const Ctx& F) {
    const float* logit = (const float*)(F.ws + WS_LOGIT); const float* bias = F.a.in[17];
    int* ltok = (int*)(F.ws + WS_LTOK); float* lw = (float*)(F.ws + WS_LW); unsigned* cnt = F.ctl + CW_CNT;
    const int lane = F.lane;
    float bs[4];
#pragma unroll
    for (int i = 0; i < 4; ++i) bs[i] = bias[lane + 64 * i];
    for (int tok = F.vcu * 8 + F.wave; tok < T; tok += F.G * 8) {
        float sc[4]; unsigned long long key[4];
#pragma unroll
        for (int i = 0; i < 4; ++i) {
            sc[i] = sigmoidf_(logit[(long)tok * 256 + lane + 64 * i]);
            const unsigned ub = __float_as_uint(sc[i] + bs[i]);
            const unsigned ord = (ub & 0x80000000u) ? ~ub : (ub | 0x80000000u);
            key[i] = ((unsigned long long)ord << 32) | (unsigned long long)(255 - (lane + 64 * i));
        }
        float wsum = 0.f; float myw = 0.f; int mye = 0;
        for (int k = 0; k < 8; ++k) {
            unsigned long long best = key[0];
#pragma unroll
            for (int i = 1; i < 4; ++i) best = (key[i] > best) ? key[i] : best;
#pragma unroll
            for (int o = 32; o > 0; o >>= 1) {
                const unsigned lo = __shfl_xor((unsigned)best, o), hi = __shfl_xor((unsigned)(best >> 32), o);
                const unsigned long long ob = ((unsigned long long)hi << 32) | lo;
                best = (ob > best) ? ob : best;
            }
            const int e = 255 - (int)(best & 0xffull);
            float s_own = 0.f;
#pragma unroll
            for (int i = 0; i < 4; ++i) { const bool mine = (e == lane + 64 * i); s_own = mine ? sc[i] : s_own; key[i] = mine ? 0ull : key[i]; }
            const float s_k = __shfl(s_own, e & 63);
            wsum += s_k;
            myw = (lane == k) ? s_k : myw; mye = (lane == k) ? e : mye;
        }
        if (lane < 8) {
            const float wgt = myw / wsum * 2.5f;
            const unsigned slot = atomicAdd(&cnt[mye], 1u);
            ltok[(long)mye * LCAP + slot] = tok * 8 + lane; lw[(long)mye * LCAP + slot] = wgt;
        }
    }
}

__device__ __forceinline__ int build_expert_tables(const Ctx& F, int per_rt) {
    volatile LAS int* offs = (volatile LAS int*)(F.lds + LDS_MISC); volatile LAS int* istart = offs + 264;
    unsigned* cnt = F.ctl + CW_CNT;
    __syncthreads();
    if (F.tid == 0) { int o = 0, is = 0;
        for (int e = 0; e < NE; ++e) { const int c = (int)cnt[e]; offs[e] = o; istart[e] = is; o += c; is += ((c + 255) >> 8) * per_rt; }
        offs[NE] = o; istart[NE] = is; }
    __syncthreads();
    return istart[NE];
}
__device__ __forceinline__ int find_expert(const Ctx& F, int it) {
    volatile LAS int* istart = (volatile LAS int*)(F.lds + LDS_MISC) + 264;
    int lo = 0, hi = NE;
    while (hi - lo > 1) { const int mid = (lo + hi) >> 1; if (istart[mid] <= it) lo = mid; else hi = mid; }
    return lo;
}
struct AGather { const bf16_t* b; const int* list; int m0, mvalid; unsigned lda;
    __device__ __forceinline__ const bf16_t* base() const { return b; }
    __device__ __forceinline__ unsigned off(int r) const { int i = m0 + r; i = (i < mvalid) ? i : (mvalid - 1); return (unsigned)(list[i] >> 3) * lda; }
    __device__ __forceinline__ long koff(int kt) const { return (long)kt * 64; } };
struct ARowsV { const bf16_t* b; unsigned lda; int m0, mvalid;
    __device__ __forceinline__ const bf16_t* base() const { return b; }
    __device__ __forceinline__ unsigned off(int r) const { int i = m0 + r; i = (i < mvalid) ? i : (mvalid - 1); return (unsigned)i * lda; }
    __device__ __forceinline__ long koff(int kt) const { return (long)kt * 64; } };

__device__ __forceinline__ void p12_exp_up(const Ctx& F) {
    const int total = build_expert_tables(F, 2);
    volatile LAS int* offs = (volatile LAS int*)(F.lds + LDS_MISC);
    volatile LAS int* istart = offs + 264;
    const bf16_t* hhi = (const bf16_t*)(F.ws + WS_H); const int* ltok = (const int*)(F.ws + WS_LTOK); bf16_t* act = (bf16_t*)(F.ws + WS_ACT);
    unsigned* cnt = F.ctl + CW_CNT;
    for (int it = F.vcu; it < total; it += F.G) {
        const int e = find_expert(F, it); const int li = it - istart[e]; const int rt = li >> 1, ct = li & 1;
        const int me = (int)cnt[e], m0 = rt * 256, j0 = ct * 128; const int ro = offs[e];
        f32x16 acc[4][2]; zero_acc<4>(acc);
        AGather af{hhi, ltok + (long)e * LCAP, m0, me, 1024u};
        BKNPair bf{F.a.in[18] + (long)e * 262144 + j0, (long)(F.a.in[19] - F.a.in[18]), 256};
        gemm_core<4>(acc, af, bf, 16, F.lds);
        run_epilogue<4>(acc, [&](int r, int c, float v0, float v1) { const int i = m0 + r; if (i < me) { const int j = j0 + (c >> 6) * 32 + (c & 31);
            act[(long)(ro + i) * 256 + j] = f2bf(siluf_(v0) * v1); } });
    }
}
__device__ __forceinline__ void p13_exp_down(const Ctx& F) {
    const int total = build_expert_tables(F, 4);
    volatile LAS int* offs = (volatile LAS int*)(F.lds + LDS_MISC);
    volatile LAS int* istart = offs + 264;
    const int* ltok = (const int*)(F.ws + WS_LTOK); const float* lw = (const float*)(F.ws + WS_LW); const bf16_t* act = (const bf16_t*)(F.ws + WS_ACT);
    bf16_t* ybuf = (bf16_t*)(F.ws + WS_YBUF); unsigned* cnt = F.ctl + CW_CNT;
    for (int it = F.vcu; it < total; it += F.G) {
        const int e = find_expert(F, it); const int li = it - istart[e]; const int rt = li >> 2, ct = li & 3;
        const int me = (int)cnt[e], m0 = rt * 256, n0 = ct * 256; const int ro = offs[e];
        f32x16 acc[4][2]; zero_acc<4>(acc);
        ARowsV af{act + (long)ro * 256, 256u, m0, me};
        BKN bf{F.a.in[20] + (long)e * 262144, 1024, n0, 1024};
        gemm_core<4>(acc, af, bf, 4, F.lds);
        const int* lt = ltok + (long)e * LCAP; const float* lwe = lw + (long)e * LCAP;
        run_epilogue<4>(acc, [&](int r, int c, float v0, float v1) { const int i = m0 + r; if (i < me) { const long ent = lt[i]; const float wg = lwe[i];
            ybuf[ent * 1024 + n0 + c] = f2bf(v0 * wg); ybuf[ent * 1024 + n0 + c + 32] = f2bf(v1 * wg); } });
    }
}
__device__ __forceinline__ void p14_final(const Ctx& F) {
    const bf16_t* acts = (const bf16_t*)(F.ws + WS_ACTS); const bf16_t* ybuf = (const bf16_t*)(F.ws + WS_YBUF);
    const float* x1 = (const float*)(F.ws + WS_X1); const float* adaf = (const float*)(F.ws + WS_ADAF);
    for (int it = F.vcu; it < 64 * 4; it += F.G) {
        const int ct = it & 3, rt = it >> 2; const int m0 = rt * 256, n0 = ct * 256; const int b = m0 >> 11;
        f32x16 acc[4][2]; zero_acc<4>(acc);
        ARows af{acts, 256, m0}; BKN bf{F.a.in[23], 1024, n0, 1024};
        gemm_core<4>(acc, af, bf, 4, F.lds);
        const float* g2 = adaf + b * 6144 + 5 * 1024;
        run_epilogue<4>(acc, [&](int r, int c, float v0, float v1) {
            const long row = m0 + r;
#pragma unroll
            for (int q = 0; q < 2; ++q) { const int col = n0 + c + 32 * q; float s = q ? v1 : v0;
#pragma unroll
                for (int k = 0; k < 8; ++k) s += bf2f(ybuf[(row * 8 + k) * 1024 + col]);
                F.out[row * 1024 + col] = x1[row * 1024 + col] + g2[col] * s; }
        });
    }
}

constexpr int NPHASE = 15;
__global__ void __launch_bounds__(NTHREADS, 2) mk_fwd(Args args) {
    extern __shared__ __attribute__((aligned(16))) unsigned char lds[];
    const int tid_ = threadIdx.x, G_ = gridDim.x, bx_ = blockIdx.x;
    Ctx F{args, args.out, args.ws, lds, (unsigned*)(args.ws + WS_CTL), tid_, tid_ & 63, __builtin_amdgcn_readfirstlane(tid_ >> 6), G_, (G_ % 8 == 0) ? (bx_ % 8) * (G_ / 8) + bx_ / 8 : bx_};
    const int lo = args.ph_lo, hi = args.ph_hi;
    volatile LAS unsigned* bst = (volatile LAS unsigned*)(lds + LDS_MISC + 4096);
    XcdBarrier bar; bar.bar = F.ctl + CW_BAR; bar.x = 0; bar.st = bst;
    if (hi - lo > 1) {
        if (F.tid == 0) { bst[0] = 0u; bst[1] = 0u; bst[2] = 0u; bst[3] = 0u; }
        __syncthreads();
        bar = xcd_barrier_post(F.ctl + CW_BAR, bst);
    }
#define PHASE(k, call) if (lo <= (k) && (k) < hi) { call; if ((k) + 1 < hi) xcd_barrier(bar); }
    PHASE(0, p0_prep(F))
    PHASE(1, p_norm_rows(F, 0))
    PHASE(2, p2_win(F))
    PHASE(3, p3_stats_chdft(F))
    PHASE(4, p4_qkv_up(F))
    PHASE(5, p5_qk_final(F))
    PHASE(6, p6_attn_dft(F))
    PHASE(7, p7_merge(F))
    PHASE(8, p8_out(F))
    PHASE(9, p_norm_rows(F, 1))
    PHASE(10, p10_router_shared(F))
    PHASE(11, p11_topk(F))
    PHASE(12, p12_exp_up(F))
    PHASE(13, p13_exp_down(F))
    PHASE(14, p14_final(F))
#undef PHASE
}

extern "C" void kernel_launch(void* const* d_in, const int* in_sizes, int n_in, void* d_out, int out_size, void* d_ws, size_t ws_size, hipStream_t stream) {
    static int grid = 0;
    if (grid == 0) {
        if (n_in != 24 || out_size != T * DM || ws_size < WS_END) {
            fprintf(stderr, "kernel_launch: unexpected shapes (n_in %d, out %d, ws %zu < %zu); nothing launched\n", n_in, out_size, ws_size, (size_t)WS_END); grid = -1; return; }
        int dev = 0, cus = 0, per_cu = 0;
        if (hipGetDevice(&dev) != hipSuccess || hipDeviceGetAttribute(&cus, hipDeviceAttributeMultiprocessorCount, dev) != hipSuccess) { grid = -1; return; }
        if (hipFuncSetAttribute((const void*)mk_fwd, hipFuncAttributeMaxDynamicSharedMemorySize, LDS_BYTES) != hipSuccess) { fprintf(stderr, "kernel_launch: hipFuncSetAttribute failed\n"); grid = -1; return; }
        if (hipOccupancyMaxActiveBlocksPerMultiprocessor(&per_cu, (const void*)mk_fwd, NTHREADS, LDS_BYTES) != hipSuccess || per_cu < 1)
            fprintf(stderr, "kernel_launch: occupancy query reports %d blocks per CU\n", per_cu);
        (void)hipGetLastError();
        grid = cus;
    }
    if (grid < 0) return;
    (void)hipMemsetAsync((char*)d_ws + WS_CTL, 0, CTL_BYTES, stream);
    Args a{};
    for (int i = 0; i < 24; ++i) a.in[i] = (const float*)d_in[i];
    a.out = (float*)d_out; a.ws = (unsigned char*)d_ws;
#if N_LAUNCH_MODE == 1
    a.ph_lo = 0; a.ph_hi = NPHASE;
    hipLaunchKernelGGL(mk_fwd, dim3(grid), dim3(NTHREADS), LDS_BYTES, stream, a);
#else
    for (int ph = 0; ph < NPHASE; ++ph) { a.ph_lo = ph; a.ph_hi = ph + 1; hipLaunchKernelGGL(mk_fwd, dim3(grid), dim3(NTHREADS), LDS_BYTES, stream, a); }
#endif
    const hipError_t le = hipPeekAtLastError();
    if (le != hipSuccess) fprintf(stderr, "kernel_launch: launch failed: %s\n", hipGetErrorName(le));
}
```

```cpp
#include <hip/hip_runtime.h>
#include <cstdio>
#include <cstdint>

typedef unsigned short bf16_t;
typedef short bf16x8 __attribute__((ext_vector_type(8)));
typedef float f32x16 __attribute__((ext_vector_type(16)));
typedef float f32x4 __attribute__((ext_vector_type(4)));
typedef unsigned u32x4 __attribute__((ext_vector_type(4)));
typedef unsigned u32x2 __attribute__((ext_vector_type(2)));

#define REPEAT_MASK 16384
#ifndef N_LAUNCH_MODE
#define N_LAUNCH_MODE 1
#endif
#ifndef NAIVE_MMA
#define NAIVE_MMA 0
#endif

constexpr int T = 16384, DM = 1024, NB = 8, SEQ = 2048;
constexpr int INW = 2976, NH = 8, DQK = 96, DV = 64;
constexpr int NE = 256, TOPK = 8, EH = 256;
constexpr float EPS = 1e-6f;
constexpr int NTHREADS = 512;
constexpr int LCAP = 16384;

constexpr size_t al256(size_t x) { return (x + 255) & ~(size_t)255; }
constexpr size_t WS_CTL   = 0;
constexpr size_t CTL_BYTES = 196608;
constexpr size_t WS_ADAP  = WS_CTL + CTL_BYTES;
constexpr size_t WS_ADAF  = WS_ADAP + al256((size_t)16 * 8 * 6144 * 4);
constexpr size_t WS_ROPE  = WS_ADAF + al256((size_t)8 * 6144 * 4);
constexpr size_t WS_WDFT  = WS_ROPE + al256((size_t)2 * 2048 * 16 * 4);
constexpr size_t WS_D64T  = WS_WDFT + al256((size_t)2048 * 4096 * 2);
constexpr size_t WS_WR3   = WS_D64T + al256((size_t)128 * 64 * 2);
constexpr size_t WS_WUQ   = WS_WR3 + al256((size_t)3072 * 256 * 4);
constexpr size_t WS_WUKV  = WS_WUQ + al256((size_t)256 * 768 * 4);
constexpr size_t WS_H     = WS_WUKV + al256((size_t)128 * 1024 * 4);
constexpr size_t WS_H2LO  = WS_H + al256((size_t)T * 1024 * 2);
constexpr size_t WS_ZQKV  = WS_H2LO + al256((size_t)T * 1024 * 2);
constexpr size_t WS_ZF    = WS_ZQKV + al256((size_t)T * 416 * 2);
constexpr size_t WS_SIG   = WS_ZF + al256((size_t)T * 512 * 2);
constexpr size_t WS_RSTD  = WS_SIG + al256((size_t)T * 2048 * 2);
constexpr size_t WS_XT    = WS_RSTD + al256((size_t)2 * T * 4);
constexpr size_t WS_QRAW  = WS_XT + al256((size_t)4096 * 4096 * 2);
constexpr size_t WS_KNRAW = WS_QRAW + al256((size_t)T * 768 * 4);
constexpr size_t WS_Q     = WS_KNRAW + al256((size_t)T * 512 * 4);
constexpr size_t WS_K     = WS_Q + al256((size_t)T * 768 * 2);
constexpr size_t WS_VT    = WS_K + al256((size_t)T * 768 * 2);
constexpr size_t WS_O     = WS_VT + al256((size_t)T * 512 * 2);
constexpr size_t WS_F     = WS_O + al256((size_t)T * 512 * 2);
constexpr size_t WS_MERGED= WS_F + al256((size_t)T * 512 * 2);
constexpr size_t WS_X1    = WS_MERGED + al256((size_t)T * 1024 * 2);
constexpr size_t WS_LOGIT = WS_X1 + al256((size_t)T * 1024 * 4);
constexpr size_t WS_ACTS  = WS_LOGIT + al256((size_t)T * 256 * 4);
constexpr size_t WS_LTOK  = WS_ACTS + al256((size_t)T * 256 * 2);
constexpr size_t WS_LW    = WS_LTOK + al256((size_t)NE * LCAP * 4);
constexpr size_t WS_ACT   = WS_LW + al256((size_t)NE * LCAP * 4);
constexpr size_t WS_YBUF  = WS_ACT + al256((size_t)T * 8 * 256 * 2);
constexpr size_t WS_WB_IN = WS_YBUF + al256((size_t)T * 8 * 1024 * 2);
constexpr size_t WS_WB_PA = WS_WB_IN + al256((size_t)3072 * 1024 * 2);
constexpr size_t WS_WB_PF = WS_WB_PA + al256((size_t)1024 * 512 * 2);
constexpr size_t WS_WB_OUT= WS_WB_PF + al256((size_t)1024 * 512 * 2);
constexpr size_t WS_WB_SH = WS_WB_OUT + al256((size_t)1024 * 1024 * 2);
constexpr size_t WS_WB_SD = WS_WB_SH + al256((size_t)512 * 1024 * 2);
constexpr size_t WS_WB_R  = WS_WB_SD + al256((size_t)1024 * 256 * 2);
constexpr size_t WS_A3    = WS_WB_R + al256((size_t)256 * 3072 * 2);
constexpr size_t WS_END   = WS_A3 + al256((size_t)T * 3072 * 2);

constexpr int CW_CNT = 16384;
constexpr int CW_QUEUE = 4400;
constexpr int CW_BAR = 0;

constexpr int LDS_GEMM = 2 * 65536;
constexpr int ST16 = 520, ST32 = 1040;
constexpr int LDS_STAGE = 256 * ST16;
constexpr int LDS_MISC = 140288;
constexpr int LDS_BYTES = LDS_MISC + 8192;

typedef __bf16 bf16x2_t __attribute__((ext_vector_type(2)));
typedef float f32x2_t __attribute__((ext_vector_type(2)));
__device__ __forceinline__ unsigned cvt_pk_bf16(float lo, float hi) { f32x2_t f = {lo, hi}; bf16x2_t h = __builtin_convertvector(f, bf16x2_t); return __builtin_bit_cast(unsigned, h); }
__device__ __forceinline__ bf16_t f2bf(float v) { __bf16 h = (__bf16)v; return __builtin_bit_cast(unsigned short, h); }
__device__ __forceinline__ float bf2f(bf16_t b) { return __uint_as_float(((unsigned)b) << 16); }
__device__ __forceinline__ float sigmoidf_(float v) { return 1.f / (1.f + __expf(-v)); }
__device__ __forceinline__ float siluf_(float v) { return v / (1.f + __expf(-v)); }
__device__ __forceinline__ float wave_sum(float v) {
#pragma unroll
    for (int o = 32; o > 0; o >>= 1) v += __shfl_xor(v, o);
    return v;
}
__device__ __forceinline__ int swz(int row) { return ((row >> 1) & 7) ^ ((row >> 4) & 1); }

#define XB_TMO      128
#define XB_XCNT(j)  (256  + 64 * (j))
#define XB_XSUB(j)  (1280 + 64 * (j))
#define XB_XGEN(j)  (2304 + 64 * (j))
#define XB_TOP      3328
#define XB_TOPGEN   3392
#define XCD_BAR_WORDS 3456
#define XB_SPIN_CAP (1u << 22)
#define LAS __attribute__((address_space(3)))
__device__ __forceinline__ unsigned xb_ld(unsigned* p)              { return __hip_atomic_load(p, __ATOMIC_RELAXED, __HIP_MEMORY_SCOPE_AGENT); }
__device__ __forceinline__ unsigned xb_add(unsigned* p, unsigned v) { return __hip_atomic_fetch_add(p, v, __ATOMIC_RELAXED, __HIP_MEMORY_SCOPE_AGENT); }
__device__ __forceinline__ unsigned xb_xcc_id() { return (unsigned)__builtin_amdgcn_s_getreg((3 << 11) | 20) & 0xFu; }
#define XB_SPIN(cond, bar) do { unsigned _sp = 0; while (cond) { __builtin_amdgcn_s_sleep(1); \
    if ((++_sp & 255u) == 0u) { if (xb_ld(&(bar)[XB_TMO])) break; if (_sp > XB_SPIN_CAP) { atomicAdd(&(bar)[XB_TMO], 1u); break; } } } } while (0)
struct XcdBarrier { unsigned* bar; unsigned x; volatile LAS unsigned* st; };
__device__ __forceinline__ XcdBarrier xcd_barrier_post(unsigned* bar, volatile LAS unsigned* st) {
    XcdBarrier b; b.bar = bar; b.x = xb_xcc_id(); b.st = st;
    if (threadIdx.x == 0) (void)xb_add(&bar[XB_XCNT(b.x)], 1u);
    return b;
}
__device__ __forceinline__ void xcd_barrier_complete(unsigned* bar, unsigned x, unsigned& nloc, unsigned& nx) {
    const unsigned G = gridDim.x * gridDim.y * gridDim.z;
    unsigned sum, cnt, mine, sp = 0u;
    for (;;) {
        sum = 0u; cnt = 0u; mine = 0u;
#pragma unroll
        for (unsigned j = 0; j < 16; ++j) { const unsigned c = xb_ld(&bar[XB_XCNT(j)]); sum += c; cnt += (c > 0u) ? 1u : 0u; mine = (j == x) ? c : mine; }
        if (sum == G) break;
        __builtin_amdgcn_s_sleep(1);
        if ((++sp & 255u) == 0u) { if (xb_ld(&bar[XB_TMO])) break; if (sp > XB_SPIN_CAP) { atomicAdd(&bar[XB_TMO], 1u); break; } }
    }
    nloc = mine > 0u ? mine : 1u; nx = cnt > 0u ? cnt : 1u;
}
__device__ __forceinline__ void xcd_barrier(const XcdBarrier& b) {
    asm volatile("s_waitcnt vmcnt(0)" ::: "memory");
    __syncthreads();
    if (threadIdx.x == 0) {
        unsigned* bar = b.bar;
        __builtin_amdgcn_s_waitcnt(0);
        unsigned nloc = b.st[0], nx = b.st[1];
        if (nloc == 0u) { xcd_barrier_complete(bar, b.x, nloc, nx); b.st[0] = nloc; b.st[1] = nx; }
        const unsigned old = xb_add(&bar[XB_XSUB(b.x)], 1u);
        const unsigned gen = old / nloc;
        if (old + 1u == (gen + 1u) * nloc) {
            __builtin_amdgcn_fence(__ATOMIC_RELEASE, "agent");
            asm volatile("s_waitcnt vmcnt(0)" ::: "memory");
            const unsigned og = xb_add(&bar[XB_TOP], 1u);
            const unsigned tg = og / nx;
            if (og + 1u == (tg + 1u) * nx) xb_add(&bar[XB_TOPGEN], 1u);
            else XB_SPIN(xb_ld(&bar[XB_TOPGEN]) == tg, bar);
            __builtin_amdgcn_fence(__ATOMIC_ACQUIRE, "agent");
            xb_add(&bar[XB_XGEN(b.x)], 1u);
            asm volatile("s_waitcnt vmcnt(0)" ::: "memory");
        } else {
            XB_SPIN(xb_ld(&bar[XB_XGEN(b.x)]) == gen, bar);
            __builtin_amdgcn_fence(__ATOMIC_ACQUIRE, "agent");
            asm volatile("s_waitcnt vmcnt(0)" ::: "memory");
        }
    }
    __syncthreads();
}

template <int MI, bool TR, class AF, class BF>
__device__ __forceinline__ void gemm_core(f32x16 (&acc)[MI][2], const AF& af, const BF& bf, const int nk, unsigned char* lds) {
    constexpr int BM = 64 * MI;
    constexpr int A_BYTES = BM * 128, STAGE = A_BYTES + 256 * 128;
    const int t = threadIdx.x, lane = t & 63, w = t >> 6, wm = w >> 2, wn = w & 3;
    const int l31 = lane & 31, hh = lane >> 5;
    const int ch = t & 7, r0 = t >> 3;
    const bf16_t* abase = af.base();
    unsigned aoff[MI];
#pragma unroll
    for (int i = 0; i < MI; ++i) aoff[i] = af.off(r0 + 64 * i);
    const int a_lds = r0 * 128 + ((ch ^ swz(r0)) << 4);
    u32x4 areg[MI];
    f32x4 bregf[8]; u32x4 bregh[4];
    unsigned boff[4];
    const float* bcolf = nullptr;
    if constexpr (BF::KN) { bcolf = bf.col(4 * lane); }
    else {
#pragma unroll
        for (int i = 0; i < 4; ++i) boff[i] = bf.off(r0 + 64 * i);
    }
    auto gload = [&](int kt) {
        const long ko = af.koff(kt) + ch * 8;
#pragma unroll
        for (int i = 0; i < MI; ++i) areg[i] = *(const u32x4*)(abase + aoff[i] + ko);
        if constexpr (BF::KN) {
            const float* bp = bcolf + (long)(kt * 64 + w * 8) * bf.ldb;
#pragma unroll
            for (int i = 0; i < 8; ++i) bregf[i] = *(const f32x4*)(bp + (long)i * bf.ldb);
        } else {
            const bf16_t* bp = bf.base() + bf.koff(kt) + ch * 8;
#pragma unroll
            for (int i = 0; i < 4; ++i) bregh[i] = *(const u32x4*)(bp + boff[i]);
        }
    };
    auto lstore = [&](int st) {
        unsigned char* base = lds + st * STAGE;
#pragma unroll
        for (int i = 0; i < MI; ++i) *(u32x4*)(base + a_lds + i * 64 * 128) = areg[i];
        unsigned char* bb = base + A_BYTES;
        if constexpr (BF::KN) {
#pragma unroll
            for (int cc = 0; cc < 4; ++cc) {
                const int col = 4 * lane + cc;
                u32x4 v; v.x = cvt_pk_bf16(bregf[0][cc], bregf[1][cc]); v.y = cvt_pk_bf16(bregf[2][cc], bregf[3][cc]);
                v.z = cvt_pk_bf16(bregf[4][cc], bregf[5][cc]); v.w = cvt_pk_bf16(bregf[6][cc], bregf[7][cc]);
                *(u32x4*)(bb + col * 128 + ((w ^ swz(col)) << 4)) = v;
            }
        } else {
#pragma unroll
            for (int i = 0; i < 4; ++i) *(u32x4*)(bb + a_lds + i * 64 * 128) = bregh[i];
        }
    };
    const int fsw = swz(l31);
    const int a_frag = (wm * 32 * MI + l31) * 128, b_frag = (wn * 64 + l31) * 128;
    auto compute = [&](int st) {
        const unsigned char* base = lds + st * STAGE;
        const unsigned char* bb = base + A_BYTES;
#if NAIVE_MMA
#pragma unroll
        for (int mi = 0; mi < MI; ++mi)
#pragma unroll
            for (int ni = 0; ni < 2; ++ni)
#pragma unroll
                for (int rg = 0; rg < 16; ++rg) {
                    const int row = TR ? (wm * 32 * MI + mi * 32 + l31) : (wm * 32 * MI + mi * 32 + (rg & 3) + 8 * (rg >> 2) + 4 * hh);
                    const int col = TR ? (wn * 64 + ni * 32 + (rg & 3) + 8 * (rg >> 2) + 4 * hh) : (wn * 64 + ni * 32 + l31);
                    float s = 0.f;
                    for (int k = 0; k < 64; ++k) {
                        const bf16_t av = *(const bf16_t*)(base + row * 128 + (((k >> 3) ^ swz(row)) << 4) + (k & 7) * 2);
                        const bf16_t bv = *(const bf16_t*)(bb + col * 128 + (((k >> 3) ^ swz(col)) << 4) + (k & 7) * 2);
                        s += bf2f(av) * bf2f(bv);
                    }
                    acc[mi][ni][rg] += s;
                }
#else
#pragma unroll 2
        for (int s = 0; s < 4; ++s) {
            const int pos = ((2 * s + hh) ^ fsw) << 4;
            bf16x8 bfr[2];
#pragma unroll
            for (int ni = 0; ni < 2; ++ni) bfr[ni] = *(const bf16x8*)(bb + b_frag + ni * 32 * 128 + pos);
#pragma unroll
            for (int mi = 0; mi < MI; ++mi) {
                const bf16x8 afr = *(const bf16x8*)(base + a_frag + mi * 32 * 128 + pos);
#pragma unroll
                for (int ni = 0; ni < 2; ++ni) acc[mi][ni] = TR ? __builtin_amdgcn_mfma_f32_32x32x16_bf16(bfr[ni], afr, acc[mi][ni], 0, 0, 0)
                                                               : __builtin_amdgcn_mfma_f32_32x32x16_bf16(afr, bfr[ni], acc[mi][ni], 0, 0, 0);
            }
        }
#endif
    };
    int nk_ = nk; asm volatile("" : "+s"(nk_));
    __syncthreads();
    gload(0);
    lstore(0);
    __syncthreads();
#pragma unroll 1
    for (int kt = 0; kt < nk_; ++kt) {
        const bool more = (kt + 1 < nk_);
        if (more) gload(kt + 1);
        compute(kt & 1);
        if (more) lstore((kt + 1) & 1);
        __syncthreads();
    }
}

template <int MI> __device__ __forceinline__ void zero_acc(f32x16 (&acc)[MI][2]) {
#pragma unroll
    for (int mi = 0; mi < MI; ++mi)
#pragma unroll
        for (int ni = 0; ni < 2; ++ni)
#pragma unroll
            for (int r = 0; r < 16; ++r) acc[mi][ni][r] = 0.f;
}
template <int MI, class EPI>
__device__ __forceinline__ void run_epilogue(const f32x16 (&acc)[MI][2], const EPI& epi) {
    const int t = threadIdx.x, lane = t & 63, w = t >> 6, wm = w >> 2, wn = w & 3, l31 = lane & 31, hh = lane >> 5;
#pragma unroll
    for (int mi = 0; mi < MI; ++mi)
#pragma unroll
        for (int rg = 0; rg < 16; ++rg) {
            const int r = wm * 32 * MI + mi * 32 + (rg & 3) + 8 * (rg >> 2) + 4 * hh;
            epi(r, wn * 64 + l31, acc[mi][0][rg], acc[mi][1][rg]);
            if ((rg & 7) == 7) __builtin_amdgcn_sched_barrier(0);
        }
}

template <int MI, class EPI>
__device__ __forceinline__ void run_epilogue_tr(const f32x16 (&acc)[MI][2], const EPI& epi) {
    const int t = threadIdx.x, lane = t & 63, w = t >> 6, wm = w >> 2, wn = w & 3, l31 = lane & 31, hh = lane >> 5;
#pragma unroll
    for (int mi = 0; mi < MI; ++mi) {
        const int r = wm * 32 * MI + mi * 32 + l31;
#pragma unroll
        for (int q4 = 0; q4 < 4; ++q4) {
            const f32x4 v0 = {acc[mi][0][4 * q4], acc[mi][0][4 * q4 + 1], acc[mi][0][4 * q4 + 2], acc[mi][0][4 * q4 + 3]};
            const f32x4 v1 = {acc[mi][1][4 * q4], acc[mi][1][4 * q4 + 1], acc[mi][1][4 * q4 + 2], acc[mi][1][4 * q4 + 3]};
            epi(r, wn * 64 + 8 * q4 + 4 * hh, v0, v1);
        }
        __builtin_amdgcn_sched_barrier(0);
    }
}
__device__ __forceinline__ u32x2 pack4(const f32x4 v) { u32x2 p; p.x = cvt_pk_bf16(v[0], v[1]); p.y = cvt_pk_bf16(v[2], v[3]); return p; }
__device__ __forceinline__ f32x4 unpack4(const u32x2 p) { f32x4 v = {__uint_as_float(p.x << 16), __uint_as_float(p.x & 0xffff0000u), __uint_as_float(p.y << 16), __uint_as_float(p.y & 0xffff0000u)}; return v; }

__device__ __forceinline__ unsigned pack_fp8x4(const f32x4 v) { int p = __builtin_amdgcn_cvt_pk_fp8_f32(v[0], v[1], 0, false); p = __builtin_amdgcn_cvt_pk_fp8_f32(v[2], v[3], p, true); return (unsigned)p; }
__device__ __forceinline__ f32x4 unpack_fp8x4(const unsigned p) { f32x4 v = {__builtin_amdgcn_cvt_f32_fp8((int)p, 0), __builtin_amdgcn_cvt_f32_fp8((int)p, 1), __builtin_amdgcn_cvt_f32_fp8((int)p, 2), __builtin_amdgcn_cvt_f32_fp8((int)p, 3)}; return v; }
template <int MI> __device__ __forceinline__ void stage_bf16(const f32x16 (&acc)[MI][2], unsigned char* lds) {
    const int t = threadIdx.x, lane = t & 63, w = t >> 6, wm = w >> 2, wn = w & 3, l31 = lane & 31, hh = lane >> 5;
#pragma unroll
    for (int mi = 0; mi < MI; ++mi) {
        unsigned char* rp = lds + (wm * 32 * MI + mi * 32 + l31) * ST16 + (wn * 64 + 4 * hh) * 2;
#pragma unroll
        for (int ni = 0; ni < 2; ++ni)
#pragma unroll
            for (int q4 = 0; q4 < 4; ++q4) {
                const f32x4 v = {acc[mi][ni][4 * q4], acc[mi][ni][4 * q4 + 1], acc[mi][ni][4 * q4 + 2], acc[mi][ni][4 * q4 + 3]};
                *(u32x2*)(rp + (ni * 32 + 8 * q4) * 2) = pack4(v);
            }
    }
}
__device__ __forceinline__ void stage_f32(const f32x16 (&acc)[2][2], unsigned char* lds) {
    const int t = threadIdx.x, lane = t & 63, w = t >> 6, wm = w >> 2, wn = w & 3, l31 = lane & 31, hh = lane >> 5;
#pragma unroll
    for (int mi = 0; mi < 2; ++mi) {
        unsigned char* rp = lds + (wm * 64 + mi * 32 + l31) * ST32 + (wn * 64 + 4 * hh) * 4;
#pragma unroll
        for (int ni = 0; ni < 2; ++ni)
#pragma unroll
            for (int q4 = 0; q4 < 4; ++q4) {
                const f32x4 v = {acc[mi][ni][4 * q4], acc[mi][ni][4 * q4 + 1], acc[mi][ni][4 * q4 + 2], acc[mi][ni][4 * q4 + 3]};
                *(f32x4*)(rp + (ni * 32 + 8 * q4) * 4) = v;
            }
    }
}

struct ARows { const bf16_t* b; unsigned lda; int m0;
    __device__ __forceinline__ const bf16_t* base() const { return b; }
    __device__ __forceinline__ unsigned off(int r) const { return (unsigned)(m0 + r) * lda; }
    __device__ __forceinline__ long koff(int kt) const { return (long)kt * 64; } };
struct BKN { const float* b; int ldb; int n0; int nvalid; static constexpr bool KN = true;
    __device__ __forceinline__ const float* col(int c) const { int cc = n0 + c; cc = (cc < nvalid) ? cc : (nvalid - 4); return b + cc; } };
struct BKNPair { const float* g; long u_minus_g; int ldb; static constexpr bool KN = true;
    __device__ __forceinline__ const float* col(int c) const { return g + (long)((c >> 5) & 1) * u_minus_g + (c >> 6) * 32 + (c & 31); } };
struct BNK { const bf16_t* b; unsigned ldb; int n0; static constexpr bool KN = false;
    __device__ __forceinline__ const bf16_t* base() const { return b; }
    __device__ __forceinline__ unsigned off(int c) const { return (unsigned)(n0 + c) * ldb; }
    __device__ __forceinline__ long koff(int kt) const { return (long)kt * 64; } };

namespace pg8 {
#define PG8_LAS __attribute__((address_space(3)))
typedef unsigned short bf16_t;
typedef short bf16x8 __attribute__((ext_vector_type(8)));
typedef float f32x4 __attribute__((ext_vector_type(4)));
typedef unsigned u32x4 __attribute__((ext_vector_type(4)));
constexpr int BM = 256, BK = 64, HALF = 128, HTB = HALF * BK * 2  , STAGE_BYTES = 8 * HTB, NXCD = 8, WGM = 8;

__host__ __device__ __forceinline__ int lds_byte(int r, int c) { const int st = (r >> 4) * 2 + (c >> 5), rr = r & 15, cc = c & 31, ob = rr * 64 + cc * 2; return st * 1024 + (ob ^ (((ob >> 9) & 1) << 5)); }
__host__ __device__ __forceinline__ void stage_rc(int b, int& R, int& C) { const int st = b / 1024, sb = b % 1024, swz = sb ^ (((sb >> 9) & 1) << 5); R = (st >> 1) * 16 + swz / 64; C = (st & 1) * 32 + (swz % 64) / 2; }
__host__ __device__ __forceinline__ int perm32(int rho) { const int n = rho >> 4, i = rho & 15; return 8 * (i >> 2) + 4 * n + (i & 3); }

struct Unit { int pm, pn; };
struct Gemm { const bf16_t* A; const bf16_t* Bt; int M, N, K; int lda; int ldb; };

struct StaticOrder {
    int nM, nN, nwg, G, c;
    __host__ __device__ void init(int M, int N, int G_, int c_) { nM = M / BM; nN = N / BM; nwg = nM * nN; G = G_; c = c_; }
    __host__ __device__ bool next(int i, Unit& u) const {
        const long L = (long)i * G + c; if (L >= nwg) return false;
        int wgid = (int)L; { const int q = nwg / NXCD, r = nwg % NXCD, xcd = wgid % NXCD, off = wgid / NXCD; wgid = (xcd < r ? xcd * (q + 1) : r * (q + 1) + (xcd - r) * q) + off; }
        const int nig = WGM * nN, gid = wgid / nig, fm = gid * WGM, gsz = (nM - fm) < WGM ? (nM - fm) : WGM;
        u.pm = fm + ((wgid % nig) % gsz); u.pn = (wgid % nig) / gsz; return true;
    }
    __device__ __forceinline__ void a_ready(const Unit&) const {}
    __device__ __forceinline__ void done(const Unit&) const {}
};
template <class Epi, class Sched, bool ALIGN_EPI = false, bool SP2 = false>
__device__ __forceinline__ void gemm_phase(PG8_LAS unsigned char* lds, const Gemm g, const Sched& S, const Epi& E) {
    const int tid = threadIdx.x, wid = __builtin_amdgcn_readfirstlane(tid >> 6), lane = tid & 63, wr = wid >> 2, wc = wid & 3, fr = lane & 15, fq = lane >> 4;
    const int K = g.K, nt = K / BK, LDA = g.lda ? g.lda : g.K, LDB = g.ldb ? g.ldb : g.K;
    unsigned voffA[2], voffB[2];
#pragma unroll
    for (int i = 0; i < 2; ++i) { int R, C; stage_rc(tid * 16 + i * 8192, R, C); const int Rb = Epi::PERM ? ((R & ~31) + perm32(R & 31)) : R;
        voffA[i] = (unsigned)(R * LDA + C) * 2u; voffB[i] = (unsigned)(Rb * LDB + C) * 2u; }
    const size_t kstep = (size_t)(BK * 2);
    const size_t hstep = (size_t)HALF * LDB * 2;
    const size_t tstep = 2 * hstep;
    const size_t hstepA = (size_t)HALF * LDA * 2, tstepA = 2 * hstepA;
    const unsigned ldsw = (unsigned)wid * 1024u;
    const int aoff = lds_byte(wr * 64 + fr, fq * 8), boff = lds_byte(wc * 32 + fr, fq * 8);
#define PG8_SA(b, h) (((b) * 2 + (h)) * HTB)
#define PG8_SB(b, h) ((4 + (b) * 2 + (h)) * HTB)
#define PG8_STAGE(bufoff, gbase, voff) do { _Pragma("unroll") for (int _i = 0; _i < 2; ++_i) \
        __builtin_amdgcn_global_load_lds((const unsigned*)((const char*)(gbase) + (voff)[_i]), (PG8_LAS unsigned*)(lds + (bufoff) + ldsw + _i * 8192), 16, 0, 0); } while (0)
#define PG8_LDA(dst, b, h) do { _Pragma("unroll") for (int m = 0; m < 4; ++m) _Pragma("unroll") for (int k = 0; k < 2; ++k) dst[m][k] = *(const PG8_LAS bf16x8*)(lds + PG8_SA(b, h) + aoff + m * 2048 + k * 1024); } while (0)
#define PG8_LDB(dst, b, h) do { _Pragma("unroll") for (int n = 0; n < 2; ++n) _Pragma("unroll") for (int k = 0; k < 2; ++k) dst[n][k] = *(const PG8_LAS bf16x8*)(lds + PG8_SB(b, h) + boff + n * 2048 + k * 1024); } while (0)
#define PG8_MMA(ai, bj, At, Bt) do { __builtin_amdgcn_s_setprio(1); _Pragma("unroll") for (int m = 0; m < 4; ++m) _Pragma("unroll") for (int n = 0; n < 2; ++n) _Pragma("unroll") for (int k = 0; k < 2; ++k) \
        acc[ai][bj][m][n] = __builtin_amdgcn_mfma_f32_16x16x32_bf16(Bt[n][k], At[m][k], acc[ai][bj][m][n], 0, 0, 0); __builtin_amdgcn_s_setprio(0); } while (0)
#define PG8_WAIT_V(n) asm volatile("s_waitcnt vmcnt(" #n ")" ::: "memory")
#define PG8_WAIT_L(n) asm volatile("s_waitcnt lgkmcnt(" #n ")" ::: "memory")
#define PG8_BAR __builtin_amdgcn_s_barrier()
#define PG8_SCHED __builtin_amdgcn_sched_barrier(0)
    Unit cur, nxt; int ui = 0;
    if (!S.next(0, cur)) return;
    f32x4 acc[2][2][4][2];
#pragma unroll
    for (int a = 0; a < 2; ++a)
#pragma unroll
        for (int b = 0; b < 2; ++b)
#pragma unroll
            for (int m = 0; m < 4; ++m)
#pragma unroll
                for (int n = 0; n < 2; ++n) acc[a][b][m][n] = (f32x4){0.f, 0.f, 0.f, 0.f};
    bf16x8 At[4][2], B0[2][2], B1[2][2];
    const char* cA = (const char*)g.A + (size_t)cur.pm * tstepA; const char* cB = (const char*)g.Bt + (size_t)cur.pn * tstep;
    S.a_ready(cur);
    if constexpr (SP2) {
        PG8_STAGE(PG8_SB(0, 0), cB, voffB); PG8_STAGE(PG8_SB(0, 1), cB + hstep, voffB); PG8_STAGE(PG8_SA(0, 0), cA, voffA); PG8_STAGE(PG8_SA(0, 1), cA + hstepA, voffA);
        if (wr == 1) PG8_BAR;
        PG8_WAIT_V(2); PG8_BAR;
        PG8_STAGE(PG8_SB(1, 0), cB + kstep, voffB); PG8_STAGE(PG8_SA(1, 0), cA + kstep, voffA); PG8_STAGE(PG8_SB(1, 1), cB + hstep + kstep, voffB);
        PG8_WAIT_V(6); PG8_BAR;
    } else {
        PG8_STAGE(PG8_SB(0, 0), cB, voffB); PG8_STAGE(PG8_SA(0, 0), cA, voffA); PG8_STAGE(PG8_SB(0, 1), cB + hstep, voffB); PG8_STAGE(PG8_SA(0, 1), cA + hstepA, voffA);
        if (wr == 1) PG8_BAR;
        PG8_WAIT_V(4); PG8_BAR;
        PG8_STAGE(PG8_SB(1, 0), cB + kstep, voffB); PG8_STAGE(PG8_SA(1, 0), cA + kstep, voffA); PG8_STAGE(PG8_SB(1, 1), cB + hstep + kstep, voffB);
        PG8_WAIT_V(6); PG8_BAR;
    }
    for (;;) {
        const bool has_next = S.next(ui + 1, nxt);
        const char* nA = has_next ? (const char*)g.A + (size_t)nxt.pm * tstepA : cA; const char* nB = has_next ? (const char*)g.Bt + (size_t)nxt.pn * tstep : cB;
        for (int t = 0; t < nt; t += 2) {
            const bool last = (t == nt - 2);
            const char* a1 = cA + (size_t)(t + 1) * kstep;
            const char* a2 = last ? nA : cA + (size_t)(t + 2) * kstep; const char* b2 = last ? nB : cB + (size_t)(t + 2) * kstep;
            const char* a3 = a2 + kstep; const char* b3 = b2 + kstep;
            if (last && has_next) S.a_ready(nxt);
            if constexpr (SP2) {
            PG8_LDB(B0, 0, 0); PG8_LDB(B1, 0, 1); PG8_SCHED; PG8_LDA(At, 0, 0); PG8_STAGE(PG8_SA(1, 1), a1 + hstepA, voffA);
            PG8_WAIT_V(8); PG8_WAIT_L(0); PG8_BAR; PG8_MMA(0, 0, At, B0); PG8_MMA(0, 1, At, B1); PG8_BAR; PG8_SCHED;
            PG8_LDA(At, 0, 1); PG8_STAGE(PG8_SB(0, 0), b2, voffB); PG8_STAGE(PG8_SB(0, 1), b2 + hstep, voffB); PG8_STAGE(PG8_SA(0, 0), a2, voffA);
            PG8_WAIT_V(8); PG8_WAIT_L(0); PG8_BAR; PG8_MMA(1, 0, At, B0); PG8_MMA(1, 1, At, B1); PG8_BAR; PG8_SCHED;
            PG8_LDB(B0, 1, 0); PG8_LDB(B1, 1, 1); PG8_SCHED; PG8_LDA(At, 1, 0); PG8_STAGE(PG8_SA(0, 1), a2 + hstepA, voffA);
            PG8_WAIT_V(8); PG8_WAIT_L(0); PG8_BAR; PG8_MMA(0, 0, At, B0); PG8_MMA(0, 1, At, B1); PG8_BAR; PG8_SCHED;
            PG8_LDA(At, 1, 1); PG8_STAGE(PG8_SB(1, 0), b3, voffB); PG8_STAGE(PG8_SB(1, 1), b3 + hstep, voffB); PG8_STAGE(PG8_SA(1, 0), a3, voffA);
            PG8_WAIT_V(8); PG8_WAIT_L(0); PG8_BAR; PG8_MMA(1, 0, At, B0); PG8_MMA(1, 1, At, B1); PG8_BAR; PG8_SCHED;
            } else {
            PG8_LDB(B0, 0, 0); PG8_SCHED; PG8_LDA(At, 0, 0); PG8_STAGE(PG8_SA(1, 1), a1 + hstepA, voffA);
            PG8_WAIT_L(8); PG8_BAR; PG8_WAIT_L(0); PG8_MMA(0, 0, At, B0); PG8_BAR; PG8_SCHED;
            PG8_LDB(B1, 0, 1); PG8_STAGE(PG8_SB(0, 0), b2, voffB);
            PG8_BAR; PG8_WAIT_L(0); PG8_MMA(0, 1, At, B1); PG8_BAR;
            PG8_LDA(At, 0, 1); PG8_STAGE(PG8_SA(0, 0), a2, voffA);
            PG8_BAR; PG8_WAIT_L(0); PG8_MMA(1, 0, At, B0); PG8_BAR; PG8_SCHED;
            PG8_STAGE(PG8_SB(0, 1), b2 + hstep, voffB);
            PG8_WAIT_V(6); PG8_BAR; PG8_MMA(1, 1, At, B1); PG8_BAR;
            PG8_LDB(B0, 1, 0); PG8_SCHED; PG8_LDA(At, 1, 0); PG8_STAGE(PG8_SA(0, 1), a2 + hstepA, voffA);
            PG8_WAIT_L(8); PG8_BAR; PG8_WAIT_L(0); PG8_MMA(0, 0, At, B0); PG8_BAR; PG8_SCHED;
            PG8_LDB(B1, 1, 1); PG8_STAGE(PG8_SB(1, 0), b3, voffB);
            PG8_BAR; PG8_WAIT_L(0); PG8_MMA(0, 1, At, B1); PG8_BAR;
            PG8_LDA(At, 1, 1); PG8_STAGE(PG8_SA(1, 0), a3, voffA);
            PG8_BAR; PG8_WAIT_L(0); PG8_MMA(1, 0, At, B0); PG8_BAR; PG8_SCHED;
            PG8_STAGE(PG8_SB(1, 1), b3 + hstep, voffB);
            PG8_WAIT_V(6); PG8_BAR; PG8_MMA(1, 1, At, B1); PG8_BAR;
            }
        }
        if constexpr (ALIGN_EPI) { if (wr == 0) PG8_BAR; }
        if constexpr (!Epi::AFTER_DRAIN) { E(acc, cur, wr, wc, fr, fq); S.done(cur); }
        if (!has_next) break;
#pragma unroll
        for (int a = 0; a < 2; ++a)
#pragma unroll
            for (int b = 0; b < 2; ++b)
#pragma unroll
                for (int m = 0; m < 4; ++m)
#pragma unroll
                    for (int n = 0; n < 2; ++n) acc[a][b][m][n] = (f32x4){0.f, 0.f, 0.f, 0.f};
        cur = nxt; cA = nA; cB = nB; ++ui;
        if constexpr (ALIGN_EPI) { if (wr == 1) PG8_BAR; }
    }
    PG8_WAIT_V(0);
    if constexpr (!ALIGN_EPI) { if (wr == 0) PG8_BAR; }
    PG8_BAR;
    if constexpr (Epi::AFTER_DRAIN) { E.fused(acc, cur, wr, wc, fr, fq, lds, wid, lane); S.done(cur); }
#undef PG8_SA
#undef PG8_SB
#undef PG8_STAGE
#undef PG8_LDA
#undef PG8_LDB
#undef PG8_MMA
#undef PG8_WAIT_V
#undef PG8_WAIT_L
#undef PG8_BAR
#undef PG8_SCHED
}
}


struct Args { const float* in[24]; float* out; unsigned char* ws; int ph_lo, ph_hi; };

struct Ctx {
    const Args& a; float* out; unsigned char* ws; unsigned char* lds; unsigned* ctl;
    int tid, lane, wave, G, vcu;
};

__device__ __forceinline__ u32x4 pack8(const f32x4 a, const f32x4 b) { u32x4 p; p.x = cvt_pk_bf16(a[0], a[1]); p.y = cvt_pk_bf16(a[2], a[3]); p.z = cvt_pk_bf16(b[0], b[1]); p.w = cvt_pk_bf16(b[2], b[3]); return p; }
__device__ __forceinline__ f32x4 unpack_lo(const u32x4 p) { f32x4 v = {__uint_as_float(p.x << 16), __uint_as_float(p.x & 0xffff0000u), __uint_as_float(p.y << 16), __uint_as_float(p.y & 0xffff0000u)}; return v; }
__device__ __forceinline__ f32x4 unpack_hi(const u32x4 p) { f32x4 v = {__uint_as_float(p.z << 16), __uint_as_float(p.z & 0xffff0000u), __uint_as_float(p.w << 16), __uint_as_float(p.w & 0xffff0000u)}; return v; }
#define EPI_LOOP(...) _Pragma("unroll") for (int ai = 0; ai < 2; ++ai) _Pragma("unroll") for (int m = 0; m < 4; ++m) { const unsigned row = row0 + ai * 128 + m * 16; \
    _Pragma("unroll") for (int bj = 0; bj < 2; ++bj) { const unsigned col = col0 + bj * 128; const f32x4 v0 = acc[ai][bj][m][0], v1 = acc[ai][bj][m][1]; __VA_ARGS__ } }
#define EPI_HEAD const unsigned row0 = u.pm * 256 + wr * 64 + fr; const unsigned col0 = u.pn * 256 + wc * 32 + 8 * fq;
struct EpiZ {
    static constexpr bool PERM = true, AFTER_DRAIN = false; bf16_t* zqkv; bf16_t* zf; bf16_t* sig;
    __device__ __forceinline__ void operator()(const f32x4 (&acc)[2][2][4][2], const pg8::Unit& u, int wr, int wc, int fr, int fq) const { EPI_HEAD
        EPI_LOOP(
            if (col < 416) *(u32x4*)(zqkv + row * 416u + col) = pack8(v0, v1);
            else if (col < 928) *(u32x4*)(zf + row * 512u + (col - 416)) = pack8(v0, v1);
            else if (col < INW) { const f32x4 s0 = {sigmoidf_(v0[0]), sigmoidf_(v0[1]), sigmoidf_(v0[2]), sigmoidf_(v0[3])}; const f32x4 s1 = {sigmoidf_(v1[0]), sigmoidf_(v1[1]), sigmoidf_(v1[2]), sigmoidf_(v1[3])};
                *(u32x4*)(sig + row * 2048u + (col - 928)) = pack8(s0, s1); } ) } };
struct EpiF {
    static constexpr bool PERM = true, AFTER_DRAIN = false; bf16_t* Fo;
    __device__ __forceinline__ void operator()(const f32x4 (&acc)[2][2][4][2], const pg8::Unit& u, int wr, int wc, int fr, int fq) const {
        const unsigned row0 = (u.pn >> 1) * 2048 + u.pm * 256 + wr * 64 + fr; const unsigned col0 = (u.pn & 1) * 256 + wc * 32 + 8 * fq;
        EPI_LOOP( *(u32x4*)(Fo + row * 512u + col) = pack8(v0, v1); ) } };
struct EpiMgA {
    static constexpr bool PERM = true, AFTER_DRAIN = false; bf16_t* mg; const bf16_t* sig;
    __device__ __forceinline__ void operator()(const f32x4 (&acc)[2][2][4][2], const pg8::Unit& u, int wr, int wc, int fr, int fq) const { EPI_HEAD
        EPI_LOOP( const u32x4 g = *(const u32x4*)(sig + row * 2048u + col); *(u32x4*)(mg + row * 1024u + col) = pack8(unpack_lo(g) * v0, unpack_hi(g) * v1); ) } };
struct EpiMgF {
    static constexpr bool PERM = true, AFTER_DRAIN = false; bf16_t* mg; const bf16_t* sig;
    __device__ __forceinline__ void operator()(const f32x4 (&acc)[2][2][4][2], const pg8::Unit& u, int wr, int wc, int fr, int fq) const { EPI_HEAD
        EPI_LOOP( const u32x4 g = *(const u32x4*)(sig + row * 2048u + 1024 + col); const u32x4 o = *(const u32x4*)(mg + row * 1024u + col);
            *(u32x4*)(mg + row * 1024u + col) = pack8(unpack_lo(o) + unpack_lo(g) * v0, unpack_hi(o) + unpack_hi(g) * v1); ) } };
struct EpiX1 {
    static constexpr bool PERM = true, AFTER_DRAIN = false; float* x1; const float* x; const float* adaf;
    __device__ __forceinline__ void operator()(const f32x4 (&acc)[2][2][4][2], const pg8::Unit& u, int wr, int wc, int fr, int fq) const { EPI_HEAD
        const float* g1 = adaf + (u.pm >> 3) * 6144 + 2 * 1024;
        EPI_LOOP( const f32x4 ga = *(const f32x4*)(g1 + col), gb = *(const f32x4*)(g1 + col + 4);
            *(f32x4*)(x1 + row * 1024u + col) = *(const f32x4*)(x + row * 1024u + col) + ga * v0; *(f32x4*)(x1 + row * 1024u + col + 4) = *(const f32x4*)(x + row * 1024u + col + 4) + gb * v1; ) } };
struct EpiSh {
    static constexpr bool PERM = true, AFTER_DRAIN = false; bf16_t* acts;
    __device__ __forceinline__ void operator()(const f32x4 (&acc)[2][2][4][2], const pg8::Unit& u, int wr, int wc, int fr, int fq) const { EPI_HEAD
        EPI_LOOP( const f32x4 a = {siluf_(v0[0]) * v1[0], siluf_(v0[1]) * v1[1], siluf_(v0[2]) * v1[2], siluf_(v0[3]) * v1[3]};
            *(u32x2*)(acts + row * 256u + (col >> 1)) = pack4(a); ) } };
struct EpiOut {
    static constexpr bool PERM = true, AFTER_DRAIN = false; float* out; const float* x1; const float* adaf; const bf16_t* ybuf;
    __device__ __forceinline__ void operator()(const f32x4 (&acc)[2][2][4][2], const pg8::Unit& u, int wr, int wc, int fr, int fq) const { EPI_HEAD
        const float* g2 = adaf + (u.pm >> 3) * 6144 + 5 * 1024;
        EPI_LOOP( f32x4 s0 = v0, s1 = v1;
            f32x4 r0 = {0.f, 0.f, 0.f, 0.f}, r1 = {0.f, 0.f, 0.f, 0.f};
            _Pragma("unroll") for (int k = 0; k < 8; ++k) { const u32x2 y = *(const u32x2*)((const unsigned char*)ybuf + (row * 8u + k) * 1024u + col); r0 += unpack_fp8x4(y.x); r1 += unpack_fp8x4(y.y); }
            s0 += r0 * 0.0625f; s1 += r1 * 0.0625f;
            *(f32x4*)(out + row * 1024u + col) = *(const f32x4*)(x1 + row * 1024u + col) + *(const f32x4*)(g2 + col) * s0;
            *(f32x4*)(out + row * 1024u + col + 4) = *(const f32x4*)(x1 + row * 1024u + col + 4) + *(const f32x4*)(g2 + col + 4) * s1;
            if (m == 1 || m == 3) __builtin_amdgcn_sched_barrier(0); ) } };

struct EpiOutS {
    static constexpr bool PERM = true, AFTER_DRAIN = true; float* out; const float* x1; const float* adaf; const unsigned char* ybuf;
    __device__ __forceinline__ void operator()(const f32x4 (&acc)[2][2][4][2], const pg8::Unit& u, int wr, int wc, int fr, int fq) const {}
    __device__ __forceinline__ void fused(const f32x4 (&acc)[2][2][4][2], const pg8::Unit& u, int wr, int wc, int fr, int fq, LAS unsigned char* lds, int wid, int lane) const {
        constexpr unsigned SP = 528;
        { const unsigned row0 = wr * 64 + fr, col0 = wc * 32 + 8 * fq;
          EPI_LOOP( *(LAS u32x4*)(lds + row * SP + col * 2u) = pack8(v0, v1); ) }
        __syncthreads();
        const unsigned r4 = (unsigned)lane >> 4, c16 = ((unsigned)lane & 15u) * 16u, gcol = u.pn * 256 + c16;
        const float* g2 = adaf + (u.pm >> 3) * 6144 + 5 * 1024 + gcol;
        const f32x4 g0 = *(const f32x4*)(g2), g1 = *(const f32x4*)(g2 + 4), g2v = *(const f32x4*)(g2 + 8), g3 = *(const f32x4*)(g2 + 12);
#pragma unroll 2
        for (int it = 0; it < 8; ++it) {
            const unsigned lr = wid * 32 + it * 4 + r4, row = u.pm * 256 + lr;
            const u32x4 sa = *(LAS const u32x4*)(lds + lr * SP + c16 * 2u), sb = *(LAS const u32x4*)(lds + lr * SP + c16 * 2u + 16u);
            f32x4 r0 = {0.f, 0.f, 0.f, 0.f}, r1 = r0, r2 = r0, r3 = r0;
            const unsigned char* yb = ybuf + (size_t)row * 8192u + gcol;
#pragma unroll
            for (int k = 0; k < 8; ++k) { const u32x4 y = *(const u32x4*)(yb + k * 1024u); r0 += unpack_fp8x4(y.x); r1 += unpack_fp8x4(y.y); r2 += unpack_fp8x4(y.z); r3 += unpack_fp8x4(y.w); }
            const float* xr = x1 + (size_t)row * 1024u + gcol; float* orow = out + (size_t)row * 1024u + gcol;
            *(f32x4*)(orow) = *(const f32x4*)(xr) + g0 * (unpack_lo(sa) + r0 * 0.0625f);
            *(f32x4*)(orow + 4) = *(const f32x4*)(xr + 4) + g1 * (unpack_hi(sa) + r1 * 0.0625f);
            *(f32x4*)(orow + 8) = *(const f32x4*)(xr + 8) + g2v * (unpack_lo(sb) + r2 * 0.0625f);
            *(f32x4*)(orow + 12) = *(const f32x4*)(xr + 12) + g3 * (unpack_hi(sb) + r3 * 0.0625f);
        }
    } };

template <class GET> __device__ __forceinline__ void conv_wt(const Ctx& F, bf16_t* dst, int K, int Nd, const GET& get) {
    const long gt = (long)F.vcu * NTHREADS + F.tid, gs = (long)F.G * NTHREADS; const long nchunk = (long)Nd * (K / 8);
    for (long c = gt; c < nchunk; c += gs) { const int n = (int)(c % Nd), k0 = (int)(c / Nd) * 8;
        u32x4 p; p.x = cvt_pk_bf16(get(k0, n), get(k0 + 1, n)); p.y = cvt_pk_bf16(get(k0 + 2, n), get(k0 + 3, n)); p.z = cvt_pk_bf16(get(k0 + 4, n), get(k0 + 5, n)); p.w = cvt_pk_bf16(get(k0 + 6, n), get(k0 + 7, n));
        *(u32x4*)(dst + (long)n * K + k0) = p; }
}

__device__ __forceinline__ void p0_prep(const Ctx& F) {
    const float* c = F.a.in[1]; const float* w_ada = F.a.in[2];
    float* adap = (float*)(F.ws + WS_ADAP);
    float* sc = (float*)F.lds;
    for (int it = F.vcu; it < 16 * 24; it += F.G) {
        const int ks = it / 24, chunk = it % 24;
        __syncthreads();
        { const int b = F.tid >> 6, k = F.tid & 63; sc[b * 64 + k] = siluf_(c[b * 1024 + ks * 64 + k]); }
        __syncthreads();
        const int col = chunk * 256 + (F.tid & 255), b0 = (F.tid >> 8) * 4;
        float a0 = 0.f, a1 = 0.f, a2 = 0.f, a3 = 0.f;
        for (int k = 0; k < 64; ++k) {
            const float wv = w_ada[(long)(ks * 64 + k) * 6144 + col];
            a0 += sc[(b0 + 0) * 64 + k] * wv; a1 += sc[(b0 + 1) * 64 + k] * wv; a2 += sc[(b0 + 2) * 64 + k] * wv; a3 += sc[(b0 + 3) * 64 + k] * wv;
        }
        adap[((long)ks * 8 + b0 + 0) * 6144 + col] = a0; adap[((long)ks * 8 + b0 + 1) * 6144 + col] = a1;
        adap[((long)ks * 8 + b0 + 2) * 6144 + col] = a2; adap[((long)ks * 8 + b0 + 3) * 6144 + col] = a3;
    }
    const long gt = (long)F.vcu * NTHREADS + F.tid, gs = (long)F.G * NTHREADS;
    { float* rc = (float*)(F.ws + WS_ROPE); float* rs = rc + 2048 * 16;
      for (long i = gt; i < 2048 * 16; i += gs) { const int pos = (int)(i >> 4), j = (int)(i & 15);
          const float inv = powf(10000.0f, -(float)(2 * j) / 32.0f); const float ang = (float)pos * inv; rc[i] = cosf(ang); rs[i] = sinf(ang); } }
    { bf16_t* wd = (bf16_t*)(F.ws + WS_WDFT); const float nrm = 0.02209708691207961f;
      for (long i = gt; i < (long)2048 * 4096; i += gs) { const int k = (int)(i >> 12), kk = (int)(i & 4095), s = kk & 2047; const int idx = (k * s) & 2047;
          const float a = (float)idx * (1.0f / 1024.0f); const float v = (kk < 2048) ? cospif(a) : sinpif(a); wd[i] = f2bf(v * nrm); } }
    { bf16_t* d6 = (bf16_t*)(F.ws + WS_D64T);
      for (long i = gt; i < 128 * 64; i += gs) { const int n = (int)(i >> 6), cc = (int)(i & 63), part = n >> 6, m = n & 63; const int idx = (m * cc) & 63;
          const float a = (float)idx * (1.0f / 32.0f); const float v = part ? -sinpif(a) : cospif(a); d6[i] = f2bf(v * 0.125f); } }
    { const float* wr = F.a.in[16];
      conv_wt(F, (bf16_t*)(F.ws + WS_WB_R), 3072, 256, [&](int k3, int n) { const int rg = k3 >> 10, k = k3 & 1023; const float wv = wr[k * 256 + n]; const float hi = bf2f(f2bf(wv)); return (rg == 2) ? (wv - hi) : hi; }); }
    { bf16_t* o = (bf16_t*)(F.ws + WS_WUQ); const float* g = F.a.in[6]; const float* wq = F.a.in[7];
      for (long i = gt; i < 8 * 96 * 256; i += gs) { const int k = (int)(i & 255), d = (int)((i >> 8) % 96), h = (int)(i / (96 * 256)); o[i] = f2bf(wq[k * 768 + h * 96 + d] * g[k]); } }
    { bf16_t* o = (bf16_t*)(F.ws + WS_WUKV); const float* g = F.a.in[8]; const float* wk = F.a.in[9];
      for (long i = gt; i < 8 * 128 * 128; i += gs) { const int k = (int)(i & 127), j = (int)((i >> 7) & 127), h = (int)(i >> 14); o[i] = f2bf(wk[k * 1024 + h * 128 + j] * g[k]); } }
    { const float* w = F.a.in[5];  conv_wt(F, (bf16_t*)(F.ws + WS_WB_IN), 1024, 3072, [&](int k, int n) { return (n < INW) ? w[(long)k * INW + n] : 0.f; }); }
    { const float* w = F.a.in[12]; conv_wt(F, (bf16_t*)(F.ws + WS_WB_PA), 512, 1024, [&](int k, int n) { return w[k * 1024 + n]; }); }
    { const float* w = F.a.in[13]; conv_wt(F, (bf16_t*)(F.ws + WS_WB_PF), 512, 1024, [&](int k, int n) { return w[k * 1024 + n]; }); }
    { const float* w = F.a.in[14]; conv_wt(F, (bf16_t*)(F.ws + WS_WB_OUT), 1024, 1024, [&](int k, int n) { return w[k * 1024 + n]; }); }
    { const float* wg = F.a.in[21]; const float* wu = F.a.in[22];
      conv_wt(F, (bf16_t*)(F.ws + WS_WB_SH), 1024, 512, [&](int k, int n) { const int j = (n >> 3) * 4 + (n & 3); return ((n >> 2) & 1) ? wu[k * 256 + j] : wg[k * 256 + j]; }); }
    { const float* w = F.a.in[23]; conv_wt(F, (bf16_t*)(F.ws + WS_WB_SD), 256, 1024, [&](int k, int n) { return w[k * 1024 + n]; }); }
}

__device__ __forceinline__ void p_norm_rows(const Ctx& F, int which) {
    const float* src = which ? (const float*)(F.ws + WS_X1) : F.a.in[0];
    const float* gain = which ? F.a.in[15] : F.a.in[4];
    const float* adap = (const float*)(F.ws + WS_ADAP); const float* b_ada = F.a.in[3];
    float* adaf = (float*)(F.ws + WS_ADAF);
    bf16_t* dhi = which ? (bf16_t*)(F.ws + WS_A3) : (bf16_t*)(F.ws + WS_H); const unsigned ldd = which ? 3072u : 1024u;
    float* smod = (float*)F.lds; float* sshift = smod + 1024;
    const int nitems = 256 + (which ? 0 : 8);
    for (int it = F.vcu; it < nitems; it += F.G) {
        if (it >= 256) {
            const int b = it - 256;
            for (int j = F.tid; j < 6144; j += NTHREADS) { float s = b_ada[j];
                for (int ks = 0; ks < 16; ++ks) s += adap[((long)ks * 8 + b) * 6144 + j];
                adaf[b * 6144 + j] = s; }
            continue;
        }
        const int b = it >> 5;
        __syncthreads();
        for (int cidx = F.tid; cidx < 1024; cidx += NTHREADS) {
            float sh, scv;
            if (which == 0) { sh = b_ada[cidx]; scv = b_ada[1024 + cidx];
                for (int ks = 0; ks < 16; ++ks) { sh += adap[((long)ks * 8 + b) * 6144 + cidx]; scv += adap[((long)ks * 8 + b) * 6144 + 1024 + cidx]; } }
            else { sh = adaf[b * 6144 + 3 * 1024 + cidx]; scv = adaf[b * 6144 + 4 * 1024 + cidx]; }
            smod[cidx] = gain[cidx] * (1.f + scv); sshift[cidx] = sh;
        }
        __syncthreads();
        for (int j = 0; j < 8; ++j) {
            const long row = (long)it * 64 + F.wave * 8 + j;
            f32x4 v[4]; float ss = 0.f;
#pragma unroll
            for (int i = 0; i < 4; ++i) { v[i] = *(const f32x4*)(src + row * 1024 + i * 256 + F.lane * 4); ss += v[i][0] * v[i][0] + v[i][1] * v[i][1] + v[i][2] * v[i][2] + v[i][3] * v[i][3]; }
            ss = wave_sum(ss);
            const float rstd = rsqrtf(ss * (1.0f / 1024.0f) + EPS);
#pragma unroll
            for (int i = 0; i < 4; ++i) {
                const int c0 = i * 256 + F.lane * 4; float hv[4];
#pragma unroll
                for (int e = 0; e < 4; ++e) hv[e] = v[i][e] * rstd * smod[c0 + e] + sshift[c0 + e];
                u32x2 pk; pk.x = cvt_pk_bf16(hv[0], hv[1]); pk.y = cvt_pk_bf16(hv[2], hv[3]);
                *(u32x2*)(dhi + row * ldd + c0) = pk;
                if (which) {
                    float lo[4];
                    lo[0] = hv[0] - __uint_as_float(pk.x << 16); lo[1] = hv[1] - __uint_as_float(pk.x & 0xffff0000u);
                    lo[2] = hv[2] - __uint_as_float(pk.y << 16); lo[3] = hv[3] - __uint_as_float(pk.y & 0xffff0000u);
                    u32x2 pl; pl.x = cvt_pk_bf16(lo[0], lo[1]); pl.y = cvt_pk_bf16(lo[2], lo[3]);
                    *(u32x2*)(dhi + row * ldd + 1024 + c0) = pl; *(u32x2*)(dhi + row * ldd + 2048 + c0) = pk;
                }
            }
        }
    }
}

__device__ __forceinline__ void p2_win(const Ctx& F) {
    pg8::Gemm g{(const bf16_t*)(F.ws + WS_H), (const bf16_t*)(F.ws + WS_WB_IN), T, 3072, 1024};
    pg8::StaticOrder S; S.init(T, 3072, F.G, (int)blockIdx.x);
    EpiZ E{(bf16_t*)(F.ws + WS_ZQKV), (bf16_t*)(F.ws + WS_ZF), (bf16_t*)(F.ws + WS_SIG)};
    pg8::gemm_phase<EpiZ, pg8::StaticOrder, true, true>((LAS unsigned char*)F.lds, g, S, E);
}

struct BKNq { const float* b; static constexpr bool KN = true; int ldb;
    __device__ __forceinline__ const float* col(int c) const { return b + ((c < 192) ? c : 188); } };
__device__ __forceinline__ void p3_mixer_inputs(const Ctx& F) {
    const bf16_t* zqkv = (const bf16_t*)(F.ws + WS_ZQKV);
    const int lane = F.lane, w = F.wave;
    {
        const bf16_t* zf = (const bf16_t*)(F.ws + WS_ZF); const bf16_t* d6 = (const bf16_t*)(F.ws + WS_D64T); bf16_t* xt = (bf16_t*)(F.ws + WS_XT);
        for (int it = F.vcu; it < 8 * 64; it += F.G) {
            const int g = it & 7, tt = it >> 3; const int tok0 = tt * 256; const int b = tok0 >> 11, s0 = tok0 & 2047;
            f32x16 acc[2][2]; zero_acc<2>(acc);
            ARows af{d6, 64, 0}; BNK bf{zf + g * 64, 512, tok0};
            gemm_core<2, true>(acc, af, bf, 1, F.lds);
            stage_bf16<2>(acc, F.lds);
            __syncthreads();
#pragma unroll 4
            for (int rr = 0; rr < 16; ++rr) {
                const int n = w * 16 + rr; const int part = n >> 6, m = n & 63;
                *(u32x2*)(xt + (unsigned)(b * 512 + g * 64 + m) * 4096u + part * 2048 + s0 + 4 * lane) = *(const u32x2*)(F.lds + n * ST16 + lane * 8);
            }
        }
    }
    {
        constexpr int WQ_P = 528, WKV_P = 272, ST_P = 208;
        constexpr int L_WQ = 0, L_WKV = 96 * WQ_P, L_G = L_WKV + 128 * WKV_P, L_ST = L_G + 768;
        static_assert(L_ST + 8 * 32 * ST_P <= LDS_MISC, "head engine LDS");
        const float* rc = (const float*)(F.ws + WS_ROPE); const float* rsn = rc + 2048 * 16;
        bf16_t* Q = (bf16_t*)(F.ws + WS_Q); bf16_t* K = (bf16_t*)(F.ws + WS_K); bf16_t* vt = (bf16_t*)(F.ws + WS_VT);
        const int hd = F.vcu & 7; const int l31 = lane & 31, hh = lane >> 5;
        __syncthreads();
        { const u32x4* wq = (const u32x4*)((const bf16_t*)(F.ws + WS_WUQ) + (size_t)hd * 96 * 256); const u32x4* wk = (const u32x4*)((const bf16_t*)(F.ws + WS_WUKV) + (size_t)hd * 128 * 128);
          for (int c = F.tid; c < 96 * 32; c += NTHREADS) *(u32x4*)(F.lds + L_WQ + (c >> 5) * WQ_P + (c & 31) * 16) = wq[c];
          for (int c = F.tid; c < 128 * 16; c += NTHREADS) *(u32x4*)(F.lds + L_WKV + (c >> 4) * WKV_P + (c & 15) * 16) = wk[c];
          if (F.tid < 96) { ((float*)(F.lds + L_G))[F.tid] = F.a.in[10][F.tid]; ((float*)(F.lds + L_G))[96 + F.tid] = F.a.in[11][F.tid]; } }
        __syncthreads();
        const float* gq = (const float*)(F.lds + L_G); const float* gk = gq + 96;
        unsigned char* st = F.lds + L_ST + w * (32 * ST_P);
        const float qscale = 0.10206207261596577f * 1.4426950408889634f;
#pragma unroll 1
        for (int i2 = 0; i2 < 2; ++i2) {
            const int sb = (F.vcu >> 3) + 32 * i2; const unsigned tok = sb * 256 + w * 32 + l31; const int b = tok >> 11, s = tok & 2047; const unsigned bh = b * 8 + hd;
            const bf16_t* zrow = zqkv + tok * 416u;
            const f32x4 cs0 = *(const f32x4*)(rc + s * 16 + 4 * hh), cs1 = *(const f32x4*)(rc + s * 16 + 8 + 4 * hh), sn0 = *(const f32x4*)(rsn + s * 16 + 4 * hh), sn1 = *(const f32x4*)(rsn + s * 16 + 8 + 4 * hh);
            {
                bf16x8 zq[16];
#pragma unroll
                for (int k = 0; k < 16; ++k) zq[k] = *(const bf16x8*)(zrow + 16 * k + 8 * hh);
                f32x16 aq[3];
#pragma unroll
                for (int f = 0; f < 3; ++f) {
#pragma unroll
                    for (int r = 0; r < 16; ++r) aq[f][r] = 0.f;
#pragma unroll
                    for (int k = 0; k < 16; ++k) { const bf16x8 wf = *(const bf16x8*)(F.lds + L_WQ + (32 * f + l31) * WQ_P + (16 * k + 8 * hh) * 2); aq[f] = __builtin_amdgcn_mfma_f32_32x32x16_bf16(wf, zq[k], aq[f], 0, 0, 0);
                        if ((k & 7) == 7) __builtin_amdgcn_sched_barrier(0); }
                }
                float ss = 0.f;
#pragma unroll
                for (int f = 0; f < 3; ++f)
#pragma unroll
                    for (int r = 0; r < 16; ++r) ss += aq[f][r] * aq[f][r];
                ss += __shfl_xor(ss, 32);
                const float rstd = rsqrtf(ss * (1.0f / 96.0f) + EPS) * qscale;
#pragma unroll
                for (int f = 0; f < 3; ++f)
#pragma unroll
                    for (int r = 0; r < 16; ++r) aq[f][r] *= rstd * gq[32 * f + (r & 3) + 8 * (r >> 2) + 4 * hh];
#pragma unroll
                for (int r = 0; r < 8; ++r) { const float c = (r < 4) ? cs0[r & 3] : cs1[r & 3], sn = (r < 4) ? sn0[r & 3] : sn1[r & 3];
                    const float r1 = aq[2][r], r2 = aq[2][r + 8]; aq[2][r] = r1 * c - r2 * sn; aq[2][r + 8] = r2 * c + r1 * sn; }
#pragma unroll
                for (int f = 0; f < 3; ++f)
#pragma unroll
                    for (int q4 = 0; q4 < 4; ++q4) { const f32x4 v = {aq[f][4 * q4], aq[f][4 * q4 + 1], aq[f][4 * q4 + 2], aq[f][4 * q4 + 3]};
                        *(u32x2*)(st + l31 * ST_P + (32 * f + 8 * q4 + 4 * hh) * 2) = pack4(v); }
                u32x4* dst = (u32x4*)(Q + ((size_t)bh * 2048 + (s - l31)) * 96);
#pragma unroll
                for (int c6 = 0; c6 < 6; ++c6) { const int c = c6 * 64 + lane; dst[c] = *(const u32x4*)(st + (c / 12) * ST_P + (c % 12) * 16); }
            }
            {
                bf16x8 zk[8]; float sk = 0.f;
#pragma unroll
                for (int k = 0; k < 8; ++k) { zk[k] = *(const bf16x8*)(zrow + 256 + 16 * k + 8 * hh);
#pragma unroll
                    for (int e = 0; e < 8; ++e) { const float z = bf2f((bf16_t)zk[k][e]); sk += z * z; } }
                sk += __shfl_xor(sk, 32);
                const float rkv = rsqrtf(sk * (1.0f / 128.0f) + EPS);
                f32x16 ak[4];
#pragma unroll
                for (int f = 0; f < 4; ++f) {
#pragma unroll
                    for (int r = 0; r < 16; ++r) ak[f][r] = 0.f;
#pragma unroll
                    for (int k = 0; k < 8; ++k) { const bf16x8 wf = *(const bf16x8*)(F.lds + L_WKV + (32 * f + l31) * WKV_P + (16 * k + 8 * hh) * 2); ak[f] = __builtin_amdgcn_mfma_f32_32x32x16_bf16(wf, zk[k], ak[f], 0, 0, 0); }
                    __builtin_amdgcn_sched_barrier(0);
                }
#pragma unroll
                for (int f = 2; f < 4; ++f)
#pragma unroll
                    for (int r = 0; r < 16; ++r) { const int dv = 32 * (f - 2) + (r & 3) + 8 * (r >> 2) + 4 * hh; vt[((size_t)bh * 64 + dv) * 2048 + s] = f2bf(ak[f][r] * rkv); }
                float zr[16];
#pragma unroll
                for (int q4 = 0; q4 < 4; ++q4) { const f32x4 t4 = unpack4(*(const u32x2*)(zrow + 384 + 8 * q4 + 4 * hh)); zr[4 * q4] = t4[0]; zr[4 * q4 + 1] = t4[1]; zr[4 * q4 + 2] = t4[2]; zr[4 * q4 + 3] = t4[3]; }
                float ss = 0.f;
#pragma unroll
                for (int f = 0; f < 2; ++f)
#pragma unroll
                    for (int r = 0; r < 16; ++r) { ak[f][r] *= rkv; ss += ak[f][r] * ak[f][r]; }
#pragma unroll
                for (int r = 0; r < 16; ++r) ss += zr[r] * zr[r];
                ss += __shfl_xor(ss, 32);
                const float rstd = rsqrtf(ss * (1.0f / 96.0f) + EPS);
#pragma unroll
                for (int f = 0; f < 2; ++f)
#pragma unroll
                    for (int r = 0; r < 16; ++r) ak[f][r] *= rstd * gk[32 * f + (r & 3) + 8 * (r >> 2) + 4 * hh];
#pragma unroll
                for (int r = 0; r < 16; ++r) zr[r] *= rstd * gk[64 + (r & 3) + 8 * (r >> 2) + 4 * hh];
#pragma unroll
                for (int r = 0; r < 8; ++r) { const float c = (r < 4) ? cs0[r & 3] : cs1[r & 3], sn = (r < 4) ? sn0[r & 3] : sn1[r & 3];
                    const float r1 = zr[r], r2 = zr[r + 8]; zr[r] = r1 * c - r2 * sn; zr[r + 8] = r2 * c + r1 * sn; }
#pragma unroll
                for (int f = 0; f < 2; ++f)
#pragma unroll
                    for (int q4 = 0; q4 < 4; ++q4) { const f32x4 v = {ak[f][4 * q4], ak[f][4 * q4 + 1], ak[f][4 * q4 + 2], ak[f][4 * q4 + 3]};
                        *(u32x2*)(st + l31 * ST_P + (32 * f + 8 * q4 + 4 * hh) * 2) = pack4(v); }
#pragma unroll
                for (int q4 = 0; q4 < 4; ++q4) { const f32x4 v = {zr[4 * q4], zr[4 * q4 + 1], zr[4 * q4 + 2], zr[4 * q4 + 3]};
                    *(u32x2*)(st + l31 * ST_P + (64 + 8 * q4 + 4 * hh) * 2) = pack4(v); }
                u32x4* dst = (u32x4*)(K + ((size_t)bh * 2048 + (s - l31)) * 96);
#pragma unroll
                for (int c6 = 0; c6 < 6; ++c6) { const int c = c6 * 64 + lane; dst[c] = *(const u32x4*)(st + (c / 12) * ST_P + (c % 12) * 16); }
            }
        }
    }
}

constexpr int KROW = 208, VROW = 136, K_TILE = 64 * KROW, V_TILE = 64 * VROW, AT_STAGE = K_TILE + V_TILE;
__device__ __forceinline__ void attn_item(const Ctx& F, int item) {
    const int qb = item & 7, bh = item >> 3, b = bh >> 3, hd = bh & 7;
    const bf16_t* Q = (const bf16_t*)(F.ws + WS_Q) + (long)bh * 2048 * 96;
    const bf16_t* K = (const bf16_t*)(F.ws + WS_K) + (long)bh * 2048 * 96;
    const bf16_t* Vt = (const bf16_t*)(F.ws + WS_VT) + (long)bh * 64 * 2048;
    bf16_t* O = (bf16_t*)(F.ws + WS_O);
    const int t = F.tid, lane = F.lane, w = F.wave, l31 = lane & 31, hh = lane >> 5;
    bf16x8 qf[6];
    { const bf16_t* qp = Q + (long)(qb * 256 + w * 32 + l31) * 96 + hh * 8;
#pragma unroll
      for (int s = 0; s < 6; ++s) qf[s] = *(const bf16x8*)(qp + s * 16); }
    f32x16 oacc[2];
#pragma unroll
    for (int d = 0; d < 2; ++d)
#pragma unroll
        for (int r = 0; r < 16; ++r) oacc[d][r] = 0.f;
    float m_run = -1e30f, l_run = 0.f;
    const int kq0 = t, kq1 = t + 512;
    const int k_l0 = (kq0 / 12) * KROW + (kq0 % 12) * 16, k_l1 = (kq1 / 12) * KROW + (kq1 % 12) * 16;
    const int v_dv = t >> 3, v_c = t & 7; const int v_l = v_dv * VROW + v_c * 16;
    u32x4 kr0, kr1, vr;
    auto gload = [&](int j) {
        const bf16_t* kp = K + (long)j * 64 * 96;
        kr0 = *(const u32x4*)(kp + kq0 * 8);
        if (t < 256) kr1 = *(const u32x4*)(kp + kq1 * 8);
        vr = *(const u32x4*)(Vt + (long)v_dv * 2048 + j * 64 + v_c * 8);
    };
    auto lstore = [&](int st) {
        unsigned char* base = F.lds + st * AT_STAGE;
        *(u32x4*)(base + k_l0) = kr0;
        if (t < 256) *(u32x4*)(base + k_l1) = kr1;
        *(u32x2*)(base + K_TILE + v_l) = (u32x2){vr.x, vr.y}; *(u32x2*)(base + K_TILE + v_l + 8) = (u32x2){vr.z, vr.w};
    };
    __syncthreads();
    gload(0); lstore(0);
    __syncthreads();
    for (int j = 0; j < 32; ++j) {
        const bool more = (j + 1 < 32);
        if (more) gload(j + 1);
        const unsigned char* kb = F.lds + (j & 1) * AT_STAGE; const unsigned char* vb = kb + K_TILE;
        f32x16 st[2];
        {
            bf16x8 kfr[2][6];
#pragma unroll
            for (int f = 0; f < 2; ++f)
#pragma unroll
                for (int s = 0; s < 6; ++s) kfr[f][s] = *(const bf16x8*)(kb + (32 * f + l31) * KROW + (16 * s + 8 * hh) * 2);
            __builtin_amdgcn_sched_barrier(0);
#pragma unroll
            for (int f = 0; f < 2; ++f) {
#pragma unroll
                for (int r = 0; r < 16; ++r) st[f][r] = 0.f;
#pragma unroll
                for (int s = 0; s < 6; ++s) st[f] = __builtin_amdgcn_mfma_f32_32x32x16_bf16(kfr[f][s], qf[s], st[f], 0, 0, 0);
            }
        }
        float mx = st[0][0];
#pragma unroll
        for (int r = 1; r < 16; ++r) mx = fmaxf(mx, st[0][r]);
#pragma unroll
        for (int r = 0; r < 16; ++r) mx = fmaxf(mx, st[1][r]);
        mx = fmaxf(mx, __shfl_xor(mx, 32));
        const float m_new = fmaxf(m_run, mx);
        const float alpha = __builtin_amdgcn_exp2f(m_run - m_new);
        m_run = m_new;
        float ps = 0.f;
#pragma unroll
        for (int f = 0; f < 2; ++f)
#pragma unroll
            for (int r = 0; r < 16; ++r) { const float p = __builtin_amdgcn_exp2f(st[f][r] - m_new); st[f][r] = p; ps += p; }
        l_run = l_run * alpha + ps;
#pragma unroll
        for (int d = 0; d < 2; ++d)
#pragma unroll
            for (int r = 0; r < 16; ++r) oacc[d][r] *= alpha;
        {
            u32x4 vfr[2][2][2];
#pragma unroll
            for (int f = 0; f < 2; ++f)
#pragma unroll
                for (int s2 = 0; s2 < 2; ++s2)
#pragma unroll
                    for (int d = 0; d < 2; ++d) { const unsigned char* vp = vb + (32 * d + l31) * VROW + (32 * f + 16 * s2 + 4 * hh) * 2;
                        const u32x2 lo = *(const u32x2*)vp, hi = *(const u32x2*)(vp + 16); vfr[f][s2][d] = (u32x4){lo.x, lo.y, hi.x, hi.y}; }
#pragma unroll
            for (int f = 0; f < 2; ++f)
#pragma unroll
                for (int s2 = 0; s2 < 2; ++s2) {
                    u32x4 pw; pw.x = cvt_pk_bf16(st[f][8 * s2 + 0], st[f][8 * s2 + 1]); pw.y = cvt_pk_bf16(st[f][8 * s2 + 2], st[f][8 * s2 + 3]);
                    pw.z = cvt_pk_bf16(st[f][8 * s2 + 4], st[f][8 * s2 + 5]); pw.w = cvt_pk_bf16(st[f][8 * s2 + 6], st[f][8 * s2 + 7]);
                    const bf16x8 pf = *(const bf16x8*)&pw;
#pragma unroll
                    for (int d = 0; d < 2; ++d) oacc[d] = __builtin_amdgcn_mfma_f32_32x32x16_bf16(*(const bf16x8*)&vfr[f][s2][d], pf, oacc[d], 0, 0, 0);
                }
        }
        if (more) lstore((j + 1) & 1);
        __syncthreads();
    }
    l_run += __shfl_xor(l_run, 32);
    const float inv = 1.0f / l_run;
    const long tok = (long)b * 2048 + qb * 256 + w * 32 + l31;
#pragma unroll
    for (int d = 0; d < 2; ++d)
#pragma unroll
        for (int q4 = 0; q4 < 4; ++q4) {
            const int dv = 32 * d + 8 * q4 + 4 * hh;
            u32x2 pk; pk.x = cvt_pk_bf16(oacc[d][4 * q4 + 0] * inv, oacc[d][4 * q4 + 1] * inv); pk.y = cvt_pk_bf16(oacc[d][4 * q4 + 2] * inv, oacc[d][4 * q4 + 3] * inv);
            *(u32x2*)(O + tok * 512 + hd * 64 + dv) = pk;
        }
}

__device__ __forceinline__ void p6_attn_dft(const Ctx& F) {
    {
        pg8::Gemm g{(const bf16_t*)(F.ws + WS_WDFT), (const bf16_t*)(F.ws + WS_XT), 2048, 4096, 4096};
        pg8::StaticOrder S; S.init(2048, 4096, F.G, (int)blockIdx.x);
        EpiF E{(bf16_t*)(F.ws + WS_F)};
        pg8::gemm_phase<EpiF, pg8::StaticOrder, true, true>((LAS unsigned char*)F.lds, g, S, E);
    }
    volatile LAS int* sitem = (volatile LAS int*)(F.lds + LDS_MISC);
    auto next_item = [&]() -> int {
        __syncthreads();
        if (F.tid == 0) sitem[0] = (int)xb_add(F.ctl + CW_QUEUE, 1u);
        __syncthreads();
        return sitem[0];
    };
    int it = next_item();
    while (it < 512) { attn_item(F, it); it = next_item(); }
}

__device__ __forceinline__ void p7_merge(const Ctx& F) {
    bf16_t* mg = (bf16_t*)(F.ws + WS_MERGED); const bf16_t* sig = (const bf16_t*)(F.ws + WS_SIG);
    pg8::StaticOrder S; S.init(T, 1024, F.G, (int)blockIdx.x);
    { pg8::Gemm g{(const bf16_t*)(F.ws + WS_O), (const bf16_t*)(F.ws + WS_WB_PA), T, 1024, 512}; EpiMgA E{mg, sig};
      pg8::gemm_phase<EpiMgA, pg8::StaticOrder, true, true>((LAS unsigned char*)F.lds, g, S, E); }
    { pg8::Gemm g{(const bf16_t*)(F.ws + WS_F), (const bf16_t*)(F.ws + WS_WB_PF), T, 1024, 512}; EpiMgF E{mg, sig};
      pg8::gemm_phase<EpiMgF, pg8::StaticOrder, true, true>((LAS unsigned char*)F.lds, g, S, E); }
}

__device__ __forceinline__ void p8_out(const Ctx& F) {
    pg8::Gemm g{(const bf16_t*)(F.ws + WS_MERGED), (const bf16_t*)(F.ws + WS_WB_OUT), T, 1024, 1024};
    pg8::StaticOrder S; S.init(T, 1024, F.G, (int)blockIdx.x);
    EpiX1 E{(float*)(F.ws + WS_X1), F.a.in[0], (const float*)(F.ws + WS_ADAF)};
    pg8::gemm_phase<EpiX1, pg8::StaticOrder, true, true>((LAS unsigned char*)F.lds, g, S, E);
}

template <int NT>
__device__ __forceinline__ void topk_tokens(const Ctx& F, int tok0, const float (&lg)[NT][4], const float (&bs)[4]) {
    int* ltok = (int*)(F.ws + WS_LTOK); float* lw = (float*)(F.ws + WS_LW); unsigned* cnt = F.ctl + CW_CNT;
    const int lane = F.lane;
    float sc[NT][4]; unsigned long long key[NT][4];
#pragma unroll
    for (int t = 0; t < NT; ++t)
#pragma unroll
        for (int i = 0; i < 4; ++i) {
            sc[t][i] = sigmoidf_(lg[t][i]);
            const unsigned ub = __float_as_uint(sc[t][i] + bs[i]);
            const unsigned ord = (ub & 0x80000000u) ? ~ub : (ub | 0x80000000u);
            key[t][i] = ((unsigned long long)ord << 32) | (unsigned long long)(255 - (lane + 64 * i));
        }
    float wsum[NT], myw[NT]; int mye[NT];
#pragma unroll
    for (int t = 0; t < NT; ++t) { wsum[t] = 0.f; myw[t] = 0.f; mye[t] = 0; }
    for (int k = 0; k < 8; ++k) {
        unsigned long long best[NT];
#pragma unroll
        for (int t = 0; t < NT; ++t) { best[t] = key[t][0];
#pragma unroll
            for (int i = 1; i < 4; ++i) best[t] = (key[t][i] > best[t]) ? key[t][i] : best[t]; }
#pragma unroll
        for (int o = 32; o > 0; o >>= 1) {
#pragma unroll
            for (int t = 0; t < NT; ++t) {
                const unsigned lo = __shfl_xor((unsigned)best[t], o), hi = __shfl_xor((unsigned)(best[t] >> 32), o);
                const unsigned long long ob = ((unsigned long long)hi << 32) | lo;
                best[t] = (ob > best[t]) ? ob : best[t];
            }
        }
#pragma unroll
        for (int t = 0; t < NT; ++t) {
            const int e = 255 - (int)(best[t] & 0xffull);
            float s_own = 0.f;
#pragma unroll
            for (int i = 0; i < 4; ++i) { const bool mine = (e == lane + 64 * i); s_own = mine ? sc[t][i] : s_own; key[t][i] = mine ? 0ull : key[t][i]; }
            const float s_k = __shfl(s_own, e & 63);
            wsum[t] += s_k;
            myw[t] = (lane == k) ? s_k : myw[t]; mye[t] = (lane == k) ? e : mye[t];
        }
    }
    if (lane < 8) {
        unsigned slot[NT];
#pragma unroll
        for (int t = 0; t < NT; ++t) slot[t] = atomicAdd(&cnt[mye[t] * 64], 1u);
#pragma unroll
        for (int t = 0; t < NT; ++t) { ltok[(long)mye[t] * LCAP + slot[t]] = (tok0 + t) * 8 + lane; lw[(long)mye[t] * LCAP + slot[t]] = myw[t] / wsum[t] * 2.5f; }
    }
}

struct EpiLog {
    static constexpr bool PERM = true, AFTER_DRAIN = false; float* dst;
    __device__ __forceinline__ void operator()(const f32x4 (&acc)[2][2][4][2], const pg8::Unit& u, int wr, int wc, int fr, int fq) const { EPI_HEAD
        EPI_LOOP( *(f32x4*)(dst + row * 256u + col) = v0; *(f32x4*)(dst + row * 256u + col + 4) = v1; ) } };
__device__ __forceinline__ void p10_router_shared(const Ctx& F) {
    const bf16_t* a3 = (const bf16_t*)(F.ws + WS_A3); const bf16_t* wr = (const bf16_t*)(F.ws + WS_WB_R); float* part = (float*)(F.ws + WS_QRAW);
    const unsigned bx = blockIdx.x, G = (unsigned)F.G;
    {
        pg8::Gemm g{a3, (const bf16_t*)(F.ws + WS_WB_SH), T, 512, 1024, 3072};
        pg8::StaticOrder S; S.init(T, 512, F.G, (int)bx);
        EpiSh E{(bf16_t*)(F.ws + WS_ACTS)};
        pg8::gemm_phase<EpiSh, pg8::StaticOrder, true, true>((LAS unsigned char*)F.lds, g, S, E);
    }
    {
        const int seg = (bx >= 192u) ? 1 : 0;
        const bool has = (bx >= 128u);
        pg8::Gemm g{a3 + seg * 1536, wr + seg * 1536, T, 256, 1536, 3072};
        g.ldb = 3072;
        pg8::StaticOrder S; S.init(T, 256, F.G, has ? (int)((bx - 128u) & 63u) : (int)(G - 1));
        EpiLog E{part + (size_t)seg * T * 256};
        pg8::gemm_phase<EpiLog, pg8::StaticOrder, true, true>((LAS unsigned char*)F.lds, g, S, E);
    }
}
__device__ __forceinline__ void p11_topk(const Ctx& F) {
    const float* part = (const float*)(F.ws + WS_QRAW);
    float bs[4];
#pragma unroll
    for (int i = 0; i < 4; ++i) bs[i] = F.a.in[17][F.lane + 64 * i];
    for (int tok0 = (F.vcu * 8 + F.wave) * 8; tok0 < T; tok0 += F.G * 8 * 8) {
        float lg[8][4];
#pragma unroll
        for (int t = 0; t < 8; ++t)
#pragma unroll
            for (int i = 0; i < 4; ++i) { const size_t o = (size_t)(tok0 + t) * 256 + F.lane + 64 * i; lg[t][i] = part[o] + part[o + (size_t)T * 256]; }
        topk_tokens<8>(F, tok0, lg, bs);
    }
}

__device__ __forceinline__ int build_expert_tables(const Ctx& F, int per_rt) {
    volatile LAS int* offs = (volatile LAS int*)(F.lds + LDS_MISC); volatile LAS int* istart = offs + 264; volatile LAS int* wtot = offs + 540;
    unsigned* cnt = F.ctl + CW_CNT;
    const int t = F.tid, lane = F.lane;
    const int c = (t < NE) ? (int)cnt[t * 64] : 0; const int ni = ((c + 255) >> 8) * per_rt;
    int x = c, y = ni;
#pragma unroll
    for (int d = 1; d < 64; d <<= 1) { const int x2 = __shfl_up(x, d), y2 = __shfl_up(y, d); x += (lane >= d) ? x2 : 0; y += (lane >= d) ? y2 : 0; }
    __syncthreads();
    if (t < NE && lane == 63) { wtot[t >> 6] = x; wtot[4 + (t >> 6)] = y; }
    __syncthreads();
    if (t < NE) { int bx = 0, by = 0; for (int k = 0; k < (t >> 6); ++k) { bx += wtot[k]; by += wtot[4 + k]; }
        offs[t] = bx + x - c; istart[t] = by + y - ni; if (t == NE - 1) { offs[NE] = bx + x; istart[NE] = by + y; } }
    __syncthreads();
    return istart[NE];
}
__device__ __forceinline__ int find_expert(const Ctx& F, int it) {
    volatile LAS int* istart = (volatile LAS int*)(F.lds + LDS_MISC) + 264;
    int lo = 0, hi = NE;
    while (hi - lo > 1) { const int mid = (lo + hi) >> 1; if (istart[mid] <= it) lo = mid; else hi = mid; }
    return lo;
}
struct AGather { const bf16_t* b; const int* list; int m0, mvalid; unsigned lda;
    __device__ __forceinline__ const bf16_t* base() const { return b; }
    __device__ __forceinline__ unsigned off(int r) const { int i = m0 + r; i = (i < mvalid) ? i : (mvalid - 1); return (unsigned)(list[i] >> 3) * lda; }
    __device__ __forceinline__ long koff(int kt) const { return (long)kt * 64; } };
struct ARowsV { const bf16_t* b; unsigned lda; int m0, mvalid;
    __device__ __forceinline__ const bf16_t* base() const { return b; }
    __device__ __forceinline__ unsigned off(int r) const { int i = m0 + r; i = (i < mvalid) ? i : (mvalid - 1); return (unsigned)i * lda; }
    __device__ __forceinline__ long koff(int kt) const { return (long)kt * 64; } };

__device__ __forceinline__ void p12_exp_up(const Ctx& F) {
    const int total = build_expert_tables(F, 2);
    volatile LAS int* offs = (volatile LAS int*)(F.lds + LDS_MISC);
    volatile LAS int* istart = offs + 264;
    const bf16_t* hhi = (const bf16_t*)(F.ws + WS_A3); const int* ltok = (const int*)(F.ws + WS_LTOK); bf16_t* act = (bf16_t*)(F.ws + WS_ACT);
    unsigned* cnt = F.ctl + CW_CNT;
    for (int it = F.vcu; it < total; it += F.G) {
        const int e = find_expert(F, it); const int li = it - istart[e]; const int rt = li >> 1, ct = li & 1;
        const int me = (int)cnt[e * 64], m0 = rt * 256, j0 = ct * 128; const int ro = offs[e];
        f32x16 acc[4][2]; zero_acc<4>(acc);
        AGather af{hhi, ltok + (long)e * LCAP, m0, me, 3072u};
        BKNPair bf{F.a.in[18] + (long)e * 262144 + j0, (long)(F.a.in[19] - F.a.in[18]), 256};
        gemm_core<4, true>(acc, af, bf, 16, F.lds);
        run_epilogue_tr<4>(acc, [&](int r, int c0, f32x4 v0, f32x4 v1) { const int i = m0 + r; if (i < me) { const int j = j0 + (c0 >> 6) * 32 + (c0 & 31);
            const f32x4 a = {siluf_(v0[0]) * v1[0], siluf_(v0[1]) * v1[1], siluf_(v0[2]) * v1[2], siluf_(v0[3]) * v1[3]};
            *(u32x2*)(act + (unsigned)(ro + i) * 256u + j) = pack4(a); } });
    }
}
__device__ __forceinline__ void p13_exp_down(const Ctx& F) {
    constexpr int W_P = 528, ST_P = 144;
    constexpr int L_W = 0, L_ST = 128 * W_P;
    static_assert(L_ST + 8 * 32 * ST_P <= LDS_MISC, "expert-down engine LDS");
    (void)build_expert_tables(F, 1);
    volatile LAS int* offs = (volatile LAS int*)(F.lds + LDS_MISC);
    const int* ltok = (const int*)(F.ws + WS_LTOK); const float* lw = (const float*)(F.ws + WS_LW); const bf16_t* act = (const bf16_t*)(F.ws + WS_ACT);
    unsigned char* ybuf8 = F.ws + WS_YBUF; unsigned* cnt = F.ctl + CW_CNT;
    const int lane = F.lane, w = F.wave, l31 = lane & 31, hh = lane >> 5;
    unsigned char* st = F.lds + L_ST + w * (32 * ST_P);
#pragma unroll 1
    for (int it = F.vcu; it < NE * 8; it += F.G) {
        const int e = it >> 3, n0 = (it & 7) * 128; const int me = (int)cnt[e * 64]; const int ro = offs[e];
        if (me == 0) continue;
        __syncthreads();
        { int tid_ = F.tid; asm volatile("" : "+v"(tid_));
#pragma unroll 1
          for (int b2 = tid_; b2 < 1024; b2 += NTHREADS) { const int kb = b2 >> 5, nq = b2 & 31;
            const float* src = F.a.in[20] + (size_t)e * 262144 + (size_t)(kb * 8) * 1024 + n0 + 4 * nq;
            f32x4 r[8];
#pragma unroll
            for (int i = 0; i < 8; ++i) r[i] = *(const f32x4*)(src + (size_t)i * 1024);
#pragma unroll
            for (int j = 0; j < 4; ++j) { u32x4 p; p.x = cvt_pk_bf16(r[0][j], r[1][j]); p.y = cvt_pk_bf16(r[2][j], r[3][j]); p.z = cvt_pk_bf16(r[4][j], r[5][j]); p.w = cvt_pk_bf16(r[6][j], r[7][j]);
                *(u32x4*)(F.lds + L_W + (4 * nq + j) * W_P + kb * 16) = p; } } }
        __syncthreads();
        const int* lt = ltok + (size_t)e * LCAP; const float* lwe = lw + (size_t)e * LCAP;
#pragma unroll 1
        for (int tb = w; tb * 32 < me; tb += 8) {
            const int idx = tb * 32 + l31; const int idc = (idx < me) ? idx : (me - 1);
            const bf16_t* arow = act + (size_t)(ro + idc) * 256 + 8 * hh;
            bf16x8 z[16];
#pragma unroll
            for (int k = 0; k < 16; ++k) z[k] = *(const bf16x8*)(arow + 16 * k);
            const int myent = lt[idc]; const float sc = lwe[idc] * 16.f;
            f32x16 acc[4];
#pragma unroll
            for (int f = 0; f < 4; ++f)
#pragma unroll
                for (int r = 0; r < 16; ++r) acc[f][r] = 0.f;
            bf16x8 wa[8], wb[8];
            const unsigned char* wbase = F.lds + L_W + l31 * W_P + 16 * hh;
#define WLOAD(dst, hs) _Pragma("unroll") for (int k = 0; k < 8; ++k) dst[k] = *(const bf16x8*)(wbase + (32 * ((hs) >> 1)) * W_P + (128 * ((hs) & 1) + 16 * k) * 2)
#define WMMA(src, hs) _Pragma("unroll") for (int k = 0; k < 8; ++k) acc[(hs) >> 1] = __builtin_amdgcn_mfma_f32_32x32x16_bf16(src[k], z[8 * ((hs) & 1) + k], acc[(hs) >> 1], 0, 0, 0)
            WLOAD(wa, 0);
#pragma unroll
            for (int hs = 0; hs < 8; hs += 2) {
                WLOAD(wb, hs + 1); __builtin_amdgcn_sched_barrier(0);
                WMMA(wa, hs); __builtin_amdgcn_sched_barrier(0);
                if (hs + 2 < 8) { WLOAD(wa, hs + 2); } __builtin_amdgcn_sched_barrier(0);
                WMMA(wb, hs + 1); __builtin_amdgcn_sched_barrier(0);
            }
#undef WLOAD
#undef WMMA
#pragma unroll
            for (int f = 0; f < 4; ++f)
#pragma unroll
                for (int q4 = 0; q4 < 4; ++q4) { const f32x4 v = {acc[f][4 * q4] * sc, acc[f][4 * q4 + 1] * sc, acc[f][4 * q4 + 2] * sc, acc[f][4 * q4 + 3] * sc};
                    *(unsigned*)(st + l31 * ST_P + 32 * f + 8 * q4 + 4 * hh) = pack_fp8x4(v); }
#pragma unroll
            for (int i = 0; i < 4; ++i) { const int row = (lane >> 3) + 8 * i, ch = lane & 7;
                const u32x4 v = *(const u32x4*)(st + row * ST_P + ch * 16); const unsigned ent = (unsigned)__shfl(myent, row);
                if (tb * 32 + row < me) *(u32x4*)(ybuf8 + (size_t)ent * 1024 + n0 + ch * 16) = v; }
        }
    }
}

__device__ __forceinline__ void p14_final(const Ctx& F) {
    pg8::Gemm g{(const bf16_t*)(F.ws + WS_ACTS), (const bf16_t*)(F.ws + WS_WB_SD), T, 1024, 256};
    pg8::StaticOrder S; S.init(T, 1024, F.G, (int)blockIdx.x);
    EpiOutS E{F.out, (const float*)(F.ws + WS_X1), (const float*)(F.ws + WS_ADAF), (const unsigned char*)(F.ws + WS_YBUF)};
    pg8::gemm_phase<EpiOutS, pg8::StaticOrder, true, true>((LAS unsigned char*)F.lds, g, S, E);
}

constexpr int NPHASE = 13;
__global__ void __launch_bounds__(NTHREADS, 2) mk_fwd(Args args) {
    extern __shared__ __attribute__((aligned(16))) unsigned char lds[];
    const int tid_ = threadIdx.x, G_ = gridDim.x, bx_ = blockIdx.x;
    Ctx F{args, args.out, args.ws, lds, (unsigned*)(args.ws + WS_CTL), tid_, tid_ & 63, __builtin_amdgcn_readfirstlane(tid_ >> 6), G_, (G_ % 8 == 0) ? (bx_ % 8) * (G_ / 8) + bx_ / 8 : bx_};
    const int lo = args.ph_lo, hi = args.ph_hi;
    volatile LAS unsigned* bst = (volatile LAS unsigned*)(lds + LDS_MISC + 4096);
    XcdBarrier bar; bar.bar = F.ctl + CW_BAR; bar.x = 0; bar.st = bst;
    if (hi - lo > 1) {
        if (F.tid == 0) { bst[0] = 0u; bst[1] = 0u; bst[2] = 0u; bst[3] = 0u; }
        __syncthreads();
        bar = xcd_barrier_post(F.ctl + CW_BAR, bst);
    }
#define PHASE(k, call) if (lo <= (k) && (k) < hi) { call; if ((k) + 1 < hi) xcd_barrier(bar); }
    PHASE(0, p0_prep(F))
    PHASE(1, p_norm_rows(F, 0))
    PHASE(2, p2_win(F))
    PHASE(3, p3_mixer_inputs(F))
    PHASE(4, p6_attn_dft(F))
    PHASE(5, p7_merge(F))
    PHASE(6, p8_out(F))
    PHASE(7, p_norm_rows(F, 1))
    PHASE(8, p10_router_shared(F))
    PHASE(9, p11_topk(F))
    PHASE(10, p12_exp_up(F))
    PHASE(11, p13_exp_down(F))
    PHASE(12, p14_final(F))
#undef PHASE
}

extern "C" void kernel_launch(void* const* d_in, const int* in_sizes, int n_in, void* d_out, int out_size, void* d_ws, size_t ws_size, hipStream_t stream) {
    static int grid = 0;
    if (grid == 0) {
        if (n_in != 24 || out_size != T * DM || ws_size < WS_END) {
            fprintf(stderr, "kernel_launch: unexpected shapes (n_in %d, out %d, ws %zu < %zu); nothing launched\n", n_in, out_size, ws_size, (size_t)WS_END); grid = -1; return; }
        int dev = 0, cus = 0, per_cu = 0;
        if (hipGetDevice(&dev) != hipSuccess || hipDeviceGetAttribute(&cus, hipDeviceAttributeMultiprocessorCount, dev) != hipSuccess) { grid = -1; return; }
        if (hipFuncSetAttribute((const void*)mk_fwd, hipFuncAttributeMaxDynamicSharedMemorySize, LDS_BYTES) != hipSuccess) { fprintf(stderr, "kernel_launch: hipFuncSetAttribute failed\n"); grid = -1; return; }
        if (hipOccupancyMaxActiveBlocksPerMultiprocessor(&per_cu, (const void*)mk_fwd, NTHREADS, LDS_BYTES) != hipSuccess || per_cu < 1)
            fprintf(stderr, "kernel_launch: occupancy query reports %d blocks per CU\n", per_cu);
        (void)hipGetLastError();
        if (cus < 256) { fprintf(stderr, "kernel_launch: this kernel is laid out for 256 CUs (device reports %d); nothing launched\n", cus); grid = -1; return; }
        grid = 256;
    }
    if (grid < 0) return;
    (void)hipMemsetAsync((char*)d_ws + WS_CTL, 0, CTL_BYTES, stream);
    Args a{};
    for (int i = 0; i < 24; ++i) a.in[i] = (const float*)d_in[i];
    a.out = (float*)d_out; a.ws = (unsigned char*)d_ws;
#if N_LAUNCH_MODE == 1
    a.ph_lo = 0; a.ph_hi = NPHASE;
    hipLaunchKernelGGL(mk_fwd, dim3(grid), dim3(NTHREADS), LDS_BYTES, stream, a);
#else
    for (int ph = 0; ph < NPHASE; ++ph) { a.ph_lo = ph; a.ph_hi = ph + 1; hipLaunchKernelGGL(mk_fwd, dim3(grid), dim3(NTHREADS), LDS_BYTES, stream, a); }
#endif
    const hipError_t le = hipPeekAtLastError();
    if (le != hipSuccess) fprintf(stderr, "kernel_launch: launch failed: %s\n", hipGetErrorName(le));
}
```

```cpp
#include <hip/hip_runtime.h>
#include <cstdio>
#include <cstdint>

typedef unsigned short bf16_t;
typedef short bf16x8 __attribute__((ext_vector_type(8)));
typedef float f32x16 __attribute__((ext_vector_type(16)));
typedef float f32x4 __attribute__((ext_vector_type(4)));
typedef unsigned u32x4 __attribute__((ext_vector_type(4)));
typedef unsigned u32x2 __attribute__((ext_vector_type(2)));

#define REPEAT_MASK 16384
#ifndef N_LAUNCH_MODE
#define N_LAUNCH_MODE 1
#endif
#ifndef NAIVE_MMA
#define NAIVE_MMA 0
#endif

constexpr int T = 16384, DM = 1024, NB = 8, SEQ = 2048;
constexpr int INW = 2976, NH = 8, DQK = 96, DV = 64;
constexpr int NE = 256, TOPK = 8, EH = 256;
constexpr float EPS = 1e-6f;
constexpr int NTHREADS = 512;
constexpr int LCAP = 16384;

constexpr size_t al256(size_t x) { return (x + 255) & ~(size_t)255; }
constexpr size_t WS_CTL   = 0;
constexpr size_t CTL_BYTES = 196608;
constexpr size_t WS_ADAP  = WS_CTL + CTL_BYTES;
constexpr size_t WS_ADAF  = WS_ADAP + al256((size_t)16 * 8 * 6144 * 4);
constexpr size_t WS_ROPE  = WS_ADAF + al256((size_t)8 * 6144 * 4);
constexpr size_t WS_WDFT  = WS_ROPE + al256((size_t)2 * 2048 * 16 * 4);
constexpr size_t WS_D64T  = WS_WDFT + al256((size_t)2048 * 4096 * 2);
constexpr size_t WS_WR3   = WS_D64T + al256((size_t)128 * 64 * 2);
constexpr size_t WS_WUQ   = WS_WR3 + al256((size_t)3072 * 256 * 4);
constexpr size_t WS_WUKV  = WS_WUQ + al256((size_t)256 * 768 * 4);
constexpr size_t WS_H     = WS_WUKV + al256((size_t)128 * 1024 * 4);
constexpr size_t WS_H2LO  = WS_H + al256((size_t)T * 1024 * 2);
constexpr size_t WS_ZQKV  = WS_H2LO + al256((size_t)T * 1024 * 2);
constexpr size_t WS_ZF    = WS_ZQKV + al256((size_t)T * 416 * 2);
constexpr size_t WS_SIG   = WS_ZF + al256((size_t)T * 512 * 2);
constexpr size_t WS_RSTD  = WS_SIG + al256((size_t)T * 2048 * 2);
constexpr size_t WS_XT    = WS_RSTD + al256((size_t)2 * T * 4);
constexpr size_t WS_QRAW  = WS_XT + al256((size_t)4096 * 4096 * 2);
constexpr size_t WS_KNRAW = WS_QRAW + al256((size_t)T * 768 * 4);
constexpr size_t WS_Q     = WS_KNRAW + al256((size_t)T * 512 * 4);
constexpr size_t WS_K     = WS_Q + al256((size_t)T * 768 * 2);
constexpr size_t WS_VT    = WS_K + al256((size_t)T * 768 * 2);
constexpr size_t WS_O     = WS_VT + al256((size_t)T * 512 * 2);
constexpr size_t WS_F     = WS_O + al256((size_t)T * 512 * 2);
constexpr size_t WS_MERGED= WS_F + al256((size_t)T * 512 * 2);
constexpr size_t WS_X1    = WS_MERGED + al256((size_t)T * 1024 * 2);
constexpr size_t WS_LOGIT = WS_X1 + al256((size_t)T * 1024 * 4);
constexpr size_t WS_ACTS  = WS_LOGIT + al256((size_t)T * 256 * 4);
constexpr size_t WS_LTOK  = WS_ACTS + al256((size_t)T * 256 * 2);
constexpr size_t WS_LW    = WS_LTOK + al256((size_t)NE * LCAP * 4);
constexpr size_t WS_ACT   = WS_LW + al256((size_t)NE * LCAP * 4);
constexpr size_t WS_YBUF  = WS_ACT + al256((size_t)T * 8 * 256 * 2);
constexpr size_t WS_WB_IN = WS_YBUF + al256((size_t)T * 8 * 1024 * 2);
constexpr size_t WS_WB_PA = WS_WB_IN + al256((size_t)3072 * 1024 * 2);
constexpr size_t WS_WB_PF = WS_WB_PA + al256((size_t)1024 * 512 * 2);
constexpr size_t WS_WB_OUT= WS_WB_PF + al256((size_t)1024 * 512 * 2);
constexpr size_t WS_WB_SH = WS_WB_OUT + al256((size_t)1024 * 1024 * 2);
constexpr size_t WS_WB_SD = WS_WB_SH + al256((size_t)512 * 1024 * 2);
constexpr size_t WS_WB_R  = WS_WB_SD + al256((size_t)1024 * 256 * 2);
constexpr size_t WS_A3    = WS_WB_R + al256((size_t)256 * 3072 * 2);
constexpr size_t WS_END   = WS_A3 + al256((size_t)T * 3072 * 2);

constexpr int CW_CNT = 16384;
constexpr int CW_QUEUE = 4400;
constexpr int CW_BAR = 0;

constexpr int LDS_GEMM = 2 * 65536;
constexpr int ST16 = 520, ST32 = 1040;
constexpr int LDS_STAGE = 256 * ST16;
constexpr int LDS_MISC = 140288;
constexpr int LDS_BYTES = LDS_MISC + 8192;

typedef __bf16 bf16x2_t __attribute__((ext_vector_type(2)));
typedef float f32x2_t __attribute__((ext_vector_type(2)));
__device__ __forceinline__ unsigned cvt_pk_bf16(float lo, float hi) { f32x2_t f = {lo, hi}; bf16x2_t h = __builtin_convertvector(f, bf16x2_t); return __builtin_bit_cast(unsigned, h); }
__device__ __forceinline__ bf16_t f2bf(float v) { __bf16 h = (__bf16)v; return __builtin_bit_cast(unsigned short, h); }
__device__ __forceinline__ float bf2f(bf16_t b) { return __uint_as_float(((unsigned)b) << 16); }
__device__ __forceinline__ float sigmoidf_(float v) { return 1.f / (1.f + __expf(-v)); }
__device__ __forceinline__ float siluf_(float v) { return v / (1.f + __expf(-v)); }
__device__ __forceinline__ float wave_sum(float v) {
#pragma unroll
    for (int o = 32; o > 0; o >>= 1) v += __shfl_xor(v, o);
    return v;
}
__device__ __forceinline__ int swz(int row) { return ((row >> 1) & 7) ^ ((row >> 4) & 1); }

#define XB_TMO      128
#define XB_XCNT(j)  (256  + 64 * (j))
#define XB_XSUB(j)  (1280 + 64 * (j))
#define XB_XGEN(j)  (2304 + 64 * (j))
#define XB_TOP      3328
#define XB_TOPGEN   3392
#define XCD_BAR_WORDS 3456
#define XB_SPIN_CAP (1u << 22)
#define LAS __attribute__((address_space(3)))
__device__ __forceinline__ unsigned xb_ld(unsigned* p)              { return __hip_atomic_load(p, __ATOMIC_RELAXED, __HIP_MEMORY_SCOPE_AGENT); }
__device__ __forceinline__ unsigned xb_add(unsigned* p, unsigned v) { return __hip_atomic_fetch_add(p, v, __ATOMIC_RELAXED, __HIP_MEMORY_SCOPE_AGENT); }
__device__ __forceinline__ unsigned xb_xcc_id() { return (unsigned)__builtin_amdgcn_s_getreg((3 << 11) | 20) & 0xFu; }
#define XB_SPIN(cond, bar) do { unsigned _sp = 0; while (cond) { __builtin_amdgcn_s_sleep(1); \
    if ((++_sp & 255u) == 0u) { if (xb_ld(&(bar)[XB_TMO])) break; if (_sp > XB_SPIN_CAP) { atomicAdd(&(bar)[XB_TMO], 1u); break; } } } } while (0)
struct XcdBarrier { unsigned* bar; unsigned x; volatile LAS unsigned* st; };
__device__ __forceinline__ XcdBarrier xcd_barrier_post(unsigned* bar, volatile LAS unsigned* st) {
    XcdBarrier b; b.bar = bar; b.x = xb_xcc_id(); b.st = st;
    if (threadIdx.x == 0) (void)xb_add(&bar[XB_XCNT(b.x)], 1u);
    return b;
}
__device__ __forceinline__ void xcd_barrier_complete(unsigned* bar, unsigned x, unsigned& nloc, unsigned& nx) {
    const unsigned G = gridDim.x * gridDim.y * gridDim.z;
    unsigned sum, cnt, mine, sp = 0u;
    for (;;) {
        sum = 0u; cnt = 0u; mine = 0u;
#pragma unroll
        for (unsigned j = 0; j < 16; ++j) { const unsigned c = xb_ld(&bar[XB_XCNT(j)]); sum += c; cnt += (c > 0u) ? 1u : 0u; mine = (j == x) ? c : mine; }
        if (sum == G) break;
        __builtin_amdgcn_s_sleep(1);
        if ((++sp & 255u) == 0u) { if (xb_ld(&bar[XB_TMO])) break; if (sp > XB_SPIN_CAP) { atomicAdd(&bar[XB_TMO], 1u); break; } }
    }
    nloc = mine > 0u ? mine : 1u; nx = cnt > 0u ? cnt : 1u;
}
__device__ __forceinline__ void xcd_barrier(const XcdBarrier& b) {
    asm volatile("s_waitcnt vmcnt(0)" ::: "memory");
    __syncthreads();
    if (threadIdx.x == 0) {
        unsigned* bar = b.bar;
        __builtin_amdgcn_s_waitcnt(0);
        unsigned nloc = b.st[0], nx = b.st[1];
        if (nloc == 0u) { xcd_barrier_complete(bar, b.x, nloc, nx); b.st[0] = nloc; b.st[1] = nx; }
        const unsigned old = xb_add(&bar[XB_XSUB(b.x)], 1u);
        const unsigned gen = old / nloc;
        if (old + 1u == (gen + 1u) * nloc) {
            __builtin_amdgcn_fence(__ATOMIC_RELEASE, "agent");
            asm volatile("s_waitcnt vmcnt(0)" ::: "memory");
            const unsigned og = xb_add(&bar[XB_TOP], 1u);
            const unsigned tg = og / nx;
            if (og + 1u == (tg + 1u) * nx) xb_add(&bar[XB_TOPGEN], 1u);
            else XB_SPIN(xb_ld(&bar[XB_TOPGEN]) == tg, bar);
            __builtin_amdgcn_fence(__ATOMIC_ACQUIRE, "agent");
            xb_add(&bar[XB_XGEN(b.x)], 1u);
            asm volatile("s_waitcnt vmcnt(0)" ::: "memory");
        } else {
            XB_SPIN(xb_ld(&bar[XB_XGEN(b.x)]) == gen, bar);
            __builtin_amdgcn_fence(__ATOMIC_ACQUIRE, "agent");
            asm volatile("s_waitcnt vmcnt(0)" ::: "memory");
        }
    }
    __syncthreads();
}

template <int MI, bool TR, class AF, class BF>
__device__ __forceinline__ void gemm_core(f32x16 (&acc)[MI][2], const AF& af, const BF& bf, const int nk, unsigned char* lds) {
    constexpr int BM = 64 * MI;
    constexpr int A_BYTES = BM * 128, STAGE = A_BYTES + 256 * 128;
    const int t = threadIdx.x, lane = t & 63, w = t >> 6, wm = w >> 2, wn = w & 3;
    const int l31 = lane & 31, hh = lane >> 5;
    const int ch = t & 7, r0 = t >> 3;
    const bf16_t* abase = af.base();
    unsigned aoff[MI];
#pragma unroll
    for (int i = 0; i < MI; ++i) aoff[i] = af.off(r0 + 64 * i);
    const int a_lds = r0 * 128 + ((ch ^ swz(r0)) << 4);
    u32x4 areg[MI];
    f32x4 bregf[8]; u32x4 bregh[4];
    unsigned boff[4];
    const float* bcolf = nullptr;
    if constexpr (BF::KN) { bcolf = bf.col(4 * lane); }
    else {
#pragma unroll
        for (int i = 0; i < 4; ++i) boff[i] = bf.off(r0 + 64 * i);
    }
    auto gload = [&](int kt) {
        const long ko = af.koff(kt) + ch * 8;
#pragma unroll
        for (int i = 0; i < MI; ++i) areg[i] = *(const u32x4*)(abase + aoff[i] + ko);
        if constexpr (BF::KN) {
            const float* bp = bcolf + (long)(kt * 64 + w * 8) * bf.ldb;
#pragma unroll
            for (int i = 0; i < 8; ++i) bregf[i] = *(const f32x4*)(bp + (long)i * bf.ldb);
        } else {
            const bf16_t* bp = bf.base() + bf.koff(kt) + ch * 8;
#pragma unroll
            for (int i = 0; i < 4; ++i) bregh[i] = *(const u32x4*)(bp + boff[i]);
        }
    };
    auto lstore = [&](int st) {
        unsigned char* base = lds + st * STAGE;
#pragma unroll
        for (int i = 0; i < MI; ++i) *(u32x4*)(base + a_lds + i * 64 * 128) = areg[i];
        unsigned char* bb = base + A_BYTES;
        if constexpr (BF::KN) {
#pragma unroll
            for (int cc = 0; cc < 4; ++cc) {
                const int col = 4 * lane + cc;
                u32x4 v; v.x = cvt_pk_bf16(bregf[0][cc], bregf[1][cc]); v.y = cvt_pk_bf16(bregf[2][cc], bregf[3][cc]);
                v.z = cvt_pk_bf16(bregf[4][cc], bregf[5][cc]); v.w = cvt_pk_bf16(bregf[6][cc], bregf[7][cc]);
                *(u32x4*)(bb + col * 128 + ((w ^ swz(col)) << 4)) = v;
            }
        } else {
#pragma unroll
            for (int i = 0; i < 4; ++i) *(u32x4*)(bb + a_lds + i * 64 * 128) = bregh[i];
        }
    };
    const int fsw = swz(l31);
    const int a_frag = (wm * 32 * MI + l31) * 128, b_frag = (wn * 64 + l31) * 128;
    auto compute = [&](int st) {
        const unsigned char* base = lds + st * STAGE;
        const unsigned char* bb = base + A_BYTES;
#if NAIVE_MMA
#pragma unroll
        for (int mi = 0; mi < MI; ++mi)
#pragma unroll
            for (int ni = 0; ni < 2; ++ni)
#pragma unroll
                for (int rg = 0; rg < 16; ++rg) {
                    const int row = TR ? (wm * 32 * MI + mi * 32 + l31) : (wm * 32 * MI + mi * 32 + (rg & 3) + 8 * (rg >> 2) + 4 * hh);
                    const int col = TR ? (wn * 64 + ni * 32 + (rg & 3) + 8 * (rg >> 2) + 4 * hh) : (wn * 64 + ni * 32 + l31);
                    float s = 0.f;
                    for (int k = 0; k < 64; ++k) {
                        const bf16_t av = *(const bf16_t*)(base + row * 128 + (((k >> 3) ^ swz(row)) << 4) + (k & 7) * 2);
                        const bf16_t bv = *(const bf16_t*)(bb + col * 128 + (((k >> 3) ^ swz(col)) << 4) + (k & 7) * 2);
                        s += bf2f(av) * bf2f(bv);
                    }
                    acc[mi][ni][rg] += s;
                }
#else
#pragma unroll 2
        for (int s = 0; s < 4; ++s) {
            const int pos = ((2 * s + hh) ^ fsw) << 4;
            bf16x8 bfr[2];
#pragma unroll
            for (int ni = 0; ni < 2; ++ni) bfr[ni] = *(const bf16x8*)(bb + b_frag + ni * 32 * 128 + pos);
#pragma unroll
            for (int mi = 0; mi < MI; ++mi) {
                const bf16x8 afr = *(const bf16x8*)(base + a_frag + mi * 32 * 128 + pos);
#pragma unroll
                for (int ni = 0; ni < 2; ++ni) acc[mi][ni] = TR ? __builtin_amdgcn_mfma_f32_32x32x16_bf16(bfr[ni], afr, acc[mi][ni], 0, 0, 0)
                                                               : __builtin_amdgcn_mfma_f32_32x32x16_bf16(afr, bfr[ni], acc[mi][ni], 0, 0, 0);
            }
        }
#endif
    };
    int nk_ = nk; asm volatile("" : "+s"(nk_));
    __syncthreads();
    gload(0);
    lstore(0);
    __syncthreads();
#pragma unroll 1
    for (int kt = 0; kt < nk_; ++kt) {
        const bool more = (kt + 1 < nk_);
        if (more) gload(kt + 1);
        compute(kt & 1);
        if (more) lstore((kt + 1) & 1);
        __syncthreads();
    }
}

template <int MI> __device__ __forceinline__ void zero_acc(f32x16 (&acc)[MI][2]) {
#pragma unroll
    for (int mi = 0; mi < MI; ++mi)
#pragma unroll
        for (int ni = 0; ni < 2; ++ni)
#pragma unroll
            for (int r = 0; r < 16; ++r) acc[mi][ni][r] = 0.f;
}
template <int MI, class EPI>
__device__ __forceinline__ void run_epilogue(const f32x16 (&acc)[MI][2], const EPI& epi) {
    const int t = threadIdx.x, lane = t & 63, w = t >> 6, wm = w >> 2, wn = w & 3, l31 = lane & 31, hh = lane >> 5;
#pragma unroll
    for (int mi = 0; mi < MI; ++mi)
#pragma unroll
        for (int rg = 0; rg < 16; ++rg) {
            const int r = wm * 32 * MI + mi * 32 + (rg & 3) + 8 * (rg >> 2) + 4 * hh;
            epi(r, wn * 64 + l31, acc[mi][0][rg], acc[mi][1][rg]);
            if ((rg & 7) == 7) __builtin_amdgcn_sched_barrier(0);
        }
}

template <int MI, class EPI>
__device__ __forceinline__ void run_epilogue_tr(const f32x16 (&acc)[MI][2], const EPI& epi) {
    const int t = threadIdx.x, lane = t & 63, w = t >> 6, wm = w >> 2, wn = w & 3, l31 = lane & 31, hh = lane >> 5;
#pragma unroll
    for (int mi = 0; mi < MI; ++mi) {
        const int r = wm * 32 * MI + mi * 32 + l31;
#pragma unroll
        for (int q4 = 0; q4 < 4; ++q4) {
            const f32x4 v0 = {acc[mi][0][4 * q4], acc[mi][0][4 * q4 + 1], acc[mi][0][4 * q4 + 2], acc[mi][0][4 * q4 + 3]};
            const f32x4 v1 = {acc[mi][1][4 * q4], acc[mi][1][4 * q4 + 1], acc[mi][1][4 * q4 + 2], acc[mi][1][4 * q4 + 3]};
            epi(r, wn * 64 + 8 * q4 + 4 * hh, v0, v1);
        }
        __builtin_amdgcn_sched_barrier(0);
    }
}
__device__ __forceinline__ u32x2 pack4(const f32x4 v) { u32x2 p; p.x = cvt_pk_bf16(v[0], v[1]); p.y = cvt_pk_bf16(v[2], v[3]); return p; }
__device__ __forceinline__ f32x4 unpack4(const u32x2 p) { f32x4 v = {__uint_as_float(p.x << 16), __uint_as_float(p.x & 0xffff0000u), __uint_as_float(p.y << 16), __uint_as_float(p.y & 0xffff0000u)}; return v; }

__device__ __forceinline__ unsigned pack_fp8x4(const f32x4 v) { int p = __builtin_amdgcn_cvt_pk_fp8_f32(v[0], v[1], 0, false); p = __builtin_amdgcn_cvt_pk_fp8_f32(v[2], v[3], p, true); return (unsigned)p; }
__device__ __forceinline__ f32x4 unpack_fp8x4(const unsigned p) { f32x4 v = {__builtin_amdgcn_cvt_f32_fp8((int)p, 0), __builtin_amdgcn_cvt_f32_fp8((int)p, 1), __builtin_amdgcn_cvt_f32_fp8((int)p, 2), __builtin_amdgcn_cvt_f32_fp8((int)p, 3)}; return v; }
template <int MI> __device__ __forceinline__ void stage_bf16(const f32x16 (&acc)[MI][2], unsigned char* lds) {
    const int t = threadIdx.x, lane = t & 63, w = t >> 6, wm = w >> 2, wn = w & 3, l31 = lane & 31, hh = lane >> 5;
#pragma unroll
    for (int mi = 0; mi < MI; ++mi) {
        unsigned char* rp = lds + (wm * 32 * MI + mi * 32 + l31) * ST16 + (wn * 64 + 4 * hh) * 2;
#pragma unroll
        for (int ni = 0; ni < 2; ++ni)
#pragma unroll
            for (int q4 = 0; q4 < 4; ++q4) {
                const f32x4 v = {acc[mi][ni][4 * q4], acc[mi][ni][4 * q4 + 1], acc[mi][ni][4 * q4 + 2], acc[mi][ni][4 * q4 + 3]};
                *(u32x2*)(rp + (ni * 32 + 8 * q4) * 2) = pack4(v);
            }
    }
}
__device__ __forceinline__ void stage_f32(const f32x16 (&acc)[2][2], unsigned char* lds) {
    const int t = threadIdx.x, lane = t & 63, w = t >> 6, wm = w >> 2, wn = w & 3, l31 = lane & 31, hh = lane >> 5;
#pragma unroll
    for (int mi = 0; mi < 2; ++mi) {
        unsigned char* rp = lds + (wm * 64 + mi * 32 + l31) * ST32 + (wn * 64 + 4 * hh) * 4;
#pragma unroll
        for (int ni = 0; ni < 2; ++ni)
#pragma unroll
            for (int q4 = 0; q4 < 4; ++q4) {
                const f32x4 v = {acc[mi][ni][4 * q4], acc[mi][ni][4 * q4 + 1], acc[mi][ni][4 * q4 + 2], acc[mi][ni][4 * q4 + 3]};
                *(f32x4*)(rp + (ni * 32 + 8 * q4) * 4) = v;
            }
    }
}

struct ARows { const bf16_t* b; unsigned lda; int m0;
    __device__ __forceinline__ const bf16_t* base() const { return b; }
    __device__ __forceinline__ unsigned off(int r) const { return (unsigned)(m0 + r) * lda; }
    __device__ __forceinline__ long koff(int kt) const { return (long)kt * 64; } };
struct BKN { const float* b; int ldb; int n0; int nvalid; static constexpr bool KN = true;
    __device__ __forceinline__ const float* col(int c) const { int cc = n0 + c; cc = (cc < nvalid) ? cc : (nvalid - 4); return b + cc; } };
struct BKNPair { const float* g; long u_minus_g; int ldb; static constexpr bool KN = true;
    __device__ __forceinline__ const float* col(int c) const { return g + (long)((c >> 5) & 1) * u_minus_g + (c >> 6) * 32 + (c & 31); } };
struct BNK { const bf16_t* b; unsigned ldb; int n0; static constexpr bool KN = false;
    __device__ __forceinline__ const bf16_t* base() const { return b; }
    __device__ __forceinline__ unsigned off(int c) const { return (unsigned)(n0 + c) * ldb; }
    __device__ __forceinline__ long koff(int kt) const { return (long)kt * 64; } };

namespace pg8 {
#define PG8_LAS __attribute__((address_space(3)))
typedef unsigned short bf16_t;
typedef short bf16x8 __attribute__((ext_vector_type(8)));
typedef float f32x4 __attribute__((ext_vector_type(4)));
typedef unsigned u32x4 __attribute__((ext_vector_type(4)));
constexpr int BM = 256, BK = 64, HALF = 128, HTB = HALF * BK * 2  , STAGE_BYTES = 8 * HTB, NXCD = 8, WGM = 8;

__host__ __device__ __forceinline__ int lds_byte(int r, int c) { const int st = (r >> 4) * 2 + (c >> 5), rr = r & 15, cc = c & 31, ob = rr * 64 + cc * 2; return st * 1024 + (ob ^ (((ob >> 9) & 1) << 5)); }
__host__ __device__ __forceinline__ void stage_rc(int b, int& R, int& C) { const int st = b / 1024, sb = b % 1024, swz = sb ^ (((sb >> 9) & 1) << 5); R = (st >> 1) * 16 + swz / 64; C = (st & 1) * 32 + (swz % 64) / 2; }
__host__ __device__ __forceinline__ int perm32(int rho) { const int n = rho >> 4, i = rho & 15; return 8 * (i >> 2) + 4 * n + (i & 3); }

struct Unit { int pm, pn; };
struct Gemm { const bf16_t* A; const bf16_t* Bt; int M, N, K; int lda; int ldb; };

struct StaticOrder {
    int nM, nN, nwg, G, c;
    __host__ __device__ void init(int M, int N, int G_, int c_) { nM = M / BM; nN = N / BM; nwg = nM * nN; G = G_; c = c_; }
    __host__ __device__ bool next(int i, Unit& u) const {
        const long L = (long)i * G + c; if (L >= nwg) return false;
        int wgid = (int)L; { const int q = nwg / NXCD, r = nwg % NXCD, xcd = wgid % NXCD, off = wgid / NXCD; wgid = (xcd < r ? xcd * (q + 1) : r * (q + 1) + (xcd - r) * q) + off; }
        const int nig = WGM * nN, gid = wgid / nig, fm = gid * WGM, gsz = (nM - fm) < WGM ? (nM - fm) : WGM;
        u.pm = fm + ((wgid % nig) % gsz); u.pn = (wgid % nig) / gsz; return true;
    }
    __device__ __forceinline__ void a_ready(const Unit&) const {}
    __device__ __forceinline__ void done(const Unit&) const {}
};
template <class Epi, class Sched, bool ALIGN_EPI = false, bool SP2 = false>
__device__ __forceinline__ void gemm_phase(PG8_LAS unsigned char* lds, const Gemm g, const Sched& S, const Epi& E) {
    const int tid = threadIdx.x, wid = __builtin_amdgcn_readfirstlane(tid >> 6), lane = tid & 63, wr = wid >> 2, wc = wid & 3, fr = lane & 15, fq = lane >> 4;
    const int K = g.K, nt = K / BK, LDA = g.lda ? g.lda : g.K, LDB = g.ldb ? g.ldb : g.K;
    unsigned voffA[2], voffB[2];
#pragma unroll
    for (int i = 0; i < 2; ++i) { int R, C; stage_rc(tid * 16 + i * 8192, R, C); const int Rb = Epi::PERM ? ((R & ~31) + perm32(R & 31)) : R;
        voffA[i] = (unsigned)(R * LDA + C) * 2u; voffB[i] = (unsigned)(Rb * LDB + C) * 2u; }
    const size_t kstep = (size_t)(BK * 2);
    const size_t hstep = (size_t)HALF * LDB * 2;
    const size_t tstep = 2 * hstep;
    const size_t hstepA = (size_t)HALF * LDA * 2, tstepA = 2 * hstepA;
    const unsigned ldsw = (unsigned)wid * 1024u;
    const int aoff = lds_byte(wr * 64 + fr, fq * 8), boff = lds_byte(wc * 32 + fr, fq * 8);
#define PG8_SA(b, h) (((b) * 2 + (h)) * HTB)
#define PG8_SB(b, h) ((4 + (b) * 2 + (h)) * HTB)
#define PG8_STAGE(bufoff, gbase, voff) do { _Pragma("unroll") for (int _i = 0; _i < 2; ++_i) \
        __builtin_amdgcn_global_load_lds((const unsigned*)((const char*)(gbase) + (voff)[_i]), (PG8_LAS unsigned*)(lds + (bufoff) + ldsw + _i * 8192), 16, 0, 0); } while (0)
#define PG8_LDA(dst, b, h) do { _Pragma("unroll") for (int m = 0; m < 4; ++m) _Pragma("unroll") for (int k = 0; k < 2; ++k) dst[m][k] = *(const PG8_LAS bf16x8*)(lds + PG8_SA(b, h) + aoff + m * 2048 + k * 1024); } while (0)
#define PG8_LDB(dst, b, h) do { _Pragma("unroll") for (int n = 0; n < 2; ++n) _Pragma("unroll") for (int k = 0; k < 2; ++k) dst[n][k] = *(const PG8_LAS bf16x8*)(lds + PG8_SB(b, h) + boff + n * 2048 + k * 1024); } while (0)
#define PG8_MMA(ai, bj, At, Bt) do { __builtin_amdgcn_s_setprio(1); _Pragma("unroll") for (int m = 0; m < 4; ++m) _Pragma("unroll") for (int n = 0; n < 2; ++n) _Pragma("unroll") for (int k = 0; k < 2; ++k) \
        acc[ai][bj][m][n] = __builtin_amdgcn_mfma_f32_16x16x32_bf16(Bt[n][k], At[m][k], acc[ai][bj][m][n], 0, 0, 0); __builtin_amdgcn_s_setprio(0); } while (0)
#define PG8_WAIT_V(n) asm volatile("s_waitcnt vmcnt(" #n ")" ::: "memory")
#define PG8_WAIT_L(n) asm volatile("s_waitcnt lgkmcnt(" #n ")" ::: "memory")
#define PG8_BAR __builtin_amdgcn_s_barrier()
#define PG8_SCHED __builtin_amdgcn_sched_barrier(0)
    Unit cur, nxt; int ui = 0;
    if (!S.next(0, cur)) return;
    f32x4 acc[2][2][4][2];
#pragma unroll
    for (int a = 0; a < 2; ++a)
#pragma unroll
        for (int b = 0; b < 2; ++b)
#pragma unroll
            for (int m = 0; m < 4; ++m)
#pragma unroll
                for (int n = 0; n < 2; ++n) acc[a][b][m][n] = (f32x4){0.f, 0.f, 0.f, 0.f};
    bf16x8 At[4][2], B0[2][2], B1[2][2];
    const char* cA = (const char*)g.A + (size_t)cur.pm * tstepA; const char* cB = (const char*)g.Bt + (size_t)cur.pn * tstep;
    S.a_ready(cur);
    if constexpr (SP2) {
        PG8_STAGE(PG8_SB(0, 0), cB, voffB); PG8_STAGE(PG8_SB(0, 1), cB + hstep, voffB); PG8_STAGE(PG8_SA(0, 0), cA, voffA); PG8_STAGE(PG8_SA(0, 1), cA + hstepA, voffA);
        if (wr == 1) PG8_BAR;
        PG8_WAIT_V(2); PG8_BAR;
        PG8_STAGE(PG8_SB(1, 0), cB + kstep, voffB); PG8_STAGE(PG8_SA(1, 0), cA + kstep, voffA); PG8_STAGE(PG8_SB(1, 1), cB + hstep + kstep, voffB);
        PG8_WAIT_V(6); PG8_BAR;
    } else {
        PG8_STAGE(PG8_SB(0, 0), cB, voffB); PG8_STAGE(PG8_SA(0, 0), cA, voffA); PG8_STAGE(PG8_SB(0, 1), cB + hstep, voffB); PG8_STAGE(PG8_SA(0, 1), cA + hstepA, voffA);
        if (wr == 1) PG8_BAR;
        PG8_WAIT_V(4); PG8_BAR;
        PG8_STAGE(PG8_SB(1, 0), cB + kstep, voffB); PG8_STAGE(PG8_SA(1, 0), cA + kstep, voffA); PG8_STAGE(PG8_SB(1, 1), cB + hstep + kstep, voffB);
        PG8_WAIT_V(6); PG8_BAR;
    }
    for (;;) {
        const bool has_next = S.next(ui + 1, nxt);
        const char* nA = has_next ? (const char*)g.A + (size_t)nxt.pm * tstepA : cA; const char* nB = has_next ? (const char*)g.Bt + (size_t)nxt.pn * tstep : cB;
        for (int t = 0; t < nt; t += 2) {
            const bool last = (t == nt - 2);
            const char* a1 = cA + (size_t)(t + 1) * kstep;
            const char* a2 = last ? nA : cA + (size_t)(t + 2) * kstep; const char* b2 = last ? nB : cB + (size_t)(t + 2) * kstep;
            const char* a3 = a2 + kstep; const char* b3 = b2 + kstep;
            if (last && has_next) S.a_ready(nxt);
            if constexpr (SP2) {
            PG8_LDB(B0, 0, 0); PG8_LDB(B1, 0, 1); PG8_SCHED; PG8_LDA(At, 0, 0); PG8_STAGE(PG8_SA(1, 1), a1 + hstepA, voffA);
            PG8_WAIT_V(8); PG8_WAIT_L(0); PG8_BAR; PG8_MMA(0, 0, At, B0); PG8_MMA(0, 1, At, B1); PG8_BAR; PG8_SCHED;
            PG8_LDA(At, 0, 1); PG8_STAGE(PG8_SB(0, 0), b2, voffB); PG8_STAGE(PG8_SB(0, 1), b2 + hstep, voffB); PG8_STAGE(PG8_SA(0, 0), a2, voffA);
            PG8_WAIT_V(8); PG8_WAIT_L(0); PG8_BAR; PG8_MMA(1, 0, At, B0); PG8_MMA(1, 1, At, B1); PG8_BAR; PG8_SCHED;
            PG8_LDB(B0, 1, 0); PG8_LDB(B1, 1, 1); PG8_SCHED; PG8_LDA(At, 1, 0); PG8_STAGE(PG8_SA(0, 1), a2 + hstepA, voffA);
            PG8_WAIT_V(8); PG8_WAIT_L(0); PG8_BAR; PG8_MMA(0, 0, At, B0); PG8_MMA(0, 1, At, B1); PG8_BAR; PG8_SCHED;
            PG8_LDA(At, 1, 1); PG8_STAGE(PG8_SB(1, 0), b3, voffB); PG8_STAGE(PG8_SB(1, 1), b3 + hstep, voffB); PG8_STAGE(PG8_SA(1, 0), a3, voffA);
            PG8_WAIT_V(8); PG8_WAIT_L(0); PG8_BAR; PG8_MMA(1, 0, At, B0); PG8_MMA(1, 1, At, B1); PG8_BAR; PG8_SCHED;
            } else {
            PG8_LDB(B0, 0, 0); PG8_SCHED; PG8_LDA(At, 0, 0); PG8_STAGE(PG8_SA(1, 1), a1 + hstepA, voffA);
            PG8_WAIT_L(8); PG8_BAR; PG8_WAIT_L(0); PG8_MMA(0, 0, At, B0); PG8_BAR; PG8_SCHED;
            PG8_LDB(B1, 0, 1); PG8_STAGE(PG8_SB(0, 0), b2, voffB);
            PG8_BAR; PG8_WAIT_L(0); PG8_MMA(0, 1, At, B1); PG8_BAR;
            PG8_LDA(At, 0, 1); PG8_STAGE(PG8_SA(0, 0), a2, voffA);
            PG8_BAR; PG8_WAIT_L(0); PG8_MMA(1, 0, At, B0); PG8_BAR; PG8_SCHED;
            PG8_STAGE(PG8_SB(0, 1), b2 + hstep, voffB);
            PG8_WAIT_V(6); PG8_BAR; PG8_MMA(1, 1, At, B1); PG8_BAR;
            PG8_LDB(B0, 1, 0); PG8_SCHED; PG8_LDA(At, 1, 0); PG8_STAGE(PG8_SA(0, 1), a2 + hstepA, voffA);
            PG8_WAIT_L(8); PG8_BAR; PG8_WAIT_L(0); PG8_MMA(0, 0, At, B0); PG8_BAR; PG8_SCHED;
            PG8_LDB(B1, 1, 1); PG8_STAGE(PG8_SB(1, 0), b3, voffB);
            PG8_BAR; PG8_WAIT_L(0); PG8_MMA(0, 1, At, B1); PG8_BAR;
            PG8_LDA(At, 1, 1); PG8_STAGE(PG8_SA(1, 0), a3, voffA);
            PG8_BAR; PG8_WAIT_L(0); PG8_MMA(1, 0, At, B0); PG8_BAR; PG8_SCHED;
            PG8_STAGE(PG8_SB(1, 1), b3 + hstep, voffB);
            PG8_WAIT_V(6); PG8_BAR; PG8_MMA(1, 1, At, B1); PG8_BAR;
            }
        }
        if constexpr (ALIGN_EPI) { if (wr == 0) PG8_BAR; }
        if constexpr (!Epi::AFTER_DRAIN) { E(acc, cur, wr, wc, fr, fq); S.done(cur); }
        if (!has_next) break;
#pragma unroll
        for (int a = 0; a < 2; ++a)
#pragma unroll
            for (int b = 0; b < 2; ++b)
#pragma unroll
                for (int m = 0; m < 4; ++m)
#pragma unroll
                    for (int n = 0; n < 2; ++n) acc[a][b][m][n] = (f32x4){0.f, 0.f, 0.f, 0.f};
        cur = nxt; cA = nA; cB = nB; ++ui;
        if constexpr (ALIGN_EPI) { if (wr == 1) PG8_BAR; }
    }
    PG8_WAIT_V(0);
    if constexpr (!ALIGN_EPI) { if (wr == 0) PG8_BAR; }
    PG8_BAR;
    if constexpr (Epi::AFTER_DRAIN) { E.fused(acc, cur, wr, wc, fr, fq, lds, wid, lane); S.done(cur); }
#undef PG8_SA
#undef PG8_SB
#undef PG8_STAGE
#undef PG8_LDA
#undef PG8_LDB
#undef PG8_MMA
#undef PG8_WAIT_V
#undef PG8_WAIT_L
#undef PG8_BAR
#undef PG8_SCHED
}
}


struct Args { const float* in[24]; float* out; unsigned char* ws; int ph_lo, ph_hi; };

struct Ctx {
    const Args& a; float* out; unsigned char* ws; unsigned char* lds; unsigned* ctl;
    int tid, lane, wave, G, vcu;
};

__device__ __forceinline__ u32x4 pack8(const f32x4 a, const f32x4 b) { u32x4 p; p.x = cvt_pk_bf16(a[0], a[1]); p.y = cvt_pk_bf16(a[2], a[3]); p.z = cvt_pk_bf16(b[0], b[1]); p.w = cvt_pk_bf16(b[2], b[3]); return p; }
__device__ __forceinline__ f32x4 unpack_lo(const u32x4 p) { f32x4 v = {__uint_as_float(p.x << 16), __uint_as_float(p.x & 0xffff0000u), __uint_as_float(p.y << 16), __uint_as_float(p.y & 0xffff0000u)}; return v; }
__device__ __forceinline__ f32x4 unpack_hi(const u32x4 p) { f32x4 v = {__uint_as_float(p.z << 16), __uint_as_float(p.z & 0xffff0000u), __uint_as_float(p.w << 16), __uint_as_float(p.w & 0xffff0000u)}; return v; }
#define EPI_LOOP(...) _Pragma("unroll") for (int ai = 0; ai < 2; ++ai) _Pragma("unroll") for (int m = 0; m < 4; ++m) { const unsigned row = row0 + ai * 128 + m * 16; \
    _Pragma("unroll") for (int bj = 0; bj < 2; ++bj) { const unsigned col = col0 + bj * 128; const f32x4 v0 = acc[ai][bj][m][0], v1 = acc[ai][bj][m][1]; __VA_ARGS__ } }
#define EPI_HEAD const unsigned row0 = u.pm * 256 + wr * 64 + fr; const unsigned col0 = u.pn * 256 + wc * 32 + 8 * fq;
struct EpiZ {
    static constexpr bool PERM = true, AFTER_DRAIN = false; bf16_t* zqkv; bf16_t* zf; bf16_t* sig;
    __device__ __forceinline__ void operator()(const f32x4 (&acc)[2][2][4][2], const pg8::Unit& u, int wr, int wc, int fr, int fq) const { EPI_HEAD
        EPI_LOOP(
            if (col < 416) *(u32x4*)(zqkv + row * 416u + col) = pack8(v0, v1);
            else if (col < 928) *(u32x4*)(zf + row * 512u + (col - 416)) = pack8(v0, v1);
            else if (col < INW) { const f32x4 s0 = {sigmoidf_(v0[0]), sigmoidf_(v0[1]), sigmoidf_(v0[2]), sigmoidf_(v0[3])}; const f32x4 s1 = {sigmoidf_(v1[0]), sigmoidf_(v1[1]), sigmoidf_(v1[2]), sigmoidf_(v1[3])};
                *(u32x4*)(sig + row * 2048u + (col - 928)) = pack8(s0, s1); } ) } };
struct EpiF {
    static constexpr bool PERM = true, AFTER_DRAIN = false; bf16_t* Fo;
    __device__ __forceinline__ void operator()(const f32x4 (&acc)[2][2][4][2], const pg8::Unit& u, int wr, int wc, int fr, int fq) const {
        const unsigned row0 = (u.pn >> 1) * 2048 + u.pm * 256 + wr * 64 + fr; const unsigned col0 = (u.pn & 1) * 256 + wc * 32 + 8 * fq;
        EPI_LOOP( *(u32x4*)(Fo + row * 512u + col) = pack8(v0, v1); ) } };
struct EpiMgA {
    static constexpr bool PERM = true, AFTER_DRAIN = false; bf16_t* mg; const bf16_t* sig;
    __device__ __forceinline__ void operator()(const f32x4 (&acc)[2][2][4][2], const pg8::Unit& u, int wr, int wc, int fr, int fq) const { EPI_HEAD
        EPI_LOOP( const u32x4 g = *(const u32x4*)(sig + row * 2048u + col); *(u32x4*)(mg + row * 1024u + col) = pack8(unpack_lo(g) * v0, unpack_hi(g) * v1); ) } };
struct EpiMgF {
    static constexpr bool PERM = true, AFTER_DRAIN = false; bf16_t* mg; const bf16_t* sig;
    __device__ __forceinline__ void operator()(const f32x4 (&acc)[2][2][4][2], const pg8::Unit& u, int wr, int wc, int fr, int fq) const { EPI_HEAD
        EPI_LOOP( const u32x4 g = *(const u32x4*)(sig + row * 2048u + 1024 + col); const u32x4 o = *(const u32x4*)(mg + row * 1024u + col);
            *(u32x4*)(mg + row * 1024u + col) = pack8(unpack_lo(o) + unpack_lo(g) * v0, unpack_hi(o) + unpack_hi(g) * v1); ) } };
struct EpiX1 {
    static constexpr bool PERM = true, AFTER_DRAIN = false; float* x1; const float* x; const float* adaf;
    __device__ __forceinline__ void operator()(const f32x4 (&acc)[2][2][4][2], const pg8::Unit& u, int wr, int wc, int fr, int fq) const { EPI_HEAD
        const float* g1 = adaf + (u.pm >> 3) * 6144 + 2 * 1024;
        EPI_LOOP( const f32x4 ga = *(const f32x4*)(g1 + col), gb = *(const f32x4*)(g1 + col + 4);
            *(f32x4*)(x1 + row * 1024u + col) = *(const f32x4*)(x + row * 1024u + col) + ga * v0; *(f32x4*)(x1 + row * 1024u + col + 4) = *(const f32x4*)(x + row * 1024u + col + 4) + gb * v1; ) } };
struct EpiSh {
    static constexpr bool PERM = true, AFTER_DRAIN = false; bf16_t* acts;
    __device__ __forceinline__ void operator()(const f32x4 (&acc)[2][2][4][2], const pg8::Unit& u, int wr, int wc, int fr, int fq) const { EPI_HEAD
        EPI_LOOP( const f32x4 a = {siluf_(v0[0]) * v1[0], siluf_(v0[1]) * v1[1], siluf_(v0[2]) * v1[2], siluf_(v0[3]) * v1[3]};
            *(u32x2*)(acts + row * 256u + (col >> 1)) = pack4(a); ) } };
struct EpiOut {
    static constexpr bool PERM = true, AFTER_DRAIN = false; float* out; const float* x1; const float* adaf; const bf16_t* ybuf;
    __device__ __forceinline__ void operator()(const f32x4 (&acc)[2][2][4][2], const pg8::Unit& u, int wr, int wc, int fr, int fq) const { EPI_HEAD
        const float* g2 = adaf + (u.pm >> 3) * 6144 + 5 * 1024;
        EPI_LOOP( f32x4 s0 = v0, s1 = v1;
            f32x4 r0 = {0.f, 0.f, 0.f, 0.f}, r1 = {0.f, 0.f, 0.f, 0.f};
            _Pragma("unroll") for (int k = 0; k < 8; ++k) { const u32x2 y = *(const u32x2*)((const unsigned char*)ybuf + (row * 8u + k) * 1024u + col); r0 += unpack_fp8x4(y.x); r1 += unpack_fp8x4(y.y); }
            s0 += r0 * 0.0625f; s1 += r1 * 0.0625f;
            *(f32x4*)(out + row * 1024u + col) = *(const f32x4*)(x1 + row * 1024u + col) + *(const f32x4*)(g2 + col) * s0;
            *(f32x4*)(out + row * 1024u + col + 4) = *(const f32x4*)(x1 + row * 1024u + col + 4) + *(const f32x4*)(g2 + col + 4) * s1;
            if (m == 1 || m == 3) __builtin_amdgcn_sched_barrier(0); ) } };

template <class GET> __device__ __forceinline__ void conv_wt(const Ctx& F, bf16_t* dst, int K, int Nd, const GET& get) {
    const long gt = (long)F.vcu * NTHREADS + F.tid, gs = (long)F.G * NTHREADS; const long nchunk = (long)Nd * (K / 8);
    for (long c = gt; c < nchunk; c += gs) { const int n = (int)(c % Nd), k0 = (int)(c / Nd) * 8;
        u32x4 p; p.x = cvt_pk_bf16(get(k0, n), get(k0 + 1, n)); p.y = cvt_pk_bf16(get(k0 + 2, n), get(k0 + 3, n)); p.z = cvt_pk_bf16(get(k0 + 4, n), get(k0 + 5, n)); p.w = cvt_pk_bf16(get(k0 + 6, n), get(k0 + 7, n));
        *(u32x4*)(dst + (long)n * K + k0) = p; }
}

__device__ __forceinline__ void p0_prep(const Ctx& F) {
    const float* c = F.a.in[1]; const float* w_ada = F.a.in[2];
    float* adap = (float*)(F.ws + WS_ADAP);
    float* sc = (float*)F.lds;
    float* red = sc + 512;
    for (int it = F.vcu; it < 256; it += F.G) {
        const int ks = it >> 4, chunk = it & 15;
        __syncthreads();
        { const int b = F.tid >> 6, k = F.tid & 63; sc[b * 64 + k] = siluf_(c[b * 1024 + ks * 64 + k]); }
        __syncthreads();
        const int cl = F.tid & 127, kq = F.tid >> 7;
        float acc[3][8];
#pragma unroll
        for (int j = 0; j < 3; ++j)
#pragma unroll
            for (int b = 0; b < 8; ++b) acc[j][b] = 0.f;
        const float* wp = w_ada + (long)(ks * 64 + kq * 16) * 6144 + chunk * 384 + cl;
#pragma unroll 8
        for (int k = 0; k < 16; ++k) {
            const float w0 = wp[k * 6144], w1 = wp[k * 6144 + 128], w2 = wp[k * 6144 + 256];
#pragma unroll
            for (int b = 0; b < 8; ++b) { const float sv = sc[b * 64 + kq * 16 + k]; acc[0][b] += sv * w0; acc[1][b] += sv * w1; acc[2][b] += sv * w2; }
        }
#pragma unroll
        for (int j = 0; j < 3; ++j)
#pragma unroll
            for (int b = 0; b < 8; ++b) red[(kq * 8 + b) * 384 + j * 128 + cl] = acc[j][b];
        __syncthreads();
        for (int o = F.tid; o < 8 * 384; o += NTHREADS) { const int b = o / 384, cc = o - b * 384;
            adap[((long)ks * 8 + b) * 6144 + chunk * 384 + cc] = (red[b * 384 + cc] + red[(8 + b) * 384 + cc]) + (red[(16 + b) * 384 + cc] + red[(24 + b) * 384 + cc]); }
    }
    const long gt = (long)F.vcu * NTHREADS + F.tid, gs = (long)F.G * NTHREADS;
    { float* rc = (float*)(F.ws + WS_ROPE); float* rs = rc + 2048 * 16;
      for (long i = gt; i < 2048 * 16; i += gs) { const int pos = (int)(i >> 4), j = (int)(i & 15);
          const float inv = powf(10000.0f, -(float)(2 * j) / 32.0f); const float ang = (float)pos * inv; rc[i] = cosf(ang); rs[i] = sinf(ang); } }
    { bf16_t* wd = (bf16_t*)(F.ws + WS_WDFT); const float nrm = 0.02209708691207961f;
      for (long g = gt; g < (long)2048 * 64; g += gs) { const int k = (int)(g >> 6), l = (int)(g & 63);
          const float cr = cospif((float)k * (1.0f / 1024.0f)), sr = sinpif((float)k * (1.0f / 1024.0f));
          const int idx0 = (k * (8 * l)) & 2047; const int q = k & 3;
          float c0 = cospif((float)idx0 * (1.0f / 1024.0f)) * nrm, s0 = sinpif((float)idx0 * (1.0f / 1024.0f)) * nrm;
#pragma unroll
          for (int i = 0; i < 4; ++i) {
              float cv[8], sv[8]; float cc = c0, ss = s0;
#pragma unroll
              for (int j = 0; j < 8; ++j) { cv[j] = cc; sv[j] = ss; const float cn = cc * cr - ss * sr; ss = ss * cr + cc * sr; cc = cn; }
              u32x4 pc, ps;
              pc.x = cvt_pk_bf16(cv[0], cv[1]); pc.y = cvt_pk_bf16(cv[2], cv[3]); pc.z = cvt_pk_bf16(cv[4], cv[5]); pc.w = cvt_pk_bf16(cv[6], cv[7]);
              ps.x = cvt_pk_bf16(sv[0], sv[1]); ps.y = cvt_pk_bf16(sv[2], sv[3]); ps.z = cvt_pk_bf16(sv[4], sv[5]); ps.w = cvt_pk_bf16(sv[6], sv[7]);
              *(u32x4*)(wd + (long)k * 4096 + 8 * l + 512 * i) = pc; *(u32x4*)(wd + (long)k * 4096 + 2048 + 8 * l + 512 * i) = ps;
              const float nc = (q == 0) ? c0 : (q == 1) ? -s0 : (q == 2) ? -c0 : s0;
              const float ns = (q == 0) ? s0 : (q == 1) ? c0 : (q == 2) ? -s0 : -c0;
              c0 = nc; s0 = ns;
          } } }
    { bf16_t* d6 = (bf16_t*)(F.ws + WS_D64T);
      for (long i = gt; i < 128 * 64; i += gs) { const int n = (int)(i >> 6), cc = (int)(i & 63), part = n >> 6, m = n & 63; const int idx = (m * cc) & 63;
          const float a = (float)idx * (1.0f / 32.0f); const float v = part ? -sinpif(a) : cospif(a); d6[i] = f2bf(v * 0.125f); } }
    { const float* wr = F.a.in[16];
      conv_wt(F, (bf16_t*)(F.ws + WS_WB_R), 3072, 256, [&](int k3, int n) { const int rg = k3 >> 10, k = k3 & 1023; const float wv = wr[k * 256 + n]; const float hi = bf2f(f2bf(wv)); return (rg == 2) ? (wv - hi) : hi; }); }
    { bf16_t* o = (bf16_t*)(F.ws + WS_WUQ); const float* g = F.a.in[6]; const float* wq = F.a.in[7];
      for (long i = gt; i < 8 * 96 * 256; i += gs) { const int k = (int)(i & 255), d = (int)((i >> 8) % 96), h = (int)(i / (96 * 256)); o[i] = f2bf(wq[k * 768 + h * 96 + d] * g[k]); } }
    { bf16_t* o = (bf16_t*)(F.ws + WS_WUKV); const float* g = F.a.in[8]; const float* wk = F.a.in[9];
      for (long i = gt; i < 8 * 128 * 128; i += gs) { const int k = (int)(i & 127), j = (int)((i >> 7) & 127), h = (int)(i >> 14); o[i] = f2bf(wk[k * 1024 + h * 128 + j] * g[k]); } }
    { const float* w = F.a.in[5];  conv_wt(F, (bf16_t*)(F.ws + WS_WB_IN), 1024, 3072, [&](int k, int n) { return (n < INW) ? w[(long)k * INW + n] : 0.f; }); }
    { const float* w = F.a.in[12]; conv_wt(F, (bf16_t*)(F.ws + WS_WB_PA), 512, 1024, [&](int k, int n) { return w[k * 1024 + n]; }); }
    { const float* w = F.a.in[13]; conv_wt(F, (bf16_t*)(F.ws + WS_WB_PF), 512, 1024, [&](int k, int n) { return w[k * 1024 + n]; }); }
    { const float* w = F.a.in[14]; conv_wt(F, (bf16_t*)(F.ws + WS_WB_OUT), 1024, 1024, [&](int k, int n) { return w[k * 1024 + n]; }); }
    { const float* wg = F.a.in[21]; const float* wu = F.a.in[22];
      conv_wt(F, (bf16_t*)(F.ws + WS_WB_SH), 1024, 512, [&](int k, int n) { const int j = (n >> 3) * 4 + (n & 3); return ((n >> 2) & 1) ? wu[k * 256 + j] : wg[k * 256 + j]; }); }
    { const float* w = F.a.in[23]; conv_wt(F, (bf16_t*)(F.ws + WS_WB_SD), 256, 1024, [&](int k, int n) { return w[k * 1024 + n]; }); }
}

__device__ __forceinline__ void p_norm_rows(const Ctx& F, int which) {
    const float* src = which ? (const float*)(F.ws + WS_X1) : F.a.in[0];
    const float* gain = which ? F.a.in[15] : F.a.in[4];
    const float* adap = (const float*)(F.ws + WS_ADAP); const float* b_ada = F.a.in[3];
    float* adaf = (float*)(F.ws + WS_ADAF);
    bf16_t* dhi = which ? (bf16_t*)(F.ws + WS_A3) : (bf16_t*)(F.ws + WS_H); const unsigned ldd = which ? 3072u : 1024u;
    float* smod = (float*)F.lds; float* sshift = smod + 1024;
    const int nitems = 256 + (which ? 0 : 8);
    for (int it = F.vcu; it < nitems; it += F.G) {
        if (it >= 256) {
            const int b = it - 256;
            for (int j = F.tid; j < 6144; j += NTHREADS) { float s = b_ada[j];
                for (int ks = 0; ks < 16; ++ks) s += adap[((long)ks * 8 + b) * 6144 + j];
                adaf[b * 6144 + j] = s; }
            continue;
        }
        const int b = it >> 5;
        __syncthreads();
        for (int cidx = F.tid; cidx < 1024; cidx += NTHREADS) {
            float sh, scv;
            if (which == 0) { sh = b_ada[cidx]; scv = b_ada[1024 + cidx];
                for (int ks = 0; ks < 16; ++ks) { sh += adap[((long)ks * 8 + b) * 6144 + cidx]; scv += adap[((long)ks * 8 + b) * 6144 + 1024 + cidx]; } }
            else { sh = adaf[b * 6144 + 3 * 1024 + cidx]; scv = adaf[b * 6144 + 4 * 1024 + cidx]; }
            smod[cidx] = gain[cidx] * (1.f + scv); sshift[cidx] = sh;
        }
        __syncthreads();
        for (int j = 0; j < 8; ++j) {
            const long row = (long)it * 64 + F.wave * 8 + j;
            f32x4 v[4]; float ss = 0.f;
#pragma unroll
            for (int i = 0; i < 4; ++i) { v[i] = *(const f32x4*)(src + row * 1024 + i * 256 + F.lane * 4); ss += v[i][0] * v[i][0] + v[i][1] * v[i][1] + v[i][2] * v[i][2] + v[i][3] * v[i][3]; }
            ss = wave_sum(ss);
            const float rstd = rsqrtf(ss * (1.0f / 1024.0f) + EPS);
#pragma unroll
            for (int i = 0; i < 4; ++i) {
                const int c0 = i * 256 + F.lane * 4; float hv[4];
#pragma unroll
                for (int e = 0; e < 4; ++e) hv[e] = v[i][e] * rstd * smod[c0 + e] + sshift[c0 + e];
                u32x2 pk; pk.x = cvt_pk_bf16(hv[0], hv[1]); pk.y = cvt_pk_bf16(hv[2], hv[3]);
                *(u32x2*)(dhi + row * ldd + c0) = pk;
                if (which) {
                    float lo[4];
                    lo[0] = hv[0] - __uint_as_float(pk.x << 16); lo[1] = hv[1] - __uint_as_float(pk.x & 0xffff0000u);
                    lo[2] = hv[2] - __uint_as_float(pk.y << 16); lo[3] = hv[3] - __uint_as_float(pk.y & 0xffff0000u);
                    u32x2 pl; pl.x = cvt_pk_bf16(lo[0], lo[1]); pl.y = cvt_pk_bf16(lo[2], lo[3]);
                    *(u32x2*)(dhi + row * ldd + 1024 + c0) = pl; *(u32x2*)(dhi + row * ldd + 2048 + c0) = pk;
                }
            }
        }
    }
}

__device__ __forceinline__ void p2_win(const Ctx& F) {
    pg8::Gemm g{(const bf16_t*)(F.ws + WS_H), (const bf16_t*)(F.ws + WS_WB_IN), T, 3072, 1024};
    pg8::StaticOrder S; S.init(T, 3072, F.G, (int)blockIdx.x);
    EpiZ E{(bf16_t*)(F.ws + WS_ZQKV), (bf16_t*)(F.ws + WS_ZF), (bf16_t*)(F.ws + WS_SIG)};
    pg8::gemm_phase<EpiZ, pg8::StaticOrder, true, true>((LAS unsigned char*)F.lds, g, S, E);
}

struct BKNq { const float* b; static constexpr bool KN = true; int ldb;
    __device__ __forceinline__ const float* col(int c) const { return b + ((c < 192) ? c : 188); } };
__device__ __forceinline__ void p3_mixer_inputs(const Ctx& F) {
    const bf16_t* zqkv = (const bf16_t*)(F.ws + WS_ZQKV);
    const int lane = F.lane, w = F.wave;
    {
        const bf16_t* zf = (const bf16_t*)(F.ws + WS_ZF); const bf16_t* d6 = (const bf16_t*)(F.ws + WS_D64T); bf16_t* xt = (bf16_t*)(F.ws + WS_XT);
        for (int it = F.vcu; it < 8 * 64; it += F.G) {
            const int g = it & 7, tt = it >> 3; const int tok0 = tt * 256; const int b = tok0 >> 11, s0 = tok0 & 2047;
            f32x16 acc[2][2]; zero_acc<2>(acc);
            ARows af{d6, 64, 0}; BNK bf{zf + g * 64, 512, tok0};
            gemm_core<2, true>(acc, af, bf, 1, F.lds);
            stage_bf16<2>(acc, F.lds);
            __syncthreads();
#pragma unroll 4
            for (int rr = 0; rr < 16; ++rr) {
                const int n = w * 16 + rr; const int part = n >> 6, m = n & 63;
                *(u32x2*)(xt + (unsigned)(b * 512 + g * 64 + m) * 4096u + part * 2048 + s0 + 4 * lane) = *(const u32x2*)(F.lds + n * ST16 + lane * 8);
            }
        }
    }
    {
        constexpr int WQ_P = 528, WKV_P = 272, ST_P = 208;
        constexpr int L_WQ = 0, L_WKV = 96 * WQ_P, L_G = L_WKV + 128 * WKV_P, L_ST = L_G + 768;
        static_assert(L_ST + 8 * 32 * ST_P <= LDS_MISC, "head engine LDS");
        const float* rc = (const float*)(F.ws + WS_ROPE); const float* rsn = rc + 2048 * 16;
        bf16_t* Q = (bf16_t*)(F.ws + WS_Q); bf16_t* K = (bf16_t*)(F.ws + WS_K); bf16_t* vt = (bf16_t*)(F.ws + WS_VT);
        const int hd = F.vcu & 7; const int l31 = lane & 31, hh = lane >> 5;
        __syncthreads();
        { const u32x4* wq = (const u32x4*)((const bf16_t*)(F.ws + WS_WUQ) + (size_t)hd * 96 * 256); const u32x4* wk = (const u32x4*)((const bf16_t*)(F.ws + WS_WUKV) + (size_t)hd * 128 * 128);
          for (int c = F.tid; c < 96 * 32; c += NTHREADS) *(u32x4*)(F.lds + L_WQ + (c >> 5) * WQ_P + (c & 31) * 16) = wq[c];
          for (int c = F.tid; c < 128 * 16; c += NTHREADS) *(u32x4*)(F.lds + L_WKV + (c >> 4) * WKV_P + (c & 15) * 16) = wk[c];
          if (F.tid < 96) { ((float*)(F.lds + L_G))[F.tid] = F.a.in[10][F.tid]; ((float*)(F.lds + L_G))[96 + F.tid] = F.a.in[11][F.tid]; } }
        __syncthreads();
        const float* gq = (const float*)(F.lds + L_G); const float* gk = gq + 96;
        unsigned char* st = F.lds + L_ST + w * (32 * ST_P);
        const float qscale = 0.10206207261596577f * 1.4426950408889634f;
#pragma unroll 1
        for (int i2 = 0; i2 < 2; ++i2) {
            const int sb = (F.vcu >> 3) + 32 * i2; const unsigned tok = sb * 256 + w * 32 + l31; const int b = tok >> 11, s = tok & 2047; const unsigned bh = b * 8 + hd;
            const bf16_t* zrow = zqkv + tok * 416u;
            const f32x4 cs0 = *(const f32x4*)(rc + s * 16 + 4 * hh), cs1 = *(const f32x4*)(rc + s * 16 + 8 + 4 * hh), sn0 = *(const f32x4*)(rsn + s * 16 + 4 * hh), sn1 = *(const f32x4*)(rsn + s * 16 + 8 + 4 * hh);
            {
                bf16x8 zq[16];
#pragma unroll
                for (int k = 0; k < 16; ++k) zq[k] = *(const bf16x8*)(zrow + 16 * k + 8 * hh);
                f32x16 aq[3];
#pragma unroll
                for (int f = 0; f < 3; ++f) {
#pragma unroll
                    for (int r = 0; r < 16; ++r) aq[f][r] = 0.f;
#pragma unroll
                    for (int k = 0; k < 16; ++k) { const bf16x8 wf = *(const bf16x8*)(F.lds + L_WQ + (32 * f + l31) * WQ_P + (16 * k + 8 * hh) * 2); aq[f] = __builtin_amdgcn_mfma_f32_32x32x16_bf16(wf, zq[k], aq[f], 0, 0, 0);
                        if ((k & 7) == 7) __builtin_amdgcn_sched_barrier(0); }
                }
                float ss = 0.f;
#pragma unroll
                for (int f = 0; f < 3; ++f)
#pragma unroll
                    for (int r = 0; r < 16; ++r) ss += aq[f][r] * aq[f][r];
                ss += __shfl_xor(ss, 32);
                const float rstd = rsqrtf(ss * (1.0f / 96.0f) + EPS) * qscale;
#pragma unroll
                for (int f = 0; f < 3; ++f)
#pragma unroll
                    for (int r = 0; r < 16; ++r) aq[f][r] *= rstd * gq[32 * f + (r & 3) + 8 * (r >> 2) + 4 * hh];
#pragma unroll
                for (int r = 0; r < 8; ++r) { const float c = (r < 4) ? cs0[r & 3] : cs1[r & 3], sn = (r < 4) ? sn0[r & 3] : sn1[r & 3];
                    const float r1 = aq[2][r], r2 = aq[2][r + 8]; aq[2][r] = r1 * c - r2 * sn; aq[2][r + 8] = r2 * c + r1 * sn; }
#pragma unroll
                for (int f = 0; f < 3; ++f)
#pragma unroll
                    for (int q4 = 0; q4 < 4; ++q4) { const f32x4 v = {aq[f][4 * q4], aq[f][4 * q4 + 1], aq[f][4 * q4 + 2], aq[f][4 * q4 + 3]};
                        *(u32x2*)(st + l31 * ST_P + (32 * f + 8 * q4 + 4 * hh) * 2) = pack4(v); }
                u32x4* dst = (u32x4*)(Q + ((size_t)bh * 2048 + (s - l31)) * 96);
#pragma unroll
                for (int c6 = 0; c6 < 6; ++c6) { const int c = c6 * 64 + lane; dst[c] = *(const u32x4*)(st + (c / 12) * ST_P + (c % 12) * 16); }
            }
            {
                bf16x8 zk[8]; float sk = 0.f;
#pragma unroll
                for (int k = 0; k < 8; ++k) { zk[k] = *(const bf16x8*)(zrow + 256 + 16 * k + 8 * hh);
#pragma unroll
                    for (int e = 0; e < 8; ++e) { const float z = bf2f((bf16_t)zk[k][e]); sk += z * z; } }
                sk += __shfl_xor(sk, 32);
                const float rkv = rsqrtf(sk * (1.0f / 128.0f) + EPS);
                f32x16 ak[4];
#pragma unroll
                for (int f = 0; f < 4; ++f) {
#pragma unroll
                    for (int r = 0; r < 16; ++r) ak[f][r] = 0.f;
#pragma unroll
                    for (int k = 0; k < 8; ++k) { const bf16x8 wf = *(const bf16x8*)(F.lds + L_WKV + (32 * f + l31) * WKV_P + (16 * k + 8 * hh) * 2); ak[f] = __builtin_amdgcn_mfma_f32_32x32x16_bf16(wf, zk[k], ak[f], 0, 0, 0); }
                    __builtin_amdgcn_sched_barrier(0);
                }
#pragma unroll
                for (int f = 2; f < 4; ++f)
#pragma unroll
                    for (int r = 0; r < 16; ++r) { const int dv = 32 * (f - 2) + (r & 3) + 8 * (r >> 2) + 4 * hh; vt[((size_t)bh * 64 + dv) * 2048 + s] = f2bf(ak[f][r] * rkv); }
                float zr[16];
#pragma unroll
                for (int q4 = 0; q4 < 4; ++q4) { const f32x4 t4 = unpack4(*(const u32x2*)(zrow + 384 + 8 * q4 + 4 * hh)); zr[4 * q4] = t4[0]; zr[4 * q4 + 1] = t4[1]; zr[4 * q4 + 2] = t4[2]; zr[4 * q4 + 3] = t4[3]; }
                float ss = 0.f;
#pragma unroll
                for (int f = 0; f < 2; ++f)
#pragma unroll
                    for (int r = 0; r < 16; ++r) { ak[f][r] *= rkv; ss += ak[f][r] * ak[f][r]; }
#pragma unroll
                for (int r = 0; r < 16; ++r) ss += zr[r] * zr[r];
                ss += __shfl_xor(ss, 32);
                const float rstd = rsqrtf(ss * (1.0f / 96.0f) + EPS);
#pragma unroll
                for (int f = 0; f < 2; ++f)
#pragma unroll
                    for (int r = 0; r < 16; ++r) ak[f][r] *= rstd * gk[32 * f + (r & 3) + 8 * (r >> 2) + 4 * hh];
#pragma unroll
                for (int r = 0; r < 16; ++r) zr[r] *= rstd * gk[64 + (r & 3) + 8 * (r >> 2) + 4 * hh];
#pragma unroll
                for (int r = 0; r < 8; ++r) { const float c = (r < 4) ? cs0[r & 3] : cs1[r & 3], sn = (r < 4) ? sn0[r & 3] : sn1[r & 3];
                    const float r1 = zr[r], r2 = zr[r + 8]; zr[r] = r1 * c - r2 * sn; zr[r + 8] = r2 * c + r1 * sn; }
#pragma unroll
                for (int f = 0; f < 2; ++f)
#pragma unroll
                    for (int q4 = 0; q4 < 4; ++q4) { const f32x4 v = {ak[f][4 * q4], ak[f][4 * q4 + 1], ak[f][4 * q4 + 2], ak[f][4 * q4 + 3]};
                        *(u32x2*)(st + l31 * ST_P + (32 * f + 8 * q4 + 4 * hh) * 2) = pack4(v); }
#pragma unroll
                for (int q4 = 0; q4 < 4; ++q4) { const f32x4 v = {zr[4 * q4], zr[4 * q4 + 1], zr[4 * q4 + 2], zr[4 * q4 + 3]};
                    *(u32x2*)(st + l31 * ST_P + (64 + 8 * q4 + 4 * hh) * 2) = pack4(v); }
                u32x4* dst = (u32x4*)(K + ((size_t)bh * 2048 + (s - l31)) * 96);
#pragma unroll
                for (int c6 = 0; c6 < 6; ++c6) { const int c = c6 * 64 + lane; dst[c] = *(const u32x4*)(st + (c / 12) * ST_P + (c % 12) * 16); }
            }
        }
    }
}

constexpr int KROW = 208, VROW = 136, K_TILE = 64 * KROW, V_TILE = 64 * VROW, AT_STAGE = K_TILE + V_TILE;
__device__ __forceinline__ void attn_item(const Ctx& F, int item) {
    const int qb = item & 7, bh = item >> 3, b = bh >> 3, hd = bh & 7;
    const bf16_t* Q = (const bf16_t*)(F.ws + WS_Q) + (long)bh * 2048 * 96;
    const bf16_t* K = (const bf16_t*)(F.ws + WS_K) + (long)bh * 2048 * 96;
    const bf16_t* Vt = (const bf16_t*)(F.ws + WS_VT) + (long)bh * 64 * 2048;
    bf16_t* O = (bf16_t*)(F.ws + WS_O);
    const int t = F.tid, lane = F.lane, w = F.wave, l31 = lane & 31, hh = lane >> 5;
    bf16x8 qf[6];
    { const bf16_t* qp = Q + (long)(qb * 256 + w * 32 + l31) * 96 + hh * 8;
#pragma unroll
      for (int s = 0; s < 6; ++s) qf[s] = *(const bf16x8*)(qp + s * 16); }
    f32x16 oacc[2];
#pragma unroll
    for (int d = 0; d < 2; ++d)
#pragma unroll
        for (int r = 0; r < 16; ++r) oacc[d][r] = 0.f;
    float m_run = -1e30f, l_run = 0.f;
    const int kq0 = t, kq1 = t + 512;
    const int k_l0 = (kq0 / 12) * KROW + (kq0 % 12) * 16, k_l1 = (kq1 / 12) * KROW + (kq1 % 12) * 16;
    const int v_dv = t >> 3, v_c = t & 7; const int v_l = v_dv * VROW + v_c * 16;
    u32x4 kr0, kr1, vr;
    auto gload = [&](int j) {
        const bf16_t* kp = K + (long)j * 64 * 96;
        kr0 = *(const u32x4*)(kp + kq0 * 8);
        if (t < 256) kr1 = *(const u32x4*)(kp + kq1 * 8);
        vr = *(const u32x4*)(Vt + (long)v_dv * 2048 + j * 64 + v_c * 8);
    };
    auto lstore = [&](int st) {
        unsigned char* base = F.lds + st * AT_STAGE;
        *(u32x4*)(base + k_l0) = kr0;
        if (t < 256) *(u32x4*)(base + k_l1) = kr1;
        *(u32x2*)(base + K_TILE + v_l) = (u32x2){vr.x, vr.y}; *(u32x2*)(base + K_TILE + v_l + 8) = (u32x2){vr.z, vr.w};
    };
    __syncthreads();
    gload(0); lstore(0);
    __syncthreads();
    for (int j = 0; j < 32; ++j) {
        const bool more = (j + 1 < 32);
        if (more) gload(j + 1);
        const unsigned char* kb = F.lds + (j & 1) * AT_STAGE; const unsigned char* vb = kb + K_TILE;
        f32x16 st[2];
        {
            bf16x8 kfr[2][6];
#pragma unroll
            for (int f = 0; f < 2; ++f)
#pragma unroll
                for (int s = 0; s < 6; ++s) kfr[f][s] = *(const bf16x8*)(kb + (32 * f + l31) * KROW + (16 * s + 8 * hh) * 2);
            __builtin_amdgcn_sched_barrier(0);
#pragma unroll
            for (int f = 0; f < 2; ++f) {
#pragma unroll
                for (int r = 0; r < 16; ++r) st[f][r] = 0.f;
#pragma unroll
                for (int s = 0; s < 6; ++s) st[f] = __builtin_amdgcn_mfma_f32_32x32x16_bf16(kfr[f][s], qf[s], st[f], 0, 0, 0);
            }
        }
        float mx = st[0][0];
#pragma unroll
        for (int r = 1; r < 16; ++r) mx = fmaxf(mx, st[0][r]);
#pragma unroll
        for (int r = 0; r < 16; ++r) mx = fmaxf(mx, st[1][r]);
        mx = fmaxf(mx, __shfl_xor(mx, 32));
        const float m_new = fmaxf(m_run, mx);
        const float alpha = __builtin_amdgcn_exp2f(m_run - m_new);
        m_run = m_new;
        float ps = 0.f;
#pragma unroll
        for (int f = 0; f < 2; ++f)
#pragma unroll
            for (int r = 0; r < 16; ++r) { const float p = __builtin_amdgcn_exp2f(st[f][r] - m_new); st[f][r] = p; ps += p; }
        l_run = l_run * alpha + ps;
#pragma unroll
        for (int d = 0; d < 2; ++d)
#pragma unroll
            for (int r = 0; r < 16; ++r) oacc[d][r] *= alpha;
        {
            u32x4 vfr[2][2][2];
#pragma unroll
            for (int f = 0; f < 2; ++f)
#pragma unroll
                for (int s2 = 0; s2 < 2; ++s2)
#pragma unroll
                    for (int d = 0; d < 2; ++d) { const unsigned char* vp = vb + (32 * d + l31) * VROW + (32 * f + 16 * s2 + 4 * hh) * 2;
                        const u32x2 lo = *(const u32x2*)vp, hi = *(const u32x2*)(vp + 16); vfr[f][s2][d] = (u32x4){lo.x, lo.y, hi.x, hi.y}; }
#pragma unroll
            for (int f = 0; f < 2; ++f)
#pragma unroll
                for (int s2 = 0; s2 < 2; ++s2) {
                    u32x4 pw; pw.x = cvt_pk_bf16(st[f][8 * s2 + 0], st[f][8 * s2 + 1]); pw.y = cvt_pk_bf16(st[f][8 * s2 + 2], st[f][8 * s2 + 3]);
                    pw.z = cvt_pk_bf16(st[f][8 * s2 + 4], st[f][8 * s2 + 5]); pw.w = cvt_pk_bf16(st[f][8 * s2 + 6], st[f][8 * s2 + 7]);
                    const bf16x8 pf = *(const bf16x8*)&pw;
#pragma unroll
                    for (int d = 0; d < 2; ++d) oacc[d] = __builtin_amdgcn_mfma_f32_32x32x16_bf16(*(const bf16x8*)&vfr[f][s2][d], pf, oacc[d], 0, 0, 0);
                }
        }
        if (more) lstore((j + 1) & 1);
        __syncthreads();
    }
    l_run += __shfl_xor(l_run, 32);
    const float inv = 1.0f / l_run;
    const long tok = (long)b * 2048 + qb * 256 + w * 32 + l31;
#pragma unroll
    for (int d = 0; d < 2; ++d)
#pragma unroll
        for (int q4 = 0; q4 < 4; ++q4) {
            const int dv = 32 * d + 8 * q4 + 4 * hh;
            u32x2 pk; pk.x = cvt_pk_bf16(oacc[d][4 * q4 + 0] * inv, oacc[d][4 * q4 + 1] * inv); pk.y = cvt_pk_bf16(oacc[d][4 * q4 + 2] * inv, oacc[d][4 * q4 + 3] * inv);
            *(u32x2*)(O + tok * 512 + hd * 64 + dv) = pk;
        }
}

__device__ __forceinline__ void p6_attn_dft(const Ctx& F) {
    {
        pg8::Gemm g{(const bf16_t*)(F.ws + WS_WDFT), (const bf16_t*)(F.ws + WS_XT), 2048, 4096, 4096};
        pg8::StaticOrder S; S.init(2048, 4096, F.G, (int)blockIdx.x);
        EpiF E{(bf16_t*)(F.ws + WS_F)};
        pg8::gemm_phase<EpiF, pg8::StaticOrder, true, true>((LAS unsigned char*)F.lds, g, S, E);
    }
    volatile LAS int* sitem = (volatile LAS int*)(F.lds + LDS_MISC);
    auto next_item = [&]() -> int {
        __syncthreads();
        if (F.tid == 0) sitem[0] = (int)xb_add(F.ctl + CW_QUEUE, 1u);
        __syncthreads();
        return sitem[0];
    };
    int it = next_item();
    while (it < 512) { attn_item(F, it); it = next_item(); }
}

__device__ __forceinline__ void p7_merge(const Ctx& F) {
    bf16_t* mg = (bf16_t*)(F.ws + WS_MERGED); const bf16_t* sig = (const bf16_t*)(F.ws + WS_SIG);
    pg8::StaticOrder S; S.init(T, 1024, F.G, (int)blockIdx.x);
    { pg8::Gemm g{(const bf16_t*)(F.ws + WS_O), (const bf16_t*)(F.ws + WS_WB_PA), T, 1024, 512}; EpiMgA E{mg, sig};
      pg8::gemm_phase<EpiMgA, pg8::StaticOrder, true, true>((LAS unsigned char*)F.lds, g, S, E); }
    { pg8::Gemm g{(const bf16_t*)(F.ws + WS_F), (const bf16_t*)(F.ws + WS_WB_PF), T, 1024, 512}; EpiMgF E{mg, sig};
      pg8::gemm_phase<EpiMgF, pg8::StaticOrder, true, true>((LAS unsigned char*)F.lds, g, S, E); }
}

__device__ __forceinline__ void p8_out(const Ctx& F) {
    pg8::Gemm g{(const bf16_t*)(F.ws + WS_MERGED), (const bf16_t*)(F.ws + WS_WB_OUT), T, 1024, 1024};
    pg8::StaticOrder S; S.init(T, 1024, F.G, (int)blockIdx.x);
    EpiX1 E{(float*)(F.ws + WS_X1), F.a.in[0], (const float*)(F.ws + WS_ADAF)};
    pg8::gemm_phase<EpiX1, pg8::StaticOrder, true, true>((LAS unsigned char*)F.lds, g, S, E);
}

template <int NT>
__device__ __forceinline__ void topk_tokens(const Ctx& F, int tok0, const float (&lg)[NT][4], const float (&bs)[4]) {
    int* ltok = (int*)(F.ws + WS_LTOK); float* lw = (float*)(F.ws + WS_LW); unsigned* cnt = F.ctl + CW_CNT;
    const int lane = F.lane;
    float sc[NT][4]; unsigned long long key[NT][4];
#pragma unroll
    for (int t = 0; t < NT; ++t)
#pragma unroll
        for (int i = 0; i < 4; ++i) {
            sc[t][i] = sigmoidf_(lg[t][i]);
            const unsigned ub = __float_as_uint(sc[t][i] + bs[i]);
            const unsigned ord = (ub & 0x80000000u) ? ~ub : (ub | 0x80000000u);
            key[t][i] = ((unsigned long long)ord << 32) | (unsigned long long)(255 - (lane + 64 * i));
        }
    float wsum[NT], myw[NT]; int mye[NT];
#pragma unroll
    for (int t = 0; t < NT; ++t) { wsum[t] = 0.f; myw[t] = 0.f; mye[t] = 0; }
    for (int k = 0; k < 8; ++k) {
        unsigned long long best[NT];
#pragma unroll
        for (int t = 0; t < NT; ++t) { best[t] = key[t][0];
#pragma unroll
            for (int i = 1; i < 4; ++i) best[t] = (key[t][i] > best[t]) ? key[t][i] : best[t]; }
#pragma unroll
        for (int o = 32; o > 0; o >>= 1) {
#pragma unroll
            for (int t = 0; t < NT; ++t) {
                const unsigned lo = __shfl_xor((unsigned)best[t], o), hi = __shfl_xor((unsigned)(best[t] >> 32), o);
                const unsigned long long ob = ((unsigned long long)hi << 32) | lo;
                best[t] = (ob > best[t]) ? ob : best[t];
            }
        }
#pragma unroll
        for (int t = 0; t < NT; ++t) {
            const int e = 255 - (int)(best[t] & 0xffull);
            float s_own = 0.f;
#pragma unroll
            for (int i = 0; i < 4; ++i) { const bool mine = (e == lane + 64 * i); s_own = mine ? sc[t][i] : s_own; key[t][i] = mine ? 0ull : key[t][i]; }
            const float s_k = __shfl(s_own, e & 63);
            wsum[t] += s_k;
            myw[t] = (lane == k) ? s_k : myw[t]; mye[t] = (lane == k) ? e : mye[t];
        }
    }
    if (lane < 8) {
        unsigned slot[NT];
#pragma unroll
        for (int t = 0; t < NT; ++t) slot[t] = atomicAdd(&cnt[mye[t] * 64], 1u);
#pragma unroll
        for (int t = 0; t < NT; ++t) { ltok[(long)mye[t] * LCAP + slot[t]] = (tok0 + t) * 8 + lane; lw[(long)mye[t] * LCAP + slot[t]] = myw[t] / wsum[t] * 2.5f; }
    }
}

struct EpiLog {
    static constexpr bool PERM = true, AFTER_DRAIN = false; float* dst;
    __device__ __forceinline__ void operator()(const f32x4 (&acc)[2][2][4][2], const pg8::Unit& u, int wr, int wc, int fr, int fq) const { EPI_HEAD
        EPI_LOOP( *(f32x4*)(dst + row * 256u + col) = v0; *(f32x4*)(dst + row * 256u + col + 4) = v1; ) } };
__device__ __forceinline__ void p10_router_shared(const Ctx& F) {
    const bf16_t* a3 = (const bf16_t*)(F.ws + WS_A3); const bf16_t* wr = (const bf16_t*)(F.ws + WS_WB_R); float* part = (float*)(F.ws + WS_QRAW);
    const unsigned bx = blockIdx.x, G = (unsigned)F.G;
    {
        pg8::Gemm g{a3, (const bf16_t*)(F.ws + WS_WB_SH), T, 512, 1024, 3072};
        pg8::StaticOrder S; S.init(T, 512, F.G, (int)bx);
        EpiSh E{(bf16_t*)(F.ws + WS_ACTS)};
        pg8::gemm_phase<EpiSh, pg8::StaticOrder, true, true>((LAS unsigned char*)F.lds, g, S, E);
    }
    {
        const int seg = (bx >= 192u) ? 1 : 0;
        const bool has = (bx >= 128u);
        pg8::Gemm g{a3 + seg * 1536, wr + seg * 1536, T, 256, 1536, 3072};
        g.ldb = 3072;
        pg8::StaticOrder S; S.init(T, 256, F.G, has ? (int)((bx - 128u) & 63u) : (int)(G - 1));
        EpiLog E{part + (size_t)seg * T * 256};
        pg8::gemm_phase<EpiLog, pg8::StaticOrder, true, true>((LAS unsigned char*)F.lds, g, S, E);
    }
}
__device__ __forceinline__ void p11_topk(const Ctx& F) {
    const float* part = (const float*)(F.ws + WS_QRAW);
    float bs[4];
#pragma unroll
    for (int i = 0; i < 4; ++i) bs[i] = F.a.in[17][F.lane + 64 * i];
    for (int tok0 = (F.vcu * 8 + F.wave) * 8; tok0 < T; tok0 += F.G * 8 * 8) {
        float lg[8][4];
#pragma unroll
        for (int t = 0; t < 8; ++t)
#pragma unroll
            for (int i = 0; i < 4; ++i) { const size_t o = (size_t)(tok0 + t) * 256 + F.lane + 64 * i; lg[t][i] = part[o] + part[o + (size_t)T * 256]; }
        topk_tokens<8>(F, tok0, lg, bs);
    }
}

__device__ __forceinline__ int build_expert_tables(const Ctx& F, int per_rt) {
    volatile LAS int* offs = (volatile LAS int*)(F.lds + LDS_MISC); volatile LAS int* istart = offs + 264; volatile LAS int* wtot = offs + 540;
    unsigned* cnt = F.ctl + CW_CNT;
    const int t = F.tid, lane = F.lane;
    const int c = (t < NE) ? (int)cnt[t * 64] : 0; const int ni = ((c + 255) >> 8) * per_rt;
    int x = c, y = ni;
#pragma unroll
    for (int d = 1; d < 64; d <<= 1) { const int x2 = __shfl_up(x, d), y2 = __shfl_up(y, d); x += (lane >= d) ? x2 : 0; y += (lane >= d) ? y2 : 0; }
    __syncthreads();
    if (t < NE && lane == 63) { wtot[t >> 6] = x; wtot[4 + (t >> 6)] = y; }
    __syncthreads();
    if (t < NE) { int bx = 0, by = 0; for (int k = 0; k < (t >> 6); ++k) { bx += wtot[k]; by += wtot[4 + k]; }
        offs[t] = bx + x - c; istart[t] = by + y - ni; if (t == NE - 1) { offs[NE] = bx + x; istart[NE] = by + y; } }
    __syncthreads();
    return istart[NE];
}
__device__ __forceinline__ int find_expert(const Ctx& F, int it) {
    volatile LAS int* istart = (volatile LAS int*)(F.lds + LDS_MISC) + 264;
    int lo = 0, hi = NE;
    while (hi - lo > 1) { const int mid = (lo + hi) >> 1; if (istart[mid] <= it) lo = mid; else hi = mid; }
    return lo;
}
struct AGather { const bf16_t* b; const int* list; int m0, mvalid; unsigned lda;
    __device__ __forceinline__ const bf16_t* base() const { return b; }
    __device__ __forceinline__ unsigned off(int r) const { int i = m0 + r; i = (i < mvalid) ? i : (mvalid - 1); return (unsigned)(list[i] >> 3) * lda; }
    __device__ __forceinline__ long koff(int kt) const { return (long)kt * 64; } };
struct ARowsV { const bf16_t* b; unsigned lda; int m0, mvalid;
    __device__ __forceinline__ const bf16_t* base() const { return b; }
    __device__ __forceinline__ unsigned off(int r) const { int i = m0 + r; i = (i < mvalid) ? i : (mvalid - 1); return (unsigned)i * lda; }
    __device__ __forceinline__ long koff(int kt) const { return (long)kt * 64; } };

__device__ __forceinline__ void p12_exp_up(const Ctx& F) {
    const int total = build_expert_tables(F, 2);
    volatile LAS int* offs = (volatile LAS int*)(F.lds + LDS_MISC);
    volatile LAS int* istart = offs + 264;
    const bf16_t* hhi = (const bf16_t*)(F.ws + WS_A3); const int* ltok = (const int*)(F.ws + WS_LTOK); bf16_t* act = (bf16_t*)(F.ws + WS_ACT);
    unsigned* cnt = F.ctl + CW_CNT;
    for (int it = F.vcu; it < total; it += F.G) {
        const int e = find_expert(F, it); const int li = it - istart[e]; const int rt = li >> 1, ct = li & 1;
        const int me = (int)cnt[e * 64], m0 = rt * 256, j0 = ct * 128; const int ro = offs[e];
        f32x16 acc[4][2]; zero_acc<4>(acc);
        AGather af{hhi, ltok + (long)e * LCAP, m0, me, 3072u};
        BKNPair bf{F.a.in[18] + (long)e * 262144 + j0, (long)(F.a.in[19] - F.a.in[18]), 256};
        gemm_core<4, true>(acc, af, bf, 16, F.lds);
        run_epilogue_tr<4>(acc, [&](int r, int c0, f32x4 v0, f32x4 v1) { const int i = m0 + r; if (i < me) { const int j = j0 + (c0 >> 6) * 32 + (c0 & 31);
            const f32x4 a = {siluf_(v0[0]) * v1[0], siluf_(v0[1]) * v1[1], siluf_(v0[2]) * v1[2], siluf_(v0[3]) * v1[3]};
            *(u32x2*)(act + (unsigned)(ro + i) * 256u + j) = pack4(a); } });
    }
}
__device__ __forceinline__ void p13_exp_down(const Ctx& F) {
    constexpr int W_P = 528, ST_P = 144;
    constexpr int L_W = 0, L_ST = 128 * W_P;
    static_assert(L_ST + 8 * 32 * ST_P <= LDS_MISC, "expert-down engine LDS");
    (void)build_expert_tables(F, 1);
    volatile LAS int* offs = (volatile LAS int*)(F.lds + LDS_MISC);
    const int* ltok = (const int*)(F.ws + WS_LTOK); const float* lw = (const float*)(F.ws + WS_LW); const bf16_t* act = (const bf16_t*)(F.ws + WS_ACT);
    unsigned char* ybuf8 = F.ws + WS_YBUF; unsigned* cnt = F.ctl + CW_CNT;
    const int lane = F.lane, w = F.wave, l31 = lane & 31, hh = lane >> 5;
    unsigned char* st = F.lds + L_ST + w * (32 * ST_P);
#pragma unroll 1
    for (int it = F.vcu; it < NE * 8; it += F.G) {
        const int e = it >> 3, n0 = (it & 7) * 128; const int me = (int)cnt[e * 64]; const int ro = offs[e];
        if (me == 0) continue;
        __syncthreads();
        { int tid_ = F.tid; asm volatile("" : "+v"(tid_));
#pragma unroll 1
          for (int b2 = tid_; b2 < 1024; b2 += NTHREADS) { const int kb = b2 >> 5, nq = b2 & 31;
            const float* src = F.a.in[20] + (size_t)e * 262144 + (size_t)(kb * 8) * 1024 + n0 + 4 * nq;
            f32x4 r[8];
#pragma unroll
            for (int i = 0; i < 8; ++i) r[i] = *(const f32x4*)(src + (size_t)i * 1024);
#pragma unroll
            for (int j = 0; j < 4; ++j) { u32x4 p; p.x = cvt_pk_bf16(r[0][j], r[1][j]); p.y = cvt_pk_bf16(r[2][j], r[3][j]); p.z = cvt_pk_bf16(r[4][j], r[5][j]); p.w = cvt_pk_bf16(r[6][j], r[7][j]);
                *(u32x4*)(F.lds + L_W + (4 * nq + j) * W_P + kb * 16) = p; } } }
        __syncthreads();
        const int* lt = ltok + (size_t)e * LCAP; const float* lwe = lw + (size_t)e * LCAP;
#pragma unroll 1
        for (int tb = w; tb * 32 < me; tb += 8) {
            const int idx = tb * 32 + l31; const int idc = (idx < me) ? idx : (me - 1);
            const bf16_t* arow = act + (size_t)(ro + idc) * 256 + 8 * hh;
            bf16x8 z[16];
#pragma unroll
            for (int k = 0; k < 16; ++k) z[k] = *(const bf16x8*)(arow + 16 * k);
            const int myent = lt[idc]; const float sc = lwe[idc] * 16.f;
            f32x16 acc[4];
#pragma unroll
            for (int f = 0; f < 4; ++f)
#pragma unroll
                for (int r = 0; r < 16; ++r) acc[f][r] = 0.f;
            bf16x8 wa[8], wb[8];
            const unsigned char* wbase = F.lds + L_W + l31 * W_P + 16 * hh;
#define WLOAD(dst, hs) _Pragma("unroll") for (int k = 0; k < 8; ++k) dst[k] = *(const bf16x8*)(wbase + (32 * ((hs) >> 1)) * W_P + (128 * ((hs) & 1) + 16 * k) * 2)
#define WMMA(src, hs) _Pragma("unroll") for (int k = 0; k < 8; ++k) acc[(hs) >> 1] = __builtin_amdgcn_mfma_f32_32x32x16_bf16(src[k], z[8 * ((hs) & 1) + k], acc[(hs) >> 1], 0, 0, 0)
            WLOAD(wa, 0);
#pragma unroll
            for (int hs = 0; hs < 8; hs += 2) {
                WLOAD(wb, hs + 1); __builtin_amdgcn_sched_barrier(0);
                WMMA(wa, hs); __builtin_amdgcn_sched_barrier(0);
                if (hs + 2 < 8) { WLOAD(wa, hs + 2); } __builtin_amdgcn_sched_barrier(0);
                WMMA(wb, hs + 1); __builtin_amdgcn_sched_barrier(0);
            }
#undef WLOAD
#undef WMMA
#pragma unroll
            for (int f = 0; f < 4; ++f)
#pragma unroll
                for (int q4 = 0; q4 < 4; ++q4) { const f32x4 v = {acc[f][4 * q4] * sc, acc[f][4 * q4 + 1] * sc, acc[f][4 * q4 + 2] * sc, acc[f][4 * q4 + 3] * sc};
                    *(unsigned*)(st + l31 * ST_P + 32 * f + 8 * q4 + 4 * hh) = pack_fp8x4(v); }
#pragma unroll
            for (int i = 0; i < 4; ++i) { const int row = (lane >> 3) + 8 * i, ch = lane & 7;
                const u32x4 v = *(const u32x4*)(st + row * ST_P + ch * 16); const unsigned ent = (unsigned)__shfl(myent, row);
                if (tb * 32 + row < me) *(u32x4*)(ybuf8 + (size_t)ent * 1024 + n0 + ch * 16) = v; }
        }
    }
}

__device__ __forceinline__ void p14_final(const Ctx& F) {
    pg8::Gemm g{(const bf16_t*)(F.ws + WS_ACTS), (const bf16_t*)(F.ws + WS_WB_SD), T, 1024, 256};
    pg8::StaticOrder S; S.init(T, 1024, F.G, (int)blockIdx.x);
    EpiOut E{F.out, (const float*)(F.ws + WS_X1), (const float*)(F.ws + WS_ADAF), (const bf16_t*)(F.ws + WS_YBUF)};
    pg8::gemm_phase<EpiOut, pg8::StaticOrder, true, true>((LAS unsigned char*)F.lds, g, S, E);
}

constexpr int NPHASE = 13;
__global__ void __launch_bounds__(NTHREADS, 2) mk_fwd(Args args) {
    extern __shared__ __attribute__((aligned(16))) unsigned char lds[];
    const int tid_ = threadIdx.x, G_ = gridDim.x, bx_ = blockIdx.x;
    Ctx F{args, args.out, args.ws, lds, (unsigned*)(args.ws + WS_CTL), tid_, tid_ & 63, __builtin_amdgcn_readfirstlane(tid_ >> 6), G_, (G_ % 8 == 0) ? (bx_ % 8) * (G_ / 8) + bx_ / 8 : bx_};
    const int lo = args.ph_lo, hi = args.ph_hi;
    volatile LAS unsigned* bst = (volatile LAS unsigned*)(lds + LDS_MISC + 4096);
    XcdBarrier bar; bar.bar = F.ctl + CW_BAR; bar.x = 0; bar.st = bst;
    if (hi - lo > 1) {
        if (F.tid == 0) { bst[0] = 0u; bst[1] = 0u; bst[2] = 0u; bst[3] = 0u; }
        __syncthreads();
        bar = xcd_barrier_post(F.ctl + CW_BAR, bst);
    }
#define PHASE(k, call) if (lo <= (k) && (k) < hi) { call; if ((k) + 1 < hi) xcd_barrier(bar); }
    PHASE(0, p0_prep(F))
    PHASE(1, p_norm_rows(F, 0))
    PHASE(2, p2_win(F))
    PHASE(3, p3_mixer_inputs(F))
    PHASE(4, p6_attn_dft(F))
    PHASE(5, p7_merge(F))
    PHASE(6, p8_out(F))
    PHASE(7, p_norm_rows(F, 1))
    PHASE(8, p10_router_shared(F))
    PHASE(9, p11_topk(F))
    PHASE(10, p12_exp_up(F))
    PHASE(11, p13_exp_down(F))
    PHASE(12, p14_final(F))
#undef PHASE
}

extern "C" void kernel_launch(void* const* d_in, const int* in_sizes, int n_in, void* d_out, int out_size, void* d_ws, size_t ws_size, hipStream_t stream) {
    static int grid = 0;
    if (grid == 0) {
        if (n_in != 24 || out_size != T * DM || ws_size < WS_END) {
            fprintf(stderr, "kernel_launch: unexpected shapes (n_in %d, out %d, ws %zu < %zu); nothing launched\n", n_in, out_size, ws_size, (size_t)WS_END); grid = -1; return; }
        int dev = 0, cus = 0, per_cu = 0;
        if (hipGetDevice(&dev) != hipSuccess || hipDeviceGetAttribute(&cus, hipDeviceAttributeMultiprocessorCount, dev) != hipSuccess) { grid = -1; return; }
        if (hipFuncSetAttribute((const void*)mk_fwd, hipFuncAttributeMaxDynamicSharedMemorySize, LDS_BYTES) != hipSuccess) { fprintf(stderr, "kernel_launch: hipFuncSetAttribute failed\n"); grid = -1; return; }
        if (hipOccupancyMaxActiveBlocksPerMultiprocessor(&per_cu, (const void*)mk_fwd, NTHREADS, LDS_BYTES) != hipSuccess || per_cu < 1)
            fprintf(stderr, "kernel_launch: occupancy query reports %d blocks per CU\n", per_cu);
        (void)hipGetLastError();
        if (cus < 256) { fprintf(stderr, "kernel_launch: this kernel is laid out for 256 CUs (device reports %d); nothing launched\n", cus); grid = -1; return; }
        grid = 256;
    }
    if (grid < 0) return;
    (void)hipMemsetAsync((char*)d_ws + WS_CTL, 0, CTL_BYTES, stream);
    Args a{};
    for (int i = 0; i < 24; ++i) a.in[i] = (const float*)d_in[i];
    a.out = (float*)d_out; a.ws = (unsigned char*)d_ws;
#if N_LAUNCH_MODE == 1
    a.ph_lo = 0; a.ph_hi = NPHASE;
    hipLaunchKernelGGL(mk_fwd, dim3(grid), dim3(NTHREADS), LDS_BYTES, stream, a);
#else
    for (int ph = 0; ph < NPHASE; ++ph) { a.ph_lo = ph; a.ph_hi = ph + 1; hipLaunchKernelGGL(mk_fwd, dim3(grid), dim3(NTHREADS), LDS_BYTES, stream, a); }
#endif
    const hipError_t le = hipPeekAtLastError();
    if (le != hipSuccess) fprintf(stderr, "kernel_launch: launch failed: %s\n", hipGetErrorName(le));
}
```

```cpp
#include <hip/hip_runtime.h>
#include <cstdio>
#include <cstdint>

typedef unsigned short bf16_t;
typedef short bf16x8 __attribute__((ext_vector_type(8)));
typedef float f32x16 __attribute__((ext_vector_type(16)));
typedef float f32x4 __attribute__((ext_vector_type(4)));
typedef unsigned u32x4 __attribute__((ext_vector_type(4)));
typedef unsigned u32x2 __attribute__((ext_vector_type(2)));

#define REPEAT_MASK 16384
#ifndef N_LAUNCH_MODE
#define N_LAUNCH_MODE 1
#endif
#ifndef NAIVE_MMA
#define NAIVE_MMA 0
#endif

constexpr int T = 16384, DM = 1024, NB = 8, SEQ = 2048;
constexpr int INW = 2976, NH = 8, DQK = 96, DV = 64;
constexpr int NE = 256, TOPK = 8, EH = 256;
constexpr float EPS = 1e-6f;
constexpr int NTHREADS = 512;
constexpr int LCAP = 16384;

constexpr size_t al256(size_t x) { return (x + 255) & ~(size_t)255; }
constexpr size_t WS_CTL   = 0;
constexpr size_t CTL_BYTES = 196608;
constexpr size_t WS_ADAP  = WS_CTL + CTL_BYTES;
constexpr size_t WS_ADAF  = WS_ADAP + al256((size_t)16 * 8 * 6144 * 4);
constexpr size_t WS_ROPE  = WS_ADAF + al256((size_t)8 * 6144 * 4);
constexpr size_t WS_WDFT  = WS_ROPE + al256((size_t)2 * 2048 * 16 * 4);
constexpr size_t WS_D64T  = WS_WDFT + al256((size_t)2048 * 4096 * 2);
constexpr size_t WS_WR3   = WS_D64T + al256((size_t)128 * 64 * 2);
constexpr size_t WS_WUQ   = WS_WR3 + al256((size_t)3072 * 256 * 4);
constexpr size_t WS_WUKV  = WS_WUQ + al256((size_t)256 * 768 * 4);
constexpr size_t WS_H     = WS_WUKV + al256((size_t)128 * 1024 * 4);
constexpr size_t WS_H2LO  = WS_H + al256((size_t)T * 1024 * 2);
constexpr size_t WS_ZQKV  = WS_H2LO + al256((size_t)T * 1024 * 2);
constexpr size_t WS_ZF    = WS_ZQKV + al256((size_t)T * 416 * 2);
constexpr size_t WS_SIG   = WS_ZF + al256((size_t)T * 512 * 2);
constexpr size_t WS_RSTD  = WS_SIG + al256((size_t)T * 2048 * 2);
constexpr size_t WS_XT    = WS_RSTD + al256((size_t)2 * T * 4);
constexpr size_t WS_QRAW  = WS_XT + al256((size_t)4096 * 4096 * 2);
constexpr size_t WS_KNRAW = WS_QRAW + al256((size_t)T * 768 * 4);
constexpr size_t WS_Q     = WS_KNRAW + al256((size_t)T * 512 * 4);
constexpr size_t WS_K     = WS_Q + al256((size_t)T * 768 * 2);
constexpr size_t WS_VT    = WS_K + al256((size_t)T * 768 * 2);
constexpr size_t WS_O     = WS_VT + al256((size_t)T * 512 * 2);
constexpr size_t WS_F     = WS_O + al256((size_t)T * 512 * 2);
constexpr size_t WS_MERGED= WS_F + al256((size_t)T * 512 * 2);
constexpr size_t WS_X1    = WS_MERGED + al256((size_t)T * 1024 * 2);
constexpr size_t WS_LOGIT = WS_X1 + al256((size_t)T * 1024 * 4);
constexpr size_t WS_ACTS  = WS_LOGIT + al256((size_t)T * 256 * 4);
constexpr size_t WS_LTOK  = WS_ACTS + al256((size_t)T * 256 * 2);
constexpr size_t WS_LW    = WS_LTOK + al256((size_t)NE * LCAP * 4);
constexpr size_t WS_ACT   = WS_LW + al256((size_t)NE * LCAP * 4);
constexpr size_t WS_YBUF  = WS_ACT + al256((size_t)T * 8 * 256 * 2);
constexpr size_t WS_WB_IN = WS_YBUF + al256((size_t)T * 8 * 1024 * 2);
constexpr size_t WS_WB_PA = WS_WB_IN + al256((size_t)3072 * 1024 * 2);
constexpr size_t WS_WB_PF = WS_WB_PA + al256((size_t)1024 * 512 * 2);
constexpr size_t WS_WB_OUT= WS_WB_PF + al256((size_t)1024 * 512 * 2);
constexpr size_t WS_WB_SH = WS_WB_OUT + al256((size_t)1024 * 1024 * 2);
constexpr size_t WS_WB_SD = WS_WB_SH + al256((size_t)512 * 1024 * 2);
constexpr size_t WS_WB_R  = WS_WB_SD + al256((size_t)1024 * 256 * 2);
constexpr size_t WS_A3    = WS_WB_R + al256((size_t)256 * 3072 * 2);
constexpr size_t WS_END   = WS_A3 + al256((size_t)T * 3072 * 2);

constexpr int CW_CNT = 16384;
constexpr int CW_QUEUE = 4400;
constexpr int CW_BAR = 0;

constexpr int LDS_GEMM = 2 * 65536;
constexpr int ST16 = 520, ST32 = 1040;
constexpr int LDS_STAGE = 256 * ST16;
constexpr int LDS_MISC = 140288;
constexpr int LDS_BYTES = LDS_MISC + 8192;

typedef __bf16 bf16x2_t __attribute__((ext_vector_type(2)));
typedef float f32x2_t __attribute__((ext_vector_type(2)));
__device__ __forceinline__ unsigned cvt_pk_bf16(float lo, float hi) { f32x2_t f = {lo, hi}; bf16x2_t h = __builtin_convertvector(f, bf16x2_t); return __builtin_bit_cast(unsigned, h); }
__device__ __forceinline__ bf16_t f2bf(float v) { __bf16 h = (__bf16)v; return __builtin_bit_cast(unsigned short, h); }
__device__ __forceinline__ float bf2f(bf16_t b) { return __uint_as_float(((unsigned)b) << 16); }
__device__ __forceinline__ float sigmoidf_(float v) { return 1.f / (1.f + __expf(-v)); }
__device__ __forceinline__ float siluf_(float v) { return v / (1.f + __expf(-v)); }
__device__ __forceinline__ float wave_sum(float v) {
#pragma unroll
    for (int o = 32; o > 0; o >>= 1) v += __shfl_xor(v, o);
    return v;
}
__device__ __forceinline__ int swz(int row) { return ((row >> 1) & 7) ^ ((row >> 4) & 1); }

#define XB_TMO      128
#define XB_XCNT(j)  (256  + 64 * (j))
#define XB_XSUB(j)  (1280 + 64 * (j))
#define XB_XGEN(j)  (2304 + 64 * (j))
#define XB_TOP      3328
#define XB_TOPGEN   3392
#define XCD_BAR_WORDS 3456
#define XB_SPIN_CAP (1u << 22)
#define LAS __attribute__((address_space(3)))
__device__ __forceinline__ unsigned xb_ld(unsigned* p)              { return __hip_atomic_load(p, __ATOMIC_RELAXED, __HIP_MEMORY_SCOPE_AGENT); }
__device__ __forceinline__ unsigned xb_add(unsigned* p, unsigned v) { return __hip_atomic_fetch_add(p, v, __ATOMIC_RELAXED, __HIP_MEMORY_SCOPE_AGENT); }
__device__ __forceinline__ unsigned xb_xcc_id() { return (unsigned)__builtin_amdgcn_s_getreg((3 << 11) | 20) & 0xFu; }
#define XB_SPIN(cond, bar) do { unsigned _sp = 0; while (cond) { __builtin_amdgcn_s_sleep(1); \
    if ((++_sp & 255u) == 0u) { if (xb_ld(&(bar)[XB_TMO])) break; if (_sp > XB_SPIN_CAP) { atomicAdd(&(bar)[XB_TMO], 1u); break; } } } } while (0)
struct XcdBarrier { unsigned* bar; unsigned x; volatile LAS unsigned* st; };
__device__ __forceinline__ XcdBarrier xcd_barrier_post(unsigned* bar, volatile LAS unsigned* st) {
    XcdBarrier b; b.bar = bar; b.x = xb_xcc_id(); b.st = st;
    if (threadIdx.x == 0) (void)xb_add(&bar[XB_XCNT(b.x)], 1u);
    return b;
}
__device__ __forceinline__ void xcd_barrier_complete(unsigned* bar, unsigned x, unsigned& nloc, unsigned& nx) {
    const unsigned G = gridDim.x * gridDim.y * gridDim.z;
    unsigned sum, cnt, mine, sp = 0u;
    for (;;) {
        sum = 0u; cnt = 0u; mine = 0u;
#pragma unroll
        for (unsigned j = 0; j < 16; ++j) { const unsigned c = xb_ld(&bar[XB_XCNT(j)]); sum += c; cnt += (c > 0u) ? 1u : 0u; mine = (j == x) ? c : mine; }
        if (sum == G) break;
        __builtin_amdgcn_s_sleep(1);
        if ((++sp & 255u) == 0u) { if (xb_ld(&bar[XB_TMO])) break; if (sp > XB_SPIN_CAP) { atomicAdd(&bar[XB_TMO], 1u); break; } }
    }
    nloc = mine > 0u ? mine : 1u; nx = cnt > 0u ? cnt : 1u;
}
__device__ __forceinline__ void xcd_barrier(const XcdBarrier& b) {
    asm volatile("s_waitcnt vmcnt(0)" ::: "memory");
    __syncthreads();
    if (threadIdx.x == 0) {
        unsigned* bar = b.bar;
        __builtin_amdgcn_s_waitcnt(0);
        unsigned nloc = b.st[0], nx = b.st[1];
        if (nloc == 0u) { xcd_barrier_complete(bar, b.x, nloc, nx); b.st[0] = nloc; b.st[1] = nx; }
        const unsigned old = xb_add(&bar[XB_XSUB(b.x)], 1u);
        const unsigned gen = old / nloc;
        if (old + 1u == (gen + 1u) * nloc) {
            __builtin_amdgcn_fence(__ATOMIC_RELEASE, "agent");
            asm volatile("s_waitcnt vmcnt(0)" ::: "memory");
            const unsigned og = xb_add(&bar[XB_TOP], 1u);
            const unsigned tg = og / nx;
            if (og + 1u == (tg + 1u) * nx) xb_add(&bar[XB_TOPGEN], 1u);
            else XB_SPIN(xb_ld(&bar[XB_TOPGEN]) == tg, bar);
            __builtin_amdgcn_fence(__ATOMIC_ACQUIRE, "agent");
            xb_add(&bar[XB_XGEN(b.x)], 1u);
            asm volatile("s_waitcnt vmcnt(0)" ::: "memory");
        } else {
            XB_SPIN(xb_ld(&bar[XB_XGEN(b.x)]) == gen, bar);
            __builtin_amdgcn_fence(__ATOMIC_ACQUIRE, "agent");
            asm volatile("s_waitcnt vmcnt(0)" ::: "memory");
        }
    }
    __syncthreads();
}

template <int MI, bool TR, class AF, class BF>
__device__ __forceinline__ void gemm_core(f32x16 (&acc)[MI][2], const AF& af, const BF& bf, const int nk, unsigned char* lds) {
    constexpr int BM = 64 * MI;
    constexpr int A_BYTES = BM * 128, STAGE = A_BYTES + 256 * 128;
    const int t = threadIdx.x, lane = t & 63, w = t >> 6, wm = w >> 2, wn = w & 3;
    const int l31 = lane & 31, hh = lane >> 5;
    const int ch = t & 7, r0 = t >> 3;
    const bf16_t* abase = af.base();
    unsigned aoff[MI];
#pragma unroll
    for (int i = 0; i < MI; ++i) aoff[i] = af.off(r0 + 64 * i);
    const int a_lds = r0 * 128 + ((ch ^ swz(r0)) << 4);
    u32x4 areg[MI];
    f32x4 bregf[8]; u32x4 bregh[4];
    unsigned boff[4];
    const float* bcolf = nullptr;
    if constexpr (BF::KN) { bcolf = bf.col(4 * lane); }
    else {
#pragma unroll
        for (int i = 0; i < 4; ++i) boff[i] = bf.off(r0 + 64 * i);
    }
    auto gload = [&](int kt) {
        const long ko = af.koff(kt) + ch * 8;
#pragma unroll
        for (int i = 0; i < MI; ++i) areg[i] = *(const u32x4*)(abase + aoff[i] + ko);
        if constexpr (BF::KN) {
            const float* bp = bcolf + (long)(kt * 64 + w * 8) * bf.ldb;
#pragma unroll
            for (int i = 0; i < 8; ++i) bregf[i] = *(const f32x4*)(bp + (long)i * bf.ldb);
        } else {
            const bf16_t* bp = bf.base() + bf.koff(kt) + ch * 8;
#pragma unroll
            for (int i = 0; i < 4; ++i) bregh[i] = *(const u32x4*)(bp + boff[i]);
        }
    };
    auto lstore = [&](int st) {
        unsigned char* base = lds + st * STAGE;
#pragma unroll
        for (int i = 0; i < MI; ++i) *(u32x4*)(base + a_lds + i * 64 * 128) = areg[i];
        unsigned char* bb = base + A_BYTES;
        if constexpr (BF::KN) {
#pragma unroll
            for (int cc = 0; cc < 4; ++cc) {
                const int col = 4 * lane + cc;
                u32x4 v; v.x = cvt_pk_bf16(bregf[0][cc], bregf[1][cc]); v.y = cvt_pk_bf16(bregf[2][cc], bregf[3][cc]);
                v.z = cvt_pk_bf16(bregf[4][cc], bregf[5][cc]); v.w = cvt_pk_bf16(bregf[6][cc], bregf[7][cc]);
                *(u32x4*)(bb + col * 128 + ((w ^ swz(col)) << 4)) = v;
            }
        } else {
#pragma unroll
            for (int i = 0; i < 4; ++i) *(u32x4*)(bb + a_lds + i * 64 * 128) = bregh[i];
        }
    };
    const int fsw = swz(l31);
    const int a_frag = (wm * 32 * MI + l31) * 128, b_frag = (wn * 64 + l31) * 128;
    auto compute = [&](int st) {
        const unsigned char* base = lds + st * STAGE;
        const unsigned char* bb = base + A_BYTES;
#if NAIVE_MMA
#pragma unroll
        for (int mi = 0; mi < MI; ++mi)
#pragma unroll
            for (int ni = 0; ni < 2; ++ni)
#pragma unroll
                for (int rg = 0; rg < 16; ++rg) {
                    const int row = TR ? (wm * 32 * MI + mi * 32 + l31) : (wm * 32 * MI + mi * 32 + (rg & 3) + 8 * (rg >> 2) + 4 * hh);
                    const int col = TR ? (wn * 64 + ni * 32 + (rg & 3) + 8 * (rg >> 2) + 4 * hh) : (wn * 64 + ni * 32 + l31);
                    float s = 0.f;
                    for (int k = 0; k < 64; ++k) {
                        const bf16_t av = *(const bf16_t*)(base + row * 128 + (((k >> 3) ^ swz(row)) << 4) + (k & 7) * 2);
                        const bf16_t bv = *(const bf16_t*)(bb + col * 128 + (((k >> 3) ^ swz(col)) << 4) + (k & 7) * 2);
                        s += bf2f(av) * bf2f(bv);
                    }
                    acc[mi][ni][rg] += s;
                }
#else
#pragma unroll 2
        for (int s = 0; s < 4; ++s) {
            const int pos = ((2 * s + hh) ^ fsw) << 4;
            bf16x8 bfr[2];
#pragma unroll
            for (int ni = 0; ni < 2; ++ni) bfr[ni] = *(const bf16x8*)(bb + b_frag + ni * 32 * 128 + pos);
#pragma unroll
            for (int mi = 0; mi < MI; ++mi) {
                const bf16x8 afr = *(const bf16x8*)(base + a_frag + mi * 32 * 128 + pos);
#pragma unroll
                for (int ni = 0; ni < 2; ++ni) acc[mi][ni] = TR ? __builtin_amdgcn_mfma_f32_32x32x16_bf16(bfr[ni], afr, acc[mi][ni], 0, 0, 0)
                                                               : __builtin_amdgcn_mfma_f32_32x32x16_bf16(afr, bfr[ni], acc[mi][ni], 0, 0, 0);
            }
        }
#endif
    };
    int nk_ = nk; asm volatile("" : "+s"(nk_));
    __syncthreads();
    gload(0);
    lstore(0);
    __syncthreads();
#pragma unroll 1
    for (int kt = 0; kt < nk_; ++kt) {
        const bool more = (kt + 1 < nk_);
        if (more) gload(kt + 1);
        compute(kt & 1);
        if (more) lstore((kt + 1) & 1);
        __syncthreads();
    }
}

template <int MI> __device__ __forceinline__ void zero_acc(f32x16 (&acc)[MI][2]) {
#pragma unroll
    for (int mi = 0; mi < MI; ++mi)
#pragma unroll
        for (int ni = 0; ni < 2; ++ni)
#pragma unroll
            for (int r = 0; r < 16; ++r) acc[mi][ni][r] = 0.f;
}
template <int MI, class EPI>
__device__ __forceinline__ void run_epilogue(const f32x16 (&acc)[MI][2], const EPI& epi) {
    const int t = threadIdx.x, lane = t & 63, w = t >> 6, wm = w >> 2, wn = w & 3, l31 = lane & 31, hh = lane >> 5;
#pragma unroll
    for (int mi = 0; mi < MI; ++mi)
#pragma unroll
        for (int rg = 0; rg < 16; ++rg) {
            const int r = wm * 32 * MI + mi * 32 + (rg & 3) + 8 * (rg >> 2) + 4 * hh;
            epi(r, wn * 64 + l31, acc[mi][0][rg], acc[mi][1][rg]);
            if ((rg & 7) == 7) __builtin_amdgcn_sched_barrier(0);
        }
}

template <int MI, class EPI>
__device__ __forceinline__ void run_epilogue_tr(const f32x16 (&acc)[MI][2], const EPI& epi) {
    const int t = threadIdx.x, lane = t & 63, w = t >> 6, wm = w >> 2, wn = w & 3, l31 = lane & 31, hh = lane >> 5;
#pragma unroll
    for (int mi = 0; mi < MI; ++mi) {
        const int r = wm * 32 * MI + mi * 32 + l31;
#pragma unroll
        for (int q4 = 0; q4 < 4; ++q4) {
            const f32x4 v0 = {acc[mi][0][4 * q4], acc[mi][0][4 * q4 + 1], acc[mi][0][4 * q4 + 2], acc[mi][0][4 * q4 + 3]};
            const f32x4 v1 = {acc[mi][1][4 * q4], acc[mi][1][4 * q4 + 1], acc[mi][1][4 * q4 + 2], acc[mi][1][4 * q4 + 3]};
            epi(r, wn * 64 + 8 * q4 + 4 * hh, v0, v1);
        }
        __builtin_amdgcn_sched_barrier(0);
    }
}
__device__ __forceinline__ u32x2 pack4(const f32x4 v) { u32x2 p; p.x = cvt_pk_bf16(v[0], v[1]); p.y = cvt_pk_bf16(v[2], v[3]); return p; }
__device__ __forceinline__ f32x4 unpack4(const u32x2 p) { f32x4 v = {__uint_as_float(p.x << 16), __uint_as_float(p.x & 0xffff0000u), __uint_as_float(p.y << 16), __uint_as_float(p.y & 0xffff0000u)}; return v; }

__device__ __forceinline__ unsigned pack_fp8x4(const f32x4 v) { int p = __builtin_amdgcn_cvt_pk_fp8_f32(v[0], v[1], 0, false); p = __builtin_amdgcn_cvt_pk_fp8_f32(v[2], v[3], p, true); return (unsigned)p; }
__device__ __forceinline__ f32x4 unpack_fp8x4(const unsigned p) { f32x4 v = {__builtin_amdgcn_cvt_f32_fp8((int)p, 0), __builtin_amdgcn_cvt_f32_fp8((int)p, 1), __builtin_amdgcn_cvt_f32_fp8((int)p, 2), __builtin_amdgcn_cvt_f32_fp8((int)p, 3)}; return v; }
template <int MI> __device__ __forceinline__ void stage_bf16(const f32x16 (&acc)[MI][2], unsigned char* lds) {
    const int t = threadIdx.x, lane = t & 63, w = t >> 6, wm = w >> 2, wn = w & 3, l31 = lane & 31, hh = lane >> 5;
#pragma unroll
    for (int mi = 0; mi < MI; ++mi) {
        unsigned char* rp = lds + (wm * 32 * MI + mi * 32 + l31) * ST16 + (wn * 64 + 4 * hh) * 2;
#pragma unroll
        for (int ni = 0; ni < 2; ++ni)
#pragma unroll
            for (int q4 = 0; q4 < 4; ++q4) {
                const f32x4 v = {acc[mi][ni][4 * q4], acc[mi][ni][4 * q4 + 1], acc[mi][ni][4 * q4 + 2], acc[mi][ni][4 * q4 + 3]};
                *(u32x2*)(rp + (ni * 32 + 8 * q4) * 2) = pack4(v);
            }
    }
}
__device__ __forceinline__ void stage_f32(const f32x16 (&acc)[2][2], unsigned char* lds) {
    const int t = threadIdx.x, lane = t & 63, w = t >> 6, wm = w >> 2, wn = w & 3, l31 = lane & 31, hh = lane >> 5;
#pragma unroll
    for (int mi = 0; mi < 2; ++mi) {
        unsigned char* rp = lds + (wm * 64 + mi * 32 + l31) * ST32 + (wn * 64 + 4 * hh) * 4;
#pragma unroll
        for (int ni = 0; ni < 2; ++ni)
#pragma unroll
            for (int q4 = 0; q4 < 4; ++q4) {
                const f32x4 v = {acc[mi][ni][4 * q4], acc[mi][ni][4 * q4 + 1], acc[mi][ni][4 * q4 + 2], acc[mi][ni][4 * q4 + 3]};
                *(f32x4*)(rp + (ni * 32 + 8 * q4) * 4) = v;
            }
    }
}

struct ARows { const bf16_t* b; unsigned lda; int m0;
    __device__ __forceinline__ const bf16_t* base() const { return b; }
    __device__ __forceinline__ unsigned off(int r) const { return (unsigned)(m0 + r) * lda; }
    __device__ __forceinline__ long koff(int kt) const { return (long)kt * 64; } };
struct BKN { const float* b; int ldb; int n0; int nvalid; static constexpr bool KN = true;
    __device__ __forceinline__ const float* col(int c) const { int cc = n0 + c; cc = (cc < nvalid) ? cc : (nvalid - 4); return b + cc; } };
struct BKNPair { const float* g; long u_minus_g; int ldb; static constexpr bool KN = true;
    __device__ __forceinline__ const float* col(int c) const { return g + (long)((c >> 5) & 1) * u_minus_g + (c >> 6) * 32 + (c & 31); } };
struct BNK { const bf16_t* b; unsigned ldb; int n0; static constexpr bool KN = false;
    __device__ __forceinline__ const bf16_t* base() const { return b; }
    __device__ __forceinline__ unsigned off(int c) const { return (unsigned)(n0 + c) * ldb; }
    __device__ __forceinline__ long koff(int kt) const { return (long)kt * 64; } };

namespace pg8 {
#define PG8_LAS __attribute__((address_space(3)))
typedef unsigned short bf16_t;
typedef short bf16x8 __attribute__((ext_vector_type(8)));
typedef float f32x4 __attribute__((ext_vector_type(4)));
typedef unsigned u32x4 __attribute__((ext_vector_type(4)));
constexpr int BM = 256, BK = 64, HALF = 128, HTB = HALF * BK * 2  , STAGE_BYTES = 8 * HTB, NXCD = 8, WGM = 8;

__host__ __device__ __forceinline__ int lds_byte(int r, int c) { const int st = (r >> 4) * 2 + (c >> 5), rr = r & 15, cc = c & 31, ob = rr * 64 + cc * 2; return st * 1024 + (ob ^ (((ob >> 9) & 1) << 5)); }
__host__ __device__ __forceinline__ void stage_rc(int b, int& R, int& C) { const int st = b / 1024, sb = b % 1024, swz = sb ^ (((sb >> 9) & 1) << 5); R = (st >> 1) * 16 + swz / 64; C = (st & 1) * 32 + (swz % 64) / 2; }
__host__ __device__ __forceinline__ int perm32(int rho) { const int n = rho >> 4, i = rho & 15; return 8 * (i >> 2) + 4 * n + (i & 3); }

struct Unit { int pm, pn; };
struct Gemm { const bf16_t* A; const bf16_t* Bt; int M, N, K; int lda; int ldb; };

struct StaticOrder {
    int nM, nN, nwg, G, c;
    __host__ __device__ void init(int M, int N, int G_, int c_) { nM = M / BM; nN = N / BM; nwg = nM * nN; G = G_; c = c_; }
    __host__ __device__ bool next(int i, Unit& u) const {
        const long L = (long)i * G + c; if (L >= nwg) return false;
        int wgid = (int)L; { const int q = nwg / NXCD, r = nwg % NXCD, xcd = wgid % NXCD, off = wgid / NXCD; wgid = (xcd < r ? xcd * (q + 1) : r * (q + 1) + (xcd - r) * q) + off; }
        const int nig = WGM * nN, gid = wgid / nig, fm = gid * WGM, gsz = (nM - fm) < WGM ? (nM - fm) : WGM;
        u.pm = fm + ((wgid % nig) % gsz); u.pn = (wgid % nig) / gsz; return true;
    }
    __device__ __forceinline__ void a_ready(const Unit&) const {}
    __device__ __forceinline__ void done(const Unit&) const {}
};
template <class Epi, class Sched, bool ALIGN_EPI = false, bool SP2 = false>
__device__ __forceinline__ void gemm_phase(PG8_LAS unsigned char* lds, const Gemm g, const Sched& S, const Epi& E) {
    const int tid = threadIdx.x, wid = __builtin_amdgcn_readfirstlane(tid >> 6), lane = tid & 63, wr = wid >> 2, wc = wid & 3, fr = lane & 15, fq = lane >> 4;
    const int K = g.K, nt = K / BK, LDA = g.lda ? g.lda : g.K, LDB = g.ldb ? g.ldb : g.K;
    unsigned voffA[2], voffB[2];
#pragma unroll
    for (int i = 0; i < 2; ++i) { int R, C; stage_rc(tid * 16 + i * 8192, R, C); const int Rb = Epi::PERM ? ((R & ~31) + perm32(R & 31)) : R;
        voffA[i] = (unsigned)(R * LDA + C) * 2u; voffB[i] = (unsigned)(Rb * LDB + C) * 2u; }
    const size_t kstep = (size_t)(BK * 2);
    const size_t hstep = (size_t)HALF * LDB * 2;
    const size_t tstep = 2 * hstep;
    const size_t hstepA = (size_t)HALF * LDA * 2, tstepA = 2 * hstepA;
    const unsigned ldsw = (unsigned)wid * 1024u;
    const int aoff = lds_byte(wr * 64 + fr, fq * 8), boff = lds_byte(wc * 32 + fr, fq * 8);
#define PG8_SA(b, h) (((b) * 2 + (h)) * HTB)
#define PG8_SB(b, h) ((4 + (b) * 2 + (h)) * HTB)
#define PG8_STAGE(bufoff, gbase, voff) do { _Pragma("unroll") for (int _i = 0; _i < 2; ++_i) \
        __builtin_amdgcn_global_load_lds((const unsigned*)((const char*)(gbase) + (voff)[_i]), (PG8_LAS unsigned*)(lds + (bufoff) + ldsw + _i * 8192), 16, 0, 0); } while (0)
#define PG8_LDA(dst, b, h) do { _Pragma("unroll") for (int m = 0; m < 4; ++m) _Pragma("unroll") for (int k = 0; k < 2; ++k) dst[m][k] = *(const PG8_LAS bf16x8*)(lds + PG8_SA(b, h) + aoff + m * 2048 + k * 1024); } while (0)
#define PG8_LDB(dst, b, h) do { _Pragma("unroll") for (int n = 0; n < 2; ++n) _Pragma("unroll") for (int k = 0; k < 2; ++k) dst[n][k] = *(const PG8_LAS bf16x8*)(lds + PG8_SB(b, h) + boff + n * 2048 + k * 1024); } while (0)
#define PG8_MMA(ai, bj, At, Bt) do { __builtin_amdgcn_s_setprio(1); _Pragma("unroll") for (int m = 0; m < 4; ++m) _Pragma("unroll") for (int n = 0; n < 2; ++n) _Pragma("unroll") for (int k = 0; k < 2; ++k) \
        acc[ai][bj][m][n] = __builtin_amdgcn_mfma_f32_16x16x32_bf16(Bt[n][k], At[m][k], acc[ai][bj][m][n], 0, 0, 0); __builtin_amdgcn_s_setprio(0); } while (0)
#define PG8_WAIT_V(n) asm volatile("s_waitcnt vmcnt(" #n ")" ::: "memory")
#define PG8_WAIT_L(n) asm volatile("s_waitcnt lgkmcnt(" #n ")" ::: "memory")
#define PG8_BAR __builtin_amdgcn_s_barrier()
#define PG8_SCHED __builtin_amdgcn_sched_barrier(0)
    Unit cur, nxt; int ui = 0;
    if (!S.next(0, cur)) return;
    f32x4 acc[2][2][4][2];
#pragma unroll
    for (int a = 0; a < 2; ++a)
#pragma unroll
        for (int b = 0; b < 2; ++b)
#pragma unroll
            for (int m = 0; m < 4; ++m)
#pragma unroll
                for (int n = 0; n < 2; ++n) acc[a][b][m][n] = (f32x4){0.f, 0.f, 0.f, 0.f};
    bf16x8 At[4][2], B0[2][2], B1[2][2];
    const char* cA = (const char*)g.A + (size_t)cur.pm * tstepA; const char* cB = (const char*)g.Bt + (size_t)cur.pn * tstep;
    S.a_ready(cur);
    if constexpr (SP2) {
        PG8_STAGE(PG8_SB(0, 0), cB, voffB); PG8_STAGE(PG8_SB(0, 1), cB + hstep, voffB); PG8_STAGE(PG8_SA(0, 0), cA, voffA); PG8_STAGE(PG8_SA(0, 1), cA + hstepA, voffA);
        if (wr == 1) PG8_BAR;
        PG8_WAIT_V(2); PG8_BAR;
        PG8_STAGE(PG8_SB(1, 0), cB + kstep, voffB); PG8_STAGE(PG8_SA(1, 0), cA + kstep, voffA); PG8_STAGE(PG8_SB(1, 1), cB + hstep + kstep, voffB);
        PG8_WAIT_V(6); PG8_BAR;
    } else {
        PG8_STAGE(PG8_SB(0, 0), cB, voffB); PG8_STAGE(PG8_SA(0, 0), cA, voffA); PG8_STAGE(PG8_SB(0, 1), cB + hstep, voffB); PG8_STAGE(PG8_SA(0, 1), cA + hstepA, voffA);
        if (wr == 1) PG8_BAR;
        PG8_WAIT_V(4); PG8_BAR;
        PG8_STAGE(PG8_SB(1, 0), cB + kstep, voffB); PG8_STAGE(PG8_SA(1, 0), cA + kstep, voffA); PG8_STAGE(PG8_SB(1, 1), cB + hstep + kstep, voffB);
        PG8_WAIT_V(6); PG8_BAR;
    }
    for (;;) {
        const bool has_next = S.next(ui + 1, nxt);
        const char* nA = has_next ? (const char*)g.A + (size_t)nxt.pm * tstepA : cA; const char* nB = has_next ? (const char*)g.Bt + (size_t)nxt.pn * tstep : cB;
        for (int t = 0; t < nt; t += 2) {
            const bool last = (t == nt - 2);
            const char* a1 = cA + (size_t)(t + 1) * kstep;
            const char* a2 = last ? nA : cA + (size_t)(t + 2) * kstep; const char* b2 = last ? nB : cB + (size_t)(t + 2) * kstep;
            const char* a3 = a2 + kstep; const char* b3 = b2 + kstep;
            if (last && has_next) S.a_ready(nxt);
            if constexpr (SP2) {
            PG8_LDB(B0, 0, 0); PG8_LDB(B1, 0, 1); PG8_SCHED; PG8_LDA(At, 0, 0); PG8_STAGE(PG8_SA(1, 1), a1 + hstepA, voffA);
            PG8_WAIT_V(8); PG8_WAIT_L(0); PG8_BAR; PG8_MMA(0, 0, At, B0); PG8_MMA(0, 1, At, B1); PG8_BAR; PG8_SCHED;
            PG8_LDA(At, 0, 1); PG8_STAGE(PG8_SB(0, 0), b2, voffB); PG8_STAGE(PG8_SB(0, 1), b2 + hstep, voffB); PG8_STAGE(PG8_SA(0, 0), a2, voffA);
            PG8_WAIT_V(8); PG8_WAIT_L(0); PG8_BAR; PG8_MMA(1, 0, At, B0); PG8_MMA(1, 1, At, B1); PG8_BAR; PG8_SCHED;
            PG8_LDB(B0, 1, 0); PG8_LDB(B1, 1, 1); PG8_SCHED; PG8_LDA(At, 1, 0); PG8_STAGE(PG8_SA(0, 1), a2 + hstepA, voffA);
            PG8_WAIT_V(8); PG8_WAIT_L(0); PG8_BAR; PG8_MMA(0, 0, At, B0); PG8_MMA(0, 1, At, B1); PG8_BAR; PG8_SCHED;
            PG8_LDA(At, 1, 1); PG8_STAGE(PG8_SB(1, 0), b3, voffB); PG8_STAGE(PG8_SB(1, 1), b3 + hstep, voffB); PG8_STAGE(PG8_SA(1, 0), a3, voffA);
            PG8_WAIT_V(8); PG8_WAIT_L(0); PG8_BAR; PG8_MMA(1, 0, At, B0); PG8_MMA(1, 1, At, B1); PG8_BAR; PG8_SCHED;
            } else {
            PG8_LDB(B0, 0, 0); PG8_SCHED; PG8_LDA(At, 0, 0); PG8_STAGE(PG8_SA(1, 1), a1 + hstepA, voffA);
            PG8_WAIT_L(8); PG8_BAR; PG8_WAIT_L(0); PG8_MMA(0, 0, At, B0); PG8_BAR; PG8_SCHED;
            PG8_LDB(B1, 0, 1); PG8_STAGE(PG8_SB(0, 0), b2, voffB);
            PG8_BAR; PG8_WAIT_L(0); PG8_MMA(0, 1, At, B1); PG8_BAR;
            PG8_LDA(At, 0, 1); PG8_STAGE(PG8_SA(0, 0), a2, voffA);
            PG8_BAR; PG8_WAIT_L(0); PG8_MMA(1, 0, At, B0); PG8_BAR; PG8_SCHED;
            PG8_STAGE(PG8_SB(0, 1), b2 + hstep, voffB);
            PG8_WAIT_V(6); PG8_BAR; PG8_MMA(1, 1, At, B1); PG8_BAR;
            PG8_LDB(B0, 1, 0); PG8_SCHED; PG8_LDA(At, 1, 0); PG8_STAGE(PG8_SA(0, 1), a2 + hstepA, voffA);
            PG8_WAIT_L(8); PG8_BAR; PG8_WAIT_L(0); PG8_MMA(0, 0, At, B0); PG8_BAR; PG8_SCHED;
            PG8_LDB(B1, 1, 1); PG8_STAGE(PG8_SB(1, 0), b3, voffB);
            PG8_BAR; PG8_WAIT_L(0); PG8_MMA(0, 1, At, B1); PG8_BAR;
            PG8_LDA(At, 1, 1); PG8_STAGE(PG8_SA(1, 0), a3, voffA);
            PG8_BAR; PG8_WAIT_L(0); PG8_MMA(1, 0, At, B0); PG8_BAR; PG8_SCHED;
            PG8_STAGE(PG8_SB(1, 1), b3 + hstep, voffB);
            PG8_WAIT_V(6); PG8_BAR; PG8_MMA(1, 1, At, B1); PG8_BAR;
            }
        }
        if constexpr (ALIGN_EPI) { if (wr == 0) PG8_BAR; }
        if constexpr (!Epi::AFTER_DRAIN) { E(acc, cur, wr, wc, fr, fq); S.done(cur); }
        if (!has_next) break;
#pragma unroll
        for (int a = 0; a < 2; ++a)
#pragma unroll
            for (int b = 0; b < 2; ++b)
#pragma unroll
                for (int m = 0; m < 4; ++m)
#pragma unroll
                    for (int n = 0; n < 2; ++n) acc[a][b][m][n] = (f32x4){0.f, 0.f, 0.f, 0.f};
        cur = nxt; cA = nA; cB = nB; ++ui;
        if constexpr (ALIGN_EPI) { if (wr == 1) PG8_BAR; }
    }
    PG8_WAIT_V(0);
    if constexpr (!ALIGN_EPI) { if (wr == 0) PG8_BAR; }
    PG8_BAR;
    if constexpr (Epi::AFTER_DRAIN) { E.fused(acc, cur, wr, wc, fr, fq, lds, wid, lane); S.done(cur); }
#undef PG8_SA
#undef PG8_SB
#undef PG8_STAGE
#undef PG8_LDA
#undef PG8_LDB
#undef PG8_MMA
#undef PG8_WAIT_V
#undef PG8_WAIT_L
#undef PG8_BAR
#undef PG8_SCHED
}
}


struct Args { const float* in[24]; float* out; unsigned char* ws; int ph_lo, ph_hi; };

struct Ctx {
    const Args& a; float* out; unsigned char* ws; unsigned char* lds; unsigned* ctl;
    int tid, lane, wave, G, vcu;
};

__device__ __forceinline__ u32x4 pack8(const f32x4 a, const f32x4 b) { u32x4 p; p.x = cvt_pk_bf16(a[0], a[1]); p.y = cvt_pk_bf16(a[2], a[3]); p.z = cvt_pk_bf16(b[0], b[1]); p.w = cvt_pk_bf16(b[2], b[3]); return p; }
__device__ __forceinline__ f32x4 unpack_lo(const u32x4 p) { f32x4 v = {__uint_as_float(p.x << 16), __uint_as_float(p.x & 0xffff0000u), __uint_as_float(p.y << 16), __uint_as_float(p.y & 0xffff0000u)}; return v; }
__device__ __forceinline__ f32x4 unpack_hi(const u32x4 p) { f32x4 v = {__uint_as_float(p.z << 16), __uint_as_float(p.z & 0xffff0000u), __uint_as_float(p.w << 16), __uint_as_float(p.w & 0xffff0000u)}; return v; }
#define EPI_LOOP(...) _Pragma("unroll") for (int ai = 0; ai < 2; ++ai) _Pragma("unroll") for (int m = 0; m < 4; ++m) { const unsigned row = row0 + ai * 128 + m * 16; \
    _Pragma("unroll") for (int bj = 0; bj < 2; ++bj) { const unsigned col = col0 + bj * 128; const f32x4 v0 = acc[ai][bj][m][0], v1 = acc[ai][bj][m][1]; __VA_ARGS__ } }
#define EPI_HEAD const unsigned row0 = u.pm * 256 + wr * 64 + fr; const unsigned col0 = u.pn * 256 + wc * 32 + 8 * fq;
struct EpiZ {
    static constexpr bool PERM = true, AFTER_DRAIN = false; bf16_t* zqkv; bf16_t* zf; bf16_t* sig;
    __device__ __forceinline__ void operator()(const f32x4 (&acc)[2][2][4][2], const pg8::Unit& u, int wr, int wc, int fr, int fq) const { EPI_HEAD
        EPI_LOOP(
            if (col < 416) *(u32x4*)(zqkv + row * 416u + col) = pack8(v0, v1);
            else if (col < 928) *(u32x4*)(zf + row * 512u + (col - 416)) = pack8(v0, v1);
            else if (col < INW) { const f32x4 s0 = {sigmoidf_(v0[0]), sigmoidf_(v0[1]), sigmoidf_(v0[2]), sigmoidf_(v0[3])}; const f32x4 s1 = {sigmoidf_(v1[0]), sigmoidf_(v1[1]), sigmoidf_(v1[2]), sigmoidf_(v1[3])};
                *(u32x4*)(sig + row * 2048u + (col - 928)) = pack8(s0, s1); } ) } };
struct EpiF {
    static constexpr bool PERM = true, AFTER_DRAIN = false; bf16_t* Fo;
    __device__ __forceinline__ void operator()(const f32x4 (&acc)[2][2][4][2], const pg8::Unit& u, int wr, int wc, int fr, int fq) const {
        const unsigned row0 = (u.pn >> 1) * 2048 + u.pm * 256 + wr * 64 + fr; const unsigned col0 = (u.pn & 1) * 256 + wc * 32 + 8 * fq;
        EPI_LOOP( *(u32x4*)(Fo + row * 512u + col) = pack8(v0, v1); ) } };
struct EpiMgA {
    static constexpr bool PERM = true, AFTER_DRAIN = false; bf16_t* mg; const bf16_t* sig;
    __device__ __forceinline__ void operator()(const f32x4 (&acc)[2][2][4][2], const pg8::Unit& u, int wr, int wc, int fr, int fq) const { EPI_HEAD
        EPI_LOOP( const u32x4 g = *(const u32x4*)(sig + row * 2048u + col); *(u32x4*)(mg + row * 1024u + col) = pack8(unpack_lo(g) * v0, unpack_hi(g) * v1); ) } };
struct EpiMgF {
    static constexpr bool PERM = true, AFTER_DRAIN = false; bf16_t* mg; const bf16_t* sig;
    __device__ __forceinline__ void operator()(const f32x4 (&acc)[2][2][4][2], const pg8::Unit& u, int wr, int wc, int fr, int fq) const { EPI_HEAD
        EPI_LOOP( const u32x4 g = *(const u32x4*)(sig + row * 2048u + 1024 + col); const u32x4 o = *(const u32x4*)(mg + row * 1024u + col);
            *(u32x4*)(mg + row * 1024u + col) = pack8(unpack_lo(o) + unpack_lo(g) * v0, unpack_hi(o) + unpack_hi(g) * v1); ) } };
struct EpiX1 {
    static constexpr bool PERM = true, AFTER_DRAIN = false; float* x1; const float* x; const float* adaf;
    __device__ __forceinline__ void operator()(const f32x4 (&acc)[2][2][4][2], const pg8::Unit& u, int wr, int wc, int fr, int fq) const { EPI_HEAD
        const float* g1 = adaf + (u.pm >> 3) * 6144 + 2 * 1024;
        EPI_LOOP( const f32x4 ga = *(const f32x4*)(g1 + col), gb = *(const f32x4*)(g1 + col + 4);
            *(f32x4*)(x1 + row * 1024u + col) = *(const f32x4*)(x + row * 1024u + col) + ga * v0; *(f32x4*)(x1 + row * 1024u + col + 4) = *(const f32x4*)(x + row * 1024u + col + 4) + gb * v1; ) } };
struct EpiSh {
    static constexpr bool PERM = true, AFTER_DRAIN = false; bf16_t* acts;
    __device__ __forceinline__ void operator()(const f32x4 (&acc)[2][2][4][2], const pg8::Unit& u, int wr, int wc, int fr, int fq) const { EPI_HEAD
        EPI_LOOP( const f32x4 a = {siluf_(v0[0]) * v1[0], siluf_(v0[1]) * v1[1], siluf_(v0[2]) * v1[2], siluf_(v0[3]) * v1[3]};
            *(u32x2*)(acts + row * 256u + (col >> 1)) = pack4(a); ) } };
struct EpiOut {
    static constexpr bool PERM = true, AFTER_DRAIN = false; float* out; const float* x1; const float* adaf; const bf16_t* ybuf;
    __device__ __forceinline__ void operator()(const f32x4 (&acc)[2][2][4][2], const pg8::Unit& u, int wr, int wc, int fr, int fq) const { EPI_HEAD
        const float* g2 = adaf + (u.pm >> 3) * 6144 + 5 * 1024;
        EPI_LOOP( f32x4 s0 = v0, s1 = v1;
            f32x4 r0 = {0.f, 0.f, 0.f, 0.f}, r1 = {0.f, 0.f, 0.f, 0.f};
            _Pragma("unroll") for (int k = 0; k < 8; ++k) { const u32x2 y = *(const u32x2*)((const unsigned char*)ybuf + (row * 8u + k) * 1024u + col); r0 += unpack_fp8x4(y.x); r1 += unpack_fp8x4(y.y); }
            s0 += r0 * 0.0625f; s1 += r1 * 0.0625f;
            *(f32x4*)(out + row * 1024u + col) = *(const f32x4*)(x1 + row * 1024u + col) + *(const f32x4*)(g2 + col) * s0;
            *(f32x4*)(out + row * 1024u + col + 4) = *(const f32x4*)(x1 + row * 1024u + col + 4) + *(const f32x4*)(g2 + col + 4) * s1;
            if (m == 1 || m == 3) __builtin_amdgcn_sched_barrier(0); ) } };

template <class GET> __device__ __forceinline__ void conv_wt(const Ctx& F, bf16_t* dst, int K, int Nd, const GET& get) {
    const long gt = (long)F.vcu * NTHREADS + F.tid, gs = (long)F.G * NTHREADS; const long nchunk = (long)Nd * (K / 8);
    for (long c = gt; c < nchunk; c += gs) { const int n = (int)(c % Nd), k0 = (int)(c / Nd) * 8;
        u32x4 p; p.x = cvt_pk_bf16(get(k0, n), get(k0 + 1, n)); p.y = cvt_pk_bf16(get(k0 + 2, n), get(k0 + 3, n)); p.z = cvt_pk_bf16(get(k0 + 4, n), get(k0 + 5, n)); p.w = cvt_pk_bf16(get(k0 + 6, n), get(k0 + 7, n));
        *(u32x4*)(dst + (long)n * K + k0) = p; }
}

template <int K, int Nd, class GET4> __device__ __forceinline__ void conv4(bf16_t* dst, unsigned c, const GET4& get4) {
    constexpr unsigned NQ = Nd / 4; const unsigned n = (c % NQ) * 4u, k0 = (c / NQ) * 8u;
    f32x4 r[8];
#pragma unroll
    for (int i = 0; i < 8; ++i) r[i] = get4(k0 + i, n);
#pragma unroll
    for (int j = 0; j < 4; ++j) { u32x4 p; p.x = cvt_pk_bf16(r[0][j], r[1][j]); p.y = cvt_pk_bf16(r[2][j], r[3][j]); p.z = cvt_pk_bf16(r[4][j], r[5][j]); p.w = cvt_pk_bf16(r[6][j], r[7][j]);
        *(u32x4*)(dst + (size_t)(n + j) * K + k0) = p; }
}

__device__ __forceinline__ void p0_prep(const Ctx& F) {
    const float* c = F.a.in[1]; const float* w_ada = F.a.in[2];
    float* adap = (float*)(F.ws + WS_ADAP);
    float* sc = (float*)F.lds;
    float* red = sc + 512;
    for (int it = F.vcu; it < 256; it += F.G) {
        const int ks = it >> 4, chunk = it & 15;
        __syncthreads();
        { const int b = F.tid >> 6, k = F.tid & 63; sc[b * 64 + k] = siluf_(c[b * 1024 + ks * 64 + k]); }
        __syncthreads();
        const int cl = F.tid & 127, kq = F.tid >> 7;
        float acc[3][8];
#pragma unroll
        for (int j = 0; j < 3; ++j)
#pragma unroll
            for (int b = 0; b < 8; ++b) acc[j][b] = 0.f;
        const float* wp = w_ada + (long)(ks * 64 + kq * 16) * 6144 + chunk * 384 + cl;
#pragma unroll 8
        for (int k = 0; k < 16; ++k) {
            const float w0 = wp[k * 6144], w1 = wp[k * 6144 + 128], w2 = wp[k * 6144 + 256];
#pragma unroll
            for (int b = 0; b < 8; ++b) { const float sv = sc[b * 64 + kq * 16 + k]; acc[0][b] += sv * w0; acc[1][b] += sv * w1; acc[2][b] += sv * w2; }
        }
#pragma unroll
        for (int j = 0; j < 3; ++j)
#pragma unroll
            for (int b = 0; b < 8; ++b) red[(kq * 8 + b) * 384 + j * 128 + cl] = acc[j][b];
        __syncthreads();
        for (int o = F.tid; o < 8 * 384; o += NTHREADS) { const int b = o / 384, cc = o - b * 384;
            adap[((long)ks * 8 + b) * 6144 + chunk * 384 + cc] = (red[b * 384 + cc] + red[(8 + b) * 384 + cc]) + (red[(16 + b) * 384 + cc] + red[(24 + b) * 384 + cc]); }
    }
    const long gt = (long)F.vcu * NTHREADS + F.tid, gs = (long)F.G * NTHREADS;
    { float* rc = (float*)(F.ws + WS_ROPE); float* rs = rc + 2048 * 16;
      for (long i = gt; i < 2048 * 16; i += gs) { const int pos = (int)(i >> 4), j = (int)(i & 15);
          const float inv = powf(10000.0f, -(float)(2 * j) / 32.0f); const float ang = (float)pos * inv; rc[i] = cosf(ang); rs[i] = sinf(ang); } }
    { bf16_t* wd = (bf16_t*)(F.ws + WS_WDFT); const float nrm = 0.02209708691207961f;
      for (long g = gt; g < (long)2048 * 64; g += gs) { const int k = (int)(g >> 6), l = (int)(g & 63);
          const float cr = cospif((float)k * (1.0f / 1024.0f)), sr = sinpif((float)k * (1.0f / 1024.0f));
          const int idx0 = (k * (8 * l)) & 2047; const int q = k & 3;
          float c0 = cospif((float)idx0 * (1.0f / 1024.0f)) * nrm, s0 = sinpif((float)idx0 * (1.0f / 1024.0f)) * nrm;
#pragma unroll
          for (int i = 0; i < 4; ++i) {
              float cv[8], sv[8]; float cc = c0, ss = s0;
#pragma unroll
              for (int j = 0; j < 8; ++j) { cv[j] = cc; sv[j] = ss; const float cn = cc * cr - ss * sr; ss = ss * cr + cc * sr; cc = cn; }
              u32x4 pc, ps;
              pc.x = cvt_pk_bf16(cv[0], cv[1]); pc.y = cvt_pk_bf16(cv[2], cv[3]); pc.z = cvt_pk_bf16(cv[4], cv[5]); pc.w = cvt_pk_bf16(cv[6], cv[7]);
              ps.x = cvt_pk_bf16(sv[0], sv[1]); ps.y = cvt_pk_bf16(sv[2], sv[3]); ps.z = cvt_pk_bf16(sv[4], sv[5]); ps.w = cvt_pk_bf16(sv[6], sv[7]);
              *(u32x4*)(wd + (long)k * 4096 + 8 * l + 512 * i) = pc; *(u32x4*)(wd + (long)k * 4096 + 2048 + 8 * l + 512 * i) = ps;
              const float nc = (q == 0) ? c0 : (q == 1) ? -s0 : (q == 2) ? -c0 : s0;
              const float ns = (q == 0) ? s0 : (q == 1) ? c0 : (q == 2) ? -s0 : -c0;
              c0 = nc; s0 = ns;
          } } }
    { bf16_t* d6 = (bf16_t*)(F.ws + WS_D64T);
      for (long i = gt; i < 128 * 64; i += gs) { const int n = (int)(i >> 6), cc = (int)(i & 63), part = n >> 6, m = n & 63; const int idx = (m * cc) & 63;
          const float a = (float)idx * (1.0f / 32.0f); const float v = part ? -sinpif(a) : cospif(a); d6[i] = f2bf(v * 0.125f); } }
    { const float* w_in = F.a.in[5]; const float* w_pa = F.a.in[12]; const float* w_pf = F.a.in[13]; const float* w_o = F.a.in[14]; const float* w_r = F.a.in[16];
      const float* w_g = F.a.in[21]; const float* w_u = F.a.in[22]; const float* w_sd = F.a.in[23];
      const float* gq = F.a.in[6]; const float* wq = F.a.in[7]; const float* gkv = F.a.in[8]; const float* wk = F.a.in[9];
      constexpr unsigned C_IN = 768 * 128, C_OUT = 256 * 128, C_R = 64 * 384, C_PA = 256 * 64, C_SH = 128 * 128, C_SD = 256 * 32, C_UQ = 192 * 32, C_UKV = 256 * 16;
      constexpr unsigned C_TOT = C_IN + C_OUT + C_R + 2 * C_PA + C_SH + C_SD + C_UQ + C_UKV;
      for (unsigned c0 = (unsigned)gt; c0 < C_TOT; c0 += (unsigned)gs) {
          unsigned c = c0;
          if (c < C_IN) { conv4<1024, 3072>((bf16_t*)(F.ws + WS_WB_IN), c, [&](unsigned k, unsigned n) { const f32x4 z = {0.f, 0.f, 0.f, 0.f}; return (n < (unsigned)INW) ? *(const f32x4*)(w_in + k * (unsigned)INW + n) : z; }); continue; }
          c -= C_IN;
          if (c < C_OUT) { conv4<1024, 1024>((bf16_t*)(F.ws + WS_WB_OUT), c, [&](unsigned k, unsigned n) { return *(const f32x4*)(w_o + k * 1024u + n); }); continue; }
          c -= C_OUT;
          if (c < C_R) { conv4<3072, 256>((bf16_t*)(F.ws + WS_WB_R), c, [&](unsigned k3, unsigned n) { const unsigned rg = k3 >> 10, k = k3 & 1023u; const f32x4 wv = *(const f32x4*)(w_r + k * 256u + n);
                  f32x4 hi; hi[0] = bf2f(f2bf(wv[0])); hi[1] = bf2f(f2bf(wv[1])); hi[2] = bf2f(f2bf(wv[2])); hi[3] = bf2f(f2bf(wv[3])); return (rg == 2u) ? (wv - hi) : hi; }); continue; }
          c -= C_R;
          if (c < C_PA) { conv4<512, 1024>((bf16_t*)(F.ws + WS_WB_PA), c, [&](unsigned k, unsigned n) { return *(const f32x4*)(w_pa + k * 1024u + n); }); continue; }
          c -= C_PA;
          if (c < C_PA) { conv4<512, 1024>((bf16_t*)(F.ws + WS_WB_PF), c, [&](unsigned k, unsigned n) { return *(const f32x4*)(w_pf + k * 1024u + n); }); continue; }
          c -= C_PA;
          if (c < C_SH) { conv4<1024, 512>((bf16_t*)(F.ws + WS_WB_SH), c, [&](unsigned k, unsigned n) { const unsigned j = (n >> 3) * 4u; return ((n >> 2) & 1u) ? *(const f32x4*)(w_u + k * 256u + j) : *(const f32x4*)(w_g + k * 256u + j); }); continue; }
          c -= C_SH;
          if (c < C_SD) { conv4<256, 1024>((bf16_t*)(F.ws + WS_WB_SD), c, [&](unsigned k, unsigned n) { return *(const f32x4*)(w_sd + k * 1024u + n); }); continue; }
          c -= C_SD;
          if (c < C_UQ) { conv4<256, 768>((bf16_t*)(F.ws + WS_WUQ), c, [&](unsigned k, unsigned n) { return *(const f32x4*)(wq + k * 768u + n) * gq[k]; }); continue; }
          c -= C_UQ;
          conv4<128, 1024>((bf16_t*)(F.ws + WS_WUKV), c, [&](unsigned k, unsigned n) { return *(const f32x4*)(wk + k * 1024u + n) * gkv[k]; });
      } }
}

__device__ __forceinline__ void p_norm_rows(const Ctx& F, int which) {
    const float* src = which ? (const float*)(F.ws + WS_X1) : F.a.in[0];
    const float* gain = which ? F.a.in[15] : F.a.in[4];
    const float* adap = (const float*)(F.ws + WS_ADAP); const float* b_ada = F.a.in[3];
    float* adaf = (float*)(F.ws + WS_ADAF);
    bf16_t* dhi = which ? (bf16_t*)(F.ws + WS_A3) : (bf16_t*)(F.ws + WS_H); const unsigned ldd = which ? 3072u : 1024u;
    float* smod = (float*)F.lds; float* sshift = smod + 1024;
    const int nitems = 256 + (which ? 0 : 8);
    for (int it = F.vcu; it < nitems; it += F.G) {
        if (it >= 256) {
            const int b = it - 256;
            for (int j = F.tid; j < 6144; j += NTHREADS) { float s = b_ada[j];
                for (int ks = 0; ks < 16; ++ks) s += adap[((long)ks * 8 + b) * 6144 + j];
                adaf[b * 6144 + j] = s; }
            continue;
        }
        const int b = it >> 5;
        __syncthreads();
        for (int cidx = F.tid; cidx < 1024; cidx += NTHREADS) {
            float sh, scv;
            if (which == 0) { sh = b_ada[cidx]; scv = b_ada[1024 + cidx];
                for (int ks = 0; ks < 16; ++ks) { sh += adap[((long)ks * 8 + b) * 6144 + cidx]; scv += adap[((long)ks * 8 + b) * 6144 + 1024 + cidx]; } }
            else { sh = adaf[b * 6144 + 3 * 1024 + cidx]; scv = adaf[b * 6144 + 4 * 1024 + cidx]; }
            smod[cidx] = gain[cidx] * (1.f + scv); sshift[cidx] = sh;
        }
        __syncthreads();
        for (int j = 0; j < 8; ++j) {
            const long row = (long)it * 64 + F.wave * 8 + j;
            f32x4 v[4]; float ss = 0.f;
#pragma unroll
            for (int i = 0; i < 4; ++i) { v[i] = *(const f32x4*)(src + row * 1024 + i * 256 + F.lane * 4); ss += v[i][0] * v[i][0] + v[i][1] * v[i][1] + v[i][2] * v[i][2] + v[i][3] * v[i][3]; }
            ss = wave_sum(ss);
            const float rstd = rsqrtf(ss * (1.0f / 1024.0f) + EPS);
#pragma unroll
            for (int i = 0; i < 4; ++i) {
                const int c0 = i * 256 + F.lane * 4; float hv[4];
#pragma unroll
                for (int e = 0; e < 4; ++e) hv[e] = v[i][e] * rstd * smod[c0 + e] + sshift[c0 + e];
                u32x2 pk; pk.x = cvt_pk_bf16(hv[0], hv[1]); pk.y = cvt_pk_bf16(hv[2], hv[3]);
                *(u32x2*)(dhi + row * ldd + c0) = pk;
                if (which) {
                    float lo[4];
                    lo[0] = hv[0] - __uint_as_float(pk.x << 16); lo[1] = hv[1] - __uint_as_float(pk.x & 0xffff0000u);
                    lo[2] = hv[2] - __uint_as_float(pk.y << 16); lo[3] = hv[3] - __uint_as_float(pk.y & 0xffff0000u);
                    u32x2 pl; pl.x = cvt_pk_bf16(lo[0], lo[1]); pl.y = cvt_pk_bf16(lo[2], lo[3]);
                    *(u32x2*)(dhi + row * ldd + 1024 + c0) = pl; *(u32x2*)(dhi + row * ldd + 2048 + c0) = pk;
                }
            }
        }
    }
}

__device__ __forceinline__ void p2_win(const Ctx& F) {
    pg8::Gemm g{(const bf16_t*)(F.ws + WS_H), (const bf16_t*)(F.ws + WS_WB_IN), T, 3072, 1024};
    pg8::StaticOrder S; S.init(T, 3072, F.G, (int)blockIdx.x);
    EpiZ E{(bf16_t*)(F.ws + WS_ZQKV), (bf16_t*)(F.ws + WS_ZF), (bf16_t*)(F.ws + WS_SIG)};
    pg8::gemm_phase<EpiZ, pg8::StaticOrder, true, true>((LAS unsigned char*)F.lds, g, S, E);
}

struct BKNq { const float* b; static constexpr bool KN = true; int ldb;
    __device__ __forceinline__ const float* col(int c) const { return b + ((c < 192) ? c : 188); } };
__device__ __forceinline__ void p3_mixer_inputs(const Ctx& F) {
    const bf16_t* zqkv = (const bf16_t*)(F.ws + WS_ZQKV);
    const int lane = F.lane, w = F.wave;
    {
        const bf16_t* zf = (const bf16_t*)(F.ws + WS_ZF); const bf16_t* d6 = (const bf16_t*)(F.ws + WS_D64T); bf16_t* xt = (bf16_t*)(F.ws + WS_XT);
        for (int it = F.vcu; it < 8 * 64; it += F.G) {
            const int g = it & 7, tt = it >> 3; const int tok0 = tt * 256; const int b = tok0 >> 11, s0 = tok0 & 2047;
            f32x16 acc[2][2]; zero_acc<2>(acc);
            ARows af{d6, 64, 0}; BNK bf{zf + g * 64, 512, tok0};
            gemm_core<2, true>(acc, af, bf, 1, F.lds);
            stage_bf16<2>(acc, F.lds);
            __syncthreads();
#pragma unroll 4
            for (int rr = 0; rr < 16; ++rr) {
                const int n = w * 16 + rr; const int part = n >> 6, m = n & 63;
                *(u32x2*)(xt + (unsigned)(b * 512 + g * 64 + m) * 4096u + part * 2048 + s0 + 4 * lane) = *(const u32x2*)(F.lds + n * ST16 + lane * 8);
            }
        }
    }
    {
        constexpr int WQ_P = 528, WKV_P = 272, ST_P = 208;
        constexpr int L_WQ = 0, L_WKV = 96 * WQ_P, L_G = L_WKV + 128 * WKV_P, L_ST = L_G + 768;
        static_assert(L_ST + 8 * 32 * ST_P <= LDS_MISC, "head engine LDS");
        const float* rc = (const float*)(F.ws + WS_ROPE); const float* rsn = rc + 2048 * 16;
        bf16_t* Q = (bf16_t*)(F.ws + WS_Q); bf16_t* K = (bf16_t*)(F.ws + WS_K); bf16_t* vt = (bf16_t*)(F.ws + WS_VT);
        const int hd = F.vcu & 7; const int l31 = lane & 31, hh = lane >> 5;
        __syncthreads();
        { const u32x4* wq = (const u32x4*)((const bf16_t*)(F.ws + WS_WUQ) + (size_t)hd * 96 * 256); const u32x4* wk = (const u32x4*)((const bf16_t*)(F.ws + WS_WUKV) + (size_t)hd * 128 * 128);
          for (int c = F.tid; c < 96 * 32; c += NTHREADS) *(u32x4*)(F.lds + L_WQ + (c >> 5) * WQ_P + (c & 31) * 16) = wq[c];
          for (int c = F.tid; c < 128 * 16; c += NTHREADS) *(u32x4*)(F.lds + L_WKV + (c >> 4) * WKV_P + (c & 15) * 16) = wk[c];
          if (F.tid < 96) { ((float*)(F.lds + L_G))[F.tid] = F.a.in[10][F.tid]; ((float*)(F.lds + L_G))[96 + F.tid] = F.a.in[11][F.tid]; } }
        __syncthreads();
        const float* gq = (const float*)(F.lds + L_G); const float* gk = gq + 96;
        unsigned char* st = F.lds + L_ST + w * (32 * ST_P);
        const float qscale = 0.10206207261596577f * 1.4426950408889634f;
#pragma unroll 1
        for (int i2 = 0; i2 < 2; ++i2) {
            const int sb = (F.vcu >> 3) + 32 * i2; const unsigned tok = sb * 256 + w * 32 + l31; const int b = tok >> 11, s = tok & 2047; const unsigned bh = b * 8 + hd;
            const bf16_t* zrow = zqkv + tok * 416u;
            const f32x4 cs0 = *(const f32x4*)(rc + s * 16 + 4 * hh), cs1 = *(const f32x4*)(rc + s * 16 + 8 + 4 * hh), sn0 = *(const f32x4*)(rsn + s * 16 + 4 * hh), sn1 = *(const f32x4*)(rsn + s * 16 + 8 + 4 * hh);
            {
                bf16x8 zq[16];
#pragma unroll
                for (int k = 0; k < 16; ++k) zq[k] = *(const bf16x8*)(zrow + 16 * k + 8 * hh);
                f32x16 aq[3];
#pragma unroll
                for (int f = 0; f < 3; ++f) {
#pragma unroll
                    for (int r = 0; r < 16; ++r) aq[f][r] = 0.f;
#pragma unroll
                    for (int k = 0; k < 16; ++k) { const bf16x8 wf = *(const bf16x8*)(F.lds + L_WQ + (32 * f + l31) * WQ_P + (16 * k + 8 * hh) * 2); aq[f] = __builtin_amdgcn_mfma_f32_32x32x16_bf16(wf, zq[k], aq[f], 0, 0, 0);
                        if ((k & 7) == 7) __builtin_amdgcn_sched_barrier(0); }
                }
                float ss = 0.f;
#pragma unroll
                for (int f = 0; f < 3; ++f)
#pragma unroll
                    for (int r = 0; r < 16; ++r) ss += aq[f][r] * aq[f][r];
                ss += __shfl_xor(ss, 32);
                const float rstd = rsqrtf(ss * (1.0f / 96.0f) + EPS) * qscale;
#pragma unroll
                for (int f = 0; f < 3; ++f)
#pragma unroll
                    for (int r = 0; r < 16; ++r) aq[f][r] *= rstd * gq[32 * f + (r & 3) + 8 * (r >> 2) + 4 * hh];
#pragma unroll
                for (int r = 0; r < 8; ++r) { const float c = (r < 4) ? cs0[r & 3] : cs1[r & 3], sn = (r < 4) ? sn0[r & 3] : sn1[r & 3];
                    const float r1 = aq[2][r], r2 = aq[2][r + 8]; aq[2][r] = r1 * c - r2 * sn; aq[2][r + 8] = r2 * c + r1 * sn; }
#pragma unroll
                for (int f = 0; f < 3; ++f)
#pragma unroll
                    for (int q4 = 0; q4 < 4; ++q4) { const f32x4 v = {aq[f][4 * q4], aq[f][4 * q4 + 1], aq[f][4 * q4 + 2], aq[f][4 * q4 + 3]};
                        *(u32x2*)(st + l31 * ST_P + (32 * f + 8 * q4 + 4 * hh) * 2) = pack4(v); }
                u32x4* dst = (u32x4*)(Q + ((size_t)bh * 2048 + (s - l31)) * 96);
#pragma unroll
                for (int c6 = 0; c6 < 6; ++c6) { const int c = c6 * 64 + lane; dst[c] = *(const u32x4*)(st + (c / 12) * ST_P + (c % 12) * 16); }
            }
            {
                bf16x8 zk[8]; float sk = 0.f;
#pragma unroll
                for (int k = 0; k < 8; ++k) { zk[k] = *(const bf16x8*)(zrow + 256 + 16 * k + 8 * hh);
#pragma unroll
                    for (int e = 0; e < 8; ++e) { const float z = bf2f((bf16_t)zk[k][e]); sk += z * z; } }
                sk += __shfl_xor(sk, 32);
                const float rkv = rsqrtf(sk * (1.0f / 128.0f) + EPS);
                f32x16 ak[4];
#pragma unroll
                for (int f = 0; f < 4; ++f) {
#pragma unroll
                    for (int r = 0; r < 16; ++r) ak[f][r] = 0.f;
#pragma unroll
                    for (int k = 0; k < 8; ++k) { const bf16x8 wf = *(const bf16x8*)(F.lds + L_WKV + (32 * f + l31) * WKV_P + (16 * k + 8 * hh) * 2); ak[f] = __builtin_amdgcn_mfma_f32_32x32x16_bf16(wf, zk[k], ak[f], 0, 0, 0); }
                    __builtin_amdgcn_sched_barrier(0);
                }
#pragma unroll
                for (int f = 2; f < 4; ++f)
#pragma unroll
                    for (int r = 0; r < 16; ++r) { const int dv = 32 * (f - 2) + (r & 3) + 8 * (r >> 2) + 4 * hh; vt[((size_t)bh * 64 + dv) * 2048 + s] = f2bf(ak[f][r] * rkv); }
                float zr[16];
#pragma unroll
                for (int q4 = 0; q4 < 4; ++q4) { const f32x4 t4 = unpack4(*(const u32x2*)(zrow + 384 + 8 * q4 + 4 * hh)); zr[4 * q4] = t4[0]; zr[4 * q4 + 1] = t4[1]; zr[4 * q4 + 2] = t4[2]; zr[4 * q4 + 3] = t4[3]; }
                float ss = 0.f;
#pragma unroll
                for (int f = 0; f < 2; ++f)
#pragma unroll
                    for (int r = 0; r < 16; ++r) { ak[f][r] *= rkv; ss += ak[f][r] * ak[f][r]; }
#pragma unroll
                for (int r = 0; r < 16; ++r) ss += zr[r] * zr[r];
                ss += __shfl_xor(ss, 32);
                const float rstd = rsqrtf(ss * (1.0f / 96.0f) + EPS);
#pragma unroll
                for (int f = 0; f < 2; ++f)
#pragma unroll
                    for (int r = 0; r < 16; ++r) ak[f][r] *= rstd * gk[32 * f + (r & 3) + 8 * (r >> 2) + 4 * hh];
#pragma unroll
                for (int r = 0; r < 16; ++r) zr[r] *= rstd * gk[64 + (r & 3) + 8 * (r >> 2) + 4 * hh];
#pragma unroll
                for (int r = 0; r < 8; ++r) { const float c = (r < 4) ? cs0[r & 3] : cs1[r & 3], sn = (r < 4) ? sn0[r & 3] : sn1[r & 3];
                    const float r1 = zr[r], r2 = zr[r + 8]; zr[r] = r1 * c - r2 * sn; zr[r + 8] = r2 * c + r1 * sn; }
#pragma unroll
                for (int f = 0; f < 2; ++f)
#pragma unroll
                    for (int q4 = 0; q4 < 4; ++q4) { const f32x4 v = {ak[f][4 * q4], ak[f][4 * q4 + 1], ak[f][4 * q4 + 2], ak[f][4 * q4 + 3]};
                        *(u32x2*)(st + l31 * ST_P + (32 * f + 8 * q4 + 4 * hh) * 2) = pack4(v); }
#pragma unroll
                for (int q4 = 0; q4 < 4; ++q4) { const f32x4 v = {zr[4 * q4], zr[4 * q4 + 1], zr[4 * q4 + 2], zr[4 * q4 + 3]};
                    *(u32x2*)(st + l31 * ST_P + (64 + 8 * q4 + 4 * hh) * 2) = pack4(v); }
                u32x4* dst = (u32x4*)(K + ((size_t)bh * 2048 + (s - l31)) * 96);
#pragma unroll
                for (int c6 = 0; c6 < 6; ++c6) { const int c = c6 * 64 + lane; dst[c] = *(const u32x4*)(st + (c / 12) * ST_P + (c % 12) * 16); }
            }
        }
    }
}

constexpr int KROW = 208, VROW = 136, K_TILE = 64 * KROW, V_TILE = 64 * VROW, AT_STAGE = K_TILE + V_TILE;
__device__ __forceinline__ void attn_item(const Ctx& F, int item) {
    const int qb = item & 7, bh = item >> 3, b = bh >> 3, hd = bh & 7;
    const bf16_t* Q = (const bf16_t*)(F.ws + WS_Q) + (long)bh * 2048 * 96;
    const bf16_t* K = (const bf16_t*)(F.ws + WS_K) + (long)bh * 2048 * 96;
    const bf16_t* Vt = (const bf16_t*)(F.ws + WS_VT) + (long)bh * 64 * 2048;
    bf16_t* O = (bf16_t*)(F.ws + WS_O);
    const int t = F.tid, lane = F.lane, w = F.wave, l31 = lane & 31, hh = lane >> 5;
    bf16x8 qf[6];
    { const bf16_t* qp = Q + (long)(qb * 256 + w * 32 + l31) * 96 + hh * 8;
#pragma unroll
      for (int s = 0; s < 6; ++s) qf[s] = *(const bf16x8*)(qp + s * 16); }
    f32x16 oacc[2];
#pragma unroll
    for (int d = 0; d < 2; ++d)
#pragma unroll
        for (int r = 0; r < 16; ++r) oacc[d][r] = 0.f;
    float m_run = -1e30f, l_run = 0.f;
    const int kq0 = t, kq1 = t + 512;
    const int k_l0 = (kq0 / 12) * KROW + (kq0 % 12) * 16, k_l1 = (kq1 / 12) * KROW + (kq1 % 12) * 16;
    const int v_dv = t >> 3, v_c = t & 7; const int v_l = v_dv * VROW + v_c * 16;
    u32x4 kr0, kr1, vr;
    auto gload = [&](int j) {
        const bf16_t* kp = K + (long)j * 64 * 96;
        kr0 = *(const u32x4*)(kp + kq0 * 8);
        if (t < 256) kr1 = *(const u32x4*)(kp + kq1 * 8);
        vr = *(const u32x4*)(Vt + (long)v_dv * 2048 + j * 64 + v_c * 8);
    };
    auto lstore = [&](int st) {
        unsigned char* base = F.lds + st * AT_STAGE;
        *(u32x4*)(base + k_l0) = kr0;
        if (t < 256) *(u32x4*)(base + k_l1) = kr1;
        *(u32x2*)(base + K_TILE + v_l) = (u32x2){vr.x, vr.y}; *(u32x2*)(base + K_TILE + v_l + 8) = (u32x2){vr.z, vr.w};
    };
    __syncthreads();
    gload(0); lstore(0);
    __syncthreads();
    for (int j = 0; j < 32; ++j) {
        const bool more = (j + 1 < 32);
        if (more) gload(j + 1);
        const unsigned char* kb = F.lds + (j & 1) * AT_STAGE; const unsigned char* vb = kb + K_TILE;
        f32x16 st[2];
        {
            bf16x8 kfr[2][6];
#pragma unroll
            for (int f = 0; f < 2; ++f)
#pragma unroll
                for (int s = 0; s < 6; ++s) kfr[f][s] = *(const bf16x8*)(kb + (32 * f + l31) * KROW + (16 * s + 8 * hh) * 2);
            __builtin_amdgcn_sched_barrier(0);
#pragma unroll
            for (int f = 0; f < 2; ++f) {
#pragma unroll
                for (int r = 0; r < 16; ++r) st[f][r] = 0.f;
#pragma unroll
                for (int s = 0; s < 6; ++s) st[f] = __builtin_amdgcn_mfma_f32_32x32x16_bf16(kfr[f][s], qf[s], st[f], 0, 0, 0);
            }
        }
        float mx = st[0][0];
#pragma unroll
        for (int r = 1; r < 16; ++r) mx = fmaxf(mx, st[0][r]);
#pragma unroll
        for (int r = 0; r < 16; ++r) mx = fmaxf(mx, st[1][r]);
        mx = fmaxf(mx, __shfl_xor(mx, 32));
        const float m_new = fmaxf(m_run, mx);
        const float alpha = __builtin_amdgcn_exp2f(m_run - m_new);
        m_run = m_new;
        float ps = 0.f;
#pragma unroll
        for (int f = 0; f < 2; ++f)
#pragma unroll
            for (int r = 0; r < 16; ++r) { const float p = __builtin_amdgcn_exp2f(st[f][r] - m_new); st[f][r] = p; ps += p; }
        l_run = l_run * alpha + ps;
#pragma unroll
        for (int d = 0; d < 2; ++d)
#pragma unroll
            for (int r = 0; r < 16; ++r) oacc[d][r] *= alpha;
        {
            u32x4 vfr[2][2][2];
#pragma unroll
            for (int f = 0; f < 2; ++f)
#pragma unroll
                for (int s2 = 0; s2 < 2; ++s2)
#pragma unroll
                    for (int d = 0; d < 2; ++d) { const unsigned char* vp = vb + (32 * d + l31) * VROW + (32 * f + 16 * s2 + 4 * hh) * 2;
                        const u32x2 lo = *(const u32x2*)vp, hi = *(const u32x2*)(vp + 16); vfr[f][s2][d] = (u32x4){lo.x, lo.y, hi.x, hi.y}; }
#pragma unroll
            for (int f = 0; f < 2; ++f)
#pragma unroll
                for (int s2 = 0; s2 < 2; ++s2) {
                    u32x4 pw; pw.x = cvt_pk_bf16(st[f][8 * s2 + 0], st[f][8 * s2 + 1]); pw.y = cvt_pk_bf16(st[f][8 * s2 + 2], st[f][8 * s2 + 3]);
                    pw.z = cvt_pk_bf16(st[f][8 * s2 + 4], st[f][8 * s2 + 5]); pw.w = cvt_pk_bf16(st[f][8 * s2 + 6], st[f][8 * s2 + 7]);
                    const bf16x8 pf = *(const bf16x8*)&pw;
#pragma unroll
                    for (int d = 0; d < 2; ++d) oacc[d] = __builtin_amdgcn_mfma_f32_32x32x16_bf16(*(const bf16x8*)&vfr[f][s2][d], pf, oacc[d], 0, 0, 0);
                }
        }
        if (more) lstore((j + 1) & 1);
        __syncthreads();
    }
    l_run += __shfl_xor(l_run, 32);
    const float inv = 1.0f / l_run;
    const long tok = (long)b * 2048 + qb * 256 + w * 32 + l31;
#pragma unroll
    for (int d = 0; d < 2; ++d)
#pragma unroll
        for (int q4 = 0; q4 < 4; ++q4) {
            const int dv = 32 * d + 8 * q4 + 4 * hh;
            u32x2 pk; pk.x = cvt_pk_bf16(oacc[d][4 * q4 + 0] * inv, oacc[d][4 * q4 + 1] * inv); pk.y = cvt_pk_bf16(oacc[d][4 * q4 + 2] * inv, oacc[d][4 * q4 + 3] * inv);
            *(u32x2*)(O + tok * 512 + hd * 64 + dv) = pk;
        }
}

__device__ __forceinline__ void p6_attn_dft(const Ctx& F) {
    {
        pg8::Gemm g{(const bf16_t*)(F.ws + WS_WDFT), (const bf16_t*)(F.ws + WS_XT), 2048, 4096, 4096};
        pg8::StaticOrder S; S.init(2048, 4096, F.G, (int)blockIdx.x);
        EpiF E{(bf16_t*)(F.ws + WS_F)};
        pg8::gemm_phase<EpiF, pg8::StaticOrder, true, true>((LAS unsigned char*)F.lds, g, S, E);
    }
    volatile LAS int* sitem = (volatile LAS int*)(F.lds + LDS_MISC);
    auto next_item = [&]() -> int {
        __syncthreads();
        if (F.tid == 0) sitem[0] = (int)xb_add(F.ctl + CW_QUEUE, 1u);
        __syncthreads();
        return sitem[0];
    };
    int it = next_item();
    while (it < 512) { attn_item(F, it); it = next_item(); }
}

__device__ __forceinline__ void p7_merge(const Ctx& F) {
    bf16_t* mg = (bf16_t*)(F.ws + WS_MERGED); const bf16_t* sig = (const bf16_t*)(F.ws + WS_SIG);
    pg8::StaticOrder S; S.init(T, 1024, F.G, (int)blockIdx.x);
    { pg8::Gemm g{(const bf16_t*)(F.ws + WS_O), (const bf16_t*)(F.ws + WS_WB_PA), T, 1024, 512}; EpiMgA E{mg, sig};
      pg8::gemm_phase<EpiMgA, pg8::StaticOrder, true, true>((LAS unsigned char*)F.lds, g, S, E); }
    { pg8::Gemm g{(const bf16_t*)(F.ws + WS_F), (const bf16_t*)(F.ws + WS_WB_PF), T, 1024, 512}; EpiMgF E{mg, sig};
      pg8::gemm_phase<EpiMgF, pg8::StaticOrder, true, true>((LAS unsigned char*)F.lds, g, S, E); }
}

__device__ __forceinline__ void p8_out(const Ctx& F) {
    pg8::Gemm g{(const bf16_t*)(F.ws + WS_MERGED), (const bf16_t*)(F.ws + WS_WB_OUT), T, 1024, 1024};
    pg8::StaticOrder S; S.init(T, 1024, F.G, (int)blockIdx.x);
    EpiX1 E{(float*)(F.ws + WS_X1), F.a.in[0], (const float*)(F.ws + WS_ADAF)};
    pg8::gemm_phase<EpiX1, pg8::StaticOrder, true, true>((LAS unsigned char*)F.lds, g, S, E);
}

template <int NT>
__device__ __forceinline__ void topk_tokens(const Ctx& F, int tok0, const float (&lg)[NT][4], const float (&bs)[4]) {
    int* ltok = (int*)(F.ws + WS_LTOK); float* lw = (float*)(F.ws + WS_LW); unsigned* cnt = F.ctl + CW_CNT;
    const int lane = F.lane;
    float sc[NT][4]; unsigned long long key[NT][4];
#pragma unroll
    for (int t = 0; t < NT; ++t)
#pragma unroll
        for (int i = 0; i < 4; ++i) {
            sc[t][i] = sigmoidf_(lg[t][i]);
            const unsigned ub = __float_as_uint(sc[t][i] + bs[i]);
            const unsigned ord = (ub & 0x80000000u) ? ~ub : (ub | 0x80000000u);
            key[t][i] = ((unsigned long long)ord << 32) | (unsigned long long)(255 - (lane + 64 * i));
        }
    float wsum[NT], myw[NT]; int mye[NT];
#pragma unroll
    for (int t = 0; t < NT; ++t) { wsum[t] = 0.f; myw[t] = 0.f; mye[t] = 0; }
    for (int k = 0; k < 8; ++k) {
        unsigned long long best[NT];
#pragma unroll
        for (int t = 0; t < NT; ++t) { best[t] = key[t][0];
#pragma unroll
            for (int i = 1; i < 4; ++i) best[t] = (key[t][i] > best[t]) ? key[t][i] : best[t]; }
#pragma unroll
        for (int o = 32; o > 0; o >>= 1) {
#pragma unroll
            for (int t = 0; t < NT; ++t) {
                const unsigned lo = __shfl_xor((unsigned)best[t], o), hi = __shfl_xor((unsigned)(best[t] >> 32), o);
                const unsigned long long ob = ((unsigned long long)hi << 32) | lo;
                best[t] = (ob > best[t]) ? ob : best[t];
            }
        }
#pragma unroll
        for (int t = 0; t < NT; ++t) {
            const int e = 255 - (int)(best[t] & 0xffull);
            float s_own = 0.f;
#pragma unroll
            for (int i = 0; i < 4; ++i) { const bool mine = (e == lane + 64 * i); s_own = mine ? sc[t][i] : s_own; key[t][i] = mine ? 0ull : key[t][i]; }
            const float s_k = __shfl(s_own, e & 63);
            wsum[t] += s_k;
            myw[t] = (lane == k) ? s_k : myw[t]; mye[t] = (lane == k) ? e : mye[t];
        }
    }
    if (lane < 8) {
        unsigned slot[NT];
#pragma unroll
        for (int t = 0; t < NT; ++t) slot[t] = atomicAdd(&cnt[mye[t] * 64], 1u);
#pragma unroll
        for (int t = 0; t < NT; ++t) { ltok[(long)mye[t] * LCAP + slot[t]] = (tok0 + t) * 8 + lane; lw[(long)mye[t] * LCAP + slot[t]] = myw[t] / wsum[t] * 2.5f; }
    }
}

struct EpiLog {
    static constexpr bool PERM = true, AFTER_DRAIN = false; float* dst;
    __device__ __forceinline__ void operator()(const f32x4 (&acc)[2][2][4][2], const pg8::Unit& u, int wr, int wc, int fr, int fq) const { EPI_HEAD
        EPI_LOOP( *(f32x4*)(dst + row * 256u + col) = v0; *(f32x4*)(dst + row * 256u + col + 4) = v1; ) } };
__device__ __forceinline__ void p10_router_shared(const Ctx& F) {
    const bf16_t* a3 = (const bf16_t*)(F.ws + WS_A3); const bf16_t* wr = (const bf16_t*)(F.ws + WS_WB_R); float* part = (float*)(F.ws + WS_QRAW);
    const unsigned bx = blockIdx.x, G = (unsigned)F.G;
    {
        pg8::Gemm g{a3, (const bf16_t*)(F.ws + WS_WB_SH), T, 512, 1024, 3072};
        pg8::StaticOrder S; S.init(T, 512, F.G, (int)bx);
        EpiSh E{(bf16_t*)(F.ws + WS_ACTS)};
        pg8::gemm_phase<EpiSh, pg8::StaticOrder, true, true>((LAS unsigned char*)F.lds, g, S, E);
    }
    {
        const int seg = (bx >= 192u) ? 1 : 0;
        const bool has = (bx >= 128u);
        pg8::Gemm g{a3 + seg * 1536, wr + seg * 1536, T, 256, 1536, 3072};
        g.ldb = 3072;
        pg8::StaticOrder S; S.init(T, 256, F.G, has ? (int)((bx - 128u) & 63u) : (int)(G - 1));
        EpiLog E{part + (size_t)seg * T * 256};
        pg8::gemm_phase<EpiLog, pg8::StaticOrder, true, true>((LAS unsigned char*)F.lds, g, S, E);
    }
}
__device__ __forceinline__ void p11_topk(const Ctx& F) {
    const float* part = (const float*)(F.ws + WS_QRAW);
    float bs[4];
#pragma unroll
    for (int i = 0; i < 4; ++i) bs[i] = F.a.in[17][F.lane + 64 * i];
    for (int tok0 = (F.vcu * 8 + F.wave) * 8; tok0 < T; tok0 += F.G * 8 * 8) {
        float lg[8][4];
#pragma unroll
        for (int t = 0; t < 8; ++t)
#pragma unroll
            for (int i = 0; i < 4; ++i) { const size_t o = (size_t)(tok0 + t) * 256 + F.lane + 64 * i; lg[t][i] = part[o] + part[o + (size_t)T * 256]; }
        topk_tokens<8>(F, tok0, lg, bs);
    }
}

__device__ __forceinline__ int build_expert_tables(const Ctx& F, int per_rt) {
    volatile LAS int* offs = (volatile LAS int*)(F.lds + LDS_MISC); volatile LAS int* istart = offs + 264; volatile LAS int* wtot = offs + 540;
    unsigned* cnt = F.ctl + CW_CNT;
    const int t = F.tid, lane = F.lane;
    const int c = (t < NE) ? (int)cnt[t * 64] : 0; const int ni = ((c + 255) >> 8) * per_rt;
    int x = c, y = ni;
#pragma unroll
    for (int d = 1; d < 64; d <<= 1) { const int x2 = __shfl_up(x, d), y2 = __shfl_up(y, d); x += (lane >= d) ? x2 : 0; y += (lane >= d) ? y2 : 0; }
    __syncthreads();
    if (t < NE && lane == 63) { wtot[t >> 6] = x; wtot[4 + (t >> 6)] = y; }
    __syncthreads();
    if (t < NE) { int bx = 0, by = 0; for (int k = 0; k < (t >> 6); ++k) { bx += wtot[k]; by += wtot[4 + k]; }
        offs[t] = bx + x - c; istart[t] = by + y - ni; if (t == NE - 1) { offs[NE] = bx + x; istart[NE] = by + y; } }
    __syncthreads();
    return istart[NE];
}
__device__ __forceinline__ int find_expert(const Ctx& F, int it) {
    volatile LAS int* istart = (volatile LAS int*)(F.lds + LDS_MISC) + 264;
    int lo = 0, hi = NE;
    while (hi - lo > 1) { const int mid = (lo + hi) >> 1; if (istart[mid] <= it) lo = mid; else hi = mid; }
    return lo;
}
struct AGather { const bf16_t* b; const int* list; int m0, mvalid; unsigned lda;
    __device__ __forceinline__ const bf16_t* base() const { return b; }
    __device__ __forceinline__ unsigned off(int r) const { int i = m0 + r; i = (i < mvalid) ? i : (mvalid - 1); return (unsigned)(list[i] >> 3) * lda; }
    __device__ __forceinline__ long koff(int kt) const { return (long)kt * 64; } };
struct ARowsV { const bf16_t* b; unsigned lda; int m0, mvalid;
    __device__ __forceinline__ const bf16_t* base() const { return b; }
    __device__ __forceinline__ unsigned off(int r) const { int i = m0 + r; i = (i < mvalid) ? i : (mvalid - 1); return (unsigned)i * lda; }
    __device__ __forceinline__ long koff(int kt) const { return (long)kt * 64; } };

__device__ __forceinline__ void p12_exp_up(const Ctx& F) {
    const int total = build_expert_tables(F, 2);
    volatile LAS int* offs = (volatile LAS int*)(F.lds + LDS_MISC);
    volatile LAS int* istart = offs + 264;
    const bf16_t* hhi = (const bf16_t*)(F.ws + WS_A3); const int* ltok = (const int*)(F.ws + WS_LTOK); bf16_t* act = (bf16_t*)(F.ws + WS_ACT);
    unsigned* cnt = F.ctl + CW_CNT;
    for (int it = F.vcu; it < total; it += F.G) {
        const int e = find_expert(F, it); const int li = it - istart[e]; const int rt = li >> 1, ct = li & 1;
        const int me = (int)cnt[e * 64], m0 = rt * 256, j0 = ct * 128; const int ro = offs[e];
        f32x16 acc[4][2]; zero_acc<4>(acc);
        AGather af{hhi, ltok + (long)e * LCAP, m0, me, 3072u};
        BKNPair bf{F.a.in[18] + (long)e * 262144 + j0, (long)(F.a.in[19] - F.a.in[18]), 256};
        gemm_core<4, true>(acc, af, bf, 16, F.lds);
        run_epilogue_tr<4>(acc, [&](int r, int c0, f32x4 v0, f32x4 v1) { const int i = m0 + r; if (i < me) { const int j = j0 + (c0 >> 6) * 32 + (c0 & 31);
            const f32x4 a = {siluf_(v0[0]) * v1[0], siluf_(v0[1]) * v1[1], siluf_(v0[2]) * v1[2], siluf_(v0[3]) * v1[3]};
            *(u32x2*)(act + (unsigned)(ro + i) * 256u + j) = pack4(a); } });
    }
}
__device__ __forceinline__ void p13_exp_down(const Ctx& F) {
    constexpr int W_P = 528, ST_P = 144;
    constexpr int L_W = 0, L_ST = 128 * W_P;
    static_assert(L_ST + 8 * 32 * ST_P <= LDS_MISC, "expert-down engine LDS");
    (void)build_expert_tables(F, 1);
    volatile LAS int* offs = (volatile LAS int*)(F.lds + LDS_MISC);
    const int* ltok = (const int*)(F.ws + WS_LTOK); const float* lw = (const float*)(F.ws + WS_LW); const bf16_t* act = (const bf16_t*)(F.ws + WS_ACT);
    unsigned char* ybuf8 = F.ws + WS_YBUF; unsigned* cnt = F.ctl + CW_CNT;
    const int lane = F.lane, w = F.wave, l31 = lane & 31, hh = lane >> 5;
    unsigned char* st = F.lds + L_ST + w * (32 * ST_P);
#pragma unroll 1
    for (int it = F.vcu; it < NE * 8; it += F.G) {
        const int e = it >> 3, n0 = (it & 7) * 128; const int me = (int)cnt[e * 64]; const int ro = offs[e];
        if (me == 0) continue;
        __syncthreads();
        { int tid_ = F.tid; asm volatile("" : "+v"(tid_));
#pragma unroll 1
          for (int b2 = tid_; b2 < 1024; b2 += NTHREADS) { const int kb = b2 >> 5, nq = b2 & 31;
            const float* src = F.a.in[20] + (size_t)e * 262144 + (size_t)(kb * 8) * 1024 + n0 + 4 * nq;
            f32x4 r[8];
#pragma unroll
            for (int i = 0; i < 8; ++i) r[i] = *(const f32x4*)(src + (size_t)i * 1024);
#pragma unroll
            for (int j = 0; j < 4; ++j) { u32x4 p; p.x = cvt_pk_bf16(r[0][j], r[1][j]); p.y = cvt_pk_bf16(r[2][j], r[3][j]); p.z = cvt_pk_bf16(r[4][j], r[5][j]); p.w = cvt_pk_bf16(r[6][j], r[7][j]);
                *(u32x4*)(F.lds + L_W + (4 * nq + j) * W_P + kb * 16) = p; } } }
        __syncthreads();
        const int* lt = ltok + (size_t)e * LCAP; const float* lwe = lw + (size_t)e * LCAP;
#pragma unroll 1
        for (int tb = w; tb * 32 < me; tb += 8) {
            const int idx = tb * 32 + l31; const int idc = (idx < me) ? idx : (me - 1);
            const bf16_t* arow = act + (size_t)(ro + idc) * 256 + 8 * hh;
            bf16x8 z[16];
#pragma unroll
            for (int k = 0; k < 16; ++k) z[k] = *(const bf16x8*)(arow + 16 * k);
            const int myent = lt[idc]; const float sc = lwe[idc] * 16.f;
            f32x16 acc[4];
#pragma unroll
            for (int f = 0; f < 4; ++f)
#pragma unroll
                for (int r = 0; r < 16; ++r) acc[f][r] = 0.f;
            bf16x8 wa[8], wb[8];
            const unsigned char* wbase = F.lds + L_W + l31 * W_P + 16 * hh;
#define WLOAD(dst, hs) _Pragma("unroll") for (int k = 0; k < 8; ++k) dst[k] = *(const bf16x8*)(wbase + (32 * ((hs) >> 1)) * W_P + (128 * ((hs) & 1) + 16 * k) * 2)
#define WMMA(src, hs) _Pragma("unroll") for (int k = 0; k < 8; ++k) acc[(hs) >> 1] = __builtin_amdgcn_mfma_f32_32x32x16_bf16(src[k], z[8 * ((hs) & 1) + k], acc[(hs) >> 1], 0, 0, 0)
            WLOAD(wa, 0);
#pragma unroll
            for (int hs = 0; hs < 8; hs += 2) {
                WLOAD(wb, hs + 1); __builtin_amdgcn_sched_barrier(0);
                WMMA(wa, hs); __builtin_amdgcn_sched_barrier(0);
                if (hs + 2 < 8) { WLOAD(wa, hs + 2); } __builtin_amdgcn_sched_barrier(0);
                WMMA(wb, hs + 1); __builtin_amdgcn_sched_barrier(0);
            }
#undef WLOAD
#undef WMMA
#pragma unroll
            for (int f = 0; f < 4; ++f)
#pragma unroll
                for (int q4 = 0; q4 < 4; ++q4) { const f32x4 v = {acc[f][4 * q4] * sc, acc[f][4 * q4 + 1] * sc, acc[f][4 * q4 + 2] * sc, acc[f][4 * q4 + 3] * sc};
                    *(unsigned*)(st + l31 * ST_P + 32 * f + 8 * q4 + 4 * hh) = pack_fp8x4(v); }
#pragma unroll
            for (int i = 0; i < 4; ++i) { const int row = (lane >> 3) + 8 * i, ch = lane & 7;
                const u32x4 v = *(const u32x4*)(st + row * ST_P + ch * 16); const unsigned ent = (unsigned)__shfl(myent, row);
                if (tb * 32 + row < me) *(u32x4*)(ybuf8 + (size_t)ent * 1024 + n0 + ch * 16) = v; }
        }
    }
}

__device__ __forceinline__ void p14_final(const Ctx& F) {
    pg8::Gemm g{(const bf16_t*)(F.ws + WS_ACTS), (const bf16_t*)(F.ws + WS_WB_SD), T, 1024, 256};
    pg8::StaticOrder S; S.init(T, 1024, F.G, (int)blockIdx.x);
    EpiOut E{F.out, (const float*)(F.ws + WS_X1), (const float*)(F.ws + WS_ADAF), (const bf16_t*)(F.ws + WS_YBUF)};
    pg8::gemm_phase<EpiOut, pg8::StaticOrder, true, true>((LAS unsigned char*)F.lds, g, S, E);
}

constexpr int NPHASE = 13;
__global__ void __launch_bounds__(NTHREADS, 2) mk_fwd(Args args) {
    extern __shared__ __attribute__((aligned(16))) unsigned char lds[];
    const int tid_ = threadIdx.x, G_ = gridDim.x, bx_ = blockIdx.x;
    Ctx F{args, args.out, args.ws, lds, (unsigned*)(args.ws + WS_CTL), tid_, tid_ & 63, __builtin_amdgcn_readfirstlane(tid_ >> 6), G_, (G_ % 8 == 0) ? (bx_ % 8) * (G_ / 8) + bx_ / 8 : bx_};
    const int lo = args.ph_lo, hi = args.ph_hi;
    volatile LAS unsigned* bst = (volatile LAS unsigned*)(lds + LDS_MISC + 4096);
    XcdBarrier bar; bar.bar = F.ctl + CW_BAR; bar.x = 0; bar.st = bst;
    if (hi - lo > 1) {
        if (F.tid == 0) { bst[0] = 0u; bst[1] = 0u; bst[2] = 0u; bst[3] = 0u; }
        __syncthreads();
        bar = xcd_barrier_post(F.ctl + CW_BAR, bst);
    }
#define PHASE(k, call) if (lo <= (k) && (k) < hi) { call; if ((k) + 1 < hi) xcd_barrier(bar); }
    PHASE(0, p0_prep(F))
    PHASE(1, p_norm_rows(F, 0))
    PHASE(2, p2_win(F))
    PHASE(3, p3_mixer_inputs(F))
    PHASE(4, p6_attn_dft(F))
    PHASE(5, p7_merge(F))
    PHASE(6, p8_out(F))
    PHASE(7, p_norm_rows(F, 1))
    PHASE(8, p10_router_shared(F))
    PHASE(9, p11_topk(F))
    PHASE(10, p12_exp_up(F))
    PHASE(11, p13_exp_down(F))
    PHASE(12, p14_final(F))
#undef PHASE
}

extern "C" void kernel_launch(void* const* d_in, const int* in_sizes, int n_in, void* d_out, int out_size, void* d_ws, size_t ws_size, hipStream_t stream) {
    static int grid = 0;
    if (grid == 0) {
        if (n_in != 24 || out_size != T * DM || ws_size < WS_END) {
            fprintf(stderr, "kernel_launch: unexpected shapes (n_in %d, out %d, ws %zu < %zu); nothing launched\n", n_in, out_size, ws_size, (size_t)WS_END); grid = -1; return; }
        int dev = 0, cus = 0, per_cu = 0;
        if (hipGetDevice(&dev) != hipSuccess || hipDeviceGetAttribute(&cus, hipDeviceAttributeMultiprocessorCount, dev) != hipSuccess) { grid = -1; return; }
        if (hipFuncSetAttribute((const void*)mk_fwd, hipFuncAttributeMaxDynamicSharedMemorySize, LDS_BYTES) != hipSuccess) { fprintf(stderr, "kernel_launch: hipFuncSetAttribute failed\n"); grid = -1; return; }
        if (hipOccupancyMaxActiveBlocksPerMultiprocessor(&per_cu, (const void*)mk_fwd, NTHREADS, LDS_BYTES) != hipSuccess || per_cu < 1)
            fprintf(stderr, "kernel_launch: occupancy query reports %d blocks per CU\n", per_cu);
        (void)hipGetLastError();
        if (cus < 256) { fprintf(stderr, "kernel_launch: this kernel is laid out for 256 CUs (device reports %d); nothing launched\n", cus); grid = -1; return; }
        grid = 256;
    }
    if (grid < 0) return;
    (void)hipMemsetAsync((char*)d_ws + WS_CTL, 0, CTL_BYTES, stream);
    Args a{};
    for (int i = 0; i < 24; ++i) a.in[i] = (const float*)d_in[i];
    a.out = (float*)d_out; a.ws = (unsigned char*)d_ws;
#if N_LAUNCH_MODE == 1
    a.ph_lo = 0; a.ph_hi = NPHASE;
    hipLaunchKernelGGL(mk_fwd, dim3(grid), dim3(NTHREADS), LDS_BYTES, stream, a);
#else
    for (int ph = 0; ph < NPHASE; ++ph) { a.ph_lo = ph; a.ph_hi = ph + 1; hipLaunchKernelGGL(mk_fwd, dim3(grid), dim3(NTHREADS), LDS_BYTES, stream, a); }
#endif
    const hipError_t le = hipPeekAtLastError();
    if (le != hipSuccess) fprintf(stderr, "kernel_launch: launch failed: %s\n", hipGetErrorName(le));
}
```

```cpp
#include <hip/hip_runtime.h>
#include <cstdio>
#include <cstdint>

typedef unsigned short bf16_t;
typedef short bf16x8 __attribute__((ext_vector_type(8)));
typedef float f32x16 __attribute__((ext_vector_type(16)));
typedef float f32x4 __attribute__((ext_vector_type(4)));
typedef unsigned u32x4 __attribute__((ext_vector_type(4)));
typedef unsigned u32x2 __attribute__((ext_vector_type(2)));

#define REPEAT_MASK 16384
#ifndef N_LAUNCH_MODE
#define N_LAUNCH_MODE 1
#endif
#ifndef NAIVE_MMA
#define NAIVE_MMA 0
#endif

constexpr int T = 16384, DM = 1024, NB = 8, SEQ = 2048;
constexpr int INW = 2976, NH = 8, DQK = 96, DV = 64;
constexpr int NE = 256, TOPK = 8, EH = 256;
constexpr float EPS = 1e-6f;
constexpr int NTHREADS = 512;
constexpr int LCAP = 16384;

constexpr size_t al256(size_t x) { return (x + 255) & ~(size_t)255; }
constexpr size_t WS_CTL   = 0;
constexpr size_t CTL_BYTES = 196608;
constexpr size_t WS_ADAP  = WS_CTL + CTL_BYTES;
constexpr size_t WS_ADAF  = WS_ADAP + al256((size_t)16 * 8 * 6144 * 4);
constexpr size_t WS_ROPE  = WS_ADAF + al256((size_t)8 * 6144 * 4);
constexpr size_t WS_WDFT  = WS_ROPE + al256((size_t)2 * 2048 * 16 * 4);
constexpr size_t WS_D64T  = WS_WDFT + al256((size_t)2048 * 4096 * 2);
constexpr size_t WS_WR3   = WS_D64T + al256((size_t)128 * 64 * 2);
constexpr size_t WS_WUQ   = WS_WR3 + al256((size_t)3072 * 256 * 4);
constexpr size_t WS_WUKV  = WS_WUQ + al256((size_t)256 * 768 * 4);
constexpr size_t WS_H     = WS_WUKV + al256((size_t)128 * 1024 * 4);
constexpr size_t WS_H2LO  = WS_H + al256((size_t)T * 1024 * 2);
constexpr size_t WS_ZQKV  = WS_H2LO + al256((size_t)T * 1024 * 2);
constexpr size_t WS_ZF    = WS_ZQKV + al256((size_t)T * 416 * 2);
constexpr size_t WS_SIG   = WS_ZF + al256((size_t)T * 512 * 2);
constexpr size_t WS_RSTD  = WS_SIG + al256((size_t)T * 2048 * 2);
constexpr size_t WS_XT    = WS_RSTD + al256((size_t)2 * T * 4);
constexpr size_t WS_QRAW  = WS_XT + al256((size_t)4096 * 4096 * 2);
constexpr size_t WS_KNRAW = WS_QRAW + al256((size_t)T * 768 * 4);
constexpr size_t WS_Q     = WS_KNRAW + al256((size_t)T * 512 * 4);
constexpr size_t WS_K     = WS_Q + al256((size_t)T * 768 * 2);
constexpr size_t WS_VT    = WS_K + al256((size_t)T * 768 * 2);
constexpr size_t WS_O     = WS_VT + al256((size_t)T * 512 * 2);
constexpr size_t WS_F     = WS_O + al256((size_t)T * 512 * 2);
constexpr size_t WS_MERGED= WS_F + al256((size_t)T * 512 * 2);
constexpr size_t WS_X1    = WS_MERGED + al256((size_t)T * 1024 * 2);
constexpr size_t WS_LOGIT = WS_X1 + al256((size_t)T * 1024 * 4);
constexpr size_t WS_ACTS  = WS_LOGIT + al256((size_t)T * 256 * 4);
constexpr size_t WS_LTOK  = WS_ACTS + al256((size_t)T * 256 * 2);
constexpr size_t WS_LW    = WS_LTOK + al256((size_t)NE * LCAP * 4);
constexpr size_t WS_ACT   = WS_LW + al256((size_t)NE * LCAP * 4);
constexpr size_t WS_YBUF  = WS_ACT + al256((size_t)T * 8 * 256 * 2);
constexpr size_t WS_WB_IN = WS_YBUF + al256((size_t)T * 8 * 1024 * 2);
constexpr size_t WS_WB_PA = WS_WB_IN + al256((size_t)3072 * 1024 * 2);
constexpr size_t WS_WB_PF = WS_WB_PA + al256((size_t)1024 * 512 * 2);
constexpr size_t WS_WB_OUT= WS_WB_PF + al256((size_t)1024 * 512 * 2);
constexpr size_t WS_WB_SH = WS_WB_OUT + al256((size_t)1024 * 1024 * 2);
constexpr size_t WS_WB_SD = WS_WB_SH + al256((size_t)512 * 1024 * 2);
constexpr size_t WS_WB_R  = WS_WB_SD + al256((size_t)1024 * 256 * 2);
constexpr size_t WS_A3    = WS_WB_R + al256((size_t)256 * 3072 * 2);
constexpr size_t WS_END   = WS_A3 + al256((size_t)T * 3072 * 2);

constexpr int CW_CNT = 16384;
constexpr int CW_QUEUE = 4400;
constexpr int CW_BAR = 0;

constexpr int LDS_GEMM = 2 * 65536;
constexpr int ST16 = 520, ST32 = 1040;
constexpr int LDS_STAGE = 256 * ST16;
constexpr int LDS_MISC = 140288;
constexpr int LDS_BYTES = LDS_MISC + 8192;

typedef __bf16 bf16x2_t __attribute__((ext_vector_type(2)));
typedef float f32x2_t __attribute__((ext_vector_type(2)));
__device__ __forceinline__ unsigned cvt_pk_bf16(float lo, float hi) { f32x2_t f = {lo, hi}; bf16x2_t h = __builtin_convertvector(f, bf16x2_t); return __builtin_bit_cast(unsigned, h); }
__device__ __forceinline__ bf16_t f2bf(float v) { __bf16 h = (__bf16)v; return __builtin_bit_cast(unsigned short, h); }
__device__ __forceinline__ float bf2f(bf16_t b) { return __uint_as_float(((unsigned)b) << 16); }
__device__ __forceinline__ float sigmoidf_(float v) { return 1.f / (1.f + __expf(-v)); }
__device__ __forceinline__ float siluf_(float v) { return v / (1.f + __expf(-v)); }
__device__ __forceinline__ float wave_sum(float v) {
#pragma unroll
    for (int o = 32; o > 0; o >>= 1) v += __shfl_xor(v, o);
    return v;
}
__device__ __forceinline__ int swz(int row) { return ((row >> 1) & 7) ^ ((row >> 4) & 1); }

#define XB_TMO      128
#define XB_XCNT(j)  (256  + 64 * (j))
#define XB_XSUB(j)  (1280 + 64 * (j))
#define XB_XGEN(j)  (2304 + 64 * (j))
#define XB_TOP      3328
#define XB_TOPGEN   3392
#define XCD_BAR_WORDS 3456
#define XB_SPIN_CAP (1u << 22)
#define LAS __attribute__((address_space(3)))
__device__ __forceinline__ unsigned xb_ld(unsigned* p)              { return __hip_atomic_load(p, __ATOMIC_RELAXED, __HIP_MEMORY_SCOPE_AGENT); }
__device__ __forceinline__ unsigned xb_add(unsigned* p, unsigned v) { return __hip_atomic_fetch_add(p, v, __ATOMIC_RELAXED, __HIP_MEMORY_SCOPE_AGENT); }
__device__ __forceinline__ unsigned xb_xcc_id() { return (unsigned)__builtin_amdgcn_s_getreg((3 << 11) | 20) & 0xFu; }
#define XB_SPIN(cond, bar) do { unsigned _sp = 0; while (cond) { __builtin_amdgcn_s_sleep(1); \
    if ((++_sp & 255u) == 0u) { if (xb_ld(&(bar)[XB_TMO])) break; if (_sp > XB_SPIN_CAP) { atomicAdd(&(bar)[XB_TMO], 1u); break; } } } } while (0)
struct XcdBarrier { unsigned* bar; unsigned x; volatile LAS unsigned* st; };
__device__ __forceinline__ XcdBarrier xcd_barrier_post(unsigned* bar, volatile LAS unsigned* st) {
    XcdBarrier b; b.bar = bar; b.x = xb_xcc_id(); b.st = st;
    if (threadIdx.x == 0) (void)xb_add(&bar[XB_XCNT(b.x)], 1u);
    return b;
}
__device__ __forceinline__ void xcd_barrier_complete(unsigned* bar, unsigned x, unsigned& nloc, unsigned& nx) {
    const unsigned G = gridDim.x * gridDim.y * gridDim.z;
    unsigned sum, cnt, mine, sp = 0u;
    for (;;) {
        sum = 0u; cnt = 0u; mine = 0u;
#pragma unroll
        for (unsigned j = 0; j < 16; ++j) { const unsigned c = xb_ld(&bar[XB_XCNT(j)]); sum += c; cnt += (c > 0u) ? 1u : 0u; mine = (j == x) ? c : mine; }
        if (sum == G) break;
        __builtin_amdgcn_s_sleep(1);
        if ((++sp & 255u) == 0u) { if (xb_ld(&bar[XB_TMO])) break; if (sp > XB_SPIN_CAP) { atomicAdd(&bar[XB_TMO], 1u); break; } }
    }
    nloc = mine > 0u ? mine : 1u; nx = cnt > 0u ? cnt : 1u;
}
__device__ __forceinline__ void xcd_barrier(const XcdBarrier& b) {
    asm volatile("s_waitcnt vmcnt(0)" ::: "memory");
    __syncthreads();
    if (threadIdx.x == 0) {
        unsigned* bar = b.bar;
        __builtin_amdgcn_s_waitcnt(0);
        unsigned nloc = b.st[0], nx = b.st[1];
        if (nloc == 0u) { xcd_barrier_complete(bar, b.x, nloc, nx); b.st[0] = nloc; b.st[1] = nx; }
        const unsigned old = xb_add(&bar[XB_XSUB(b.x)], 1u);
        const unsigned gen = old / nloc;
        if (old + 1u == (gen + 1u) * nloc) {
            __builtin_amdgcn_fence(__ATOMIC_RELEASE, "agent");
            asm volatile("s_waitcnt vmcnt(0)" ::: "memory");
            const unsigned og = xb_add(&bar[XB_TOP], 1u);
            const unsigned tg = og / nx;
            if (og + 1u == (tg + 1u) * nx) xb_add(&bar[XB_TOPGEN], 1u);
            else XB_SPIN(xb_ld(&bar[XB_TOPGEN]) == tg, bar);
            __builtin_amdgcn_fence(__ATOMIC_ACQUIRE, "agent");
            xb_add(&bar[XB_XGEN(b.x)], 1u);
            asm volatile("s_waitcnt vmcnt(0)" ::: "memory");
        } else {
            XB_SPIN(xb_ld(&bar[XB_XGEN(b.x)]) == gen, bar);
            __builtin_amdgcn_fence(__ATOMIC_ACQUIRE, "agent");
            asm volatile("s_waitcnt vmcnt(0)" ::: "memory");
        }
    }
    __syncthreads();
}

template <int MI, bool TR, class AF, class BF>
__device__ __forceinline__ void gemm_core(f32x16 (&acc)[MI][2], const AF& af, const BF& bf, const int nk, unsigned char* lds) {
    constexpr int BM = 64 * MI;
    constexpr int A_BYTES = BM * 128, STAGE = A_BYTES + 256 * 128;
    const int t = threadIdx.x, lane = t & 63, w = t >> 6, wm = w >> 2, wn = w & 3;
    const int l31 = lane & 31, hh = lane >> 5;
    const int ch = t & 7, r0 = t >> 3;
    const bf16_t* abase = af.base();
    unsigned aoff[MI];
#pragma unroll
    for (int i = 0; i < MI; ++i) aoff[i] = af.off(r0 + 64 * i);
    const int a_lds = r0 * 128 + ((ch ^ swz(r0)) << 4);
    u32x4 areg[MI];
    f32x4 bregf[8]; u32x4 bregh[4];
    unsigned boff[4];
    const float* bcolf = nullptr;
    if constexpr (BF::KN) { bcolf = bf.col(4 * lane); }
    else {
#pragma unroll
        for (int i = 0; i < 4; ++i) boff[i] = bf.off(r0 + 64 * i);
    }
    auto gload = [&](int kt) {
        const long ko = af.koff(kt) + ch * 8;
#pragma unroll
        for (int i = 0; i < MI; ++i) areg[i] = *(const u32x4*)(abase + aoff[i] + ko);
        if constexpr (BF::KN) {
            const float* bp = bcolf + (long)(kt * 64 + w * 8) * bf.ldb;
#pragma unroll
            for (int i = 0; i < 8; ++i) bregf[i] = *(const f32x4*)(bp + (long)i * bf.ldb);
        } else {
            const bf16_t* bp = bf.base() + bf.koff(kt) + ch * 8;
#pragma unroll
            for (int i = 0; i < 4; ++i) bregh[i] = *(const u32x4*)(bp + boff[i]);
        }
    };
    auto lstore = [&](int st) {
        unsigned char* base = lds + st * STAGE;
#pragma unroll
        for (int i = 0; i < MI; ++i) *(u32x4*)(base + a_lds + i * 64 * 128) = areg[i];
        unsigned char* bb = base + A_BYTES;
        if constexpr (BF::KN) {
#pragma unroll
            for (int cc = 0; cc < 4; ++cc) {
                const int col = 4 * lane + cc;
                u32x4 v; v.x = cvt_pk_bf16(bregf[0][cc], bregf[1][cc]); v.y = cvt_pk_bf16(bregf[2][cc], bregf[3][cc]);
                v.z = cvt_pk_bf16(bregf[4][cc], bregf[5][cc]); v.w = cvt_pk_bf16(bregf[6][cc], bregf[7][cc]);
                *(u32x4*)(bb + col * 128 + ((w ^ swz(col)) << 4)) = v;
            }
        } else {
#pragma unroll
            for (int i = 0; i < 4; ++i) *(u32x4*)(bb + a_lds + i * 64 * 128) = bregh[i];
        }
    };
    const int fsw = swz(l31);
    const int a_frag = (wm * 32 * MI + l31) * 128, b_frag = (wn * 64 + l31) * 128;
    auto compute = [&](int st) {
        const unsigned char* base = lds + st * STAGE;
        const unsigned char* bb = base + A_BYTES;
#if NAIVE_MMA
#pragma unroll
        for (int mi = 0; mi < MI; ++mi)
#pragma unroll
            for (int ni = 0; ni < 2; ++ni)
#pragma unroll
                for (int rg = 0; rg < 16; ++rg) {
                    const int row = TR ? (wm * 32 * MI + mi * 32 + l31) : (wm * 32 * MI + mi * 32 + (rg & 3) + 8 * (rg >> 2) + 4 * hh);
                    const int col = TR ? (wn * 64 + ni * 32 + (rg & 3) + 8 * (rg >> 2) + 4 * hh) : (wn * 64 + ni * 32 + l31);
                    float s = 0.f;
                    for (int k = 0; k < 64; ++k) {
                        const bf16_t av = *(const bf16_t*)(base + row * 128 + (((k >> 3) ^ swz(row)) << 4) + (k & 7) * 2);
                        const bf16_t bv = *(const bf16_t*)(bb + col * 128 + (((k >> 3) ^ swz(col)) << 4) + (k & 7) * 2);
                        s += bf2f(av) * bf2f(bv);
                    }
                    acc[mi][ni][rg] += s;
                }
#else
#pragma unroll 2
        for (int s = 0; s < 4; ++s) {
            const int pos = ((2 * s + hh) ^ fsw) << 4;
            bf16x8 bfr[2];
#pragma unroll
            for (int ni = 0; ni < 2; ++ni) bfr[ni] = *(const bf16x8*)(bb + b_frag + ni * 32 * 128 + pos);
#pragma unroll
            for (int mi = 0; mi < MI; ++mi) {
                const bf16x8 afr = *(const bf16x8*)(base + a_frag + mi * 32 * 128 + pos);
#pragma unroll
                for (int ni = 0; ni < 2; ++ni) acc[mi][ni] = TR ? __builtin_amdgcn_mfma_f32_32x32x16_bf16(bfr[ni], afr, acc[mi][ni], 0, 0, 0)
                                                               : __builtin_amdgcn_mfma_f32_32x32x16_bf16(afr, bfr[ni], acc[mi][ni], 0, 0, 0);
            }
        }
#endif
    };
    int nk_ = nk; asm volatile("" : "+s"(nk_));
    __syncthreads();
    gload(0);
    lstore(0);
    __syncthreads();
#pragma unroll 1
    for (int kt = 0; kt < nk_; ++kt) {
        const bool more = (kt + 1 < nk_);
        if (more) gload(kt + 1);
        compute(kt & 1);
        if (more) lstore((kt + 1) & 1);
        __syncthreads();
    }
}

template <int MI> __device__ __forceinline__ void zero_acc(f32x16 (&acc)[MI][2]) {
#pragma unroll
    for (int mi = 0; mi < MI; ++mi)
#pragma unroll
        for (int ni = 0; ni < 2; ++ni)
#pragma unroll
            for (int r = 0; r < 16; ++r) acc[mi][ni][r] = 0.f;
}
template <int MI, class EPI>
__device__ __forceinline__ void run_epilogue(const f32x16 (&acc)[MI][2], const EPI& epi) {
    const int t = threadIdx.x, lane = t & 63, w = t >> 6, wm = w >> 2, wn = w & 3, l31 = lane & 31, hh = lane >> 5;
#pragma unroll
    for (int mi = 0; mi < MI; ++mi)
#pragma unroll
        for (int rg = 0; rg < 16; ++rg) {
            const int r = wm * 32 * MI + mi * 32 + (rg & 3) + 8 * (rg >> 2) + 4 * hh;
            epi(r, wn * 64 + l31, acc[mi][0][rg], acc[mi][1][rg]);
            if ((rg & 7) == 7) __builtin_amdgcn_sched_barrier(0);
        }
}

template <int MI, class EPI>
__device__ __forceinline__ void run_epilogue_tr(const f32x16 (&acc)[MI][2], const EPI& epi) {
    const int t = threadIdx.x, lane = t & 63, w = t >> 6, wm = w >> 2, wn = w & 3, l31 = lane & 31, hh = lane >> 5;
#pragma unroll
    for (int mi = 0; mi < MI; ++mi) {
        const int r = wm * 32 * MI + mi * 32 + l31;
#pragma unroll
        for (int q4 = 0; q4 < 4; ++q4) {
            const f32x4 v0 = {acc[mi][0][4 * q4], acc[mi][0][4 * q4 + 1], acc[mi][0][4 * q4 + 2], acc[mi][0][4 * q4 + 3]};
            const f32x4 v1 = {acc[mi][1][4 * q4], acc[mi][1][4 * q4 + 1], acc[mi][1][4 * q4 + 2], acc[mi][1][4 * q4 + 3]};
            epi(r, wn * 64 + 8 * q4 + 4 * hh, v0, v1);
        }
        __builtin_amdgcn_sched_barrier(0);
    }
}
__device__ __forceinline__ u32x2 pack4(const f32x4 v) { u32x2 p; p.x = cvt_pk_bf16(v[0], v[1]); p.y = cvt_pk_bf16(v[2], v[3]); return p; }
__device__ __forceinline__ f32x4 unpack4(const u32x2 p) { f32x4 v = {__uint_as_float(p.x << 16), __uint_as_float(p.x & 0xffff0000u), __uint_as_float(p.y << 16), __uint_as_float(p.y & 0xffff0000u)}; return v; }

__device__ __forceinline__ unsigned pack_fp8x4(const f32x4 v) { int p = __builtin_amdgcn_cvt_pk_fp8_f32(v[0], v[1], 0, false); p = __builtin_amdgcn_cvt_pk_fp8_f32(v[2], v[3], p, true); return (unsigned)p; }
__device__ __forceinline__ f32x4 unpack_fp8x4(const unsigned p) { f32x4 v = {__builtin_amdgcn_cvt_f32_fp8((int)p, 0), __builtin_amdgcn_cvt_f32_fp8((int)p, 1), __builtin_amdgcn_cvt_f32_fp8((int)p, 2), __builtin_amdgcn_cvt_f32_fp8((int)p, 3)}; return v; }
template <int MI> __device__ __forceinline__ void stage_bf16(const f32x16 (&acc)[MI][2], unsigned char* lds) {
    const int t = threadIdx.x, lane = t & 63, w = t >> 6, wm = w >> 2, wn = w & 3, l31 = lane & 31, hh = lane >> 5;
#pragma unroll
    for (int mi = 0; mi < MI; ++mi) {
        unsigned char* rp = lds + (wm * 32 * MI + mi * 32 + l31) * ST16 + (wn * 64 + 4 * hh) * 2;
#pragma unroll
        for (int ni = 0; ni < 2; ++ni)
#pragma unroll
            for (int q4 = 0; q4 < 4; ++q4) {
                const f32x4 v = {acc[mi][ni][4 * q4], acc[mi][ni][4 * q4 + 1], acc[mi][ni][4 * q4 + 2], acc[mi][ni][4 * q4 + 3]};
                *(u32x2*)(rp + (ni * 32 + 8 * q4) * 2) = pack4(v);
            }
    }
}
__device__ __forceinline__ void stage_f32(const f32x16 (&acc)[2][2], unsigned char* lds) {
    const int t = threadIdx.x, lane = t & 63, w = t >> 6, wm = w >> 2, wn = w & 3, l31 = lane & 31, hh = lane >> 5;
#pragma unroll
    for (int mi = 0; mi < 2; ++mi) {
        unsigned char* rp = lds + (wm * 64 + mi * 32 + l31) * ST32 + (wn * 64 + 4 * hh) * 4;
#pragma unroll
        for (int ni = 0; ni < 2; ++ni)
#pragma unroll
            for (int q4 = 0; q4 < 4; ++q4) {
                const f32x4 v = {acc[mi][ni][4 * q4], acc[mi][ni][4 * q4 + 1], acc[mi][ni][4 * q4 + 2], acc[mi][ni][4 * q4 + 3]};
                *(f32x4*)(rp + (ni * 32 + 8 * q4) * 4) = v;
            }
    }
}

struct ARows { const bf16_t* b; unsigned lda; int m0;
    __device__ __forceinline__ const bf16_t* base() const { return b; }
    __device__ __forceinline__ unsigned off(int r) const { return (unsigned)(m0 + r) * lda; }
    __device__ __forceinline__ long koff(int kt) const { return (long)kt * 64; } };
struct BKN { const float* b; int ldb; int n0; int nvalid; static constexpr bool KN = true;
    __device__ __forceinline__ const float* col(int c) const { int cc = n0 + c; cc = (cc < nvalid) ? cc : (nvalid - 4); return b + cc; } };
struct BKNPair { const float* g; long u_minus_g; int ldb; static constexpr bool KN = true;
    __device__ __forceinline__ const float* col(int c) const { return g + (long)((c >> 5) & 1) * u_minus_g + (c >> 6) * 32 + (c & 31); } };
struct BNK { const bf16_t* b; unsigned ldb; int n0; static constexpr bool KN = false;
    __device__ __forceinline__ const bf16_t* base() const { return b; }
    __device__ __forceinline__ unsigned off(int c) const { return (unsigned)(n0 + c) * ldb; }
    __device__ __forceinline__ long koff(int kt) const { return (long)kt * 64; } };

namespace pg8 {
#define PG8_LAS __attribute__((address_space(3)))
typedef unsigned short bf16_t;
typedef short bf16x8 __attribute__((ext_vector_type(8)));
typedef float f32x4 __attribute__((ext_vector_type(4)));
typedef unsigned u32x4 __attribute__((ext_vector_type(4)));
constexpr int BM = 256, BK = 64, HALF = 128, HTB = HALF * BK * 2  , STAGE_BYTES = 8 * HTB, NXCD = 8, WGM = 8;

__host__ __device__ __forceinline__ int lds_byte(int r, int c) { const int st = (r >> 4) * 2 + (c >> 5), rr = r & 15, cc = c & 31, ob = rr * 64 + cc * 2; return st * 1024 + (ob ^ (((ob >> 9) & 1) << 5)); }
__host__ __device__ __forceinline__ void stage_rc(int b, int& R, int& C) { const int st = b / 1024, sb = b % 1024, swz = sb ^ (((sb >> 9) & 1) << 5); R = (st >> 1) * 16 + swz / 64; C = (st & 1) * 32 + (swz % 64) / 2; }
__host__ __device__ __forceinline__ int perm32(int rho) { const int n = rho >> 4, i = rho & 15; return 8 * (i >> 2) + 4 * n + (i & 3); }

struct Unit { int pm, pn; };
struct Gemm { const bf16_t* A; const bf16_t* Bt; int M, N, K; int lda; int ldb; };

struct StaticOrder {
    int nM, nN, nwg, G, c;
    __host__ __device__ void init(int M, int N, int G_, int c_) { nM = M / BM; nN = N / BM; nwg = nM * nN; G = G_; c = c_; }
    __host__ __device__ bool next(int i, Unit& u) const {
        const long L = (long)i * G + c; if (L >= nwg) return false;
        int wgid = (int)L; { const int q = nwg / NXCD, r = nwg % NXCD, xcd = wgid % NXCD, off = wgid / NXCD; wgid = (xcd < r ? xcd * (q + 1) : r * (q + 1) + (xcd - r) * q) + off; }
        const int nig = WGM * nN, gid = wgid / nig, fm = gid * WGM, gsz = (nM - fm) < WGM ? (nM - fm) : WGM;
        u.pm = fm + ((wgid % nig) % gsz); u.pn = (wgid % nig) / gsz; return true;
    }
    __device__ __forceinline__ void a_ready(const Unit&) const {}
    __device__ __forceinline__ void done(const Unit&) const {}
};
template <class Epi, class Sched, bool ALIGN_EPI = false, bool SP2 = false>
__device__ __forceinline__ void gemm_phase(PG8_LAS unsigned char* lds, const Gemm g, const Sched& S, const Epi& E) {
    const int tid = threadIdx.x, wid = __builtin_amdgcn_readfirstlane(tid >> 6), lane = tid & 63, wr = wid >> 2, wc = wid & 3, fr = lane & 15, fq = lane >> 4;
    const int K = g.K, nt = K / BK, LDA = g.lda ? g.lda : g.K, LDB = g.ldb ? g.ldb : g.K;
    unsigned voffA[2], voffB[2];
#pragma unroll
    for (int i = 0; i < 2; ++i) { int R, C; stage_rc(tid * 16 + i * 8192, R, C); const int Rb = Epi::PERM ? ((R & ~31) + perm32(R & 31)) : R;
        voffA[i] = (unsigned)(R * LDA + C) * 2u; voffB[i] = (unsigned)(Rb * LDB + C) * 2u; }
    const size_t kstep = (size_t)(BK * 2);
    const size_t hstep = (size_t)HALF * LDB * 2;
    const size_t tstep = 2 * hstep;
    const size_t hstepA = (size_t)HALF * LDA * 2, tstepA = 2 * hstepA;
    const unsigned ldsw = (unsigned)wid * 1024u;
    const int aoff = lds_byte(wr * 64 + fr, fq * 8), boff = lds_byte(wc * 32 + fr, fq * 8);
#define PG8_SA(b, h) (((b) * 2 + (h)) * HTB)
#define PG8_SB(b, h) ((4 + (b) * 2 + (h)) * HTB)
#define PG8_STAGE(bufoff, gbase, voff) do { _Pragma("unroll") for (int _i = 0; _i < 2; ++_i) \
        __builtin_amdgcn_global_load_lds((const unsigned*)((const char*)(gbase) + (voff)[_i]), (PG8_LAS unsigned*)(lds + (bufoff) + ldsw + _i * 8192), 16, 0, 0); } while (0)
#define PG8_LDA(dst, b, h) do { _Pragma("unroll") for (int m = 0; m < 4; ++m) _Pragma("unroll") for (int k = 0; k < 2; ++k) dst[m][k] = *(const PG8_LAS bf16x8*)(lds + PG8_SA(b, h) + aoff + m * 2048 + k * 1024); } while (0)
#define PG8_LDB(dst, b, h) do { _Pragma("unroll") for (int n = 0; n < 2; ++n) _Pragma("unroll") for (int k = 0; k < 2; ++k) dst[n][k] = *(const PG8_LAS bf16x8*)(lds + PG8_SB(b, h) + boff + n * 2048 + k * 1024); } while (0)
#define PG8_MMA(ai, bj, At, Bt) do { __builtin_amdgcn_s_setprio(1); _Pragma("unroll") for (int m = 0; m < 4; ++m) _Pragma("unroll") for (int n = 0; n < 2; ++n) _Pragma("unroll") for (int k = 0; k < 2; ++k) \
        acc[ai][bj][m][n] = __builtin_amdgcn_mfma_f32_16x16x32_bf16(Bt[n][k], At[m][k], acc[ai][bj][m][n], 0, 0, 0); __builtin_amdgcn_s_setprio(0); } while (0)
#define PG8_WAIT_V(n) asm volatile("s_waitcnt vmcnt(" #n ")" ::: "memory")
#define PG8_WAIT_L(n) asm volatile("s_waitcnt lgkmcnt(" #n ")" ::: "memory")
#define PG8_BAR __builtin_amdgcn_s_barrier()
#define PG8_SCHED __builtin_amdgcn_sched_barrier(0)
    Unit cur, nxt; int ui = 0;
    if (!S.next(0, cur)) return;
    f32x4 acc[2][2][4][2];
#pragma unroll
    for (int a = 0; a < 2; ++a)
#pragma unroll
        for (int b = 0; b < 2; ++b)
#pragma unroll
            for (int m = 0; m < 4; ++m)
#pragma unroll
                for (int n = 0; n < 2; ++n) acc[a][b][m][n] = (f32x4){0.f, 0.f, 0.f, 0.f};
    bf16x8 At[4][2], B0[2][2], B1[2][2];
    const char* cA = (const char*)g.A + (size_t)cur.pm * tstepA; const char* cB = (const char*)g.Bt + (size_t)cur.pn * tstep;
    S.a_ready(cur);
    if constexpr (SP2) {
        PG8_STAGE(PG8_SB(0, 0), cB, voffB); PG8_STAGE(PG8_SB(0, 1), cB + hstep, voffB); PG8_STAGE(PG8_SA(0, 0), cA, voffA); PG8_STAGE(PG8_SA(0, 1), cA + hstepA, voffA);
        if (wr == 1) PG8_BAR;
        PG8_WAIT_V(2); PG8_BAR;
        PG8_STAGE(PG8_SB(1, 0), cB + kstep, voffB); PG8_STAGE(PG8_SA(1, 0), cA + kstep, voffA); PG8_STAGE(PG8_SB(1, 1), cB + hstep + kstep, voffB);
        PG8_WAIT_V(6); PG8_BAR;
    } else {
        PG8_STAGE(PG8_SB(0, 0), cB, voffB); PG8_STAGE(PG8_SA(0, 0), cA, voffA); PG8_STAGE(PG8_SB(0, 1), cB + hstep, voffB); PG8_STAGE(PG8_SA(0, 1), cA + hstepA, voffA);
        if (wr == 1) PG8_BAR;
        PG8_WAIT_V(4); PG8_BAR;
        PG8_STAGE(PG8_SB(1, 0), cB + kstep, voffB); PG8_STAGE(PG8_SA(1, 0), cA + kstep, voffA); PG8_STAGE(PG8_SB(1, 1), cB + hstep + kstep, voffB);
        PG8_WAIT_V(6); PG8_BAR;
    }
    for (;;) {
        const bool has_next = S.next(ui + 1, nxt);
        const char* nA = has_next ? (const char*)g.A + (size_t)nxt.pm * tstepA : cA; const char* nB = has_next ? (const char*)g.Bt + (size_t)nxt.pn * tstep : cB;
        for (int t = 0; t < nt; t += 2) {
            const bool last = (t == nt - 2);
            const char* a1 = cA + (size_t)(t + 1) * kstep;
            const char* a2 = last ? nA : cA + (size_t)(t + 2) * kstep; const char* b2 = last ? nB : cB + (size_t)(t + 2) * kstep;
            const char* a3 = a2 + kstep; const char* b3 = b2 + kstep;
            if (last && has_next) S.a_ready(nxt);
            if constexpr (SP2) {
            PG8_LDB(B0, 0, 0); PG8_LDB(B1, 0, 1); PG8_SCHED; PG8_LDA(At, 0, 0); PG8_STAGE(PG8_SA(1, 1), a1 + hstepA, voffA);
            PG8_WAIT_V(8); PG8_WAIT_L(0); PG8_BAR; PG8_MMA(0, 0, At, B0); PG8_MMA(0, 1, At, B1); PG8_BAR; PG8_SCHED;
            PG8_LDA(At, 0, 1); PG8_STAGE(PG8_SB(0, 0), b2, voffB); PG8_STAGE(PG8_SB(0, 1), b2 + hstep, voffB); PG8_STAGE(PG8_SA(0, 0), a2, voffA);
            PG8_WAIT_V(8); PG8_WAIT_L(0); PG8_BAR; PG8_MMA(1, 0, At, B0); PG8_MMA(1, 1, At, B1); PG8_BAR; PG8_SCHED;
            PG8_LDB(B0, 1, 0); PG8_LDB(B1, 1, 1); PG8_SCHED; PG8_LDA(At, 1, 0); PG8_STAGE(PG8_SA(0, 1), a2 + hstepA, voffA);
            PG8_WAIT_V(8); PG8_WAIT_L(0); PG8_BAR; PG8_MMA(0, 0, At, B0); PG8_MMA(0, 1, At, B1); PG8_BAR; PG8_SCHED;
            PG8_LDA(At, 1, 1); PG8_STAGE(PG8_SB(1, 0), b3, voffB); PG8_STAGE(PG8_SB(1, 1), b3 + hstep, voffB); PG8_STAGE(PG8_SA(1, 0), a3, voffA);
            PG8_WAIT_V(8); PG8_WAIT_L(0); PG8_BAR; PG8_MMA(1, 0, At, B0); PG8_MMA(1, 1, At, B1); PG8_BAR; PG8_SCHED;
            } else {
            PG8_LDB(B0, 0, 0); PG8_SCHED; PG8_LDA(At, 0, 0); PG8_STAGE(PG8_SA(1, 1), a1 + hstepA, voffA);
            PG8_WAIT_L(8); PG8_BAR; PG8_WAIT_L(0); PG8_MMA(0, 0, At, B0); PG8_BAR; PG8_SCHED;
            PG8_LDB(B1, 0, 1); PG8_STAGE(PG8_SB(0, 0), b2, voffB);
            PG8_BAR; PG8_WAIT_L(0); PG8_MMA(0, 1, At, B1); PG8_BAR;
            PG8_LDA(At, 0, 1); PG8_STAGE(PG8_SA(0, 0), a2, voffA);
            PG8_BAR; PG8_WAIT_L(0); PG8_MMA(1, 0, At, B0); PG8_BAR; PG8_SCHED;
            PG8_STAGE(PG8_SB(0, 1), b2 + hstep, voffB);
            PG8_WAIT_V(6); PG8_BAR; PG8_MMA(1, 1, At, B1); PG8_BAR;
            PG8_LDB(B0, 1, 0); PG8_SCHED; PG8_LDA(At, 1, 0); PG8_STAGE(PG8_SA(0, 1), a2 + hstepA, voffA);
            PG8_WAIT_L(8); PG8_BAR; PG8_WAIT_L(0); PG8_MMA(0, 0, At, B0); PG8_BAR; PG8_SCHED;
            PG8_LDB(B1, 1, 1); PG8_STAGE(PG8_SB(1, 0), b3, voffB);
            PG8_BAR; PG8_WAIT_L(0); PG8_MMA(0, 1, At, B1); PG8_BAR;
            PG8_LDA(At, 1, 1); PG8_STAGE(PG8_SA(1, 0), a3, voffA);
            PG8_BAR; PG8_WAIT_L(0); PG8_MMA(1, 0, At, B0); PG8_BAR; PG8_SCHED;
            PG8_STAGE(PG8_SB(1, 1), b3 + hstep, voffB);
            PG8_WAIT_V(6); PG8_BAR; PG8_MMA(1, 1, At, B1); PG8_BAR;
            }
        }
        if constexpr (ALIGN_EPI) { if (wr == 0) PG8_BAR; }
        if constexpr (!Epi::AFTER_DRAIN) { E(acc, cur, wr, wc, fr, fq); S.done(cur); }
        if (!has_next) break;
#pragma unroll
        for (int a = 0; a < 2; ++a)
#pragma unroll
            for (int b = 0; b < 2; ++b)
#pragma unroll
                for (int m = 0; m < 4; ++m)
#pragma unroll
                    for (int n = 0; n < 2; ++n) acc[a][b][m][n] = (f32x4){0.f, 0.f, 0.f, 0.f};
        cur = nxt; cA = nA; cB = nB; ++ui;
        if constexpr (ALIGN_EPI) { if (wr == 1) PG8_BAR; }
    }
    PG8_WAIT_V(0);
    if constexpr (!ALIGN_EPI) { if (wr == 0) PG8_BAR; }
    PG8_BAR;
    if constexpr (Epi::AFTER_DRAIN) { E.fused(acc, cur, wr, wc, fr, fq, lds, wid, lane); S.done(cur); }
#undef PG8_SA
#undef PG8_SB
#undef PG8_STAGE
#undef PG8_LDA
#undef PG8_LDB
#undef PG8_MMA
#undef PG8_WAIT_V
#undef PG8_WAIT_L
#undef PG8_BAR
#undef PG8_SCHED
}
}


struct Args { const float* in[24]; float* out; unsigned char* ws; int ph_lo, ph_hi; };

struct Ctx {
    const Args& a; float* out; unsigned char* ws; unsigned char* lds; unsigned* ctl;
    int tid, lane, wave, G, vcu;
};

__device__ __forceinline__ u32x4 pack8(const f32x4 a, const f32x4 b) { u32x4 p; p.x = cvt_pk_bf16(a[0], a[1]); p.y = cvt_pk_bf16(a[2], a[3]); p.z = cvt_pk_bf16(b[0], b[1]); p.w = cvt_pk_bf16(b[2], b[3]); return p; }
__device__ __forceinline__ f32x4 unpack_lo(const u32x4 p) { f32x4 v = {__uint_as_float(p.x << 16), __uint_as_float(p.x & 0xffff0000u), __uint_as_float(p.y << 16), __uint_as_float(p.y & 0xffff0000u)}; return v; }
__device__ __forceinline__ f32x4 unpack_hi(const u32x4 p) { f32x4 v = {__uint_as_float(p.z << 16), __uint_as_float(p.z & 0xffff0000u), __uint_as_float(p.w << 16), __uint_as_float(p.w & 0xffff0000u)}; return v; }
#define EPI_LOOP(...) _Pragma("unroll") for (int ai = 0; ai < 2; ++ai) _Pragma("unroll") for (int m = 0; m < 4; ++m) { const unsigned row = row0 + ai * 128 + m * 16; \
    _Pragma("unroll") for (int bj = 0; bj < 2; ++bj) { const unsigned col = col0 + bj * 128; const f32x4 v0 = acc[ai][bj][m][0], v1 = acc[ai][bj][m][1]; __VA_ARGS__ } }
#define EPI_HEAD const unsigned row0 = u.pm * 256 + wr * 64 + fr; const unsigned col0 = u.pn * 256 + wc * 32 + 8 * fq;
struct EpiZ {
    static constexpr bool PERM = true, AFTER_DRAIN = false; bf16_t* zqkv; bf16_t* zf; bf16_t* sig;
    __device__ __forceinline__ void operator()(const f32x4 (&acc)[2][2][4][2], const pg8::Unit& u, int wr, int wc, int fr, int fq) const { EPI_HEAD
        EPI_LOOP(
            if (col < 416) *(u32x4*)(zqkv + row * 416u + col) = pack8(v0, v1);
            else if (col < 928) *(u32x4*)(zf + row * 512u + (col - 416)) = pack8(v0, v1);
            else if (col < INW) { const f32x4 s0 = {sigmoidf_(v0[0]), sigmoidf_(v0[1]), sigmoidf_(v0[2]), sigmoidf_(v0[3])}; const f32x4 s1 = {sigmoidf_(v1[0]), sigmoidf_(v1[1]), sigmoidf_(v1[2]), sigmoidf_(v1[3])};
                *(u32x4*)(sig + row * 2048u + (col - 928)) = pack8(s0, s1); } ) } };
struct EpiF {
    static constexpr bool PERM = true, AFTER_DRAIN = false; bf16_t* Fo;
    __device__ __forceinline__ void operator()(const f32x4 (&acc)[2][2][4][2], const pg8::Unit& u, int wr, int wc, int fr, int fq) const {
        const unsigned row0 = (u.pn >> 1) * 2048 + u.pm * 256 + wr * 64 + fr; const unsigned col0 = (u.pn & 1) * 256 + wc * 32 + 8 * fq;
        EPI_LOOP( *(u32x4*)(Fo + row * 512u + col) = pack8(v0, v1); ) } };
struct EpiMgA {
    static constexpr bool PERM = true, AFTER_DRAIN = false; bf16_t* mg; const bf16_t* sig;
    __device__ __forceinline__ void operator()(const f32x4 (&acc)[2][2][4][2], const pg8::Unit& u, int wr, int wc, int fr, int fq) const { EPI_HEAD
        EPI_LOOP( const u32x4 g = *(const u32x4*)(sig + row * 2048u + col); *(u32x4*)(mg + row * 1024u + col) = pack8(unpack_lo(g) * v0, unpack_hi(g) * v1); ) } };
struct EpiMgF {
    static constexpr bool PERM = true, AFTER_DRAIN = false; bf16_t* mg; const bf16_t* sig;
    __device__ __forceinline__ void operator()(const f32x4 (&acc)[2][2][4][2], const pg8::Unit& u, int wr, int wc, int fr, int fq) const { EPI_HEAD
        EPI_LOOP( const u32x4 g = *(const u32x4*)(sig + row * 2048u + 1024 + col); const u32x4 o = *(const u32x4*)(mg + row * 1024u + col);
            *(u32x4*)(mg + row * 1024u + col) = pack8(unpack_lo(o) + unpack_lo(g) * v0, unpack_hi(o) + unpack_hi(g) * v1); ) } };
struct EpiX1 {
    static constexpr bool PERM = true, AFTER_DRAIN = false; float* x1; const float* x; const float* adaf;
    __device__ __forceinline__ void operator()(const f32x4 (&acc)[2][2][4][2], const pg8::Unit& u, int wr, int wc, int fr, int fq) const { EPI_HEAD
        const float* g1 = adaf + (u.pm >> 3) * 6144 + 2 * 1024;
        EPI_LOOP( const f32x4 ga = *(const f32x4*)(g1 + col), gb = *(const f32x4*)(g1 + col + 4);
            *(f32x4*)(x1 + row * 1024u + col) = *(const f32x4*)(x + row * 1024u + col) + ga * v0; *(f32x4*)(x1 + row * 1024u + col + 4) = *(const f32x4*)(x + row * 1024u + col + 4) + gb * v1; ) } };
struct EpiSh {
    static constexpr bool PERM = true, AFTER_DRAIN = false; bf16_t* acts;
    __device__ __forceinline__ void operator()(const f32x4 (&acc)[2][2][4][2], const pg8::Unit& u, int wr, int wc, int fr, int fq) const { EPI_HEAD
        EPI_LOOP( const f32x4 a = {siluf_(v0[0]) * v1[0], siluf_(v0[1]) * v1[1], siluf_(v0[2]) * v1[2], siluf_(v0[3]) * v1[3]};
            *(u32x2*)(acts + row * 256u + (col >> 1)) = pack4(a); ) } };
struct EpiOut {
    static constexpr bool PERM = true, AFTER_DRAIN = false; float* out; const float* x1; const float* adaf; const bf16_t* ybuf;
    __device__ __forceinline__ void operator()(const f32x4 (&acc)[2][2][4][2], const pg8::Unit& u, int wr, int wc, int fr, int fq) const { EPI_HEAD
        const float* g2 = adaf + (u.pm >> 3) * 6144 + 5 * 1024;
        EPI_LOOP( f32x4 s0 = v0, s1 = v1;
            f32x4 r0 = {0.f, 0.f, 0.f, 0.f}, r1 = {0.f, 0.f, 0.f, 0.f};
            _Pragma("unroll") for (int k = 0; k < 8; ++k) { const u32x2 y = *(const u32x2*)((const unsigned char*)ybuf + (row * 8u + k) * 1024u + col); r0 += unpack_fp8x4(y.x); r1 += unpack_fp8x4(y.y); }
            s0 += r0 * 0.0625f; s1 += r1 * 0.0625f;
            *(f32x4*)(out + row * 1024u + col) = *(const f32x4*)(x1 + row * 1024u + col) + *(const f32x4*)(g2 + col) * s0;
            *(f32x4*)(out + row * 1024u + col + 4) = *(const f32x4*)(x1 + row * 1024u + col + 4) + *(const f32x4*)(g2 + col + 4) * s1;
            if (m == 1 || m == 3) __builtin_amdgcn_sched_barrier(0); ) } };

template <class GET> __device__ __forceinline__ void conv_wt(const Ctx& F, bf16_t* dst, int K, int Nd, const GET& get) {
    const long gt = (long)F.vcu * NTHREADS + F.tid, gs = (long)F.G * NTHREADS; const long nchunk = (long)Nd * (K / 8);
    for (long c = gt; c < nchunk; c += gs) { const int n = (int)(c % Nd), k0 = (int)(c / Nd) * 8;
        u32x4 p; p.x = cvt_pk_bf16(get(k0, n), get(k0 + 1, n)); p.y = cvt_pk_bf16(get(k0 + 2, n), get(k0 + 3, n)); p.z = cvt_pk_bf16(get(k0 + 4, n), get(k0 + 5, n)); p.w = cvt_pk_bf16(get(k0 + 6, n), get(k0 + 7, n));
        *(u32x4*)(dst + (long)n * K + k0) = p; }
}

template <int K, int Nd, class GET4> __device__ __forceinline__ void conv4(bf16_t* dst, unsigned c, const GET4& get4) {
    constexpr unsigned NQ = Nd / 4; const unsigned n = (c % NQ) * 4u, k0 = (c / NQ) * 8u;
    f32x4 r[8];
#pragma unroll
    for (int i = 0; i < 8; ++i) r[i] = get4(k0 + i, n);
#pragma unroll
    for (int j = 0; j < 4; ++j) { u32x4 p; p.x = cvt_pk_bf16(r[0][j], r[1][j]); p.y = cvt_pk_bf16(r[2][j], r[3][j]); p.z = cvt_pk_bf16(r[4][j], r[5][j]); p.w = cvt_pk_bf16(r[6][j], r[7][j]);
        *(u32x4*)(dst + (size_t)(n + j) * K + k0) = p; }
}

__device__ __forceinline__ void p0_prep(const Ctx& F) {
    const float* c = F.a.in[1]; const float* w_ada = F.a.in[2];
    float* adap = (float*)(F.ws + WS_ADAP);
    float* sc = (float*)F.lds;
    float* red = sc + 512;
    for (int it = F.vcu; it < 256; it += F.G) {
        const int ks = it >> 4, chunk = it & 15;
        __syncthreads();
        { const int b = F.tid >> 6, k = F.tid & 63; sc[b * 64 + k] = siluf_(c[b * 1024 + ks * 64 + k]); }
        __syncthreads();
        const int cl = F.tid & 127, kq = F.tid >> 7;
        float acc[3][8];
#pragma unroll
        for (int j = 0; j < 3; ++j)
#pragma unroll
            for (int b = 0; b < 8; ++b) acc[j][b] = 0.f;
        const float* wp = w_ada + (long)(ks * 64 + kq * 16) * 6144 + chunk * 384 + cl;
#pragma unroll 8
        for (int k = 0; k < 16; ++k) {
            const float w0 = wp[k * 6144], w1 = wp[k * 6144 + 128], w2 = wp[k * 6144 + 256];
#pragma unroll
            for (int b = 0; b < 8; ++b) { const float sv = sc[b * 64 + kq * 16 + k]; acc[0][b] += sv * w0; acc[1][b] += sv * w1; acc[2][b] += sv * w2; }
        }
#pragma unroll
        for (int j = 0; j < 3; ++j)
#pragma unroll
            for (int b = 0; b < 8; ++b) red[(kq * 8 + b) * 384 + j * 128 + cl] = acc[j][b];
        __syncthreads();
        for (int o = F.tid; o < 8 * 384; o += NTHREADS) { const int b = o / 384, cc = o - b * 384;
            adap[((long)ks * 8 + b) * 6144 + chunk * 384 + cc] = (red[b * 384 + cc] + red[(8 + b) * 384 + cc]) + (red[(16 + b) * 384 + cc] + red[(24 + b) * 384 + cc]); }
    }
    const long gt = (long)F.vcu * NTHREADS + F.tid, gs = (long)F.G * NTHREADS;
    { float* rc = (float*)(F.ws + WS_ROPE); float* rs = rc + 2048 * 16;
      for (long i = gt; i < 2048 * 16; i += gs) { const int pos = (int)(i >> 4), j = (int)(i & 15);
          const float inv = powf(10000.0f, -(float)(2 * j) / 32.0f); const float ang = (float)pos * inv; rc[i] = cosf(ang); rs[i] = sinf(ang); } }
    { bf16_t* wd = (bf16_t*)(F.ws + WS_WDFT); const float nrm = 0.02209708691207961f;
      for (long g = gt; g < (long)2048 * 64; g += gs) { const int k = (int)(g >> 6), l = (int)(g & 63);
          const float cr = cospif((float)k * (1.0f / 1024.0f)), sr = sinpif((float)k * (1.0f / 1024.0f));
          const int idx0 = (k * (8 * l)) & 2047; const int q = k & 3;
          float c0 = cospif((float)idx0 * (1.0f / 1024.0f)) * nrm, s0 = sinpif((float)idx0 * (1.0f / 1024.0f)) * nrm;
#pragma unroll
          for (int i = 0; i < 4; ++i) {
              float cv[8], sv[8]; float cc = c0, ss = s0;
#pragma unroll
              for (int j = 0; j < 8; ++j) { cv[j] = cc; sv[j] = ss; const float cn = cc * cr - ss * sr; ss = ss * cr + cc * sr; cc = cn; }
              u32x4 pc, ps;
              pc.x = cvt_pk_bf16(cv[0], cv[1]); pc.y = cvt_pk_bf16(cv[2], cv[3]); pc.z = cvt_pk_bf16(cv[4], cv[5]); pc.w = cvt_pk_bf16(cv[6], cv[7]);
              ps.x = cvt_pk_bf16(sv[0], sv[1]); ps.y = cvt_pk_bf16(sv[2], sv[3]); ps.z = cvt_pk_bf16(sv[4], sv[5]); ps.w = cvt_pk_bf16(sv[6], sv[7]);
              *(u32x4*)(wd + (long)k * 4096 + 8 * l + 512 * i) = pc; *(u32x4*)(wd + (long)k * 4096 + 2048 + 8 * l + 512 * i) = ps;
              const float nc = (q == 0) ? c0 : (q == 1) ? -s0 : (q == 2) ? -c0 : s0;
              const float ns = (q == 0) ? s0 : (q == 1) ? c0 : (q == 2) ? -s0 : -c0;
              c0 = nc; s0 = ns;
          } } }
    { bf16_t* d6 = (bf16_t*)(F.ws + WS_D64T);
      for (long i = gt; i < 128 * 64; i += gs) { const int n = (int)(i >> 6), cc = (int)(i & 63), part = n >> 6, m = n & 63; const int idx = (m * cc) & 63;
          const float a = (float)idx * (1.0f / 32.0f); const float v = part ? -sinpif(a) : cospif(a); d6[i] = f2bf(v * 0.125f); } }
    { const float* w_in = F.a.in[5]; const float* w_pa = F.a.in[12]; const float* w_pf = F.a.in[13]; const float* w_o = F.a.in[14]; const float* w_r = F.a.in[16];
      const float* w_g = F.a.in[21]; const float* w_u = F.a.in[22]; const float* w_sd = F.a.in[23];
      const float* gq = F.a.in[6]; const float* wq = F.a.in[7]; const float* gkv = F.a.in[8]; const float* wk = F.a.in[9];
      constexpr unsigned C_IN = 768 * 128, C_OUT = 256 * 128, C_R = 64 * 384, C_PA = 256 * 64, C_SH = 128 * 128, C_SD = 256 * 32, C_UQ = 192 * 32, C_UKV = 256 * 16;
      constexpr unsigned C_TOT = C_IN + C_OUT + C_R + 2 * C_PA + C_SH + C_SD + C_UQ + C_UKV;
      for (unsigned c0 = (unsigned)gt; c0 < C_TOT; c0 += (unsigned)gs) {
          unsigned c = c0;
          if (c < C_IN) { conv4<1024, 3072>((bf16_t*)(F.ws + WS_WB_IN), c, [&](unsigned k, unsigned n) { const f32x4 z = {0.f, 0.f, 0.f, 0.f}; return (n < (unsigned)INW) ? *(const f32x4*)(w_in + k * (unsigned)INW + n) : z; }); continue; }
          c -= C_IN;
          if (c < C_OUT) { conv4<1024, 1024>((bf16_t*)(F.ws + WS_WB_OUT), c, [&](unsigned k, unsigned n) { return *(const f32x4*)(w_o + k * 1024u + n); }); continue; }
          c -= C_OUT;
          if (c < C_R) { conv4<3072, 256>((bf16_t*)(F.ws + WS_WB_R), c, [&](unsigned k3, unsigned n) { const unsigned rg = k3 >> 10, k = k3 & 1023u; const f32x4 wv = *(const f32x4*)(w_r + k * 256u + n);
                  f32x4 hi; hi[0] = bf2f(f2bf(wv[0])); hi[1] = bf2f(f2bf(wv[1])); hi[2] = bf2f(f2bf(wv[2])); hi[3] = bf2f(f2bf(wv[3])); return (rg == 2u) ? (wv - hi) : hi; }); continue; }
          c -= C_R;
          if (c < C_PA) { conv4<512, 1024>((bf16_t*)(F.ws + WS_WB_PA), c, [&](unsigned k, unsigned n) { return *(const f32x4*)(w_pa + k * 1024u + n); }); continue; }
          c -= C_PA;
          if (c < C_PA) { conv4<512, 1024>((bf16_t*)(F.ws + WS_WB_PF), c, [&](unsigned k, unsigned n) { return *(const f32x4*)(w_pf + k * 1024u + n); }); continue; }
          c -= C_PA;
          if (c < C_SH) { conv4<1024, 512>((bf16_t*)(F.ws + WS_WB_SH), c, [&](unsigned k, unsigned n) { const unsigned j = (n >> 3) * 4u; return ((n >> 2) & 1u) ? *(const f32x4*)(w_u + k * 256u + j) : *(const f32x4*)(w_g + k * 256u + j); }); continue; }
          c -= C_SH;
          if (c < C_SD) { conv4<256, 1024>((bf16_t*)(F.ws + WS_WB_SD), c, [&](unsigned k, unsigned n) { return *(const f32x4*)(w_sd + k * 1024u + n); }); continue; }
          c -= C_SD;
          if (c < C_UQ) { conv4<256, 768>((bf16_t*)(F.ws + WS_WUQ), c, [&](unsigned k, unsigned n) { return *(const f32x4*)(wq + k * 768u + n) * gq[k]; }); continue; }
          c -= C_UQ;
          conv4<128, 1024>((bf16_t*)(F.ws + WS_WUKV), c, [&](unsigned k, unsigned n) { return *(const f32x4*)(wk + k * 1024u + n) * gkv[k]; });
      } }
}

__device__ __forceinline__ void p_norm_rows(const Ctx& F, int which) {
    const float* src = which ? (const float*)(F.ws + WS_X1) : F.a.in[0];
    const float* gain = which ? F.a.in[15] : F.a.in[4];
    const float* adap = (const float*)(F.ws + WS_ADAP); const float* b_ada = F.a.in[3];
    float* adaf = (float*)(F.ws + WS_ADAF);
    bf16_t* dhi = which ? (bf16_t*)(F.ws + WS_A3) : (bf16_t*)(F.ws + WS_H); const unsigned ldd = which ? 3072u : 1024u;
    float* smod = (float*)F.lds; float* sshift = smod + 1024;
    if (which == 0) {
        for (int idx = F.vcu * NTHREADS + F.tid; idx < 8 * 6144; idx += F.G * NTHREADS) { const int b = idx / 6144, j = idx - b * 6144; float s = b_ada[j];
#pragma unroll
            for (int ks = 0; ks < 16; ++ks) s += adap[((long)ks * 8 + b) * 6144 + j];
            adaf[idx] = s; }
    }
    for (int it = F.vcu; it < 256; it += F.G) {
        const int b = it >> 5;
        __syncthreads();
        for (int cidx = F.tid; cidx < 1024; cidx += NTHREADS) {
            float sh, scv;
            if (which == 0) { sh = b_ada[cidx]; scv = b_ada[1024 + cidx];
                for (int ks = 0; ks < 16; ++ks) { sh += adap[((long)ks * 8 + b) * 6144 + cidx]; scv += adap[((long)ks * 8 + b) * 6144 + 1024 + cidx]; } }
            else { sh = adaf[b * 6144 + 3 * 1024 + cidx]; scv = adaf[b * 6144 + 4 * 1024 + cidx]; }
            smod[cidx] = gain[cidx] * (1.f + scv); sshift[cidx] = sh;
        }
        __syncthreads();
#pragma unroll 1
        for (int jb = 0; jb < 8; jb += 4) {
        f32x4 va[4][4];
#pragma unroll
        for (int j = 0; j < 4; ++j)
#pragma unroll
            for (int i = 0; i < 4; ++i) va[j][i] = *(const f32x4*)(src + ((long)it * 64 + F.wave * 8 + jb + j) * 1024 + i * 256 + F.lane * 4);
#pragma unroll
        for (int j = 0; j < 4; ++j) {
            const long row = (long)it * 64 + F.wave * 8 + jb + j;
            f32x4 v[4]; float ss = 0.f;
#pragma unroll
            for (int i = 0; i < 4; ++i) { v[i] = va[j][i]; ss += v[i][0] * v[i][0] + v[i][1] * v[i][1] + v[i][2] * v[i][2] + v[i][3] * v[i][3]; }
            ss = wave_sum(ss);
            const float rstd = rsqrtf(ss * (1.0f / 1024.0f) + EPS);
#pragma unroll
            for (int i = 0; i < 4; ++i) {
                const int c0 = i * 256 + F.lane * 4; float hv[4];
#pragma unroll
                for (int e = 0; e < 4; ++e) hv[e] = v[i][e] * rstd * smod[c0 + e] + sshift[c0 + e];
                u32x2 pk; pk.x = cvt_pk_bf16(hv[0], hv[1]); pk.y = cvt_pk_bf16(hv[2], hv[3]);
                *(u32x2*)(dhi + row * ldd + c0) = pk;
                if (which) {
                    float lo[4];
                    lo[0] = hv[0] - __uint_as_float(pk.x << 16); lo[1] = hv[1] - __uint_as_float(pk.x & 0xffff0000u);
                    lo[2] = hv[2] - __uint_as_float(pk.y << 16); lo[3] = hv[3] - __uint_as_float(pk.y & 0xffff0000u);
                    u32x2 pl; pl.x = cvt_pk_bf16(lo[0], lo[1]); pl.y = cvt_pk_bf16(lo[2], lo[3]);
                    *(u32x2*)(dhi + row * ldd + 1024 + c0) = pl; *(u32x2*)(dhi + row * ldd + 2048 + c0) = pk;
                }
            }
        }
        }
    }
}

__device__ __forceinline__ void p2_win(const Ctx& F) {
    pg8::Gemm g{(const bf16_t*)(F.ws + WS_H), (const bf16_t*)(F.ws + WS_WB_IN), T, 3072, 1024};
    pg8::StaticOrder S; S.init(T, 3072, F.G, (int)blockIdx.x);
    EpiZ E{(bf16_t*)(F.ws + WS_ZQKV), (bf16_t*)(F.ws + WS_ZF), (bf16_t*)(F.ws + WS_SIG)};
    pg8::gemm_phase<EpiZ, pg8::StaticOrder, true, true>((LAS unsigned char*)F.lds, g, S, E);
}

struct BKNq { const float* b; static constexpr bool KN = true; int ldb;
    __device__ __forceinline__ const float* col(int c) const { return b + ((c < 192) ? c : 188); } };
__device__ __forceinline__ void p3_mixer_inputs(const Ctx& F) {
    const bf16_t* zqkv = (const bf16_t*)(F.ws + WS_ZQKV);
    const int lane = F.lane, w = F.wave;
    {
        const bf16_t* zf = (const bf16_t*)(F.ws + WS_ZF); const bf16_t* d6 = (const bf16_t*)(F.ws + WS_D64T); bf16_t* xt = (bf16_t*)(F.ws + WS_XT);
        for (int it = F.vcu; it < 8 * 64; it += F.G) {
            const int g = it & 7, tt = it >> 3; const int tok0 = tt * 256; const int b = tok0 >> 11, s0 = tok0 & 2047;
            f32x16 acc[2][2]; zero_acc<2>(acc);
            ARows af{d6, 64, 0}; BNK bf{zf + g * 64, 512, tok0};
            gemm_core<2, true>(acc, af, bf, 1, F.lds);
            stage_bf16<2>(acc, F.lds);
            __syncthreads();
#pragma unroll 4
            for (int rr = 0; rr < 16; ++rr) {
                const int n = w * 16 + rr; const int part = n >> 6, m = n & 63;
                *(u32x2*)(xt + (unsigned)(b * 512 + g * 64 + m) * 4096u + part * 2048 + s0 + 4 * lane) = *(const u32x2*)(F.lds + n * ST16 + lane * 8);
            }
        }
    }
    {
        constexpr int WQ_P = 528, WKV_P = 272, ST_P = 208;
        constexpr int L_WQ = 0, L_WKV = 96 * WQ_P, L_G = L_WKV + 128 * WKV_P, L_ST = L_G + 768;
        static_assert(L_ST + 8 * 32 * ST_P <= LDS_MISC, "head engine LDS");
        const float* rc = (const float*)(F.ws + WS_ROPE); const float* rsn = rc + 2048 * 16;
        bf16_t* Q = (bf16_t*)(F.ws + WS_Q); bf16_t* K = (bf16_t*)(F.ws + WS_K); bf16_t* vt = (bf16_t*)(F.ws + WS_VT);
        const int hd = F.vcu & 7; const int l31 = lane & 31, hh = lane >> 5;
        __syncthreads();
        { const u32x4* wq = (const u32x4*)((const bf16_t*)(F.ws + WS_WUQ) + (size_t)hd * 96 * 256); const u32x4* wk = (const u32x4*)((const bf16_t*)(F.ws + WS_WUKV) + (size_t)hd * 128 * 128);
          for (int c = F.tid; c < 96 * 32; c += NTHREADS) *(u32x4*)(F.lds + L_WQ + (c >> 5) * WQ_P + (c & 31) * 16) = wq[c];
          for (int c = F.tid; c < 128 * 16; c += NTHREADS) *(u32x4*)(F.lds + L_WKV + (c >> 4) * WKV_P + (c & 15) * 16) = wk[c];
          if (F.tid < 96) { ((float*)(F.lds + L_G))[F.tid] = F.a.in[10][F.tid]; ((float*)(F.lds + L_G))[96 + F.tid] = F.a.in[11][F.tid]; } }
        __syncthreads();
        const float* gq = (const float*)(F.lds + L_G); const float* gk = gq + 96;
        unsigned char* st = F.lds + L_ST + w * (32 * ST_P);
        const float qscale = 0.10206207261596577f * 1.4426950408889634f;
#pragma unroll 1
        for (int i2 = 0; i2 < 2; ++i2) {
            const int sb = (F.vcu >> 3) + 32 * i2; const unsigned tok = sb * 256 + w * 32 + l31; const int b = tok >> 11, s = tok & 2047; const unsigned bh = b * 8 + hd;
            const bf16_t* zrow = zqkv + tok * 416u;
            const f32x4 cs0 = *(const f32x4*)(rc + s * 16 + 4 * hh), cs1 = *(const f32x4*)(rc + s * 16 + 8 + 4 * hh), sn0 = *(const f32x4*)(rsn + s * 16 + 4 * hh), sn1 = *(const f32x4*)(rsn + s * 16 + 8 + 4 * hh);
            {
                bf16x8 zq[16];
#pragma unroll
                for (int k = 0; k < 16; ++k) zq[k] = *(const bf16x8*)(zrow + 16 * k + 8 * hh);
                f32x16 aq[3];
#pragma unroll
                for (int f = 0; f < 3; ++f) {
#pragma unroll
                    for (int r = 0; r < 16; ++r) aq[f][r] = 0.f;
#pragma unroll
                    for (int k = 0; k < 16; ++k) { const bf16x8 wf = *(const bf16x8*)(F.lds + L_WQ + (32 * f + l31) * WQ_P + (16 * k + 8 * hh) * 2); aq[f] = __builtin_amdgcn_mfma_f32_32x32x16_bf16(wf, zq[k], aq[f], 0, 0, 0);
                        if ((k & 7) == 7) __builtin_amdgcn_sched_barrier(0); }
                }
                float ss = 0.f;
#pragma unroll
                for (int f = 0; f < 3; ++f)
#pragma unroll
                    for (int r = 0; r < 16; ++r) ss += aq[f][r] * aq[f][r];
                ss += __shfl_xor(ss, 32);
                const float rstd = rsqrtf(ss * (1.0f / 96.0f) + EPS) * qscale;
#pragma unroll
                for (int f = 0; f < 3; ++f)
#pragma unroll
                    for (int r = 0; r < 16; ++r) aq[f][r] *= rstd * gq[32 * f + (r & 3) + 8 * (r >> 2) + 4 * hh];
#pragma unroll
                for (int r = 0; r < 8; ++r) { const float c = (r < 4) ? cs0[r & 3] : cs1[r & 3], sn = (r < 4) ? sn0[r & 3] : sn1[r & 3];
                    const float r1 = aq[2][r], r2 = aq[2][r + 8]; aq[2][r] = r1 * c - r2 * sn; aq[2][r + 8] = r2 * c + r1 * sn; }
#pragma unroll
                for (int f = 0; f < 3; ++f)
#pragma unroll
                    for (int q4 = 0; q4 < 4; ++q4) { const f32x4 v = {aq[f][4 * q4], aq[f][4 * q4 + 1], aq[f][4 * q4 + 2], aq[f][4 * q4 + 3]};
                        *(u32x2*)(st + l31 * ST_P + (32 * f + 8 * q4 + 4 * hh) * 2) = pack4(v); }
                u32x4* dst = (u32x4*)(Q + ((size_t)bh * 2048 + (s - l31)) * 96);
#pragma unroll
                for (int c6 = 0; c6 < 6; ++c6) { const int c = c6 * 64 + lane; dst[c] = *(const u32x4*)(st + (c / 12) * ST_P + (c % 12) * 16); }
            }
            {
                bf16x8 zk[8]; float sk = 0.f;
#pragma unroll
                for (int k = 0; k < 8; ++k) { zk[k] = *(const bf16x8*)(zrow + 256 + 16 * k + 8 * hh);
#pragma unroll
                    for (int e = 0; e < 8; ++e) { const float z = bf2f((bf16_t)zk[k][e]); sk += z * z; } }
                sk += __shfl_xor(sk, 32);
                const float rkv = rsqrtf(sk * (1.0f / 128.0f) + EPS);
                f32x16 ak[4];
#pragma unroll
                for (int f = 0; f < 4; ++f) {
#pragma unroll
                    for (int r = 0; r < 16; ++r) ak[f][r] = 0.f;
#pragma unroll
                    for (int k = 0; k < 8; ++k) { const bf16x8 wf = *(const bf16x8*)(F.lds + L_WKV + (32 * f + l31) * WKV_P + (16 * k + 8 * hh) * 2); ak[f] = __builtin_amdgcn_mfma_f32_32x32x16_bf16(wf, zk[k], ak[f], 0, 0, 0); }
                    __builtin_amdgcn_sched_barrier(0);
                }
#pragma unroll
                for (int f = 2; f < 4; ++f)
#pragma unroll
                    for (int r = 0; r < 16; ++r) { const int dv = 32 * (f - 2) + (r & 3) + 8 * (r >> 2) + 4 * hh; vt[((size_t)bh * 64 + dv) * 2048 + s] = f2bf(ak[f][r] * rkv); }
                float zr[16];
#pragma unroll
                for (int q4 = 0; q4 < 4; ++q4) { const f32x4 t4 = unpack4(*(const u32x2*)(zrow + 384 + 8 * q4 + 4 * hh)); zr[4 * q4] = t4[0]; zr[4 * q4 + 1] = t4[1]; zr[4 * q4 + 2] = t4[2]; zr[4 * q4 + 3] = t4[3]; }
                float ss = 0.f;
#pragma unroll
                for (int f = 0; f < 2; ++f)
#pragma unroll
                    for (int r = 0; r < 16; ++r) { ak[f][r] *= rkv; ss += ak[f][r] * ak[f][r]; }
#pragma unroll
                for (int r = 0; r < 16; ++r) ss += zr[r] * zr[r];
                ss += __shfl_xor(ss, 32);
                const float rstd = rsqrtf(ss * (1.0f / 96.0f) + EPS);
#pragma unroll
                for (int f = 0; f < 2; ++f)
#pragma unroll
                    for (int r = 0; r < 16; ++r) ak[f][r] *= rstd * gk[32 * f + (r & 3) + 8 * (r >> 2) + 4 * hh];
#pragma unroll
                for (int r = 0; r < 16; ++r) zr[r] *= rstd * gk[64 + (r & 3) + 8 * (r >> 2) + 4 * hh];
#pragma unroll
                for (int r = 0; r < 8; ++r) { const float c = (r < 4) ? cs0[r & 3] : cs1[r & 3], sn = (r < 4) ? sn0[r & 3] : sn1[r & 3];
                    const float r1 = zr[r], r2 = zr[r + 8]; zr[r] = r1 * c - r2 * sn; zr[r + 8] = r2 * c + r1 * sn; }
#pragma unroll
                for (int f = 0; f < 2; ++f)
#pragma unroll
                    for (int q4 = 0; q4 < 4; ++q4) { const f32x4 v = {ak[f][4 * q4], ak[f][4 * q4 + 1], ak[f][4 * q4 + 2], ak[f][4 * q4 + 3]};
                        *(u32x2*)(st + l31 * ST_P + (32 * f + 8 * q4 + 4 * hh) * 2) = pack4(v); }
#pragma unroll
                for (int q4 = 0; q4 < 4; ++q4) { const f32x4 v = {zr[4 * q4], zr[4 * q4 + 1], zr[4 * q4 + 2], zr[4 * q4 + 3]};
                    *(u32x2*)(st + l31 * ST_P + (64 + 8 * q4 + 4 * hh) * 2) = pack4(v); }
                u32x4* dst = (u32x4*)(K + ((size_t)bh * 2048 + (s - l31)) * 96);
#pragma unroll
                for (int c6 = 0; c6 < 6; ++c6) { const int c = c6 * 64 + lane; dst[c] = *(const u32x4*)(st + (c / 12) * ST_P + (c % 12) * 16); }
            }
        }
    }
}

constexpr int KROW = 208, VROW = 136, K_TILE = 64 * KROW, V_TILE = 64 * VROW, AT_STAGE = K_TILE + V_TILE;
__device__ __forceinline__ void attn_item(const Ctx& F, int item) {
    const int qb = item & 7, bh = item >> 3, b = bh >> 3, hd = bh & 7;
    const bf16_t* Q = (const bf16_t*)(F.ws + WS_Q) + (long)bh * 2048 * 96;
    const bf16_t* K = (const bf16_t*)(F.ws + WS_K) + (long)bh * 2048 * 96;
    const bf16_t* Vt = (const bf16_t*)(F.ws + WS_VT) + (long)bh * 64 * 2048;
    bf16_t* O = (bf16_t*)(F.ws + WS_O);
    const int t = F.tid, lane = F.lane, w = F.wave, l31 = lane & 31, hh = lane >> 5;
    bf16x8 qf[6];
    { const bf16_t* qp = Q + (long)(qb * 256 + w * 32 + l31) * 96 + hh * 8;
#pragma unroll
      for (int s = 0; s < 6; ++s) qf[s] = *(const bf16x8*)(qp + s * 16); }
    f32x16 oacc[2];
#pragma unroll
    for (int d = 0; d < 2; ++d)
#pragma unroll
        for (int r = 0; r < 16; ++r) oacc[d][r] = 0.f;
    float m_run = -1e30f, l_run = 0.f;
    const int kq0 = t, kq1 = t + 512;
    const int k_l0 = (kq0 / 12) * KROW + (kq0 % 12) * 16, k_l1 = (kq1 / 12) * KROW + (kq1 % 12) * 16;
    const int v_dv = t >> 3, v_c = t & 7; const int v_l = v_dv * VROW + v_c * 16;
    u32x4 kr0, kr1, vr;
    auto gload = [&](int j) {
        const bf16_t* kp = K + (long)j * 64 * 96;
        kr0 = *(const u32x4*)(kp + kq0 * 8);
        if (t < 256) kr1 = *(const u32x4*)(kp + kq1 * 8);
        vr = *(const u32x4*)(Vt + (long)v_dv * 2048 + j * 64 + v_c * 8);
    };
    auto lstore = [&](int st) {
        unsigned char* base = F.lds + st * AT_STAGE;
        *(u32x4*)(base + k_l0) = kr0;
        if (t < 256) *(u32x4*)(base + k_l1) = kr1;
        *(u32x2*)(base + K_TILE + v_l) = (u32x2){vr.x, vr.y}; *(u32x2*)(base + K_TILE + v_l + 8) = (u32x2){vr.z, vr.w};
    };
    __syncthreads();
    gload(0); lstore(0);
    __syncthreads();
    for (int j = 0; j < 32; ++j) {
        const bool more = (j + 1 < 32);
        if (more) gload(j + 1);
        const unsigned char* kb = F.lds + (j & 1) * AT_STAGE; const unsigned char* vb = kb + K_TILE;
        f32x16 st[2];
        {
            bf16x8 kfr[2][6];
#pragma unroll
            for (int f = 0; f < 2; ++f)
#pragma unroll
                for (int s = 0; s < 6; ++s) kfr[f][s] = *(const bf16x8*)(kb + (32 * f + l31) * KROW + (16 * s + 8 * hh) * 2);
            __builtin_amdgcn_sched_barrier(0);
#pragma unroll
            for (int f = 0; f < 2; ++f) {
#pragma unroll
                for (int r = 0; r < 16; ++r) st[f][r] = 0.f;
#pragma unroll
                for (int s = 0; s < 6; ++s) st[f] = __builtin_amdgcn_mfma_f32_32x32x16_bf16(kfr[f][s], qf[s], st[f], 0, 0, 0);
            }
        }
        float mx = st[0][0];
#pragma unroll
        for (int r = 1; r < 16; ++r) mx = fmaxf(mx, st[0][r]);
#pragma unroll
        for (int r = 0; r < 16; ++r) mx = fmaxf(mx, st[1][r]);
        mx = fmaxf(mx, __shfl_xor(mx, 32));
        const float m_new = fmaxf(m_run, mx);
        const float alpha = __builtin_amdgcn_exp2f(m_run - m_new);
        m_run = m_new;
        float ps = 0.f;
#pragma unroll
        for (int f = 0; f < 2; ++f)
#pragma unroll
            for (int r = 0; r < 16; ++r) { const float p = __builtin_amdgcn_exp2f(st[f][r] - m_new); st[f][r] = p; ps += p; }
        l_run = l_run * alpha + ps;
#pragma unroll
        for (int d = 0; d < 2; ++d)
#pragma unroll
            for (int r = 0; r < 16; ++r) oacc[d][r] *= alpha;
        {
            u32x4 vfr[2][2][2];
#pragma unroll
            for (int f = 0; f < 2; ++f)
#pragma unroll
                for (int s2 = 0; s2 < 2; ++s2)
#pragma unroll
                    for (int d = 0; d < 2; ++d) { const unsigned char* vp = vb + (32 * d + l31) * VROW + (32 * f + 16 * s2 + 4 * hh) * 2;
                        const u32x2 lo = *(const u32x2*)vp, hi = *(const u32x2*)(vp + 16); vfr[f][s2][d] = (u32x4){lo.x, lo.y, hi.x, hi.y}; }
#pragma unroll
            for (int f = 0; f < 2; ++f)
#pragma unroll
                for (int s2 = 0; s2 < 2; ++s2) {
                    u32x4 pw; pw.x = cvt_pk_bf16(st[f][8 * s2 + 0], st[f][8 * s2 + 1]); pw.y = cvt_pk_bf16(st[f][8 * s2 + 2], st[f][8 * s2 + 3]);
                    pw.z = cvt_pk_bf16(st[f][8 * s2 + 4], st[f][8 * s2 + 5]); pw.w = cvt_pk_bf16(st[f][8 * s2 + 6], st[f][8 * s2 + 7]);
                    const bf16x8 pf = *(const bf16x8*)&pw;
#pragma unroll
                    for (int d = 0; d < 2; ++d) oacc[d] = __builtin_amdgcn_mfma_f32_32x32x16_bf16(*(const bf16x8*)&vfr[f][s2][d], pf, oacc[d], 0, 0, 0);
                }
        }
        if (more) lstore((j + 1) & 1);
        __syncthreads();
    }
    l_run += __shfl_xor(l_run, 32);
    const float inv = 1.0f / l_run;
    const long tok = (long)b * 2048 + qb * 256 + w * 32 + l31;
#pragma unroll
    for (int d = 0; d < 2; ++d)
#pragma unroll
        for (int q4 = 0; q4 < 4; ++q4) {
            const int dv = 32 * d + 8 * q4 + 4 * hh;
            u32x2 pk; pk.x = cvt_pk_bf16(oacc[d][4 * q4 + 0] * inv, oacc[d][4 * q4 + 1] * inv); pk.y = cvt_pk_bf16(oacc[d][4 * q4 + 2] * inv, oacc[d][4 * q4 + 3] * inv);
            *(u32x2*)(O + tok * 512 + hd * 64 + dv) = pk;
        }
}

__device__ __forceinline__ void p6_attn_dft(const Ctx& F) {
    {
        pg8::Gemm g{(const bf16_t*)(F.ws + WS_WDFT), (const bf16_t*)(F.ws + WS_XT), 2048, 4096, 4096};
        pg8::StaticOrder S; S.init(2048, 4096, F.G, (int)blockIdx.x);
        EpiF E{(bf16_t*)(F.ws + WS_F)};
        pg8::gemm_phase<EpiF, pg8::StaticOrder, true, true>((LAS unsigned char*)F.lds, g, S, E);
    }
    volatile LAS int* sitem = (volatile LAS int*)(F.lds + LDS_MISC);
    auto next_item = [&]() -> int {
        __syncthreads();
        if (F.tid == 0) sitem[0] = (int)xb_add(F.ctl + CW_QUEUE, 1u);
        __syncthreads();
        return sitem[0];
    };
    int it = next_item();
    while (it < 512) { attn_item(F, it); it = next_item(); }
}

__device__ __forceinline__ void p7_merge(const Ctx& F) {
    bf16_t* mg = (bf16_t*)(F.ws + WS_MERGED); const bf16_t* sig = (const bf16_t*)(F.ws + WS_SIG);
    pg8::StaticOrder S; S.init(T, 1024, F.G, (int)blockIdx.x);
    { pg8::Gemm g{(const bf16_t*)(F.ws + WS_O), (const bf16_t*)(F.ws + WS_WB_PA), T, 1024, 512}; EpiMgA E{mg, sig};
      pg8::gemm_phase<EpiMgA, pg8::StaticOrder, true, true>((LAS unsigned char*)F.lds, g, S, E); }
    { pg8::Gemm g{(const bf16_t*)(F.ws + WS_F), (const bf16_t*)(F.ws + WS_WB_PF), T, 1024, 512}; EpiMgF E{mg, sig};
      pg8::gemm_phase<EpiMgF, pg8::StaticOrder, true, true>((LAS unsigned char*)F.lds, g, S, E); }
}

__device__ __forceinline__ void p8_out(const Ctx& F) {
    pg8::Gemm g{(const bf16_t*)(F.ws + WS_MERGED), (const bf16_t*)(F.ws + WS_WB_OUT), T, 1024, 1024};
    pg8::StaticOrder S; S.init(T, 1024, F.G, (int)blockIdx.x);
    EpiX1 E{(float*)(F.ws + WS_X1), F.a.in[0], (const float*)(F.ws + WS_ADAF)};
    pg8::gemm_phase<EpiX1, pg8::StaticOrder, true, true>((LAS unsigned char*)F.lds, g, S, E);
}

template <int NT>
__device__ __forceinline__ void topk_tokens(const Ctx& F, int tok0, const float (&lg)[NT][4], const float (&bs)[4]) {
    int* ltok = (int*)(F.ws + WS_LTOK); float* lw = (float*)(F.ws + WS_LW); unsigned* cnt = F.ctl + CW_CNT;
    const int lane = F.lane;
    float sc[NT][4]; unsigned long long key[NT][4];
#pragma unroll
    for (int t = 0; t < NT; ++t)
#pragma unroll
        for (int i = 0; i < 4; ++i) {
            sc[t][i] = sigmoidf_(lg[t][i]);
            const unsigned ub = __float_as_uint(sc[t][i] + bs[i]);
            const unsigned ord = (ub & 0x80000000u) ? ~ub : (ub | 0x80000000u);
            key[t][i] = ((unsigned long long)ord << 32) | (unsigned long long)(255 - (lane + 64 * i));
        }
    float wsum[NT], myw[NT]; int mye[NT];
#pragma unroll
    for (int t = 0; t < NT; ++t) { wsum[t] = 0.f; myw[t] = 0.f; mye[t] = 0; }
    for (int k = 0; k < 8; ++k) {
        unsigned long long best[NT];
#pragma unroll
        for (int t = 0; t < NT; ++t) { best[t] = key[t][0];
#pragma unroll
            for (int i = 1; i < 4; ++i) best[t] = (key[t][i] > best[t]) ? key[t][i] : best[t]; }
#pragma unroll
        for (int o = 32; o > 0; o >>= 1) {
#pragma unroll
            for (int t = 0; t < NT; ++t) {
                const unsigned lo = __shfl_xor((unsigned)best[t], o), hi = __shfl_xor((unsigned)(best[t] >> 32), o);
                const unsigned long long ob = ((unsigned long long)hi << 32) | lo;
                best[t] = (ob > best[t]) ? ob : best[t];
            }
        }
#pragma unroll
        for (int t = 0; t < NT; ++t) {
            const int e = 255 - (int)(best[t] & 0xffull);
            float s_own = 0.f;
#pragma unroll
            for (int i = 0; i < 4; ++i) { const bool mine = (e == lane + 64 * i); s_own = mine ? sc[t][i] : s_own; key[t][i] = mine ? 0ull : key[t][i]; }
            const float s_k = __shfl(s_own, e & 63);
            wsum[t] += s_k;
            myw[t] = (lane == k) ? s_k : myw[t]; mye[t] = (lane == k) ? e : mye[t];
        }
    }
    if (lane < 8) {
        unsigned slot[NT];
#pragma unroll
        for (int t = 0; t < NT; ++t) slot[t] = atomicAdd(&cnt[mye[t] * 64], 1u);
#pragma unroll
        for (int t = 0; t < NT; ++t) { ltok[(long)mye[t] * LCAP + slot[t]] = (tok0 + t) * 8 + lane; lw[(long)mye[t] * LCAP + slot[t]] = myw[t] / wsum[t] * 2.5f; }
    }
}

struct EpiLog {
    static constexpr bool PERM = true, AFTER_DRAIN = false; float* dst;
    __device__ __forceinline__ void operator()(const f32x4 (&acc)[2][2][4][2], const pg8::Unit& u, int wr, int wc, int fr, int fq) const { EPI_HEAD
        EPI_LOOP( *(f32x4*)(dst + row * 256u + col) = v0; *(f32x4*)(dst + row * 256u + col + 4) = v1; ) } };
__device__ __forceinline__ void p10_router_shared(const Ctx& F) {
    const bf16_t* a3 = (const bf16_t*)(F.ws + WS_A3); const bf16_t* wr = (const bf16_t*)(F.ws + WS_WB_R); float* part = (float*)(F.ws + WS_QRAW);
    const unsigned bx = blockIdx.x, G = (unsigned)F.G;
    {
        pg8::Gemm g{a3, (const bf16_t*)(F.ws + WS_WB_SH), T, 512, 1024, 3072};
        pg8::StaticOrder S; S.init(T, 512, F.G, (int)bx);
        EpiSh E{(bf16_t*)(F.ws + WS_ACTS)};
        pg8::gemm_phase<EpiSh, pg8::StaticOrder, true, true>((LAS unsigned char*)F.lds, g, S, E);
    }
    {
        const int seg = (bx >= 192u) ? 1 : 0;
        const bool has = (bx >= 128u);
        pg8::Gemm g{a3 + seg * 1536, wr + seg * 1536, T, 256, 1536, 3072};
        g.ldb = 3072;
        pg8::StaticOrder S; S.init(T, 256, F.G, has ? (int)((bx - 128u) & 63u) : (int)(G - 1));
        EpiLog E{part + (size_t)seg * T * 256};
        pg8::gemm_phase<EpiLog, pg8::StaticOrder, true, true>((LAS unsigned char*)F.lds, g, S, E);
    }
}
__device__ __forceinline__ void p11_topk(const Ctx& F) {
    const float* part = (const float*)(F.ws + WS_QRAW);
    float bs[4];
#pragma unroll
    for (int i = 0; i < 4; ++i) bs[i] = F.a.in[17][F.lane + 64 * i];
    for (int tok0 = (F.vcu * 8 + F.wave) * 8; tok0 < T; tok0 += F.G * 8 * 8) {
        float lg[8][4];
#pragma unroll
        for (int t = 0; t < 8; ++t)
#pragma unroll
            for (int i = 0; i < 4; ++i) { const size_t o = (size_t)(tok0 + t) * 256 + F.lane + 64 * i; lg[t][i] = part[o] + part[o + (size_t)T * 256]; }
        topk_tokens<8>(F, tok0, lg, bs);
    }
}

__device__ __forceinline__ int build_expert_tables(const Ctx& F, int per_rt) {
    volatile LAS int* offs = (volatile LAS int*)(F.lds + LDS_MISC); volatile LAS int* istart = offs + 264; volatile LAS int* wtot = offs + 540;
    unsigned* cnt = F.ctl + CW_CNT;
    const int t = F.tid, lane = F.lane;
    const int c = (t < NE) ? (int)cnt[t * 64] : 0; const int ni = ((c + 255) >> 8) * per_rt;
    int x = c, y = ni;
#pragma unroll
    for (int d = 1; d < 64; d <<= 1) { const int x2 = __shfl_up(x, d), y2 = __shfl_up(y, d); x += (lane >= d) ? x2 : 0; y += (lane >= d) ? y2 : 0; }
    __syncthreads();
    if (t < NE && lane == 63) { wtot[t >> 6] = x; wtot[4 + (t >> 6)] = y; }
    __syncthreads();
    if (t < NE) { int bx = 0, by = 0; for (int k = 0; k < (t >> 6); ++k) { bx += wtot[k]; by += wtot[4 + k]; }
        offs[t] = bx + x - c; istart[t] = by + y - ni; if (t == NE - 1) { offs[NE] = bx + x; istart[NE] = by + y; } }
    __syncthreads();
    return istart[NE];
}
__device__ __forceinline__ int find_expert(const Ctx& F, int it) {
    volatile LAS int* istart = (volatile LAS int*)(F.lds + LDS_MISC) + 264;
    int lo = 0, hi = NE;
    while (hi - lo > 1) { const int mid = (lo + hi) >> 1; if (istart[mid] <= it) lo = mid; else hi = mid; }
    return lo;
}
struct AGather { const bf16_t* b; const int* list; int m0, mvalid; unsigned lda;
    __device__ __forceinline__ const bf16_t* base() const { return b; }
    __device__ __forceinline__ unsigned off(int r) const { int i = m0 + r; i = (i < mvalid) ? i : (mvalid - 1); return (unsigned)(list[i] >> 3) * lda; }
    __device__ __forceinline__ long koff(int kt) const { return (long)kt * 64; } };
struct ARowsV { const bf16_t* b; unsigned lda; int m0, mvalid;
    __device__ __forceinline__ const bf16_t* base() const { return b; }
    __device__ __forceinline__ unsigned off(int r) const { int i = m0 + r; i = (i < mvalid) ? i : (mvalid - 1); return (unsigned)i * lda; }
    __device__ __forceinline__ long koff(int kt) const { return (long)kt * 64; } };

__device__ __forceinline__ void p12_exp_up(const Ctx& F) {
    const int total = build_expert_tables(F, 2);
    volatile LAS int* offs = (volatile LAS int*)(F.lds + LDS_MISC);
    volatile LAS int* istart = offs + 264;
    const bf16_t* hhi = (const bf16_t*)(F.ws + WS_A3); const int* ltok = (const int*)(F.ws + WS_LTOK); bf16_t* act = (bf16_t*)(F.ws + WS_ACT);
    unsigned* cnt = F.ctl + CW_CNT;
    for (int it = F.vcu; it < total; it += F.G) {
        const int e = find_expert(F, it); const int li = it - istart[e]; const int rt = li >> 1, ct = li & 1;
        const int me = (int)cnt[e * 64], m0 = rt * 256, j0 = ct * 128; const int ro = offs[e];
        f32x16 acc[4][2]; zero_acc<4>(acc);
        AGather af{hhi, ltok + (long)e * LCAP, m0, me, 3072u};
        BKNPair bf{F.a.in[18] + (long)e * 262144 + j0, (long)(F.a.in[19] - F.a.in[18]), 256};
        gemm_core<4, true>(acc, af, bf, 16, F.lds);
        run_epilogue_tr<4>(acc, [&](int r, int c0, f32x4 v0, f32x4 v1) { const int i = m0 + r; if (i < me) { const int j = j0 + (c0 >> 6) * 32 + (c0 & 31);
            const f32x4 a = {siluf_(v0[0]) * v1[0], siluf_(v0[1]) * v1[1], siluf_(v0[2]) * v1[2], siluf_(v0[3]) * v1[3]};
            *(u32x2*)(act + (unsigned)(ro + i) * 256u + j) = pack4(a); } });
    }
}
__device__ __forceinline__ void p13_exp_down(const Ctx& F) {
    constexpr int W_P = 528, ST_P = 144;
    constexpr int L_W = 0, L_ST = 128 * W_P;
    static_assert(L_ST + 8 * 32 * ST_P <= LDS_MISC, "expert-down engine LDS");
    (void)build_expert_tables(F, 1);
    volatile LAS int* offs = (volatile LAS int*)(F.lds + LDS_MISC);
    const int* ltok = (const int*)(F.ws + WS_LTOK); const float* lw = (const float*)(F.ws + WS_LW); const bf16_t* act = (const bf16_t*)(F.ws + WS_ACT);
    unsigned char* ybuf8 = F.ws + WS_YBUF; unsigned* cnt = F.ctl + CW_CNT;
    const int lane = F.lane, w = F.wave, l31 = lane & 31, hh = lane >> 5;
    unsigned char* st = F.lds + L_ST + w * (32 * ST_P);
#pragma unroll 1
    for (int it = F.vcu; it < NE * 8; it += F.G) {
        const int e = it >> 3, n0 = (it & 7) * 128; const int me = (int)cnt[e * 64]; const int ro = offs[e];
        if (me == 0) continue;
        __syncthreads();
        { int tid_ = F.tid; asm volatile("" : "+v"(tid_));
#pragma unroll 1
          for (int b2 = tid_; b2 < 1024; b2 += NTHREADS) { const int kb = b2 >> 5, nq = b2 & 31;
            const float* src = F.a.in[20] + (size_t)e * 262144 + (size_t)(kb * 8) * 1024 + n0 + 4 * nq;
            f32x4 r[8];
#pragma unroll
            for (int i = 0; i < 8; ++i) r[i] = *(const f32x4*)(src + (size_t)i * 1024);
#pragma unroll
            for (int j = 0; j < 4; ++j) { u32x4 p; p.x = cvt_pk_bf16(r[0][j], r[1][j]); p.y = cvt_pk_bf16(r[2][j], r[3][j]); p.z = cvt_pk_bf16(r[4][j], r[5][j]); p.w = cvt_pk_bf16(r[6][j], r[7][j]);
                *(u32x4*)(F.lds + L_W + (4 * nq + j) * W_P + kb * 16) = p; } } }
        __syncthreads();
        const int* lt = ltok + (size_t)e * LCAP; const float* lwe = lw + (size_t)e * LCAP;
#pragma unroll 1
        for (int tb = w; tb * 32 < me; tb += 8) {
            const int idx = tb * 32 + l31; const int idc = (idx < me) ? idx : (me - 1);
            const bf16_t* arow = act + (size_t)(ro + idc) * 256 + 8 * hh;
            bf16x8 z[16];
#pragma unroll
            for (int k = 0; k < 16; ++k) z[k] = *(const bf16x8*)(arow + 16 * k);
            const int myent = lt[idc]; const float sc = lwe[idc] * 16.f;
            f32x16 acc[4];
#pragma unroll
            for (int f = 0; f < 4; ++f)
#pragma unroll
                for (int r = 0; r < 16; ++r) acc[f][r] = 0.f;
            bf16x8 wa[8], wb[8];
            const unsigned char* wbase = F.lds + L_W + l31 * W_P + 16 * hh;
#define WLOAD(dst, hs) _Pragma("unroll") for (int k = 0; k < 8; ++k) dst[k] = *(const bf16x8*)(wbase + (32 * ((hs) >> 1)) * W_P + (128 * ((hs) & 1) + 16 * k) * 2)
#define WMMA(src, hs) _Pragma("unroll") for (int k = 0; k < 8; ++k) acc[(hs) >> 1] = __builtin_amdgcn_mfma_f32_32x32x16_bf16(src[k], z[8 * ((hs) & 1) + k], acc[(hs) >> 1], 0, 0, 0)
            WLOAD(wa, 0);
#pragma unroll
            for (int hs = 0; hs < 8; hs += 2) {
                WLOAD(wb, hs + 1); __builtin_amdgcn_sched_barrier(0);
                WMMA(wa, hs); __builtin_amdgcn_sched_barrier(0);
                if (hs + 2 < 8) { WLOAD(wa, hs + 2); } __builtin_amdgcn_sched_barrier(0);
                WMMA(wb, hs + 1); __builtin_amdgcn_sched_barrier(0);
            }
#undef WLOAD
#undef WMMA
#pragma unroll
            for (int f = 0; f < 4; ++f)
#pragma unroll
                for (int q4 = 0; q4 < 4; ++q4) { const f32x4 v = {acc[f][4 * q4] * sc, acc[f][4 * q4 + 1] * sc, acc[f][4 * q4 + 2] * sc, acc[f][4 * q4 + 3] * sc};
                    *(unsigned*)(st + l31 * ST_P + 32 * f + 8 * q4 + 4 * hh) = pack_fp8x4(v); }
#pragma unroll
            for (int i = 0; i < 4; ++i) { const int row = (lane >> 3) + 8 * i, ch = lane & 7;
                const u32x4 v = *(const u32x4*)(st + row * ST_P + ch * 16); const unsigned ent = (unsigned)__shfl(myent, row);
                if (tb * 32 + row < me) *(u32x4*)(ybuf8 + (size_t)ent * 1024 + n0 + ch * 16) = v; }
        }
    }
}

__device__ __forceinline__ void p14_final(const Ctx& F) {
    pg8::Gemm g{(const bf16_t*)(F.ws + WS_ACTS), (const bf16_t*)(F.ws + WS_WB_SD), T, 1024, 256};
    pg8::StaticOrder S; S.init(T, 1024, F.G, (int)blockIdx.x);
    EpiOut E{F.out, (const float*)(F.ws + WS_X1), (const float*)(F.ws + WS_ADAF), (const bf16_t*)(F.ws + WS_YBUF)};
    pg8::gemm_phase<EpiOut, pg8::StaticOrder, true, true>((LAS unsigned char*)F.lds, g, S, E);
}

constexpr int NPHASE = 13;
__global__ void __launch_bounds__(NTHREADS, 2) mk_fwd(Args args) {
    extern __shared__ __attribute__((aligned(16))) unsigned char lds[];
    const int tid_ = threadIdx.x, G_ = gridDim.x, bx_ = blockIdx.x;
    Ctx F{args, args.out, args.ws, lds, (unsigned*)(args.ws + WS_CTL), tid_, tid_ & 63, __builtin_amdgcn_readfirstlane(tid_ >> 6), G_, (G_ % 8 == 0) ? (bx_ % 8) * (G_ / 8) + bx_ / 8 : bx_};
    const int lo = args.ph_lo, hi = args.ph_hi;
    volatile LAS unsigned* bst = (volatile LAS unsigned*)(lds + LDS_MISC + 4096);
    XcdBarrier bar; bar.bar = F.ctl + CW_BAR; bar.x = 0; bar.st = bst;
    if (hi - lo > 1) {
        if (F.tid == 0) { bst[0] = 0u; bst[1] = 0u; bst[2] = 0u; bst[3] = 0u; }
        __syncthreads();
        bar = xcd_barrier_post(F.ctl + CW_BAR, bst);
    }
#define PHASE(k, call) if (lo <= (k) && (k) < hi) { call; if ((k) + 1 < hi) xcd_barrier(bar); }
    PHASE(0, p0_prep(F))
    PHASE(1, p_norm_rows(F, 0))
    PHASE(2, p2_win(F))
    PHASE(3, p3_mixer_inputs(F))
    PHASE(4, p6_attn_dft(F))
    PHASE(5, p7_merge(F))
    PHASE(6, p8_out(F))
    PHASE(7, p_norm_rows(F, 1))
    PHASE(8, p10_router_shared(F))
    PHASE(9, p11_topk(F))
    PHASE(10, p12_exp_up(F))
    PHASE(11, p13_exp_down(F))
    PHASE(12, p14_final(F))
#undef PHASE
}

extern "C" void kernel_launch(void* const* d_in, const int* in_sizes, int n_in, void* d_out, int out_size, void* d_ws, size_t ws_size, hipStream_t stream) {
    static int grid = 0;
    if (grid == 0) {
        if (n_in != 24 || out_size != T * DM || ws_size < WS_END) {
            fprintf(stderr, "kernel_launch: unexpected shapes (n_in %d, out %d, ws %zu < %zu); nothing launched\n", n_in, out_size, ws_size, (size_t)WS_END); grid = -1; return; }
        int dev = 0, cus = 0, per_cu = 0;
        if (hipGetDevice(&dev) != hipSuccess || hipDeviceGetAttribute(&cus, hipDeviceAttributeMultiprocessorCount, dev) != hipSuccess) { grid = -1; return; }
        if (hipFuncSetAttribute((const void*)mk_fwd, hipFuncAttributeMaxDynamicSharedMemorySize, LDS_BYTES) != hipSuccess) { fprintf(stderr, "kernel_launch: hipFuncSetAttribute failed\n"); grid = -1; return; }
        if (hipOccupancyMaxActiveBlocksPerMultiprocessor(&per_cu, (const void*)mk_fwd, NTHREADS, LDS_BYTES) != hipSuccess || per_cu < 1)
            fprintf(stderr, "kernel_launch: occupancy query reports %d blocks per CU\n", per_cu);
        (void)hipGetLastError();
        if (cus < 256) { fprintf(stderr, "kernel_launch: this kernel is laid out for 256 CUs (device reports %d); nothing launched\n", cus); grid = -1; return; }
        grid = 256;
    }
    if (grid < 0) return;
    (void)hipMemsetAsync((char*)d_ws + WS_CTL, 0, CTL_BYTES, stream);
    Args a{};
    for (int i = 0; i < 24; ++i) a.in[i] = (const float*)d_in[i];
    a.out = (float*)d_out; a.ws = (unsigned char*)d_ws;
#if N_LAUNCH_MODE == 1
    a.ph_lo = 0; a.ph_hi = NPHASE;
    hipLaunchKernelGGL(mk_fwd, dim3(grid), dim3(NTHREADS), LDS_BYTES, stream, a);
#else
    for (int ph = 0; ph < NPHASE; ++ph) { a.ph_lo = ph; a.ph_hi = ph + 1; hipLaunchKernelGGL(mk_fwd, dim3(grid), dim3(NTHREADS), LDS_BYTES, stream, a); }
#endif
    const hipError_t le = hipPeekAtLastError();
    if (le != hipSuccess) fprintf(stderr, "kernel_launch: launch failed: %s\n", hipGetErrorName(le));
}
```

```cpp
#include <hip/hip_runtime.h>
#include <cstdio>
#include <cstdint>

typedef unsigned short bf16_t;
typedef short bf16x8 __attribute__((ext_vector_type(8)));
typedef float f32x16 __attribute__((ext_vector_type(16)));
typedef float f32x4 __attribute__((ext_vector_type(4)));
typedef unsigned u32x4 __attribute__((ext_vector_type(4)));
typedef unsigned u32x2 __attribute__((ext_vector_type(2)));

#define REPEAT_MASK 16384
#ifndef N_LAUNCH_MODE
#define N_LAUNCH_MODE 1
#endif
#ifndef NAIVE_MMA
#define NAIVE_MMA 0
#endif

constexpr int T = 16384, DM = 1024, NB = 8, SEQ = 2048;
constexpr int INW = 2976, NH = 8, DQK = 96, DV = 64;
constexpr int NE = 256, TOPK = 8, EH = 256;
constexpr float EPS = 1e-6f;
constexpr int NTHREADS = 512;
constexpr int LCAP = 16384;

constexpr size_t al256(size_t x) { return (x + 255) & ~(size_t)255; }
constexpr size_t WS_CTL   = 0;
constexpr size_t CTL_BYTES = 196608;
constexpr size_t WS_ADAP  = WS_CTL + CTL_BYTES;
constexpr size_t WS_ADAF  = WS_ADAP + al256((size_t)16 * 8 * 6144 * 4);
constexpr size_t WS_ROPE  = WS_ADAF + al256((size_t)8 * 6144 * 4);
constexpr size_t WS_WDFT  = WS_ROPE + al256((size_t)2 * 2048 * 16 * 4);
constexpr size_t WS_D64T  = WS_WDFT + al256((size_t)2048 * 4096 * 2);
constexpr size_t WS_WR3   = WS_D64T + al256((size_t)128 * 64 * 2);
constexpr size_t WS_WUQ   = WS_WR3 + al256((size_t)3072 * 256 * 4);
constexpr size_t WS_WUKV  = WS_WUQ + al256((size_t)256 * 768 * 4);
constexpr size_t WS_H     = WS_WUKV + al256((size_t)128 * 1024 * 4);
constexpr size_t WS_H2LO  = WS_H + al256((size_t)T * 1024 * 2);
constexpr size_t WS_ZQKV  = WS_H2LO + al256((size_t)T * 1024 * 2);
constexpr size_t WS_ZF    = WS_ZQKV + al256((size_t)T * 416 * 2);
constexpr size_t WS_SIG   = WS_ZF + al256((size_t)T * 512 * 2);
constexpr size_t WS_RSTD  = WS_SIG + al256((size_t)T * 2048 * 2);
constexpr size_t WS_XT    = WS_RSTD + al256((size_t)2 * T * 4);
constexpr size_t WS_QRAW  = WS_XT + al256((size_t)4096 * 4096 * 2);
constexpr size_t WS_KNRAW = WS_QRAW + al256((size_t)T * 768 * 4);
constexpr size_t WS_Q     = WS_KNRAW + al256((size_t)T * 512 * 4);
constexpr size_t WS_K     = WS_Q + al256((size_t)T * 768 * 2);
constexpr size_t WS_VT    = WS_K + al256((size_t)T * 768 * 2);
constexpr size_t WS_O     = WS_VT + al256((size_t)T * 512 * 2);
constexpr size_t WS_F     = WS_O + al256((size_t)T * 512 * 2);
constexpr size_t WS_MERGED= WS_F + al256((size_t)T * 512 * 2);
constexpr size_t WS_X1    = WS_MERGED + al256((size_t)T * 1024 * 2);
constexpr size_t WS_LOGIT = WS_X1 + al256((size_t)T * 1024 * 4);
constexpr size_t WS_ACTS  = WS_LOGIT + al256((size_t)T * 256 * 4);
constexpr size_t WS_LTOK  = WS_ACTS + al256((size_t)T * 256 * 2);
constexpr size_t WS_LW    = WS_LTOK + al256((size_t)NE * LCAP * 4);
constexpr size_t WS_ACT   = WS_LW + al256((size_t)NE * LCAP * 4);
constexpr size_t WS_YBUF  = WS_ACT + al256((size_t)T * 8 * 256 * 2);
constexpr size_t WS_WB_IN = WS_YBUF + al256((size_t)T * 8 * 1024 * 2);
constexpr size_t WS_WB_PA = WS_WB_IN + al256((size_t)3072 * 1024 * 2);
constexpr size_t WS_WB_PF = WS_WB_PA + al256((size_t)1024 * 512 * 2);
constexpr size_t WS_WB_OUT= WS_WB_PF + al256((size_t)1024 * 512 * 2);
constexpr size_t WS_WB_SH = WS_WB_OUT + al256((size_t)1024 * 1024 * 2);
constexpr size_t WS_WB_SD = WS_WB_SH + al256((size_t)512 * 1024 * 2);
constexpr size_t WS_WB_R  = WS_WB_SD + al256((size_t)1024 * 256 * 2);
constexpr size_t WS_A3    = WS_WB_R + al256((size_t)256 * 3072 * 2);
constexpr size_t WS_END   = WS_A3 + al256((size_t)T * 3072 * 2);

constexpr int CW_CNT = 16384;
constexpr int CW_QUEUE = 4400;
constexpr int CW_BAR = 0;

constexpr int LDS_GEMM = 2 * 65536;
constexpr int ST16 = 520, ST32 = 1040;
constexpr int LDS_STAGE = 256 * ST16;
constexpr int LDS_MISC = 140288;
constexpr int LDS_BYTES = LDS_MISC + 8192;

typedef __bf16 bf16x2_t __attribute__((ext_vector_type(2)));
typedef float f32x2_t __attribute__((ext_vector_type(2)));
__device__ __forceinline__ unsigned cvt_pk_bf16(float lo, float hi) { f32x2_t f = {lo, hi}; bf16x2_t h = __builtin_convertvector(f, bf16x2_t); return __builtin_bit_cast(unsigned, h); }
__device__ __forceinline__ bf16_t f2bf(float v) { __bf16 h = (__bf16)v; return __builtin_bit_cast(unsigned short, h); }
__device__ __forceinline__ float bf2f(bf16_t b) { return __uint_as_float(((unsigned)b) << 16); }
__device__ __forceinline__ float sigmoidf_(float v) { return 1.f / (1.f + __expf(-v)); }
__device__ __forceinline__ float siluf_(float v) { return v / (1.f + __expf(-v)); }
__device__ __forceinline__ float wave_sum(float v) {
#pragma unroll
    for (int o = 32; o > 0; o >>= 1) v += __shfl_xor(v, o);
    return v;
}
__device__ __forceinline__ int swz(int row) { return ((row >> 1) & 7) ^ ((row >> 4) & 1); }

#define XB_TMO      128
#define XB_XCNT(j)  (256  + 64 * (j))
#define XB_XSUB(j)  (1280 + 64 * (j))
#define XB_XGEN(j)  (2304 + 64 * (j))
#define XB_TOP      3328
#define XB_TOPGEN   3392
#define XCD_BAR_WORDS 3456
#define XB_SPIN_CAP (1u << 22)
#define LAS __attribute__((address_space(3)))
__device__ __forceinline__ unsigned xb_ld(unsigned* p)              { return __hip_atomic_load(p, __ATOMIC_RELAXED, __HIP_MEMORY_SCOPE_AGENT); }
__device__ __forceinline__ unsigned xb_add(unsigned* p, unsigned v) { return __hip_atomic_fetch_add(p, v, __ATOMIC_RELAXED, __HIP_MEMORY_SCOPE_AGENT); }
__device__ __forceinline__ unsigned xb_xcc_id() { return (unsigned)__builtin_amdgcn_s_getreg((3 << 11) | 20) & 0xFu; }
#define XB_SPIN(cond, bar) do { unsigned _sp = 0; while (cond) { __builtin_amdgcn_s_sleep(1); \
    if ((++_sp & 255u) == 0u) { if (xb_ld(&(bar)[XB_TMO])) break; if (_sp > XB_SPIN_CAP) { atomicAdd(&(bar)[XB_TMO], 1u); break; } } } } while (0)
struct XcdBarrier { unsigned* bar; unsigned x; volatile LAS unsigned* st; };
__device__ __forceinline__ XcdBarrier xcd_barrier_post(unsigned* bar, volatile LAS unsigned* st) {
    XcdBarrier b; b.bar = bar; b.x = xb_xcc_id(); b.st = st;
    if (threadIdx.x == 0) (void)xb_add(&bar[XB_XCNT(b.x)], 1u);
    return b;
}
__device__ __forceinline__ void xcd_barrier_complete(unsigned* bar, unsigned x, unsigned& nloc, unsigned& nx) {
    const unsigned G = gridDim.x * gridDim.y * gridDim.z;
    unsigned sum, cnt, mine, sp = 0u;
    for (;;) {
        sum = 0u; cnt = 0u; mine = 0u;
#pragma unroll
        for (unsigned j = 0; j < 16; ++j) { const unsigned c = xb_ld(&bar[XB_XCNT(j)]); sum += c; cnt += (c > 0u) ? 1u : 0u; mine = (j == x) ? c : mine; }
        if (sum == G) break;
        __builtin_amdgcn_s_sleep(1);
        if ((++sp & 255u) == 0u) { if (xb_ld(&bar[XB_TMO])) break; if (sp > XB_SPIN_CAP) { atomicAdd(&bar[XB_TMO], 1u); break; } }
    }
    nloc = mine > 0u ? mine : 1u; nx = cnt > 0u ? cnt : 1u;
}
__device__ __forceinline__ void xcd_barrier(const XcdBarrier& b) {
    asm volatile("s_waitcnt vmcnt(0)" ::: "memory");
    __syncthreads();
    if (threadIdx.x == 0) {
        unsigned* bar = b.bar;
        __builtin_amdgcn_s_waitcnt(0);
        unsigned nloc = b.st[0], nx = b.st[1];
        if (nloc == 0u) { xcd_barrier_complete(bar, b.x, nloc, nx); b.st[0] = nloc; b.st[1] = nx; }
        const unsigned old = xb_add(&bar[XB_XSUB(b.x)], 1u);
        const unsigned gen = old / nloc;
        if (old + 1u == (gen + 1u) * nloc) {
            __builtin_amdgcn_fence(__ATOMIC_RELEASE, "agent");
            asm volatile("s_waitcnt vmcnt(0)" ::: "memory");
            const unsigned og = xb_add(&bar[XB_TOP], 1u);
            const unsigned tg = og / nx;
            if (og + 1u == (tg + 1u) * nx) xb_add(&bar[XB_TOPGEN], 1u);
            else XB_SPIN(xb_ld(&bar[XB_TOPGEN]) == tg, bar);
            __builtin_amdgcn_fence(__ATOMIC_ACQUIRE, "agent");
            xb_add(&bar[XB_XGEN(b.x)], 1u);
            asm volatile("s_waitcnt vmcnt(0)" ::: "memory");
        } else {
            XB_SPIN(xb_ld(&bar[XB_XGEN(b.x)]) == gen, bar);
            __builtin_amdgcn_fence(__ATOMIC_ACQUIRE, "agent");
            asm volatile("s_waitcnt vmcnt(0)" ::: "memory");
        }
    }
    __syncthreads();
}

template <int MI, bool TR, class AF, class BF>
__device__ __forceinline__ void gemm_core(f32x16 (&acc)[MI][2], const AF& af, const BF& bf, const int nk, unsigned char* lds) {
    constexpr int BM = 64 * MI;
    constexpr int A_BYTES = BM * 128, STAGE = A_BYTES + 256 * 128;
    const int t = threadIdx.x, lane = t & 63, w = t >> 6, wm = w >> 2, wn = w & 3;
    const int l31 = lane & 31, hh = lane >> 5;
    const int ch = t & 7, r0 = t >> 3;
    const bf16_t* abase = af.base();
    unsigned aoff[MI];
#pragma unroll
    for (int i = 0; i < MI; ++i) aoff[i] = af.off(r0 + 64 * i);
    const int a_lds = r0 * 128 + ((ch ^ swz(r0)) << 4);
    u32x4 areg[MI];
    f32x4 bregf[8]; u32x4 bregh[4];
    unsigned boff[4];
    const float* bcolf = nullptr;
    if constexpr (BF::KN) { bcolf = bf.col(4 * lane); }
    else {
#pragma unroll
        for (int i = 0; i < 4; ++i) boff[i] = bf.off(r0 + 64 * i);
    }
    auto gload = [&](int kt) {
        const long ko = af.koff(kt) + ch * 8;
#pragma unroll
        for (int i = 0; i < MI; ++i) areg[i] = *(const u32x4*)(abase + aoff[i] + ko);
        if constexpr (BF::KN) {
            const float* bp = bcolf + (long)(kt * 64 + w * 8) * bf.ldb;
#pragma unroll
            for (int i = 0; i < 8; ++i) bregf[i] = *(const f32x4*)(bp + (long)i * bf.ldb);
        } else {
            const bf16_t* bp = bf.base() + bf.koff(kt) + ch * 8;
#pragma unroll
            for (int i = 0; i < 4; ++i) bregh[i] = *(const u32x4*)(bp + boff[i]);
        }
    };
    auto lstore = [&](int st) {
        unsigned char* base = lds + st * STAGE;
#pragma unroll
        for (int i = 0; i < MI; ++i) *(u32x4*)(base + a_lds + i * 64 * 128) = areg[i];
        unsigned char* bb = base + A_BYTES;
        if constexpr (BF::KN) {
#pragma unroll
            for (int cc = 0; cc < 4; ++cc) {
                const int col = 4 * lane + cc;
                u32x4 v; v.x = cvt_pk_bf16(bregf[0][cc], bregf[1][cc]); v.y = cvt_pk_bf16(bregf[2][cc], bregf[3][cc]);
                v.z = cvt_pk_bf16(bregf[4][cc], bregf[5][cc]); v.w = cvt_pk_bf16(bregf[6][cc], bregf[7][cc]);
                *(u32x4*)(bb + col * 128 + ((w ^ swz(col)) << 4)) = v;
            }
        } else {
#pragma unroll
            for (int i = 0; i < 4; ++i) *(u32x4*)(bb + a_lds + i * 64 * 128) = bregh[i];
        }
    };
    const int fsw = swz(l31);
    const int a_frag = (wm * 32 * MI + l31) * 128, b_frag = (wn * 64 + l31) * 128;
    auto compute = [&](int st) {
        const unsigned char* base = lds + st * STAGE;
        const unsigned char* bb = base + A_BYTES;
#if NAIVE_MMA
#pragma unroll
        for (int mi = 0; mi < MI; ++mi)
#pragma unroll
            for (int ni = 0; ni < 2; ++ni)
#pragma unroll
                for (int rg = 0; rg < 16; ++rg) {
                    const int row = TR ? (wm * 32 * MI + mi * 32 + l31) : (wm * 32 * MI + mi * 32 + (rg & 3) + 8 * (rg >> 2) + 4 * hh);
                    const int col = TR ? (wn * 64 + ni * 32 + (rg & 3) + 8 * (rg >> 2) + 4 * hh) : (wn * 64 + ni * 32 + l31);
                    float s = 0.f;
                    for (int k = 0; k < 64; ++k) {
                        const bf16_t av = *(const bf16_t*)(base + row * 128 + (((k >> 3) ^ swz(row)) << 4) + (k & 7) * 2);
                        const bf16_t bv = *(const bf16_t*)(bb + col * 128 + (((k >> 3) ^ swz(col)) << 4) + (k & 7) * 2);
                        s += bf2f(av) * bf2f(bv);
                    }
                    acc[mi][ni][rg] += s;
                }
#else
#pragma unroll 2
        for (int s = 0; s < 4; ++s) {
            const int pos = ((2 * s + hh) ^ fsw) << 4;
            bf16x8 bfr[2];
#pragma unroll
            for (int ni = 0; ni < 2; ++ni) bfr[ni] = *(const bf16x8*)(bb + b_frag + ni * 32 * 128 + pos);
#pragma unroll
            for (int mi = 0; mi < MI; ++mi) {
                const bf16x8 afr = *(const bf16x8*)(base + a_frag + mi * 32 * 128 + pos);
#pragma unroll
                for (int ni = 0; ni < 2; ++ni) acc[mi][ni] = TR ? __builtin_amdgcn_mfma_f32_32x32x16_bf16(bfr[ni], afr, acc[mi][ni], 0, 0, 0)
                                                               : __builtin_amdgcn_mfma_f32_32x32x16_bf16(afr, bfr[ni], acc[mi][ni], 0, 0, 0);
            }
        }
#endif
    };
    int nk_ = nk; asm volatile("" : "+s"(nk_));
    __syncthreads();
    gload(0);
    lstore(0);
    __syncthreads();
#pragma unroll 1
    for (int kt = 0; kt < nk_; ++kt) {
        const bool more = (kt + 1 < nk_);
        if (more) gload(kt + 1);
        compute(kt & 1);
        if (more) lstore((kt + 1) & 1);
        __syncthreads();
    }
}

template <int MI> __device__ __forceinline__ void zero_acc(f32x16 (&acc)[MI][2]) {
#pragma unroll
    for (int mi = 0; mi < MI; ++mi)
#pragma unroll
        for (int ni = 0; ni < 2; ++ni)
#pragma unroll
            for (int r = 0; r < 16; ++r) acc[mi][ni][r] = 0.f;
}
template <int MI, class EPI>
__device__ __forceinline__ void run_epilogue(const f32x16 (&acc)[MI][2], const EPI& epi) {
    const int t = threadIdx.x, lane = t & 63, w = t >> 6, wm = w >> 2, wn = w & 3, l31 = lane & 31, hh = lane >> 5;
#pragma unroll
    for (int mi = 0; mi < MI; ++mi)
#pragma unroll
        for (int rg = 0; rg < 16; ++rg) {
            const int r = wm * 32 * MI + mi * 32 + (rg & 3) + 8 * (rg >> 2) + 4 * hh;
            epi(r, wn * 64 + l31, acc[mi][0][rg], acc[mi][1][rg]);
            if ((rg & 7) == 7) __builtin_amdgcn_sched_barrier(0);
        }
}

template <int MI, class EPI>
__device__ __forceinline__ void run_epilogue_tr(const f32x16 (&acc)[MI][2], const EPI& epi) {
    const int t = threadIdx.x, lane = t & 63, w = t >> 6, wm = w >> 2, wn = w & 3, l31 = lane & 31, hh = lane >> 5;
#pragma unroll
    for (int mi = 0; mi < MI; ++mi) {
        const int r = wm * 32 * MI + mi * 32 + l31;
#pragma unroll
        for (int q4 = 0; q4 < 4; ++q4) {
            const f32x4 v0 = {acc[mi][0][4 * q4], acc[mi][0][4 * q4 + 1], acc[mi][0][4 * q4 + 2], acc[mi][0][4 * q4 + 3]};
            const f32x4 v1 = {acc[mi][1][4 * q4], acc[mi][1][4 * q4 + 1], acc[mi][1][4 * q4 + 2], acc[mi][1][4 * q4 + 3]};
            epi(r, wn * 64 + 8 * q4 + 4 * hh, v0, v1);
        }
        __builtin_amdgcn_sched_barrier(0);
    }
}
__device__ __forceinline__ u32x2 pack4(const f32x4 v) { u32x2 p; p.x = cvt_pk_bf16(v[0], v[1]); p.y = cvt_pk_bf16(v[2], v[3]); return p; }
__device__ __forceinline__ f32x4 unpack4(const u32x2 p) { f32x4 v = {__uint_as_float(p.x << 16), __uint_as_float(p.x & 0xffff0000u), __uint_as_float(p.y << 16), __uint_as_float(p.y & 0xffff0000u)}; return v; }

__device__ __forceinline__ unsigned pack_fp8x4(const f32x4 v) { int p = __builtin_amdgcn_cvt_pk_fp8_f32(v[0], v[1], 0, false); p = __builtin_amdgcn_cvt_pk_fp8_f32(v[2], v[3], p, true); return (unsigned)p; }
__device__ __forceinline__ f32x4 unpack_fp8x4(const unsigned p) { f32x4 v = {__builtin_amdgcn_cvt_f32_fp8((int)p, 0), __builtin_amdgcn_cvt_f32_fp8((int)p, 1), __builtin_amdgcn_cvt_f32_fp8((int)p, 2), __builtin_amdgcn_cvt_f32_fp8((int)p, 3)}; return v; }
template <int MI> __device__ __forceinline__ void stage_bf16(const f32x16 (&acc)[MI][2], unsigned char* lds) {
    const int t = threadIdx.x, lane = t & 63, w = t >> 6, wm = w >> 2, wn = w & 3, l31 = lane & 31, hh = lane >> 5;
#pragma unroll
    for (int mi = 0; mi < MI; ++mi) {
        unsigned char* rp = lds + (wm * 32 * MI + mi * 32 + l31) * ST16 + (wn * 64 + 4 * hh) * 2;
#pragma unroll
        for (int ni = 0; ni < 2; ++ni)
#pragma unroll
            for (int q4 = 0; q4 < 4; ++q4) {
                const f32x4 v = {acc[mi][ni][4 * q4], acc[mi][ni][4 * q4 + 1], acc[mi][ni][4 * q4 + 2], acc[mi][ni][4 * q4 + 3]};
                *(u32x2*)(rp + (ni * 32 + 8 * q4) * 2) = pack4(v);
            }
    }
}
__device__ __forceinline__ void stage_f32(const f32x16 (&acc)[2][2], unsigned char* lds) {
    const int t = threadIdx.x, lane = t & 63, w = t >> 6, wm = w >> 2, wn = w & 3, l31 = lane & 31, hh = lane >> 5;
#pragma unroll
    for (int mi = 0; mi < 2; ++mi) {
        unsigned char* rp = lds + (wm * 64 + mi * 32 + l31) * ST32 + (wn * 64 + 4 * hh) * 4;
#pragma unroll
        for (int ni = 0; ni < 2; ++ni)
#pragma unroll
            for (int q4 = 0; q4 < 4; ++q4) {
                const f32x4 v = {acc[mi][ni][4 * q4], acc[mi][ni][4 * q4 + 1], acc[mi][ni][4 * q4 + 2], acc[mi][ni][4 * q4 + 3]};
                *(f32x4*)(rp + (ni * 32 + 8 * q4) * 4) = v;
            }
    }
}

struct ARows { const bf16_t* b; unsigned lda; int m0;
    __device__ __forceinline__ const bf16_t* base() const { return b; }
    __device__ __forceinline__ unsigned off(int r) const { return (unsigned)(m0 + r) * lda; }
    __device__ __forceinline__ long koff(int kt) const { return (long)kt * 64; } };
struct BKN { const float* b; int ldb; int n0; int nvalid; static constexpr bool KN = true;
    __device__ __forceinline__ const float* col(int c) const { int cc = n0 + c; cc = (cc < nvalid) ? cc : (nvalid - 4); return b + cc; } };
struct BKNPair { const float* g; long u_minus_g; int ldb; static constexpr bool KN = true;
    __device__ __forceinline__ const float* col(int c) const { return g + (long)((c >> 5) & 1) * u_minus_g + (c >> 6) * 32 + (c & 31); } };
struct BNK { const bf16_t* b; unsigned ldb; int n0; static constexpr bool KN = false;
    __device__ __forceinline__ const bf16_t* base() const { return b; }
    __device__ __forceinline__ unsigned off(int c) const { return (unsigned)(n0 + c) * ldb; }
    __device__ __forceinline__ long koff(int kt) const { return (long)kt * 64; } };

namespace pg8 {
#define PG8_LAS __attribute__((address_space(3)))
typedef unsigned short bf16_t;
typedef short bf16x8 __attribute__((ext_vector_type(8)));
typedef float f32x4 __attribute__((ext_vector_type(4)));
typedef unsigned u32x4 __attribute__((ext_vector_type(4)));
constexpr int BM = 256, BK = 64, HALF = 128, HTB = HALF * BK * 2  , STAGE_BYTES = 8 * HTB, NXCD = 8, WGM = 8;

__host__ __device__ __forceinline__ int lds_byte(int r, int c) { const int st = (r >> 4) * 2 + (c >> 5), rr = r & 15, cc = c & 31, ob = rr * 64 + cc * 2; return st * 1024 + (ob ^ (((ob >> 9) & 1) << 5)); }
__host__ __device__ __forceinline__ void stage_rc(int b, int& R, int& C) { const int st = b / 1024, sb = b % 1024, swz = sb ^ (((sb >> 9) & 1) << 5); R = (st >> 1) * 16 + swz / 64; C = (st & 1) * 32 + (swz % 64) / 2; }
__host__ __device__ __forceinline__ int perm32(int rho) { const int n = rho >> 4, i = rho & 15; return 8 * (i >> 2) + 4 * n + (i & 3); }

struct Unit { int pm, pn; };
struct Gemm { const bf16_t* A; const bf16_t* Bt; int M, N, K; int lda; int ldb; };

struct StaticOrder {
    int nM, nN, nwg, G, c;
    __host__ __device__ void init(int M, int N, int G_, int c_) { nM = M / BM; nN = N / BM; nwg = nM * nN; G = G_; c = c_; }
    __host__ __device__ bool next(int i, Unit& u) const {
        const long L = (long)i * G + c; if (L >= nwg) return false;
        int wgid = (int)L; { const int q = nwg / NXCD, r = nwg % NXCD, xcd = wgid % NXCD, off = wgid / NXCD; wgid = (xcd < r ? xcd * (q + 1) : r * (q + 1) + (xcd - r) * q) + off; }
        const int nig = WGM * nN, gid = wgid / nig, fm = gid * WGM, gsz = (nM - fm) < WGM ? (nM - fm) : WGM;
        u.pm = fm + ((wgid % nig) % gsz); u.pn = (wgid % nig) / gsz; return true;
    }
    __device__ __forceinline__ void a_ready(const Unit&) const {}
    __device__ __forceinline__ void done(const Unit&) const {}
};
template <class Epi, class Sched, bool ALIGN_EPI = false, bool SP2 = false, bool MIDHOOK = false>
__device__ __forceinline__ void gemm_phase(PG8_LAS unsigned char* lds, const Gemm g, const Sched& S, const Epi& E) {
    const int tid = threadIdx.x, wid = __builtin_amdgcn_readfirstlane(tid >> 6), lane = tid & 63, wr = wid >> 2, wc = wid & 3, fr = lane & 15, fq = lane >> 4;
    const int K = g.K, nt = K / BK, LDA = g.lda ? g.lda : g.K, LDB = g.ldb ? g.ldb : g.K;
    unsigned voffA[2], voffB[2];
#pragma unroll
    for (int i = 0; i < 2; ++i) { int R, C; stage_rc(tid * 16 + i * 8192, R, C); const int Rb = Epi::PERM ? ((R & ~31) + perm32(R & 31)) : R;
        voffA[i] = (unsigned)(R * LDA + C) * 2u; voffB[i] = (unsigned)(Rb * LDB + C) * 2u; }
    const size_t kstep = (size_t)(BK * 2);
    const size_t hstep = (size_t)HALF * LDB * 2;
    const size_t tstep = 2 * hstep;
    const size_t hstepA = (size_t)HALF * LDA * 2, tstepA = 2 * hstepA;
    const unsigned ldsw = (unsigned)wid * 1024u;
    const int aoff = lds_byte(wr * 64 + fr, fq * 8), boff = lds_byte(wc * 32 + fr, fq * 8);
#define PG8_SA(b, h) (((b) * 2 + (h)) * HTB)
#define PG8_SB(b, h) ((4 + (b) * 2 + (h)) * HTB)
#define PG8_STAGE(bufoff, gbase, voff) do { _Pragma("unroll") for (int _i = 0; _i < 2; ++_i) \
        __builtin_amdgcn_global_load_lds((const unsigned*)((const char*)(gbase) + (voff)[_i]), (PG8_LAS unsigned*)(lds + (bufoff) + ldsw + _i * 8192), 16, 0, 0); } while (0)
#define PG8_LDA(dst, b, h) do { _Pragma("unroll") for (int m = 0; m < 4; ++m) _Pragma("unroll") for (int k = 0; k < 2; ++k) dst[m][k] = *(const PG8_LAS bf16x8*)(lds + PG8_SA(b, h) + aoff + m * 2048 + k * 1024); } while (0)
#define PG8_LDB(dst, b, h) do { _Pragma("unroll") for (int n = 0; n < 2; ++n) _Pragma("unroll") for (int k = 0; k < 2; ++k) dst[n][k] = *(const PG8_LAS bf16x8*)(lds + PG8_SB(b, h) + boff + n * 2048 + k * 1024); } while (0)
#define PG8_MMA(ai, bj, At, Bt) do { __builtin_amdgcn_s_setprio(1); _Pragma("unroll") for (int m = 0; m < 4; ++m) _Pragma("unroll") for (int n = 0; n < 2; ++n) _Pragma("unroll") for (int k = 0; k < 2; ++k) \
        acc[ai][bj][m][n] = __builtin_amdgcn_mfma_f32_16x16x32_bf16(Bt[n][k], At[m][k], acc[ai][bj][m][n], 0, 0, 0); __builtin_amdgcn_s_setprio(0); } while (0)
#define PG8_WAIT_V(n) asm volatile("s_waitcnt vmcnt(" #n ")" ::: "memory")
#define PG8_WAIT_L(n) asm volatile("s_waitcnt lgkmcnt(" #n ")" ::: "memory")
#define PG8_BAR __builtin_amdgcn_s_barrier()
#define PG8_SCHED __builtin_amdgcn_sched_barrier(0)
    Unit cur, nxt; int ui = 0;
    if (!S.next(0, cur)) return;
    f32x4 acc[2][2][4][2];
#pragma unroll
    for (int a = 0; a < 2; ++a)
#pragma unroll
        for (int b = 0; b < 2; ++b)
#pragma unroll
            for (int m = 0; m < 4; ++m)
#pragma unroll
                for (int n = 0; n < 2; ++n) acc[a][b][m][n] = (f32x4){0.f, 0.f, 0.f, 0.f};
    bf16x8 At[4][2], B0[2][2], B1[2][2];
    const char* cA = (const char*)g.A + (size_t)cur.pm * tstepA; const char* cB = (const char*)g.Bt + (size_t)cur.pn * tstep;
    S.a_ready(cur);
    if constexpr (SP2) {
        PG8_STAGE(PG8_SB(0, 0), cB, voffB); PG8_STAGE(PG8_SB(0, 1), cB + hstep, voffB); PG8_STAGE(PG8_SA(0, 0), cA, voffA); PG8_STAGE(PG8_SA(0, 1), cA + hstepA, voffA);
        if (wr == 1) PG8_BAR;
        PG8_WAIT_V(2); PG8_BAR;
        PG8_STAGE(PG8_SB(1, 0), cB + kstep, voffB); PG8_STAGE(PG8_SA(1, 0), cA + kstep, voffA); PG8_STAGE(PG8_SB(1, 1), cB + hstep + kstep, voffB);
        PG8_WAIT_V(6); PG8_BAR;
    } else {
        PG8_STAGE(PG8_SB(0, 0), cB, voffB); PG8_STAGE(PG8_SA(0, 0), cA, voffA); PG8_STAGE(PG8_SB(0, 1), cB + hstep, voffB); PG8_STAGE(PG8_SA(0, 1), cA + hstepA, voffA);
        if (wr == 1) PG8_BAR;
        PG8_WAIT_V(4); PG8_BAR;
        PG8_STAGE(PG8_SB(1, 0), cB + kstep, voffB); PG8_STAGE(PG8_SA(1, 0), cA + kstep, voffA); PG8_STAGE(PG8_SB(1, 1), cB + hstep + kstep, voffB);
        PG8_WAIT_V(6); PG8_BAR;
    }
    for (;;) {
        const bool has_next = S.next(ui + 1, nxt);
        const char* nA = has_next ? (const char*)g.A + (size_t)nxt.pm * tstepA : cA; const char* nB = has_next ? (const char*)g.Bt + (size_t)nxt.pn * tstep : cB;
        for (int t = 0; t < nt; t += 2) {
            if constexpr (MIDHOOK) { if (t == (nt >> 1)) E.mid(acc, cur, wr, wc, fr, fq); }
            const bool last = (t == nt - 2);
            const char* a1 = cA + (size_t)(t + 1) * kstep;
            const char* a2 = last ? nA : cA + (size_t)(t + 2) * kstep; const char* b2 = last ? nB : cB + (size_t)(t + 2) * kstep;
            const char* a3 = a2 + kstep; const char* b3 = b2 + kstep;
            if (last && has_next) S.a_ready(nxt);
            if constexpr (SP2) {
            PG8_LDB(B0, 0, 0); PG8_LDB(B1, 0, 1); PG8_SCHED; PG8_LDA(At, 0, 0); PG8_STAGE(PG8_SA(1, 1), a1 + hstepA, voffA);
            PG8_WAIT_V(8); PG8_WAIT_L(0); PG8_BAR; PG8_MMA(0, 0, At, B0); PG8_MMA(0, 1, At, B1); PG8_BAR; PG8_SCHED;
            PG8_LDA(At, 0, 1); PG8_STAGE(PG8_SB(0, 0), b2, voffB); PG8_STAGE(PG8_SB(0, 1), b2 + hstep, voffB); PG8_STAGE(PG8_SA(0, 0), a2, voffA);
            PG8_WAIT_V(8); PG8_WAIT_L(0); PG8_BAR; PG8_MMA(1, 0, At, B0); PG8_MMA(1, 1, At, B1); PG8_BAR; PG8_SCHED;
            PG8_LDB(B0, 1, 0); PG8_LDB(B1, 1, 1); PG8_SCHED; PG8_LDA(At, 1, 0); PG8_STAGE(PG8_SA(0, 1), a2 + hstepA, voffA);
            PG8_WAIT_V(8); PG8_WAIT_L(0); PG8_BAR; PG8_MMA(0, 0, At, B0); PG8_MMA(0, 1, At, B1); PG8_BAR; PG8_SCHED;
            PG8_LDA(At, 1, 1); PG8_STAGE(PG8_SB(1, 0), b3, voffB); PG8_STAGE(PG8_SB(1, 1), b3 + hstep, voffB); PG8_STAGE(PG8_SA(1, 0), a3, voffA);
            PG8_WAIT_V(8); PG8_WAIT_L(0); PG8_BAR; PG8_MMA(1, 0, At, B0); PG8_MMA(1, 1, At, B1); PG8_BAR; PG8_SCHED;
            } else {
            PG8_LDB(B0, 0, 0); PG8_SCHED; PG8_LDA(At, 0, 0); PG8_STAGE(PG8_SA(1, 1), a1 + hstepA, voffA);
            PG8_WAIT_L(8); PG8_BAR; PG8_WAIT_L(0); PG8_MMA(0, 0, At, B0); PG8_BAR; PG8_SCHED;
            PG8_LDB(B1, 0, 1); PG8_STAGE(PG8_SB(0, 0), b2, voffB);
            PG8_BAR; PG8_WAIT_L(0); PG8_MMA(0, 1, At, B1); PG8_BAR;
            PG8_LDA(At, 0, 1); PG8_STAGE(PG8_SA(0, 0), a2, voffA);
            PG8_BAR; PG8_WAIT_L(0); PG8_MMA(1, 0, At, B0); PG8_BAR; PG8_SCHED;
            PG8_STAGE(PG8_SB(0, 1), b2 + hstep, voffB);
            PG8_WAIT_V(6); PG8_BAR; PG8_MMA(1, 1, At, B1); PG8_BAR;
            PG8_LDB(B0, 1, 0); PG8_SCHED; PG8_LDA(At, 1, 0); PG8_STAGE(PG8_SA(0, 1), a2 + hstepA, voffA);
            PG8_WAIT_L(8); PG8_BAR; PG8_WAIT_L(0); PG8_MMA(0, 0, At, B0); PG8_BAR; PG8_SCHED;
            PG8_LDB(B1, 1, 1); PG8_STAGE(PG8_SB(1, 0), b3, voffB);
            PG8_BAR; PG8_WAIT_L(0); PG8_MMA(0, 1, At, B1); PG8_BAR;
            PG8_LDA(At, 1, 1); PG8_STAGE(PG8_SA(1, 0), a3, voffA);
            PG8_BAR; PG8_WAIT_L(0); PG8_MMA(1, 0, At, B0); PG8_BAR; PG8_SCHED;
            PG8_STAGE(PG8_SB(1, 1), b3 + hstep, voffB);
            PG8_WAIT_V(6); PG8_BAR; PG8_MMA(1, 1, At, B1); PG8_BAR;
            }
        }
        if constexpr (ALIGN_EPI) { if (wr == 0) PG8_BAR; }
        if constexpr (!Epi::AFTER_DRAIN) { E(acc, cur, wr, wc, fr, fq); S.done(cur); }
        if (!has_next) break;
#pragma unroll
        for (int a = 0; a < 2; ++a)
#pragma unroll
            for (int b = 0; b < 2; ++b)
#pragma unroll
                for (int m = 0; m < 4; ++m)
#pragma unroll
                    for (int n = 0; n < 2; ++n) acc[a][b][m][n] = (f32x4){0.f, 0.f, 0.f, 0.f};
        cur = nxt; cA = nA; cB = nB; ++ui;
        if constexpr (ALIGN_EPI) { if (wr == 1) PG8_BAR; }
    }
    PG8_WAIT_V(0);
    if constexpr (!ALIGN_EPI) { if (wr == 0) PG8_BAR; }
    PG8_BAR;
    if constexpr (Epi::AFTER_DRAIN) { E.fused(acc, cur, wr, wc, fr, fq, lds, wid, lane); S.done(cur); }
#undef PG8_SA
#undef PG8_SB
#undef PG8_STAGE
#undef PG8_LDA
#undef PG8_LDB
#undef PG8_MMA
#undef PG8_WAIT_V
#undef PG8_WAIT_L
#undef PG8_BAR
#undef PG8_SCHED
}
}


struct Args { const float* in[24]; float* out; unsigned char* ws; int ph_lo, ph_hi; };

struct Ctx {
    const Args& a; float* out; unsigned char* ws; unsigned char* lds; unsigned* ctl;
    int tid, lane, wave, G, vcu;
};

__device__ __forceinline__ u32x4 pack8(const f32x4 a, const f32x4 b) { u32x4 p; p.x = cvt_pk_bf16(a[0], a[1]); p.y = cvt_pk_bf16(a[2], a[3]); p.z = cvt_pk_bf16(b[0], b[1]); p.w = cvt_pk_bf16(b[2], b[3]); return p; }
__device__ __forceinline__ f32x4 unpack_lo(const u32x4 p) { f32x4 v = {__uint_as_float(p.x << 16), __uint_as_float(p.x & 0xffff0000u), __uint_as_float(p.y << 16), __uint_as_float(p.y & 0xffff0000u)}; return v; }
__device__ __forceinline__ f32x4 unpack_hi(const u32x4 p) { f32x4 v = {__uint_as_float(p.z << 16), __uint_as_float(p.z & 0xffff0000u), __uint_as_float(p.w << 16), __uint_as_float(p.w & 0xffff0000u)}; return v; }
#define EPI_LOOP(...) _Pragma("unroll") for (int ai = 0; ai < 2; ++ai) _Pragma("unroll") for (int m = 0; m < 4; ++m) { const unsigned row = row0 + ai * 128 + m * 16; \
    _Pragma("unroll") for (int bj = 0; bj < 2; ++bj) { const unsigned col = col0 + bj * 128; const f32x4 v0 = acc[ai][bj][m][0], v1 = acc[ai][bj][m][1]; __VA_ARGS__ } }
#define EPI_HEAD const unsigned row0 = u.pm * 256 + wr * 64 + fr; const unsigned col0 = u.pn * 256 + wc * 32 + 8 * fq;
struct EpiZ {
    static constexpr bool PERM = true, AFTER_DRAIN = false; bf16_t* zqkv; bf16_t* zf; bf16_t* sig;
    __device__ __forceinline__ void operator()(const f32x4 (&acc)[2][2][4][2], const pg8::Unit& u, int wr, int wc, int fr, int fq) const { EPI_HEAD
        EPI_LOOP(
            if (col < 416) *(u32x4*)(zqkv + row * 416u + col) = pack8(v0, v1);
            else if (col < 928) *(u32x4*)(zf + row * 512u + (col - 416)) = pack8(v0, v1);
            else if (col < INW) { const f32x4 s0 = {sigmoidf_(v0[0]), sigmoidf_(v0[1]), sigmoidf_(v0[2]), sigmoidf_(v0[3])}; const f32x4 s1 = {sigmoidf_(v1[0]), sigmoidf_(v1[1]), sigmoidf_(v1[2]), sigmoidf_(v1[3])};
                *(u32x4*)(sig + row * 2048u + (col - 928)) = pack8(s0, s1); } ) } };
struct EpiF {
    static constexpr bool PERM = true, AFTER_DRAIN = false; bf16_t* Fo;
    __device__ __forceinline__ void operator()(const f32x4 (&acc)[2][2][4][2], const pg8::Unit& u, int wr, int wc, int fr, int fq) const {
        const unsigned row0 = (u.pn >> 1) * 2048 + u.pm * 256 + wr * 64 + fr; const unsigned col0 = (u.pn & 1) * 256 + wc * 32 + 8 * fq;
        EPI_LOOP( *(u32x4*)(Fo + row * 1024u + 512u + col) = pack8(v0, v1); ) } };
struct EpiMg {
    static constexpr bool PERM = true, AFTER_DRAIN = false; bf16_t* mg; const bf16_t* sig;
    __device__ __forceinline__ void mid(f32x4 (&acc)[2][2][4][2], const pg8::Unit& u, int wr, int wc, int fr, int fq) const { EPI_HEAD
#pragma unroll
        for (int ai = 0; ai < 2; ++ai)
#pragma unroll
            for (int m = 0; m < 4; ++m) { const unsigned row = row0 + ai * 128 + m * 16;
#pragma unroll
                for (int bj = 0; bj < 2; ++bj) { const unsigned col = col0 + bj * 128;
                    const u32x4 ga = *(const u32x4*)(sig + row * 2048u + col), gf = *(const u32x4*)(sig + row * 2048u + 1024 + col);
                    const f32x4 al = unpack_lo(ga), ah = unpack_hi(ga), fl = unpack_lo(gf), fh = unpack_hi(gf);
#pragma unroll
                    for (int e = 0; e < 4; ++e) { acc[ai][bj][m][0][e] *= al[e] * __builtin_amdgcn_rcpf(fl[e]); acc[ai][bj][m][1][e] *= ah[e] * __builtin_amdgcn_rcpf(fh[e]); } }
                if (m == 1 || m == 3) __builtin_amdgcn_sched_barrier(0); } }
    __device__ __forceinline__ void operator()(const f32x4 (&acc)[2][2][4][2], const pg8::Unit& u, int wr, int wc, int fr, int fq) const { EPI_HEAD
        EPI_LOOP( const u32x4 g = *(const u32x4*)(sig + row * 2048u + 1024 + col); *(u32x4*)(mg + row * 1024u + col) = pack8(unpack_lo(g) * v0, unpack_hi(g) * v1); ) } };
struct EpiX1 {
    static constexpr bool PERM = true, AFTER_DRAIN = false; float* x1; const float* x; const float* adaf;
    __device__ __forceinline__ void operator()(const f32x4 (&acc)[2][2][4][2], const pg8::Unit& u, int wr, int wc, int fr, int fq) const { EPI_HEAD
        const float* g1 = adaf + (u.pm >> 3) * 6144 + 2 * 1024;
        EPI_LOOP( const f32x4 ga = *(const f32x4*)(g1 + col), gb = *(const f32x4*)(g1 + col + 4);
            *(f32x4*)(x1 + row * 1024u + col) = *(const f32x4*)(x + row * 1024u + col) + ga * v0; *(f32x4*)(x1 + row * 1024u + col + 4) = *(const f32x4*)(x + row * 1024u + col + 4) + gb * v1; ) } };
struct EpiSh {
    static constexpr bool PERM = true, AFTER_DRAIN = false; bf16_t* acts;
    __device__ __forceinline__ void operator()(const f32x4 (&acc)[2][2][4][2], const pg8::Unit& u, int wr, int wc, int fr, int fq) const { EPI_HEAD
        EPI_LOOP( const f32x4 a = {siluf_(v0[0]) * v1[0], siluf_(v0[1]) * v1[1], siluf_(v0[2]) * v1[2], siluf_(v0[3]) * v1[3]};
            *(u32x2*)(acts + row * 256u + (col >> 1)) = pack4(a); ) } };
struct EpiOut {
    static constexpr bool PERM = true, AFTER_DRAIN = false; float* out; const float* x1; const float* adaf; const bf16_t* ybuf;
    __device__ __forceinline__ void operator()(const f32x4 (&acc)[2][2][4][2], const pg8::Unit& u, int wr, int wc, int fr, int fq) const { EPI_HEAD
        const float* g2 = adaf + (u.pm >> 3) * 6144 + 5 * 1024;
        EPI_LOOP( f32x4 s0 = v0, s1 = v1;
            f32x4 r0 = {0.f, 0.f, 0.f, 0.f}, r1 = {0.f, 0.f, 0.f, 0.f};
            _Pragma("unroll") for (int k = 0; k < 8; ++k) { const u32x2 y = *(const u32x2*)((const unsigned char*)ybuf + (row * 8u + k) * 1024u + col); r0 += unpack_fp8x4(y.x); r1 += unpack_fp8x4(y.y); }
            s0 += r0 * 0.0625f; s1 += r1 * 0.0625f;
            *(f32x4*)(out + row * 1024u + col) = *(const f32x4*)(x1 + row * 1024u + col) + *(const f32x4*)(g2 + col) * s0;
            *(f32x4*)(out + row * 1024u + col + 4) = *(const f32x4*)(x1 + row * 1024u + col + 4) + *(const f32x4*)(g2 + col + 4) * s1;
            if (m == 1 || m == 3) __builtin_amdgcn_sched_barrier(0); ) } };

template <class GET> __device__ __forceinline__ void conv_wt(const Ctx& F, bf16_t* dst, int K, int Nd, const GET& get) {
    const long gt = (long)F.vcu * NTHREADS + F.tid, gs = (long)F.G * NTHREADS; const long nchunk = (long)Nd * (K / 8);
    for (long c = gt; c < nchunk; c += gs) { const int n = (int)(c % Nd), k0 = (int)(c / Nd) * 8;
        u32x4 p; p.x = cvt_pk_bf16(get(k0, n), get(k0 + 1, n)); p.y = cvt_pk_bf16(get(k0 + 2, n), get(k0 + 3, n)); p.z = cvt_pk_bf16(get(k0 + 4, n), get(k0 + 5, n)); p.w = cvt_pk_bf16(get(k0 + 6, n), get(k0 + 7, n));
        *(u32x4*)(dst + (long)n * K + k0) = p; }
}

template <int K, int Nd, class GET4> __device__ __forceinline__ void conv4(bf16_t* dst, unsigned c, const GET4& get4) {
    constexpr unsigned NQ = Nd / 4; const unsigned n = (c % NQ) * 4u, k0 = (c / NQ) * 8u;
    f32x4 r[8];
#pragma unroll
    for (int i = 0; i < 8; ++i) r[i] = get4(k0 + i, n);
#pragma unroll
    for (int j = 0; j < 4; ++j) { u32x4 p; p.x = cvt_pk_bf16(r[0][j], r[1][j]); p.y = cvt_pk_bf16(r[2][j], r[3][j]); p.z = cvt_pk_bf16(r[4][j], r[5][j]); p.w = cvt_pk_bf16(r[6][j], r[7][j]);
        *(u32x4*)(dst + (size_t)(n + j) * K + k0) = p; }
}

__device__ __forceinline__ void p0_prep(const Ctx& F) {
    const float* c = F.a.in[1]; const float* w_ada = F.a.in[2];
    float* adap = (float*)(F.ws + WS_ADAP);
    float* sc = (float*)F.lds;
    float* red = sc + 512;
    for (int it = F.vcu; it < 256; it += F.G) {
        const int ks = it >> 4, chunk = it & 15;
        __syncthreads();
        { const int b = F.tid >> 6, k = F.tid & 63; sc[b * 64 + k] = siluf_(c[b * 1024 + ks * 64 + k]); }
        __syncthreads();
        const int cl = F.tid & 127, kq = F.tid >> 7;
        float acc[3][8];
#pragma unroll
        for (int j = 0; j < 3; ++j)
#pragma unroll
            for (int b = 0; b < 8; ++b) acc[j][b] = 0.f;
        const float* wp = w_ada + (long)(ks * 64 + kq * 16) * 6144 + chunk * 384 + cl;
#pragma unroll 8
        for (int k = 0; k < 16; ++k) {
            const float w0 = wp[k * 6144], w1 = wp[k * 6144 + 128], w2 = wp[k * 6144 + 256];
#pragma unroll
            for (int b = 0; b < 8; ++b) { const float sv = sc[b * 64 + kq * 16 + k]; acc[0][b] += sv * w0; acc[1][b] += sv * w1; acc[2][b] += sv * w2; }
        }
#pragma unroll
        for (int j = 0; j < 3; ++j)
#pragma unroll
            for (int b = 0; b < 8; ++b) red[(kq * 8 + b) * 384 + j * 128 + cl] = acc[j][b];
        __syncthreads();
        for (int o = F.tid; o < 8 * 384; o += NTHREADS) { const int b = o / 384, cc = o - b * 384;
            adap[((long)ks * 8 + b) * 6144 + chunk * 384 + cc] = (red[b * 384 + cc] + red[(8 + b) * 384 + cc]) + (red[(16 + b) * 384 + cc] + red[(24 + b) * 384 + cc]); }
    }
    const long gt = (long)F.vcu * NTHREADS + F.tid, gs = (long)F.G * NTHREADS;
    { float* rc = (float*)(F.ws + WS_ROPE); float* rs = rc + 2048 * 16;
      for (long i = gt; i < 2048 * 16; i += gs) { const int pos = (int)(i >> 4), j = (int)(i & 15);
          const float inv = powf(10000.0f, -(float)(2 * j) / 32.0f); const float ang = (float)pos * inv; rc[i] = cosf(ang); rs[i] = sinf(ang); } }
    { bf16_t* wd = (bf16_t*)(F.ws + WS_WDFT); const float nrm = 0.02209708691207961f;
      for (long g = gt; g < (long)2048 * 64; g += gs) { const int k = (int)(g >> 6), l = (int)(g & 63);
          const float cr = cospif((float)k * (1.0f / 1024.0f)), sr = sinpif((float)k * (1.0f / 1024.0f));
          const int idx0 = (k * (8 * l)) & 2047; const int q = k & 3;
          float c0 = cospif((float)idx0 * (1.0f / 1024.0f)) * nrm, s0 = sinpif((float)idx0 * (1.0f / 1024.0f)) * nrm;
#pragma unroll
          for (int i = 0; i < 4; ++i) {
              float cv[8], sv[8]; float cc = c0, ss = s0;
#pragma unroll
              for (int j = 0; j < 8; ++j) { cv[j] = cc; sv[j] = ss; const float cn = cc * cr - ss * sr; ss = ss * cr + cc * sr; cc = cn; }
              u32x4 pc, ps;
              pc.x = cvt_pk_bf16(cv[0], cv[1]); pc.y = cvt_pk_bf16(cv[2], cv[3]); pc.z = cvt_pk_bf16(cv[4], cv[5]); pc.w = cvt_pk_bf16(cv[6], cv[7]);
              ps.x = cvt_pk_bf16(sv[0], sv[1]); ps.y = cvt_pk_bf16(sv[2], sv[3]); ps.z = cvt_pk_bf16(sv[4], sv[5]); ps.w = cvt_pk_bf16(sv[6], sv[7]);
              *(u32x4*)(wd + (long)k * 4096 + 8 * l + 512 * i) = pc; *(u32x4*)(wd + (long)k * 4096 + 2048 + 8 * l + 512 * i) = ps;
              const float nc = (q == 0) ? c0 : (q == 1) ? -s0 : (q == 2) ? -c0 : s0;
              const float ns = (q == 0) ? s0 : (q == 1) ? c0 : (q == 2) ? -s0 : -c0;
              c0 = nc; s0 = ns;
          } } }
    { bf16_t* d6 = (bf16_t*)(F.ws + WS_D64T);
      for (long i = gt; i < 128 * 64; i += gs) { const int n = (int)(i >> 6), cc = (int)(i & 63), part = n >> 6, m = n & 63; const int idx = (m * cc) & 63;
          const float a = (float)idx * (1.0f / 32.0f); const float v = part ? -sinpif(a) : cospif(a); d6[i] = f2bf(v * 0.125f); } }
    { const float* w_in = F.a.in[5]; const float* w_pa = F.a.in[12]; const float* w_pf = F.a.in[13]; const float* w_o = F.a.in[14]; const float* w_r = F.a.in[16];
      const float* w_g = F.a.in[21]; const float* w_u = F.a.in[22]; const float* w_sd = F.a.in[23];
      const float* gq = F.a.in[6]; const float* wq = F.a.in[7]; const float* gkv = F.a.in[8]; const float* wk = F.a.in[9];
      constexpr unsigned C_IN = 768 * 128, C_OUT = 256 * 128, C_R = 64 * 384, C_PA = 256 * 64, C_SH = 128 * 128, C_SD = 256 * 32, C_UQ = 192 * 32, C_UKV = 256 * 16;
      constexpr unsigned C_TOT = C_IN + C_OUT + C_R + 2 * C_PA + C_SH + C_SD + C_UQ + C_UKV;
      for (unsigned c0 = (unsigned)gt; c0 < C_TOT; c0 += (unsigned)gs) {
          unsigned c = c0;
          if (c < C_IN) { conv4<1024, 3072>((bf16_t*)(F.ws + WS_WB_IN), c, [&](unsigned k, unsigned n) { const f32x4 z = {0.f, 0.f, 0.f, 0.f}; return (n < (unsigned)INW) ? *(const f32x4*)(w_in + k * (unsigned)INW + n) : z; }); continue; }
          c -= C_IN;
          if (c < C_OUT) { conv4<1024, 1024>((bf16_t*)(F.ws + WS_WB_OUT), c, [&](unsigned k, unsigned n) { return *(const f32x4*)(w_o + k * 1024u + n); }); continue; }
          c -= C_OUT;
          if (c < C_R) { conv4<3072, 256>((bf16_t*)(F.ws + WS_WB_R), c, [&](unsigned k3, unsigned n) { const unsigned rg = k3 >> 10, k = k3 & 1023u; const f32x4 wv = *(const f32x4*)(w_r + k * 256u + n);
                  f32x4 hi; hi[0] = bf2f(f2bf(wv[0])); hi[1] = bf2f(f2bf(wv[1])); hi[2] = bf2f(f2bf(wv[2])); hi[3] = bf2f(f2bf(wv[3])); return (rg == 2u) ? (wv - hi) : hi; }); continue; }
          c -= C_R;
          if (c < 2 * C_PA) { conv4<1024, 1024>((bf16_t*)(F.ws + WS_WB_PA), c, [&](unsigned k, unsigned n) { return (k < 512u) ? *(const f32x4*)(w_pa + k * 1024u + n) : *(const f32x4*)(w_pf + (k - 512u) * 1024u + n); }); continue; }
          c -= 2 * C_PA;
          if (c < C_SH) { conv4<1024, 512>((bf16_t*)(F.ws + WS_WB_SH), c, [&](unsigned k, unsigned n) { const unsigned j = (n >> 3) * 4u; return ((n >> 2) & 1u) ? *(const f32x4*)(w_u + k * 256u + j) : *(const f32x4*)(w_g + k * 256u + j); }); continue; }
          c -= C_SH;
          if (c < C_SD) { conv4<256, 1024>((bf16_t*)(F.ws + WS_WB_SD), c, [&](unsigned k, unsigned n) { return *(const f32x4*)(w_sd + k * 1024u + n); }); continue; }
          c -= C_SD;
          if (c < C_UQ) { conv4<256, 768>((bf16_t*)(F.ws + WS_WUQ), c, [&](unsigned k, unsigned n) { return *(const f32x4*)(wq + k * 768u + n) * gq[k]; }); continue; }
          c -= C_UQ;
          conv4<128, 1024>((bf16_t*)(F.ws + WS_WUKV), c, [&](unsigned k, unsigned n) { return *(const f32x4*)(wk + k * 1024u + n) * gkv[k]; });
      } }
}

__device__ __forceinline__ void p_norm_rows(const Ctx& F, int which) {
    const float* src = which ? (const float*)(F.ws + WS_X1) : F.a.in[0];
    const float* gain = which ? F.a.in[15] : F.a.in[4];
    const float* adap = (const float*)(F.ws + WS_ADAP); const float* b_ada = F.a.in[3];
    float* adaf = (float*)(F.ws + WS_ADAF);
    bf16_t* dhi = which ? (bf16_t*)(F.ws + WS_A3) : (bf16_t*)(F.ws + WS_H); const unsigned ldd = which ? 3072u : 1024u;
    float* smod = (float*)F.lds; float* sshift = smod + 1024;
    if (which == 0) {
        for (int idx = F.vcu * NTHREADS + F.tid; idx < 8 * 6144; idx += F.G * NTHREADS) { const int b = idx / 6144, j = idx - b * 6144; float s = b_ada[j];
#pragma unroll
            for (int ks = 0; ks < 16; ++ks) s += adap[((long)ks * 8 + b) * 6144 + j];
            adaf[idx] = s; }
    }
    for (int it = F.vcu; it < 256; it += F.G) {
        const int b = it >> 5;
        __syncthreads();
        for (int cidx = F.tid; cidx < 1024; cidx += NTHREADS) {
            float sh, scv;
            if (which == 0) { sh = b_ada[cidx]; scv = b_ada[1024 + cidx];
                for (int ks = 0; ks < 16; ++ks) { sh += adap[((long)ks * 8 + b) * 6144 + cidx]; scv += adap[((long)ks * 8 + b) * 6144 + 1024 + cidx]; } }
            else { sh = adaf[b * 6144 + 3 * 1024 + cidx]; scv = adaf[b * 6144 + 4 * 1024 + cidx]; }
            smod[cidx] = gain[cidx] * (1.f + scv); sshift[cidx] = sh;
        }
        __syncthreads();
#pragma unroll 1
        for (int jb = 0; jb < 8; jb += 4) {
        f32x4 va[4][4];
#pragma unroll
        for (int j = 0; j < 4; ++j)
#pragma unroll
            for (int i = 0; i < 4; ++i) va[j][i] = *(const f32x4*)(src + ((long)it * 64 + F.wave * 8 + jb + j) * 1024 + i * 256 + F.lane * 4);
#pragma unroll
        for (int j = 0; j < 4; ++j) {
            const long row = (long)it * 64 + F.wave * 8 + jb + j;
            f32x4 v[4]; float ss = 0.f;
#pragma unroll
            for (int i = 0; i < 4; ++i) { v[i] = va[j][i]; ss += v[i][0] * v[i][0] + v[i][1] * v[i][1] + v[i][2] * v[i][2] + v[i][3] * v[i][3]; }
            ss = wave_sum(ss);
            const float rstd = rsqrtf(ss * (1.0f / 1024.0f) + EPS);
#pragma unroll
            for (int i = 0; i < 4; ++i) {
                const int c0 = i * 256 + F.lane * 4; float hv[4];
#pragma unroll
                for (int e = 0; e < 4; ++e) hv[e] = v[i][e] * rstd * smod[c0 + e] + sshift[c0 + e];
                u32x2 pk; pk.x = cvt_pk_bf16(hv[0], hv[1]); pk.y = cvt_pk_bf16(hv[2], hv[3]);
                *(u32x2*)(dhi + row * ldd + c0) = pk;
                if (which) {
                    float lo[4];
                    lo[0] = hv[0] - __uint_as_float(pk.x << 16); lo[1] = hv[1] - __uint_as_float(pk.x & 0xffff0000u);
                    lo[2] = hv[2] - __uint_as_float(pk.y << 16); lo[3] = hv[3] - __uint_as_float(pk.y & 0xffff0000u);
                    u32x2 pl; pl.x = cvt_pk_bf16(lo[0], lo[1]); pl.y = cvt_pk_bf16(lo[2], lo[3]);
                    *(u32x2*)(dhi + row * ldd + 1024 + c0) = pl; *(u32x2*)(dhi + row * ldd + 2048 + c0) = pk;
                }
            }
        }
        }
    }
}

__device__ __forceinline__ void p2_win(const Ctx& F) {
    pg8::Gemm g{(const bf16_t*)(F.ws + WS_H), (const bf16_t*)(F.ws + WS_WB_IN), T, 3072, 1024};
    pg8::StaticOrder S; S.init(T, 3072, F.G, (int)blockIdx.x);
    EpiZ E{(bf16_t*)(F.ws + WS_ZQKV), (bf16_t*)(F.ws + WS_ZF), (bf16_t*)(F.ws + WS_SIG)};
    pg8::gemm_phase<EpiZ, pg8::StaticOrder, true, true>((LAS unsigned char*)F.lds, g, S, E);
}

struct BKNq { const float* b; static constexpr bool KN = true; int ldb;
    __device__ __forceinline__ const float* col(int c) const { return b + ((c < 192) ? c : 188); } };
__device__ __forceinline__ void p3_mixer_inputs(const Ctx& F) {
    const bf16_t* zqkv = (const bf16_t*)(F.ws + WS_ZQKV);
    const int lane = F.lane, w = F.wave;
    {
        const bf16_t* zf = (const bf16_t*)(F.ws + WS_ZF); const bf16_t* d6 = (const bf16_t*)(F.ws + WS_D64T); bf16_t* xt = (bf16_t*)(F.ws + WS_XT);
        for (int it = F.vcu; it < 8 * 64; it += F.G) {
            const int g = it & 7, tt = it >> 3; const int tok0 = tt * 256; const int b = tok0 >> 11, s0 = tok0 & 2047;
            f32x16 acc[2][2]; zero_acc<2>(acc);
            ARows af{d6, 64, 0}; BNK bf{zf + g * 64, 512, tok0};
            gemm_core<2, true>(acc, af, bf, 1, F.lds);
            stage_bf16<2>(acc, F.lds);
            __syncthreads();
#pragma unroll 4
            for (int rr = 0; rr < 16; ++rr) {
                const int n = w * 16 + rr; const int part = n >> 6, m = n & 63;
                *(u32x2*)(xt + (unsigned)(b * 512 + g * 64 + m) * 4096u + part * 2048 + s0 + 4 * lane) = *(const u32x2*)(F.lds + n * ST16 + lane * 8);
            }
        }
    }
    {
        constexpr int WQ_P = 528, WKV_P = 272, ST_P = 208;
        constexpr int L_WQ = 0, L_WKV = 96 * WQ_P, L_G = L_WKV + 128 * WKV_P, L_ST = L_G + 768;
        static_assert(L_ST + 8 * 32 * ST_P <= LDS_MISC, "head engine LDS");
        const float* rc = (const float*)(F.ws + WS_ROPE); const float* rsn = rc + 2048 * 16;
        bf16_t* Q = (bf16_t*)(F.ws + WS_Q); bf16_t* K = (bf16_t*)(F.ws + WS_K); bf16_t* vt = (bf16_t*)(F.ws + WS_VT);
        const int hd = F.vcu & 7; const int l31 = lane & 31, hh = lane >> 5;
        __syncthreads();
        { const u32x4* wq = (const u32x4*)((const bf16_t*)(F.ws + WS_WUQ) + (size_t)hd * 96 * 256); const u32x4* wk = (const u32x4*)((const bf16_t*)(F.ws + WS_WUKV) + (size_t)hd * 128 * 128);
          for (int c = F.tid; c < 96 * 32; c += NTHREADS) *(u32x4*)(F.lds + L_WQ + (c >> 5) * WQ_P + (c & 31) * 16) = wq[c];
          for (int c = F.tid; c < 128 * 16; c += NTHREADS) *(u32x4*)(F.lds + L_WKV + (c >> 4) * WKV_P + (c & 15) * 16) = wk[c];
          if (F.tid < 96) { ((float*)(F.lds + L_G))[F.tid] = F.a.in[10][F.tid]; ((float*)(F.lds + L_G))[96 + F.tid] = F.a.in[11][F.tid]; } }
        __syncthreads();
        const float* gq = (const float*)(F.lds + L_G); const float* gk = gq + 96;
        unsigned char* st = F.lds + L_ST + w * (32 * ST_P);
        const float qscale = 0.10206207261596577f * 1.4426950408889634f;
#pragma unroll 1
        for (int i2 = 0; i2 < 2; ++i2) {
            const int sb = (F.vcu >> 3) + 32 * i2; const unsigned tok = sb * 256 + w * 32 + l31; const int b = tok >> 11, s = tok & 2047; const unsigned bh = b * 8 + hd;
            const bf16_t* zrow = zqkv + tok * 416u;
            const f32x4 cs0 = *(const f32x4*)(rc + s * 16 + 4 * hh), cs1 = *(const f32x4*)(rc + s * 16 + 8 + 4 * hh), sn0 = *(const f32x4*)(rsn + s * 16 + 4 * hh), sn1 = *(const f32x4*)(rsn + s * 16 + 8 + 4 * hh);
            {
                bf16x8 zq[16];
#pragma unroll
                for (int k = 0; k < 16; ++k) zq[k] = *(const bf16x8*)(zrow + 16 * k + 8 * hh);
                f32x16 aq[3];
#pragma unroll
                for (int f = 0; f < 3; ++f) {
#pragma unroll
                    for (int r = 0; r < 16; ++r) aq[f][r] = 0.f;
#pragma unroll
                    for (int k = 0; k < 16; ++k) { const bf16x8 wf = *(const bf16x8*)(F.lds + L_WQ + (32 * f + l31) * WQ_P + (16 * k + 8 * hh) * 2); aq[f] = __builtin_amdgcn_mfma_f32_32x32x16_bf16(wf, zq[k], aq[f], 0, 0, 0);
                        if ((k & 7) == 7) __builtin_amdgcn_sched_barrier(0); }
                }
                float ss = 0.f;
#pragma unroll
                for (int f = 0; f < 3; ++f)
#pragma unroll
                    for (int r = 0; r < 16; ++r) ss += aq[f][r] * aq[f][r];
                ss += __shfl_xor(ss, 32);
                const float rstd = rsqrtf(ss * (1.0f / 96.0f) + EPS) * qscale;
#pragma unroll
                for (int f = 0; f < 3; ++f)
#pragma unroll
                    for (int r = 0; r < 16; ++r) aq[f][r] *= rstd * gq[32 * f + (r & 3) + 8 * (r >> 2) + 4 * hh];
#pragma unroll
                for (int r = 0; r < 8; ++r) { const float c = (r < 4) ? cs0[r & 3] : cs1[r & 3], sn = (r < 4) ? sn0[r & 3] : sn1[r & 3];
                    const float r1 = aq[2][r], r2 = aq[2][r + 8]; aq[2][r] = r1 * c - r2 * sn; aq[2][r + 8] = r2 * c + r1 * sn; }
#pragma unroll
                for (int f = 0; f < 3; ++f)
#pragma unroll
                    for (int q4 = 0; q4 < 4; ++q4) { const f32x4 v = {aq[f][4 * q4], aq[f][4 * q4 + 1], aq[f][4 * q4 + 2], aq[f][4 * q4 + 3]};
                        *(u32x2*)(st + l31 * ST_P + (32 * f + 8 * q4 + 4 * hh) * 2) = pack4(v); }
                u32x4* dst = (u32x4*)(Q + ((size_t)bh * 2048 + (s - l31)) * 96);
#pragma unroll
                for (int c6 = 0; c6 < 6; ++c6) { const int c = c6 * 64 + lane; dst[c] = *(const u32x4*)(st + (c / 12) * ST_P + (c % 12) * 16); }
            }
            {
                bf16x8 zk[8]; float sk = 0.f;
#pragma unroll
                for (int k = 0; k < 8; ++k) { zk[k] = *(const bf16x8*)(zrow + 256 + 16 * k + 8 * hh);
#pragma unroll
                    for (int e = 0; e < 8; ++e) { const float z = bf2f((bf16_t)zk[k][e]); sk += z * z; } }
                sk += __shfl_xor(sk, 32);
                const float rkv = rsqrtf(sk * (1.0f / 128.0f) + EPS);
                f32x16 ak[4];
#pragma unroll
                for (int f = 0; f < 4; ++f) {
#pragma unroll
                    for (int r = 0; r < 16; ++r) ak[f][r] = 0.f;
#pragma unroll
                    for (int k = 0; k < 8; ++k) { const bf16x8 wf = *(const bf16x8*)(F.lds + L_WKV + (32 * f + l31) * WKV_P + (16 * k + 8 * hh) * 2); ak[f] = __builtin_amdgcn_mfma_f32_32x32x16_bf16(wf, zk[k], ak[f], 0, 0, 0); }
                    __builtin_amdgcn_sched_barrier(0);
                }
#pragma unroll
                for (int f = 2; f < 4; ++f)
#pragma unroll
                    for (int r = 0; r < 16; ++r) { const int dv = 32 * (f - 2) + (r & 3) + 8 * (r >> 2) + 4 * hh; vt[((size_t)bh * 64 + dv) * 2048 + s] = f2bf(ak[f][r] * rkv); }
                float zr[16];
#pragma unroll
                for (int q4 = 0; q4 < 4; ++q4) { const f32x4 t4 = unpack4(*(const u32x2*)(zrow + 384 + 8 * q4 + 4 * hh)); zr[4 * q4] = t4[0]; zr[4 * q4 + 1] = t4[1]; zr[4 * q4 + 2] = t4[2]; zr[4 * q4 + 3] = t4[3]; }
                float ss = 0.f;
#pragma unroll
                for (int f = 0; f < 2; ++f)
#pragma unroll
                    for (int r = 0; r < 16; ++r) { ak[f][r] *= rkv; ss += ak[f][r] * ak[f][r]; }
#pragma unroll
                for (int r = 0; r < 16; ++r) ss += zr[r] * zr[r];
                ss += __shfl_xor(ss, 32);
                const float rstd = rsqrtf(ss * (1.0f / 96.0f) + EPS);
#pragma unroll
                for (int f = 0; f < 2; ++f)
#pragma unroll
                    for (int r = 0; r < 16; ++r) ak[f][r] *= rstd * gk[32 * f + (r & 3) + 8 * (r >> 2) + 4 * hh];
#pragma unroll
                for (int r = 0; r < 16; ++r) zr[r] *= rstd * gk[64 + (r & 3) + 8 * (r >> 2) + 4 * hh];
#pragma unroll
                for (int r = 0; r < 8; ++r) { const float c = (r < 4) ? cs0[r & 3] : cs1[r & 3], sn = (r < 4) ? sn0[r & 3] : sn1[r & 3];
                    const float r1 = zr[r], r2 = zr[r + 8]; zr[r] = r1 * c - r2 * sn; zr[r + 8] = r2 * c + r1 * sn; }
#pragma unroll
                for (int f = 0; f < 2; ++f)
#pragma unroll
                    for (int q4 = 0; q4 < 4; ++q4) { const f32x4 v = {ak[f][4 * q4], ak[f][4 * q4 + 1], ak[f][4 * q4 + 2], ak[f][4 * q4 + 3]};
                        *(u32x2*)(st + l31 * ST_P + (32 * f + 8 * q4 + 4 * hh) * 2) = pack4(v); }
#pragma unroll
                for (int q4 = 0; q4 < 4; ++q4) { const f32x4 v = {zr[4 * q4], zr[4 * q4 + 1], zr[4 * q4 + 2], zr[4 * q4 + 3]};
                    *(u32x2*)(st + l31 * ST_P + (64 + 8 * q4 + 4 * hh) * 2) = pack4(v); }
                u32x4* dst = (u32x4*)(K + ((size_t)bh * 2048 + (s - l31)) * 96);
#pragma unroll
                for (int c6 = 0; c6 < 6; ++c6) { const int c = c6 * 64 + lane; dst[c] = *(const u32x4*)(st + (c / 12) * ST_P + (c % 12) * 16); }
            }
        }
    }
}

constexpr int KROW = 208, VROW = 136, K_TILE = 64 * KROW, V_TILE = 64 * VROW, AT_STAGE = K_TILE + V_TILE;
__device__ __forceinline__ void attn_item(const Ctx& F, int item) {
    const int qb = item & 7, bh = item >> 3, b = bh >> 3, hd = bh & 7;
    const bf16_t* Q = (const bf16_t*)(F.ws + WS_Q) + (long)bh * 2048 * 96;
    const bf16_t* K = (const bf16_t*)(F.ws + WS_K) + (long)bh * 2048 * 96;
    const bf16_t* Vt = (const bf16_t*)(F.ws + WS_VT) + (long)bh * 64 * 2048;
    bf16_t* O = (bf16_t*)(F.ws + WS_O);
    const int t = F.tid, lane = F.lane, w = F.wave, l31 = lane & 31, hh = lane >> 5;
    bf16x8 qf[6];
    { const bf16_t* qp = Q + (long)(qb * 256 + w * 32 + l31) * 96 + hh * 8;
#pragma unroll
      for (int s = 0; s < 6; ++s) qf[s] = *(const bf16x8*)(qp + s * 16); }
    f32x16 oacc[2];
#pragma unroll
    for (int d = 0; d < 2; ++d)
#pragma unroll
        for (int r = 0; r < 16; ++r) oacc[d][r] = 0.f;
    float m_run = -1e30f, l_run = 0.f;
    const int kq0 = t, kq1 = t + 512;
    const int k_l0 = (kq0 / 12) * KROW + (kq0 % 12) * 16, k_l1 = (kq1 / 12) * KROW + (kq1 % 12) * 16;
    const int v_dv = t >> 3, v_c = t & 7; const int v_l = v_dv * VROW + v_c * 16;
    u32x4 kr0, kr1, vr;
    auto gload = [&](int j) {
        const bf16_t* kp = K + (long)j * 64 * 96;
        kr0 = *(const u32x4*)(kp + kq0 * 8);
        if (t < 256) kr1 = *(const u32x4*)(kp + kq1 * 8);
        vr = *(const u32x4*)(Vt + (long)v_dv * 2048 + j * 64 + v_c * 8);
    };
    auto lstore = [&](int st) {
        unsigned char* base = F.lds + st * AT_STAGE;
        *(u32x4*)(base + k_l0) = kr0;
        if (t < 256) *(u32x4*)(base + k_l1) = kr1;
        *(u32x2*)(base + K_TILE + v_l) = (u32x2){vr.x, vr.y}; *(u32x2*)(base + K_TILE + v_l + 8) = (u32x2){vr.z, vr.w};
    };
    __syncthreads();
    gload(0); lstore(0);
    __syncthreads();
    for (int j = 0; j < 32; ++j) {
        const bool more = (j + 1 < 32);
        if (more) gload(j + 1);
        const unsigned char* kb = F.lds + (j & 1) * AT_STAGE; const unsigned char* vb = kb + K_TILE;
        f32x16 st[2];
        {
            bf16x8 kfr[2][6];
#pragma unroll
            for (int f = 0; f < 2; ++f)
#pragma unroll
                for (int s = 0; s < 6; ++s) kfr[f][s] = *(const bf16x8*)(kb + (32 * f + l31) * KROW + (16 * s + 8 * hh) * 2);
            __builtin_amdgcn_sched_barrier(0);
#pragma unroll
            for (int f = 0; f < 2; ++f) {
#pragma unroll
                for (int r = 0; r < 16; ++r) st[f][r] = 0.f;
#pragma unroll
                for (int s = 0; s < 6; ++s) st[f] = __builtin_amdgcn_mfma_f32_32x32x16_bf16(kfr[f][s], qf[s], st[f], 0, 0, 0);
            }
        }
        float mx = st[0][0];
#pragma unroll
        for (int r = 1; r < 16; ++r) mx = fmaxf(mx, st[0][r]);
#pragma unroll
        for (int r = 0; r < 16; ++r) mx = fmaxf(mx, st[1][r]);
        mx = fmaxf(mx, __shfl_xor(mx, 32));
        const float m_new = fmaxf(m_run, mx);
        const float alpha = __builtin_amdgcn_exp2f(m_run - m_new);
        m_run = m_new;
        float ps = 0.f;
#pragma unroll
        for (int f = 0; f < 2; ++f)
#pragma unroll
            for (int r = 0; r < 16; ++r) { const float p = __builtin_amdgcn_exp2f(st[f][r] - m_new); st[f][r] = p; ps += p; }
        l_run = l_run * alpha + ps;
#pragma unroll
        for (int d = 0; d < 2; ++d)
#pragma unroll
            for (int r = 0; r < 16; ++r) oacc[d][r] *= alpha;
        {
            u32x4 vfr[2][2][2];
#pragma unroll
            for (int f = 0; f < 2; ++f)
#pragma unroll
                for (int s2 = 0; s2 < 2; ++s2)
#pragma unroll
                    for (int d = 0; d < 2; ++d) { const unsigned char* vp = vb + (32 * d + l31) * VROW + (32 * f + 16 * s2 + 4 * hh) * 2;
                        const u32x2 lo = *(const u32x2*)vp, hi = *(const u32x2*)(vp + 16); vfr[f][s2][d] = (u32x4){lo.x, lo.y, hi.x, hi.y}; }
#pragma unroll
            for (int f = 0; f < 2; ++f)
#pragma unroll
                for (int s2 = 0; s2 < 2; ++s2) {
                    u32x4 pw; pw.x = cvt_pk_bf16(st[f][8 * s2 + 0], st[f][8 * s2 + 1]); pw.y = cvt_pk_bf16(st[f][8 * s2 + 2], st[f][8 * s2 + 3]);
                    pw.z = cvt_pk_bf16(st[f][8 * s2 + 4], st[f][8 * s2 + 5]); pw.w = cvt_pk_bf16(st[f][8 * s2 + 6], st[f][8 * s2 + 7]);
                    const bf16x8 pf = *(const bf16x8*)&pw;
#pragma unroll
                    for (int d = 0; d < 2; ++d) oacc[d] = __builtin_amdgcn_mfma_f32_32x32x16_bf16(*(const bf16x8*)&vfr[f][s2][d], pf, oacc[d], 0, 0, 0);
                }
        }
        if (more) lstore((j + 1) & 1);
        __syncthreads();
    }
    l_run += __shfl_xor(l_run, 32);
    const float inv = 1.0f / l_run;
    const long tok = (long)b * 2048 + qb * 256 + w * 32 + l31;
#pragma unroll
    for (int d = 0; d < 2; ++d)
#pragma unroll
        for (int q4 = 0; q4 < 4; ++q4) {
            const int dv = 32 * d + 8 * q4 + 4 * hh;
            u32x2 pk; pk.x = cvt_pk_bf16(oacc[d][4 * q4 + 0] * inv, oacc[d][4 * q4 + 1] * inv); pk.y = cvt_pk_bf16(oacc[d][4 * q4 + 2] * inv, oacc[d][4 * q4 + 3] * inv);
            *(u32x2*)(O + tok * 1024 + hd * 64 + dv) = pk;
        }
}

__device__ __forceinline__ void p6_attn_dft(const Ctx& F) {
    {
        pg8::Gemm g{(const bf16_t*)(F.ws + WS_WDFT), (const bf16_t*)(F.ws + WS_XT), 2048, 4096, 4096};
        pg8::StaticOrder S; S.init(2048, 4096, F.G, (int)blockIdx.x);
        EpiF E{(bf16_t*)(F.ws + WS_O)};
        pg8::gemm_phase<EpiF, pg8::StaticOrder, true, true>((LAS unsigned char*)F.lds, g, S, E);
    }
    volatile LAS int* sitem = (volatile LAS int*)(F.lds + LDS_MISC);
    auto next_item = [&]() -> int {
        __syncthreads();
        if (F.tid == 0) sitem[0] = (int)xb_add(F.ctl + CW_QUEUE, 1u);
        __syncthreads();
        return sitem[0];
    };
    int it = next_item();
    while (it < 512) { attn_item(F, it); it = next_item(); }
}

__device__ __forceinline__ void p7_merge(const Ctx& F) {
    bf16_t* mg = (bf16_t*)(F.ws + WS_MERGED); const bf16_t* sig = (const bf16_t*)(F.ws + WS_SIG);
    pg8::StaticOrder S; S.init(T, 1024, F.G, (int)blockIdx.x);
    pg8::Gemm g{(const bf16_t*)(F.ws + WS_O), (const bf16_t*)(F.ws + WS_WB_PA), T, 1024, 1024}; EpiMg E{mg, sig};
    pg8::gemm_phase<EpiMg, pg8::StaticOrder, true, true, true>((LAS unsigned char*)F.lds, g, S, E);
}

__device__ __forceinline__ void p8_out(const Ctx& F) {
    pg8::Gemm g{(const bf16_t*)(F.ws + WS_MERGED), (const bf16_t*)(F.ws + WS_WB_OUT), T, 1024, 1024};
    pg8::StaticOrder S; S.init(T, 1024, F.G, (int)blockIdx.x);
    EpiX1 E{(float*)(F.ws + WS_X1), F.a.in[0], (const float*)(F.ws + WS_ADAF)};
    pg8::gemm_phase<EpiX1, pg8::StaticOrder, true, true>((LAS unsigned char*)F.lds, g, S, E);
}

template <int NT>
__device__ __forceinline__ void topk_tokens(const Ctx& F, int tok0, const float (&lg)[NT][4], const float (&bs)[4]) {
    int* ltok = (int*)(F.ws + WS_LTOK); float* lw = (float*)(F.ws + WS_LW); unsigned* cnt = F.ctl + CW_CNT;
    const int lane = F.lane;
    float sc[NT][4]; unsigned long long key[NT][4];
#pragma unroll
    for (int t = 0; t < NT; ++t)
#pragma unroll
        for (int i = 0; i < 4; ++i) {
            sc[t][i] = sigmoidf_(lg[t][i]);
            const unsigned ub = __float_as_uint(sc[t][i] + bs[i]);
            const unsigned ord = (ub & 0x80000000u) ? ~ub : (ub | 0x80000000u);
            key[t][i] = ((unsigned long long)ord << 32) | (unsigned long long)(255 - (lane + 64 * i));
        }
    float wsum[NT], myw[NT]; int mye[NT];
#pragma unroll
    for (int t = 0; t < NT; ++t) { wsum[t] = 0.f; myw[t] = 0.f; mye[t] = 0; }
    for (int k = 0; k < 8; ++k) {
        unsigned long long best[NT];
#pragma unroll
        for (int t = 0; t < NT; ++t) { best[t] = key[t][0];
#pragma unroll
            for (int i = 1; i < 4; ++i) best[t] = (key[t][i] > best[t]) ? key[t][i] : best[t]; }
#pragma unroll
        for (int o = 32; o > 0; o >>= 1) {
#pragma unroll
            for (int t = 0; t < NT; ++t) {
                const unsigned lo = __shfl_xor((unsigned)best[t], o), hi = __shfl_xor((unsigned)(best[t] >> 32), o);
                const unsigned long long ob = ((unsigned long long)hi << 32) | lo;
                best[t] = (ob > best[t]) ? ob : best[t];
            }
        }
#pragma unroll
        for (int t = 0; t < NT; ++t) {
            const int e = 255 - (int)(best[t] & 0xffull);
            float s_own = 0.f;
#pragma unroll
            for (int i = 0; i < 4; ++i) { const bool mine = (e == lane + 64 * i); s_own = mine ? sc[t][i] : s_own; key[t][i] = mine ? 0ull : key[t][i]; }
            const float s_k = __shfl(s_own, e & 63);
            wsum[t] += s_k;
            myw[t] = (lane == k) ? s_k : myw[t]; mye[t] = (lane == k) ? e : mye[t];
        }
    }
    if (lane < 8) {
        unsigned slot[NT];
#pragma unroll
        for (int t = 0; t < NT; ++t) slot[t] = atomicAdd(&cnt[mye[t] * 64], 1u);
#pragma unroll
        for (int t = 0; t < NT; ++t) { ltok[(long)mye[t] * LCAP + slot[t]] = (tok0 + t) * 8 + lane; lw[(long)mye[t] * LCAP + slot[t]] = myw[t] / wsum[t] * 2.5f; }
    }
}

struct EpiLog {
    static constexpr bool PERM = true, AFTER_DRAIN = false; float* dst;
    __device__ __forceinline__ void operator()(const f32x4 (&acc)[2][2][4][2], const pg8::Unit& u, int wr, int wc, int fr, int fq) const { EPI_HEAD
        EPI_LOOP( *(f32x4*)(dst + row * 256u + col) = v0; *(f32x4*)(dst + row * 256u + col + 4) = v1; ) } };
__device__ __forceinline__ void p10_router_shared(const Ctx& F) {
    const bf16_t* a3 = (const bf16_t*)(F.ws + WS_A3); const bf16_t* wr = (const bf16_t*)(F.ws + WS_WB_R); float* part = (float*)(F.ws + WS_QRAW);
    const unsigned bx = blockIdx.x, G = (unsigned)F.G;
    {
        pg8::Gemm g{a3, (const bf16_t*)(F.ws + WS_WB_SH), T, 512, 1024, 3072};
        pg8::StaticOrder S; S.init(T, 512, F.G, (int)bx);
        EpiSh E{(bf16_t*)(F.ws + WS_ACTS)};
        pg8::gemm_phase<EpiSh, pg8::StaticOrder, true, true>((LAS unsigned char*)F.lds, g, S, E);
    }
    {
        const int seg = (bx >= 192u) ? 1 : 0;
        const bool has = (bx >= 128u);
        pg8::Gemm g{a3 + seg * 1536, wr + seg * 1536, T, 256, 1536, 3072};
        g.ldb = 3072;
        pg8::StaticOrder S; S.init(T, 256, F.G, has ? (int)((bx - 128u) & 63u) : (int)(G - 1));
        EpiLog E{part + (size_t)seg * T * 256};
        pg8::gemm_phase<EpiLog, pg8::StaticOrder, true, true>((LAS unsigned char*)F.lds, g, S, E);
    }
}
__device__ __forceinline__ void p11_topk(const Ctx& F) {
    const float* part = (const float*)(F.ws + WS_QRAW);
    float bs[4];
#pragma unroll
    for (int i = 0; i < 4; ++i) bs[i] = F.a.in[17][F.lane + 64 * i];
    for (int tok0 = (F.vcu * 8 + F.wave) * 8; tok0 < T; tok0 += F.G * 8 * 8) {
        float lg[8][4];
#pragma unroll
        for (int t = 0; t < 8; ++t)
#pragma unroll
            for (int i = 0; i < 4; ++i) { const size_t o = (size_t)(tok0 + t) * 256 + F.lane + 64 * i; lg[t][i] = part[o] + part[o + (size_t)T * 256]; }
        topk_tokens<8>(F, tok0, lg, bs);
    }
}

__device__ __forceinline__ int build_expert_tables(const Ctx& F, int per_rt) {
    volatile LAS int* offs = (volatile LAS int*)(F.lds + LDS_MISC); volatile LAS int* istart = offs + 264; volatile LAS int* wtot = offs + 540;
    unsigned* cnt = F.ctl + CW_CNT;
    const int t = F.tid, lane = F.lane;
    const int c = (t < NE) ? (int)cnt[t * 64] : 0; const int ni = ((c + 255) >> 8) * per_rt;
    int x = c, y = ni;
#pragma unroll
    for (int d = 1; d < 64; d <<= 1) { const int x2 = __shfl_up(x, d), y2 = __shfl_up(y, d); x += (lane >= d) ? x2 : 0; y += (lane >= d) ? y2 : 0; }
    __syncthreads();
    if (t < NE && lane == 63) { wtot[t >> 6] = x; wtot[4 + (t >> 6)] = y; }
    __syncthreads();
    if (t < NE) { int bx = 0, by = 0; for (int k = 0; k < (t >> 6); ++k) { bx += wtot[k]; by += wtot[4 + k]; }
        offs[t] = bx + x - c; istart[t] = by + y - ni; if (t == NE - 1) { offs[NE] = bx + x; istart[NE] = by + y; } }
    __syncthreads();
    return istart[NE];
}
__device__ __forceinline__ int find_expert(const Ctx& F, int it) {
    volatile LAS int* istart = (volatile LAS int*)(F.lds + LDS_MISC) + 264;
    int lo = 0, hi = NE;
    while (hi - lo > 1) { const int mid = (lo + hi) >> 1; if (istart[mid] <= it) lo = mid; else hi = mid; }
    return lo;
}
struct AGather { const bf16_t* b; const int* list; int m0, mvalid; unsigned lda;
    __device__ __forceinline__ const bf16_t* base() const { return b; }
    __device__ __forceinline__ unsigned off(int r) const { int i = m0 + r; i = (i < mvalid) ? i : (mvalid - 1); return (unsigned)(list[i] >> 3) * lda; }
    __device__ __forceinline__ long koff(int kt) const { return (long)kt * 64; } };
struct ARowsV { const bf16_t* b; unsigned lda; int m0, mvalid;
    __device__ __forceinline__ const bf16_t* base() const { return b; }
    __device__ __forceinline__ unsigned off(int r) const { int i = m0 + r; i = (i < mvalid) ? i : (mvalid - 1); return (unsigned)i * lda; }
    __device__ __forceinline__ long koff(int kt) const { return (long)kt * 64; } };

__device__ __forceinline__ void p12_exp_up(const Ctx& F) {
    const int total = build_expert_tables(F, 2);
    volatile LAS int* offs = (volatile LAS int*)(F.lds + LDS_MISC);
    volatile LAS int* istart = offs + 264;
    const bf16_t* hhi = (const bf16_t*)(F.ws + WS_A3); const int* ltok = (const int*)(F.ws + WS_LTOK); bf16_t* act = (bf16_t*)(F.ws + WS_ACT);
    unsigned* cnt = F.ctl + CW_CNT;
    for (int it = F.vcu; it < total; it += F.G) {
        const int e = find_expert(F, it); const int li = it - istart[e]; const int rt = li >> 1, ct = li & 1;
        const int me = (int)cnt[e * 64], m0 = rt * 256, j0 = ct * 128; const int ro = offs[e];
        f32x16 acc[4][2]; zero_acc<4>(acc);
        AGather af{hhi, ltok + (long)e * LCAP, m0, me, 3072u};
        BKNPair bf{F.a.in[18] + (long)e * 262144 + j0, (long)(F.a.in[19] - F.a.in[18]), 256};
        gemm_core<4, true>(acc, af, bf, 16, F.lds);
        run_epilogue_tr<4>(acc, [&](int r, int c0, f32x4 v0, f32x4 v1) { const int i = m0 + r; if (i < me) { const int j = j0 + (c0 >> 6) * 32 + (c0 & 31);
            const f32x4 a = {siluf_(v0[0]) * v1[0], siluf_(v0[1]) * v1[1], siluf_(v0[2]) * v1[2], siluf_(v0[3]) * v1[3]};
            *(u32x2*)(act + (unsigned)(ro + i) * 256u + j) = pack4(a); } });
    }
}
__device__ __forceinline__ void p13_exp_down(const Ctx& F) {
    constexpr int W_P = 528, ST_P = 144;
    constexpr int L_W = 0, L_ST = 128 * W_P;
    static_assert(L_ST + 8 * 32 * ST_P <= LDS_MISC, "expert-down engine LDS");
    (void)build_expert_tables(F, 1);
    volatile LAS int* offs = (volatile LAS int*)(F.lds + LDS_MISC);
    const int* ltok = (const int*)(F.ws + WS_LTOK); const float* lw = (const float*)(F.ws + WS_LW); const bf16_t* act = (const bf16_t*)(F.ws + WS_ACT);
    unsigned char* ybuf8 = F.ws + WS_YBUF; unsigned* cnt = F.ctl + CW_CNT;
    const int lane = F.lane, w = F.wave, l31 = lane & 31, hh = lane >> 5;
    unsigned char* st = F.lds + L_ST + w * (32 * ST_P);
#pragma unroll 1
    for (int it = F.vcu; it < NE * 8; it += F.G) {
        const int e = it >> 3, n0 = (it & 7) * 128; const int me = (int)cnt[e * 64]; const int ro = offs[e];
        if (me == 0) continue;
        __syncthreads();
        { int tid_ = F.tid; asm volatile("" : "+v"(tid_));
#pragma unroll 1
          for (int b2 = tid_; b2 < 1024; b2 += NTHREADS) { const int kb = b2 >> 5, nq = b2 & 31;
            const float* src = F.a.in[20] + (size_t)e * 262144 + (size_t)(kb * 8) * 1024 + n0 + 4 * nq;
            f32x4 r[8];
#pragma unroll
            for (int i = 0; i < 8; ++i) r[i] = *(const f32x4*)(src + (size_t)i * 1024);
#pragma unroll
            for (int j = 0; j < 4; ++j) { u32x4 p; p.x = cvt_pk_bf16(r[0][j], r[1][j]); p.y = cvt_pk_bf16(r[2][j], r[3][j]); p.z = cvt_pk_bf16(r[4][j], r[5][j]); p.w = cvt_pk_bf16(r[6][j], r[7][j]);
                *(u32x4*)(F.lds + L_W + (4 * nq + j) * W_P + kb * 16) = p; } } }
        __syncthreads();
        const int* lt = ltok + (size_t)e * LCAP; const float* lwe = lw + (size_t)e * LCAP;
#pragma unroll 1
        for (int tb = w; tb * 32 < me; tb += 8) {
            const int idx = tb * 32 + l31; const int idc = (idx < me) ? idx : (me - 1);
            const bf16_t* arow = act + (size_t)(ro + idc) * 256 + 8 * hh;
            bf16x8 z[16];
#pragma unroll
            for (int k = 0; k < 16; ++k) z[k] = *(const bf16x8*)(arow + 16 * k);
            const int myent = lt[idc]; const float sc = lwe[idc] * 16.f;
            f32x16 acc[4];
#pragma unroll
            for (int f = 0; f < 4; ++f)
#pragma unroll
                for (int r = 0; r < 16; ++r) acc[f][r] = 0.f;
            bf16x8 wa[8], wb[8];
            const unsigned char* wbase = F.lds + L_W + l31 * W_P + 16 * hh;
#define WLOAD(dst, hs) _Pragma("unroll") for (int k = 0; k < 8; ++k) dst[k] = *(const bf16x8*)(wbase + (32 * ((hs) >> 1)) * W_P + (128 * ((hs) & 1) + 16 * k) * 2)
#define WMMA(src, hs) _Pragma("unroll") for (int k = 0; k < 8; ++k) acc[(hs) >> 1] = __builtin_amdgcn_mfma_f32_32x32x16_bf16(src[k], z[8 * ((hs) & 1) + k], acc[(hs) >> 1], 0, 0, 0)
            WLOAD(wa, 0);
#pragma unroll
            for (int hs = 0; hs < 8; hs += 2) {
                WLOAD(wb, hs + 1); __builtin_amdgcn_sched_barrier(0);
                WMMA(wa, hs); __builtin_amdgcn_sched_barrier(0);
                if (hs + 2 < 8) { WLOAD(wa, hs + 2); } __builtin_amdgcn_sched_barrier(0);
                WMMA(wb, hs + 1); __builtin_amdgcn_sched_barrier(0);
            }
#undef WLOAD
#undef WMMA
#pragma unroll
            for (int f = 0; f < 4; ++f)
#pragma unroll
                for (int q4 = 0; q4 < 4; ++q4) { const f32x4 v = {acc[f][4 * q4] * sc, acc[f][4 * q4 + 1] * sc, acc[f][4 * q4 + 2] * sc, acc[f][4 * q4 + 3] * sc};
                    *(unsigned*)(st + l31 * ST_P + 32 * f + 8 * q4 + 4 * hh) = pack_fp8x4(v); }
#pragma unroll
            for (int i = 0; i < 4; ++i) { const int row = (lane >> 3) + 8 * i, ch = lane & 7;
                const u32x4 v = *(const u32x4*)(st + row * ST_P + ch * 16); const unsigned ent = (unsigned)__shfl(myent, row);
                if (tb * 32 + row < me) *(u32x4*)(ybuf8 + (size_t)ent * 1024 + n0 + ch * 16) = v; }
        }
    }
}

__device__ __forceinline__ void p14_final(const Ctx& F) {
    pg8::Gemm g{(const bf16_t*)(F.ws + WS_ACTS), (const bf16_t*)(F.ws + WS_WB_SD), T, 1024, 256};
    pg8::StaticOrder S; S.init(T, 1024, F.G, (int)blockIdx.x);
    EpiOut E{F.out, (const float*)(F.ws + WS_X1), (const float*)(F.ws + WS_ADAF), (const bf16_t*)(F.ws + WS_YBUF)};
    pg8::gemm_phase<EpiOut, pg8::StaticOrder, true, true>((LAS unsigned char*)F.lds, g, S, E);
}

constexpr int NPHASE = 13;
__global__ void __launch_bounds__(NTHREADS, 2) mk_fwd(Args args) {
    extern __shared__ __attribute__((aligned(16))) unsigned char lds[];
    const int tid_ = threadIdx.x, G_ = gridDim.x, bx_ = blockIdx.x;
    Ctx F{args, args.out, args.ws, lds, (unsigned*)(args.ws + WS_CTL), tid_, tid_ & 63, __builtin_amdgcn_readfirstlane(tid_ >> 6), G_, (G_ % 8 == 0) ? (bx_ % 8) * (G_ / 8) + bx_ / 8 : bx_};
    const int lo = args.ph_lo, hi = args.ph_hi;
    volatile LAS unsigned* bst = (volatile LAS unsigned*)(lds + LDS_MISC + 4096);
    XcdBarrier bar; bar.bar = F.ctl + CW_BAR; bar.x = 0; bar.st = bst;
    if (hi - lo > 1) {
        if (F.tid == 0) { bst[0] = 0u; bst[1] = 0u; bst[2] = 0u; bst[3] = 0u; }
        __syncthreads();
        bar = xcd_barrier_post(F.ctl + CW_BAR, bst);
    }
#define PHASE(k, call) if (lo <= (k) && (k) < hi) { call; if ((k) + 1 < hi) xcd_barrier(bar); }
    PHASE(0, p0_prep(F))
    PHASE(1, p_norm_rows(F, 0))
    PHASE(2, p2_win(F))
    PHASE(3, p3_mixer_inputs(F))
    PHASE(4, p6_attn_dft(F))
    PHASE(5, p7_merge(F))
    PHASE(6, p8_out(F))
    PHASE(7, p_norm_rows(F, 1))
    PHASE(8, p10_router_shared(F))
    PHASE(9, p11_topk(F))
    PHASE(10, p12_exp_up(F))
    PHASE(11, p13_exp_down(F))
    PHASE(12, p14_final(F))
#undef PHASE
}

extern "C" void kernel_launch(void* const* d_in, const int* in_sizes, int n_in, void* d_out, int out_size, void* d_ws, size_t ws_size, hipStream_t stream) {
    static int grid = 0;
    if (grid == 0) {
        if (n_in != 24 || out_size != T * DM || ws_size < WS_END) {
            fprintf(stderr, "kernel_launch: unexpected shapes (n_in %d, out %d, ws %zu < %zu); nothing launched\n", n_in, out_size, ws_size, (size_t)WS_END); grid = -1; return; }
        int dev = 0, cus = 0, per_cu = 0;
        if (hipGetDevice(&dev) != hipSuccess || hipDeviceGetAttribute(&cus, hipDeviceAttributeMultiprocessorCount, dev) != hipSuccess) { grid = -1; return; }
        if (hipFuncSetAttribute((const void*)mk_fwd, hipFuncAttributeMaxDynamicSharedMemorySize, LDS_BYTES) != hipSuccess) { fprintf(stderr, "kernel_launch: hipFuncSetAttribute failed\n"); grid = -1; return; }
        if (hipOccupancyMaxActiveBlocksPerMultiprocessor(&per_cu, (const void*)mk_fwd, NTHREADS, LDS_BYTES) != hipSuccess || per_cu < 1)
            fprintf(stderr, "kernel_launch: occupancy query reports %d blocks per CU\n", per_cu);
        (void)hipGetLastError();
        if (cus < 256) { fprintf(stderr, "kernel_launch: this kernel is laid out for 256 CUs (device reports %d); nothing launched\n", cus); grid = -1; return; }
        grid = 256;
    }
    if (grid < 0) return;
    (void)hipMemsetAsync((char*)d_ws + WS_CTL, 0, CTL_BYTES, stream);
    Args a{};
    for (int i = 0; i < 24; ++i) a.in[i] = (const float*)d_in[i];
    a.out = (float*)d_out; a.ws = (unsigned char*)d_ws;
#if N_LAUNCH_MODE == 1
    a.ph_lo = 0; a.ph_hi = NPHASE;
    hipLaunchKernelGGL(mk_fwd, dim3(grid), dim3(NTHREADS), LDS_BYTES, stream, a);
#else
    for (int ph = 0; ph < NPHASE; ++ph) { a.ph_lo = ph; a.ph_hi = ph + 1; hipLaunchKernelGGL(mk_fwd, dim3(grid), dim3(NTHREADS), LDS_BYTES, stream, a); }
#endif
    const hipError_t le = hipPeekAtLastError();
    if (le != hipSuccess) fprintf(stderr, "kernel_launch: launch failed: %s\n", hipGetErrorName(le));
}
```

```cpp
#include <hip/hip_runtime.h>
#include <cstdio>
#include <cstdint>

typedef unsigned short bf16_t;
typedef short bf16x8 __attribute__((ext_vector_type(8)));
typedef float f32x16 __attribute__((ext_vector_type(16)));
typedef float f32x4 __attribute__((ext_vector_type(4)));
typedef unsigned u32x4 __attribute__((ext_vector_type(4)));
typedef unsigned u32x2 __attribute__((ext_vector_type(2)));

#define REPEAT_MASK 16384
#ifndef N_LAUNCH_MODE
#define N_LAUNCH_MODE 1
#endif
#ifndef NAIVE_MMA
#define NAIVE_MMA 0
#endif

constexpr int T = 16384, DM = 1024, NB = 8, SEQ = 2048;
constexpr int INW = 2976, NH = 8, DQK = 96, DV = 64;
constexpr int NE = 256, TOPK = 8, EH = 256;
constexpr float EPS = 1e-6f;
constexpr int NTHREADS = 512;
constexpr int LCAP = 16384;

constexpr size_t al256(size_t x) { return (x + 255) & ~(size_t)255; }
constexpr size_t WS_CTL   = 0;
constexpr size_t CTL_BYTES = 196608;
constexpr size_t WS_ADAP  = WS_CTL + CTL_BYTES;
constexpr size_t WS_ADAF  = WS_ADAP + al256((size_t)16 * 8 * 6144 * 4);
constexpr size_t WS_ROPE  = WS_ADAF + al256((size_t)8 * 6144 * 4);
constexpr size_t WS_WDFT  = WS_ROPE + al256((size_t)2 * 2048 * 16 * 4);
constexpr size_t WS_D64T  = WS_WDFT + al256((size_t)2048 * 4096 * 2);
constexpr size_t WS_WR3   = WS_D64T + al256((size_t)128 * 64 * 2);
constexpr size_t WS_WUQ   = WS_WR3 + al256((size_t)3072 * 256 * 4);
constexpr size_t WS_WUKV  = WS_WUQ + al256((size_t)256 * 768 * 4);
constexpr size_t WS_H     = WS_WUKV + al256((size_t)128 * 1024 * 4);
constexpr size_t WS_H2LO  = WS_H + al256((size_t)T * 1024 * 2);
constexpr size_t WS_ZQKV  = WS_H2LO + al256((size_t)T * 1024 * 2);
constexpr size_t WS_ZF    = WS_ZQKV + al256((size_t)T * 416 * 2);
constexpr size_t WS_SIG   = WS_ZF + al256((size_t)T * 512 * 2);
constexpr size_t WS_RSTD  = WS_SIG + al256((size_t)T * 2048 * 2);
constexpr size_t WS_XT    = WS_RSTD + al256((size_t)2 * T * 4);
constexpr size_t WS_QRAW  = WS_XT + al256((size_t)4096 * 4096 * 2);
constexpr size_t WS_KNRAW = WS_QRAW + al256((size_t)T * 768 * 4);
constexpr size_t WS_Q     = WS_KNRAW + al256((size_t)T * 512 * 4);
constexpr size_t WS_K     = WS_Q + al256((size_t)T * 768 * 2);
constexpr size_t WS_VT    = WS_K + al256((size_t)T * 768 * 2);
constexpr size_t WS_O     = WS_VT + al256((size_t)T * 512 * 2);
constexpr size_t WS_F     = WS_O + al256((size_t)T * 512 * 2);
constexpr size_t WS_MERGED= WS_F + al256((size_t)T * 512 * 2);
constexpr size_t WS_X1    = WS_MERGED + al256((size_t)T * 1024 * 2);
constexpr size_t WS_LOGIT = WS_X1 + al256((size_t)T * 1024 * 4);
constexpr size_t WS_ACTS  = WS_LOGIT + al256((size_t)T * 256 * 4);
constexpr size_t WS_LTOK  = WS_ACTS + al256((size_t)T * 256 * 2);
constexpr size_t WS_LW    = WS_LTOK + al256((size_t)NE * LCAP * 4);
constexpr size_t WS_ACT   = WS_LW + al256((size_t)NE * LCAP * 4);
constexpr size_t WS_YBUF  = WS_ACT + al256((size_t)T * 8 * 256 * 2);
constexpr size_t WS_WB_IN = WS_YBUF + al256((size_t)T * 8 * 1024 * 2);
constexpr size_t WS_WB_PA = WS_WB_IN + al256((size_t)3072 * 1024 * 2);
constexpr size_t WS_WB_PF = WS_WB_PA + al256((size_t)1024 * 512 * 2);
constexpr size_t WS_WB_OUT= WS_WB_PF + al256((size_t)1024 * 512 * 2);
constexpr size_t WS_WB_SH = WS_WB_OUT + al256((size_t)1024 * 1024 * 2);
constexpr size_t WS_WB_SD = WS_WB_SH + al256((size_t)512 * 1024 * 2);
constexpr size_t WS_WB_R  = WS_WB_SD + al256((size_t)1024 * 256 * 2);
constexpr size_t WS_A3    = WS_WB_R + al256((size_t)256 * 3072 * 2);
constexpr size_t WS_END   = WS_A3 + al256((size_t)T * 3072 * 2);

constexpr int CW_CNT = 16384;
constexpr int CW_QUEUE = 4400;
constexpr int CW_BAR = 0;

constexpr int LDS_GEMM = 2 * 65536;
constexpr int ST16 = 520, ST32 = 1040;
constexpr int LDS_STAGE = 256 * ST16;
constexpr int LDS_MISC = 140288;
constexpr int LDS_BYTES = LDS_MISC + 8192;

typedef __bf16 bf16x2_t __attribute__((ext_vector_type(2)));
typedef float f32x2_t __attribute__((ext_vector_type(2)));
__device__ __forceinline__ unsigned cvt_pk_bf16(float lo, float hi) { f32x2_t f = {lo, hi}; bf16x2_t h = __builtin_convertvector(f, bf16x2_t); return __builtin_bit_cast(unsigned, h); }
__device__ __forceinline__ bf16_t f2bf(float v) { __bf16 h = (__bf16)v; return __builtin_bit_cast(unsigned short, h); }
__device__ __forceinline__ float bf2f(bf16_t b) { return __uint_as_float(((unsigned)b) << 16); }
__device__ __forceinline__ float sigmoidf_(float v) { return 1.f / (1.f + __expf(-v)); }
__device__ __forceinline__ float siluf_(float v) { return v / (1.f + __expf(-v)); }
__device__ __forceinline__ float wave_sum(float v) {
#pragma unroll
    for (int o = 32; o > 0; o >>= 1) v += __shfl_xor(v, o);
    return v;
}
__device__ __forceinline__ int swz(int row) { return ((row >> 1) & 7) ^ ((row >> 4) & 1); }

#define XB_TMO      128
#define XB_XCNT(j)  (256  + 64 * (j))
#define XB_XSUB(j)  (1280 + 64 * (j))
#define XB_XGEN(j)  (2304 + 64 * (j))
#define XB_TOP      3328
#define XB_TOPGEN   3392
#define XCD_BAR_WORDS 3456
#define XB_SPIN_CAP (1u << 22)
#define LAS __attribute__((address_space(3)))
__device__ __forceinline__ unsigned xb_ld(unsigned* p)              { return __hip_atomic_load(p, __ATOMIC_RELAXED, __HIP_MEMORY_SCOPE_AGENT); }
__device__ __forceinline__ unsigned xb_add(unsigned* p, unsigned v) { return __hip_atomic_fetch_add(p, v, __ATOMIC_RELAXED, __HIP_MEMORY_SCOPE_AGENT); }
__device__ __forceinline__ unsigned xb_xcc_id() { return (unsigned)__builtin_amdgcn_s_getreg((3 << 11) | 20) & 0xFu; }
#define XB_SPIN(cond, bar) do { unsigned _sp = 0; while (cond) { __builtin_amdgcn_s_sleep(1); \
    if ((++_sp & 255u) == 0u) { if (xb_ld(&(bar)[XB_TMO])) break; if (_sp > XB_SPIN_CAP) { atomicAdd(&(bar)[XB_TMO], 1u); break; } } } } while (0)
struct XcdBarrier { unsigned* bar; unsigned x; volatile LAS unsigned* st; };
__device__ __forceinline__ XcdBarrier xcd_barrier_post(unsigned* bar, volatile LAS unsigned* st) {
    XcdBarrier b; b.bar = bar; b.x = xb_xcc_id(); b.st = st;
    if (threadIdx.x == 0) (void)xb_add(&bar[XB_XCNT(b.x)], 1u);
    return b;
}
__device__ __forceinline__ void xcd_barrier_complete(unsigned* bar, unsigned x, unsigned& nloc, unsigned& nx) {
    const unsigned G = gridDim.x * gridDim.y * gridDim.z;
    unsigned sum, cnt, mine, sp = 0u;
    for (;;) {
        sum = 0u; cnt = 0u; mine = 0u;
#pragma unroll
        for (unsigned j = 0; j < 16; ++j) { const unsigned c = xb_ld(&bar[XB_XCNT(j)]); sum += c; cnt += (c > 0u) ? 1u : 0u; mine = (j == x) ? c : mine; }
        if (sum == G) break;
        __builtin_amdgcn_s_sleep(1);
        if ((++sp & 255u) == 0u) { if (xb_ld(&bar[XB_TMO])) break; if (sp > XB_SPIN_CAP) { atomicAdd(&bar[XB_TMO], 1u); break; } }
    }
    nloc = mine > 0u ? mine : 1u; nx = cnt > 0u ? cnt : 1u;
}
__device__ __forceinline__ void xcd_barrier(const XcdBarrier& b) {
    asm volatile("s_waitcnt vmcnt(0)" ::: "memory");
    __syncthreads();
    if (threadIdx.x == 0) {
        unsigned* bar = b.bar;
        __builtin_amdgcn_s_waitcnt(0);
        unsigned nloc = b.st[0], nx = b.st[1];
        if (nloc == 0u) { xcd_barrier_complete(bar, b.x, nloc, nx); b.st[0] = nloc; b.st[1] = nx; }
        const unsigned old = xb_add(&bar[XB_XSUB(b.x)], 1u);
        const unsigned gen = old / nloc;
        if (old + 1u == (gen + 1u) * nloc) {
            __builtin_amdgcn_fence(__ATOMIC_RELEASE, "agent");
            asm volatile("s_waitcnt vmcnt(0)" ::: "memory");
            const unsigned og = xb_add(&bar[XB_TOP], 1u);
            const unsigned tg = og / nx;
            if (og + 1u == (tg + 1u) * nx) xb_add(&bar[XB_TOPGEN], 1u);
            else XB_SPIN(xb_ld(&bar[XB_TOPGEN]) == tg, bar);
            __builtin_amdgcn_fence(__ATOMIC_ACQUIRE, "agent");
            xb_add(&bar[XB_XGEN(b.x)], 1u);
            asm volatile("s_waitcnt vmcnt(0)" ::: "memory");
        } else {
            XB_SPIN(xb_ld(&bar[XB_XGEN(b.x)]) == gen, bar);
            __builtin_amdgcn_fence(__ATOMIC_ACQUIRE, "agent");
            asm volatile("s_waitcnt vmcnt(0)" ::: "memory");
        }
    }
    __syncthreads();
}

template <int MI, bool TR, class AF, class BF>
__device__ __forceinline__ void gemm_core(f32x16 (&acc)[MI][2], const AF& af, const BF& bf, const int nk, unsigned char* lds) {
    constexpr int BM = 64 * MI;
    constexpr int A_BYTES = BM * 128, STAGE = A_BYTES + 256 * 128;
    const int t = threadIdx.x, lane = t & 63, w = t >> 6, wm = w >> 2, wn = w & 3;
    const int l31 = lane & 31, hh = lane >> 5;
    const int ch = t & 7, r0 = t >> 3;
    const bf16_t* abase = af.base();
    unsigned aoff[MI];
#pragma unroll
    for (int i = 0; i < MI; ++i) aoff[i] = af.off(r0 + 64 * i);
    const int a_lds = r0 * 128 + ((ch ^ swz(r0)) << 4);
    u32x4 areg[MI];
    f32x4 bregf[8]; u32x4 bregh[4];
    unsigned boff[4];
    const float* bcolf = nullptr;
    if constexpr (BF::KN) { bcolf = bf.col(4 * lane); }
    else {
#pragma unroll
        for (int i = 0; i < 4; ++i) boff[i] = bf.off(r0 + 64 * i);
    }
    auto gload = [&](int kt) {
        const long ko = af.koff(kt) + ch * 8;
#pragma unroll
        for (int i = 0; i < MI; ++i) areg[i] = *(const u32x4*)(abase + aoff[i] + ko);
        if constexpr (BF::KN) {
            const float* bp = bcolf + (long)(kt * 64 + w * 8) * bf.ldb;
#pragma unroll
            for (int i = 0; i < 8; ++i) bregf[i] = *(const f32x4*)(bp + (long)i * bf.ldb);
        } else {
            const bf16_t* bp = bf.base() + bf.koff(kt) + ch * 8;
#pragma unroll
            for (int i = 0; i < 4; ++i) bregh[i] = *(const u32x4*)(bp + boff[i]);
        }
    };
    auto lstore = [&](int st) {
        unsigned char* base = lds + st * STAGE;
#pragma unroll
        for (int i = 0; i < MI; ++i) *(u32x4*)(base + a_lds + i * 64 * 128) = areg[i];
        unsigned char* bb = base + A_BYTES;
        if constexpr (BF::KN) {
#pragma unroll
            for (int cc = 0; cc < 4; ++cc) {
                const int col = 4 * lane + cc;
                u32x4 v; v.x = cvt_pk_bf16(bregf[0][cc], bregf[1][cc]); v.y = cvt_pk_bf16(bregf[2][cc], bregf[3][cc]);
                v.z = cvt_pk_bf16(bregf[4][cc], bregf[5][cc]); v.w = cvt_pk_bf16(bregf[6][cc], bregf[7][cc]);
                *(u32x4*)(bb + col * 128 + ((w ^ swz(col)) << 4)) = v;
            }
        } else {
#pragma unroll
            for (int i = 0; i < 4; ++i) *(u32x4*)(bb + a_lds + i * 64 * 128) = bregh[i];
        }
    };
    const int fsw = swz(l31);
    const int a_frag = (wm * 32 * MI + l31) * 128, b_frag = (wn * 64 + l31) * 128;
    auto compute = [&](int st) {
        const unsigned char* base = lds + st * STAGE;
        const unsigned char* bb = base + A_BYTES;
#if NAIVE_MMA
#pragma unroll
        for (int mi = 0; mi < MI; ++mi)
#pragma unroll
            for (int ni = 0; ni < 2; ++ni)
#pragma unroll
                for (int rg = 0; rg < 16; ++rg) {
                    const int row = TR ? (wm * 32 * MI + mi * 32 + l31) : (wm * 32 * MI + mi * 32 + (rg & 3) + 8 * (rg >> 2) + 4 * hh);
                    const int col = TR ? (wn * 64 + ni * 32 + (rg & 3) + 8 * (rg >> 2) + 4 * hh) : (wn * 64 + ni * 32 + l31);
                    float s = 0.f;
                    for (int k = 0; k < 64; ++k) {
                        const bf16_t av = *(const bf16_t*)(base + row * 128 + (((k >> 3) ^ swz(row)) << 4) + (k & 7) * 2);
                        const bf16_t bv = *(const bf16_t*)(bb + col * 128 + (((k >> 3) ^ swz(col)) << 4) + (k & 7) * 2);
                        s += bf2f(av) * bf2f(bv);
                    }
                    acc[mi][ni][rg] += s;
                }
#else
#pragma unroll 2
        for (int s = 0; s < 4; ++s) {
            const int pos = ((2 * s + hh) ^ fsw) << 4;
            bf16x8 bfr[2];
#pragma unroll
            for (int ni = 0; ni < 2; ++ni) bfr[ni] = *(const bf16x8*)(bb + b_frag + ni * 32 * 128 + pos);
#pragma unroll
            for (int mi = 0; mi < MI; ++mi) {
                const bf16x8 afr = *(const bf16x8*)(base + a_frag + mi * 32 * 128 + pos);
#pragma unroll
                for (int ni = 0; ni < 2; ++ni) acc[mi][ni] = TR ? __builtin_amdgcn_mfma_f32_32x32x16_bf16(bfr[ni], afr, acc[mi][ni], 0, 0, 0)
                                                               : __builtin_amdgcn_mfma_f32_32x32x16_bf16(afr, bfr[ni], acc[mi][ni], 0, 0, 0);
            }
        }
#endif
    };
    int nk_ = nk; asm volatile("" : "+s"(nk_));
    __syncthreads();
    gload(0);
    lstore(0);
    __syncthreads();
#pragma unroll 1
    for (int kt = 0; kt < nk_; ++kt) {
        const bool more = (kt + 1 < nk_);
        if (more) gload(kt + 1);
        compute(kt & 1);
        if (more) lstore((kt + 1) & 1);
        __syncthreads();
    }
}

template <int MI> __device__ __forceinline__ void zero_acc(f32x16 (&acc)[MI][2]) {
#pragma unroll
    for (int mi = 0; mi < MI; ++mi)
#pragma unroll
        for (int ni = 0; ni < 2; ++ni)
#pragma unroll
            for (int r = 0; r < 16; ++r) acc[mi][ni][r] = 0.f;
}
template <int MI, class EPI>
__device__ __forceinline__ void run_epilogue(const f32x16 (&acc)[MI][2], const EPI& epi) {
    const int t = threadIdx.x, lane = t & 63, w = t >> 6, wm = w >> 2, wn = w & 3, l31 = lane & 31, hh = lane >> 5;
#pragma unroll
    for (int mi = 0; mi < MI; ++mi)
#pragma unroll
        for (int rg = 0; rg < 16; ++rg) {
            const int r = wm * 32 * MI + mi * 32 + (rg & 3) + 8 * (rg >> 2) + 4 * hh;
            epi(r, wn * 64 + l31, acc[mi][0][rg], acc[mi][1][rg]);
            if ((rg & 7) == 7) __builtin_amdgcn_sched_barrier(0);
        }
}

template <int MI, class EPI>
__device__ __forceinline__ void run_epilogue_tr(const f32x16 (&acc)[MI][2], const EPI& epi) {
    const int t = threadIdx.x, lane = t & 63, w = t >> 6, wm = w >> 2, wn = w & 3, l31 = lane & 31, hh = lane >> 5;
#pragma unroll
    for (int mi = 0; mi < MI; ++mi) {
        const int r = wm * 32 * MI + mi * 32 + l31;
#pragma unroll
        for (int q4 = 0; q4 < 4; ++q4) {
            const f32x4 v0 = {acc[mi][0][4 * q4], acc[mi][0][4 * q4 + 1], acc[mi][0][4 * q4 + 2], acc[mi][0][4 * q4 + 3]};
            const f32x4 v1 = {acc[mi][1][4 * q4], acc[mi][1][4 * q4 + 1], acc[mi][1][4 * q4 + 2], acc[mi][1][4 * q4 + 3]};
            epi(r, wn * 64 + 8 * q4 + 4 * hh, v0, v1);
        }
        __builtin_amdgcn_sched_barrier(0);
    }
}
__device__ __forceinline__ u32x2 pack4(const f32x4 v) { u32x2 p; p.x = cvt_pk_bf16(v[0], v[1]); p.y = cvt_pk_bf16(v[2], v[3]); return p; }
__device__ __forceinline__ f32x4 unpack4(const u32x2 p) { f32x4 v = {__uint_as_float(p.x << 16), __uint_as_float(p.x & 0xffff0000u), __uint_as_float(p.y << 16), __uint_as_float(p.y & 0xffff0000u)}; return v; }

__device__ __forceinline__ unsigned pack_fp8x4(const f32x4 v) { int p = __builtin_amdgcn_cvt_pk_fp8_f32(v[0], v[1], 0, false); p = __builtin_amdgcn_cvt_pk_fp8_f32(v[2], v[3], p, true); return (unsigned)p; }
__device__ __forceinline__ f32x4 unpack_fp8x4(const unsigned p) { f32x4 v = {__builtin_amdgcn_cvt_f32_fp8((int)p, 0), __builtin_amdgcn_cvt_f32_fp8((int)p, 1), __builtin_amdgcn_cvt_f32_fp8((int)p, 2), __builtin_amdgcn_cvt_f32_fp8((int)p, 3)}; return v; }
template <int MI> __device__ __forceinline__ void stage_bf16(const f32x16 (&acc)[MI][2], unsigned char* lds) {
    const int t = threadIdx.x, lane = t & 63, w = t >> 6, wm = w >> 2, wn = w & 3, l31 = lane & 31, hh = lane >> 5;
#pragma unroll
    for (int mi = 0; mi < MI; ++mi) {
        unsigned char* rp = lds + (wm * 32 * MI + mi * 32 + l31) * ST16 + (wn * 64 + 4 * hh) * 2;
#pragma unroll
        for (int ni = 0; ni < 2; ++ni)
#pragma unroll
            for (int q4 = 0; q4 < 4; ++q4) {
                const f32x4 v = {acc[mi][ni][4 * q4], acc[mi][ni][4 * q4 + 1], acc[mi][ni][4 * q4 + 2], acc[mi][ni][4 * q4 + 3]};
                *(u32x2*)(rp + (ni * 32 + 8 * q4) * 2) = pack4(v);
            }
    }
}
__device__ __forceinline__ void stage_f32(const f32x16 (&acc)[2][2], unsigned char* lds) {
    const int t = threadIdx.x, lane = t & 63, w = t >> 6, wm = w >> 2, wn = w & 3, l31 = lane & 31, hh = lane >> 5;
#pragma unroll
    for (int mi = 0; mi < 2; ++mi) {
        unsigned char* rp = lds + (wm * 64 + mi * 32 + l31) * ST32 + (wn * 64 + 4 * hh) * 4;
#pragma unroll
        for (int ni = 0; ni < 2; ++ni)
#pragma unroll
            for (int q4 = 0; q4 < 4; ++q4) {
                const f32x4 v = {acc[mi][ni][4 * q4], acc[mi][ni][4 * q4 + 1], acc[mi][ni][4 * q4 + 2], acc[mi][ni][4 * q4 + 3]};
                *(f32x4*)(rp + (ni * 32 + 8 * q4) * 4) = v;
            }
    }
}

struct ARows { const bf16_t* b; unsigned lda; int m0;
    __device__ __forceinline__ const bf16_t* base() const { return b; }
    __device__ __forceinline__ unsigned off(int r) const { return (unsigned)(m0 + r) * lda; }
    __device__ __forceinline__ long koff(int kt) const { return (long)kt * 64; } };
struct BKN { const float* b; int ldb; int n0; int nvalid; static constexpr bool KN = true;
    __device__ __forceinline__ const float* col(int c) const { int cc = n0 + c; cc = (cc < nvalid) ? cc : (nvalid - 4); return b + cc; } };
struct BKNPair { const float* g; long u_minus_g; int ldb; static constexpr bool KN = true;
    __device__ __forceinline__ const float* col(int c) const { return g + (long)((c >> 5) & 1) * u_minus_g + (c >> 6) * 32 + (c & 31); } };
struct BNK { const bf16_t* b; unsigned ldb; int n0; static constexpr bool KN = false;
    __device__ __forceinline__ const bf16_t* base() const { return b; }
    __device__ __forceinline__ unsigned off(int c) const { return (unsigned)(n0 + c) * ldb; }
    __device__ __forceinline__ long koff(int kt) const { return (long)kt * 64; } };

namespace pg8 {
#define PG8_LAS __attribute__((address_space(3)))
typedef unsigned short bf16_t;
typedef short bf16x8 __attribute__((ext_vector_type(8)));
typedef float f32x4 __attribute__((ext_vector_type(4)));
typedef unsigned u32x4 __attribute__((ext_vector_type(4)));
constexpr int BM = 256, BK = 64, HALF = 128, HTB = HALF * BK * 2  , STAGE_BYTES = 8 * HTB, NXCD = 8, WGM = 8;

__host__ __device__ __forceinline__ int lds_byte(int r, int c) { const int st = (r >> 4) * 2 + (c >> 5), rr = r & 15, cc = c & 31, ob = rr * 64 + cc * 2; return st * 1024 + (ob ^ (((ob >> 9) & 1) << 5)); }
__host__ __device__ __forceinline__ void stage_rc(int b, int& R, int& C) { const int st = b / 1024, sb = b % 1024, swz = sb ^ (((sb >> 9) & 1) << 5); R = (st >> 1) * 16 + swz / 64; C = (st & 1) * 32 + (swz % 64) / 2; }
__host__ __device__ __forceinline__ int perm32(int rho) { const int n = rho >> 4, i = rho & 15; return 8 * (i >> 2) + 4 * n + (i & 3); }

struct Unit { int pm, pn; };
struct Gemm { const bf16_t* A; const bf16_t* Bt; int M, N, K; int lda; int ldb; };

struct StaticOrder {
    int nM, nN, nwg, G, c;
    __host__ __device__ void init(int M, int N, int G_, int c_) { nM = M / BM; nN = N / BM; nwg = nM * nN; G = G_; c = c_; }
    __host__ __device__ bool next(int i, Unit& u) const {
        const long L = (long)i * G + c; if (L >= nwg) return false;
        int wgid = (int)L; { const int q = nwg / NXCD, r = nwg % NXCD, xcd = wgid % NXCD, off = wgid / NXCD; wgid = (xcd < r ? xcd * (q + 1) : r * (q + 1) + (xcd - r) * q) + off; }
        const int nig = WGM * nN, gid = wgid / nig, fm = gid * WGM, gsz = (nM - fm) < WGM ? (nM - fm) : WGM;
        u.pm = fm + ((wgid % nig) % gsz); u.pn = (wgid % nig) / gsz; return true;
    }
    __device__ __forceinline__ void a_ready(const Unit&) const {}
    __device__ __forceinline__ void done(const Unit&) const {}
};
template <class Epi, class Sched, bool ALIGN_EPI = false, bool SP2 = false, bool MIDHOOK = false>
__device__ __forceinline__ void gemm_phase(PG8_LAS unsigned char* lds, const Gemm g, const Sched& S, const Epi& E) {
    const int tid = threadIdx.x, wid = __builtin_amdgcn_readfirstlane(tid >> 6), lane = tid & 63, wr = wid >> 2, wc = wid & 3, fr = lane & 15, fq = lane >> 4;
    const int K = g.K, nt = K / BK, LDA = g.lda ? g.lda : g.K, LDB = g.ldb ? g.ldb : g.K;
    unsigned voffA[2], voffB[2];
#pragma unroll
    for (int i = 0; i < 2; ++i) { int R, C; stage_rc(tid * 16 + i * 8192, R, C); const int Rb = Epi::PERM ? ((R & ~31) + perm32(R & 31)) : R;
        voffA[i] = (unsigned)(R * LDA + C) * 2u; voffB[i] = (unsigned)(Rb * LDB + C) * 2u; }
    const size_t kstep = (size_t)(BK * 2);
    const size_t hstep = (size_t)HALF * LDB * 2;
    const size_t tstep = 2 * hstep;
    const size_t hstepA = (size_t)HALF * LDA * 2, tstepA = 2 * hstepA;
    const unsigned ldsw = (unsigned)wid * 1024u;
    const int aoff = lds_byte(wr * 64 + fr, fq * 8), boff = lds_byte(wc * 32 + fr, fq * 8);
#define PG8_SA(b, h) (((b) * 2 + (h)) * HTB)
#define PG8_SB(b, h) ((4 + (b) * 2 + (h)) * HTB)
#define PG8_STAGE(bufoff, gbase, voff) do { _Pragma("unroll") for (int _i = 0; _i < 2; ++_i) \
        __builtin_amdgcn_global_load_lds((const unsigned*)((const char*)(gbase) + (voff)[_i]), (PG8_LAS unsigned*)(lds + (bufoff) + ldsw + _i * 8192), 16, 0, 0); } while (0)
#define PG8_LDA(dst, b, h) do { _Pragma("unroll") for (int m = 0; m < 4; ++m) _Pragma("unroll") for (int k = 0; k < 2; ++k) dst[m][k] = *(const PG8_LAS bf16x8*)(lds + PG8_SA(b, h) + aoff + m * 2048 + k * 1024); } while (0)
#define PG8_LDB(dst, b, h) do { _Pragma("unroll") for (int n = 0; n < 2; ++n) _Pragma("unroll") for (int k = 0; k < 2; ++k) dst[n][k] = *(const PG8_LAS bf16x8*)(lds + PG8_SB(b, h) + boff + n * 2048 + k * 1024); } while (0)
#define PG8_MMA(ai, bj, At, Bt) do { __builtin_amdgcn_s_setprio(1); _Pragma("unroll") for (int m = 0; m < 4; ++m) _Pragma("unroll") for (int n = 0; n < 2; ++n) _Pragma("unroll") for (int k = 0; k < 2; ++k) \
        acc[ai][bj][m][n] = __builtin_amdgcn_mfma_f32_16x16x32_bf16(Bt[n][k], At[m][k], acc[ai][bj][m][n], 0, 0, 0); __builtin_amdgcn_s_setprio(0); } while (0)
#define PG8_WAIT_V(n) asm volatile("s_waitcnt vmcnt(" #n ")" ::: "memory")
#define PG8_WAIT_L(n) asm volatile("s_waitcnt lgkmcnt(" #n ")" ::: "memory")
#define PG8_BAR __builtin_amdgcn_s_barrier()
#define PG8_SCHED __builtin_amdgcn_sched_barrier(0)
    Unit cur, nxt; int ui = 0;
    if (!S.next(0, cur)) return;
    f32x4 acc[2][2][4][2];
#pragma unroll
    for (int a = 0; a < 2; ++a)
#pragma unroll
        for (int b = 0; b < 2; ++b)
#pragma unroll
            for (int m = 0; m < 4; ++m)
#pragma unroll
                for (int n = 0; n < 2; ++n) acc[a][b][m][n] = (f32x4){0.f, 0.f, 0.f, 0.f};
    bf16x8 At[4][2], B0[2][2], B1[2][2];
    const char* cA = (const char*)g.A + (size_t)cur.pm * tstepA; const char* cB = (const char*)g.Bt + (size_t)cur.pn * tstep;
    S.a_ready(cur);
    if constexpr (SP2) {
        PG8_STAGE(PG8_SB(0, 0), cB, voffB); PG8_STAGE(PG8_SB(0, 1), cB + hstep, voffB); PG8_STAGE(PG8_SA(0, 0), cA, voffA); PG8_STAGE(PG8_SA(0, 1), cA + hstepA, voffA);
        if (wr == 1) PG8_BAR;
        PG8_WAIT_V(2); PG8_BAR;
        PG8_STAGE(PG8_SB(1, 0), cB + kstep, voffB); PG8_STAGE(PG8_SA(1, 0), cA + kstep, voffA); PG8_STAGE(PG8_SB(1, 1), cB + hstep + kstep, voffB);
        PG8_WAIT_V(6); PG8_BAR;
    } else {
        PG8_STAGE(PG8_SB(0, 0), cB, voffB); PG8_STAGE(PG8_SA(0, 0), cA, voffA); PG8_STAGE(PG8_SB(0, 1), cB + hstep, voffB); PG8_STAGE(PG8_SA(0, 1), cA + hstepA, voffA);
        if (wr == 1) PG8_BAR;
        PG8_WAIT_V(4); PG8_BAR;
        PG8_STAGE(PG8_SB(1, 0), cB + kstep, voffB); PG8_STAGE(PG8_SA(1, 0), cA + kstep, voffA); PG8_STAGE(PG8_SB(1, 1), cB + hstep + kstep, voffB);
        PG8_WAIT_V(6); PG8_BAR;
    }
    for (;;) {
        const bool has_next = S.next(ui + 1, nxt);
        const char* nA = has_next ? (const char*)g.A + (size_t)nxt.pm * tstepA : cA; const char* nB = has_next ? (const char*)g.Bt + (size_t)nxt.pn * tstep : cB;
        for (int t = 0; t < nt; t += 2) {
            if constexpr (MIDHOOK) { if (t == (nt >> 1)) E.mid(acc, cur, wr, wc, fr, fq); }
            const bool last = (t == nt - 2);
            const char* a1 = cA + (size_t)(t + 1) * kstep;
            const char* a2 = last ? nA : cA + (size_t)(t + 2) * kstep; const char* b2 = last ? nB : cB + (size_t)(t + 2) * kstep;
            const char* a3 = a2 + kstep; const char* b3 = b2 + kstep;
            if (last && has_next) S.a_ready(nxt);
            if constexpr (SP2) {
            PG8_LDB(B0, 0, 0); PG8_LDB(B1, 0, 1); PG8_SCHED; PG8_LDA(At, 0, 0); PG8_STAGE(PG8_SA(1, 1), a1 + hstepA, voffA);
            PG8_WAIT_V(8); PG8_WAIT_L(0); PG8_BAR; PG8_MMA(0, 0, At, B0); PG8_MMA(0, 1, At, B1); PG8_BAR; PG8_SCHED;
            PG8_LDA(At, 0, 1); PG8_STAGE(PG8_SB(0, 0), b2, voffB); PG8_STAGE(PG8_SB(0, 1), b2 + hstep, voffB); PG8_STAGE(PG8_SA(0, 0), a2, voffA);
            PG8_WAIT_V(8); PG8_WAIT_L(0); PG8_BAR; PG8_MMA(1, 0, At, B0); PG8_MMA(1, 1, At, B1); PG8_BAR; PG8_SCHED;
            PG8_LDB(B0, 1, 0); PG8_LDB(B1, 1, 1); PG8_SCHED; PG8_LDA(At, 1, 0); PG8_STAGE(PG8_SA(0, 1), a2 + hstepA, voffA);
            PG8_WAIT_V(8); PG8_WAIT_L(0); PG8_BAR; PG8_MMA(0, 0, At, B0); PG8_MMA(0, 1, At, B1); PG8_BAR; PG8_SCHED;
            PG8_LDA(At, 1, 1); PG8_STAGE(PG8_SB(1, 0), b3, voffB); PG8_STAGE(PG8_SB(1, 1), b3 + hstep, voffB); PG8_STAGE(PG8_SA(1, 0), a3, voffA);
            PG8_WAIT_V(8); PG8_WAIT_L(0); PG8_BAR; PG8_MMA(1, 0, At, B0); PG8_MMA(1, 1, At, B1); PG8_BAR; PG8_SCHED;
            } else {
            PG8_LDB(B0, 0, 0); PG8_SCHED; PG8_LDA(At, 0, 0); PG8_STAGE(PG8_SA(1, 1), a1 + hstepA, voffA);
            PG8_WAIT_L(8); PG8_BAR; PG8_WAIT_L(0); PG8_MMA(0, 0, At, B0); PG8_BAR; PG8_SCHED;
            PG8_LDB(B1, 0, 1); PG8_STAGE(PG8_SB(0, 0), b2, voffB);
            PG8_BAR; PG8_WAIT_L(0); PG8_MMA(0, 1, At, B1); PG8_BAR;
            PG8_LDA(At, 0, 1); PG8_STAGE(PG8_SA(0, 0), a2, voffA);
            PG8_BAR; PG8_WAIT_L(0); PG8_MMA(1, 0, At, B0); PG8_BAR; PG8_SCHED;
            PG8_STAGE(PG8_SB(0, 1), b2 + hstep, voffB);
            PG8_WAIT_V(6); PG8_BAR; PG8_MMA(1, 1, At, B1); PG8_BAR;
            PG8_LDB(B0, 1, 0); PG8_SCHED; PG8_LDA(At, 1, 0); PG8_STAGE(PG8_SA(0, 1), a2 + hstepA, voffA);
            PG8_WAIT_L(8); PG8_BAR; PG8_WAIT_L(0); PG8_MMA(0, 0, At, B0); PG8_BAR; PG8_SCHED;
            PG8_LDB(B1, 1, 1); PG8_STAGE(PG8_SB(1, 0), b3, voffB);
            PG8_BAR; PG8_WAIT_L(0); PG8_MMA(0, 1, At, B1); PG8_BAR;
            PG8_LDA(At, 1, 1); PG8_STAGE(PG8_SA(1, 0), a3, voffA);
            PG8_BAR; PG8_WAIT_L(0); PG8_MMA(1, 0, At, B0); PG8_BAR; PG8_SCHED;
            PG8_STAGE(PG8_SB(1, 1), b3 + hstep, voffB);
            PG8_WAIT_V(6); PG8_BAR; PG8_MMA(1, 1, At, B1); PG8_BAR;
            }
        }
        if constexpr (ALIGN_EPI) { if (wr == 0) PG8_BAR; }
        if constexpr (!Epi::AFTER_DRAIN) { E(acc, cur, wr, wc, fr, fq); S.done(cur); }
        if (!has_next) break;
#pragma unroll
        for (int a = 0; a < 2; ++a)
#pragma unroll
            for (int b = 0; b < 2; ++b)
#pragma unroll
                for (int m = 0; m < 4; ++m)
#pragma unroll
                    for (int n = 0; n < 2; ++n) acc[a][b][m][n] = (f32x4){0.f, 0.f, 0.f, 0.f};
        cur = nxt; cA = nA; cB = nB; ++ui;
        if constexpr (ALIGN_EPI) { if (wr == 1) PG8_BAR; }
    }
    PG8_WAIT_V(0);
    if constexpr (!ALIGN_EPI) { if (wr == 0) PG8_BAR; }
    PG8_BAR;
    if constexpr (Epi::AFTER_DRAIN) { E.fused(acc, cur, wr, wc, fr, fq, lds, wid, lane); S.done(cur); }
#undef PG8_SA
#undef PG8_SB
#undef PG8_STAGE
#undef PG8_LDA
#undef PG8_LDB
#undef PG8_MMA
#undef PG8_WAIT_V
#undef PG8_WAIT_L
#undef PG8_BAR
#undef PG8_SCHED
}
}


struct Args { const float* in[24]; float* out; unsigned char* ws; int ph_lo, ph_hi; };

struct Ctx {
    const Args& a; float* out; unsigned char* ws; unsigned char* lds; unsigned* ctl;
    int tid, lane, wave, G, vcu;
};

__device__ __forceinline__ u32x4 pack8(const f32x4 a, const f32x4 b) { u32x4 p; p.x = cvt_pk_bf16(a[0], a[1]); p.y = cvt_pk_bf16(a[2], a[3]); p.z = cvt_pk_bf16(b[0], b[1]); p.w = cvt_pk_bf16(b[2], b[3]); return p; }
__device__ __forceinline__ f32x4 unpack_lo(const u32x4 p) { f32x4 v = {__uint_as_float(p.x << 16), __uint_as_float(p.x & 0xffff0000u), __uint_as_float(p.y << 16), __uint_as_float(p.y & 0xffff0000u)}; return v; }
__device__ __forceinline__ f32x4 unpack_hi(const u32x4 p) { f32x4 v = {__uint_as_float(p.z << 16), __uint_as_float(p.z & 0xffff0000u), __uint_as_float(p.w << 16), __uint_as_float(p.w & 0xffff0000u)}; return v; }
#define EPI_LOOP(...) _Pragma("unroll") for (int ai = 0; ai < 2; ++ai) _Pragma("unroll") for (int m = 0; m < 4; ++m) { const unsigned row = row0 + ai * 128 + m * 16; \
    _Pragma("unroll") for (int bj = 0; bj < 2; ++bj) { const unsigned col = col0 + bj * 128; const f32x4 v0 = acc[ai][bj][m][0], v1 = acc[ai][bj][m][1]; __VA_ARGS__ } }
#define EPI_HEAD const unsigned row0 = u.pm * 256 + wr * 64 + fr; const unsigned col0 = u.pn * 256 + wc * 32 + 8 * fq;
struct EpiZ {
    static constexpr bool PERM = true, AFTER_DRAIN = false; bf16_t* zqkv; bf16_t* zf; bf16_t* sig;
    __device__ __forceinline__ void operator()(const f32x4 (&acc)[2][2][4][2], const pg8::Unit& u, int wr, int wc, int fr, int fq) const { EPI_HEAD
        EPI_LOOP(
            if (col < 416) *(u32x4*)(zqkv + row * 416u + col) = pack8(v0, v1);
            else if (col < 928) *(u32x4*)(zf + row * 512u + (col - 416)) = pack8(v0, v1);
            else if (col < INW) { const f32x4 s0 = {sigmoidf_(v0[0]), sigmoidf_(v0[1]), sigmoidf_(v0[2]), sigmoidf_(v0[3])}; const f32x4 s1 = {sigmoidf_(v1[0]), sigmoidf_(v1[1]), sigmoidf_(v1[2]), sigmoidf_(v1[3])};
                *(u32x4*)(sig + row * 2048u + (col - 928)) = pack8(s0, s1); } ) } };
struct EpiF {
    static constexpr bool PERM = true, AFTER_DRAIN = false; bf16_t* Fo;
    __device__ __forceinline__ void operator()(const f32x4 (&acc)[2][2][4][2], const pg8::Unit& u, int wr, int wc, int fr, int fq) const {
        const unsigned row0 = (u.pn >> 1) * 2048 + u.pm * 256 + wr * 64 + fr; const unsigned col0 = (u.pn & 1) * 256 + wc * 32 + 8 * fq;
        EPI_LOOP( *(u32x4*)(Fo + row * 1024u + 512u + col) = pack8(v0, v1); ) } };
struct EpiMg {
    static constexpr bool PERM = true, AFTER_DRAIN = false; bf16_t* mg; const bf16_t* sig;
    __device__ __forceinline__ void mid(f32x4 (&acc)[2][2][4][2], const pg8::Unit& u, int wr, int wc, int fr, int fq) const { EPI_HEAD
#pragma unroll
        for (int ai = 0; ai < 2; ++ai)
#pragma unroll
            for (int m = 0; m < 4; ++m) { const unsigned row = row0 + ai * 128 + m * 16;
#pragma unroll
                for (int bj = 0; bj < 2; ++bj) { const unsigned col = col0 + bj * 128;
                    const u32x4 ga = *(const u32x4*)(sig + row * 2048u + col), gf = *(const u32x4*)(sig + row * 2048u + 1024 + col);
                    const f32x4 al = unpack_lo(ga), ah = unpack_hi(ga), fl = unpack_lo(gf), fh = unpack_hi(gf);
#pragma unroll
                    for (int e = 0; e < 4; ++e) { acc[ai][bj][m][0][e] *= al[e] * __builtin_amdgcn_rcpf(fl[e]); acc[ai][bj][m][1][e] *= ah[e] * __builtin_amdgcn_rcpf(fh[e]); } }
                if (m == 1 || m == 3) __builtin_amdgcn_sched_barrier(0); } }
    __device__ __forceinline__ void operator()(const f32x4 (&acc)[2][2][4][2], const pg8::Unit& u, int wr, int wc, int fr, int fq) const { EPI_HEAD
        EPI_LOOP( const u32x4 g = *(const u32x4*)(sig + row * 2048u + 1024 + col); *(u32x4*)(mg + row * 1024u + col) = pack8(unpack_lo(g) * v0, unpack_hi(g) * v1); ) } };
struct EpiX1 {
    static constexpr bool PERM = true, AFTER_DRAIN = false; float* x1; const float* x; const float* adaf;
    __device__ __forceinline__ void operator()(const f32x4 (&acc)[2][2][4][2], const pg8::Unit& u, int wr, int wc, int fr, int fq) const { EPI_HEAD
        const float* g1 = adaf + (u.pm >> 3) * 6144 + 2 * 1024;
        EPI_LOOP( const f32x4 ga = *(const f32x4*)(g1 + col), gb = *(const f32x4*)(g1 + col + 4);
            *(f32x4*)(x1 + row * 1024u + col) = *(const f32x4*)(x + row * 1024u + col) + ga * v0; *(f32x4*)(x1 + row * 1024u + col + 4) = *(const f32x4*)(x + row * 1024u + col + 4) + gb * v1; ) } };
struct EpiSh {
    static constexpr bool PERM = true, AFTER_DRAIN = false; bf16_t* acts;
    __device__ __forceinline__ void operator()(const f32x4 (&acc)[2][2][4][2], const pg8::Unit& u, int wr, int wc, int fr, int fq) const { EPI_HEAD
        EPI_LOOP( const f32x4 a = {siluf_(v0[0]) * v1[0], siluf_(v0[1]) * v1[1], siluf_(v0[2]) * v1[2], siluf_(v0[3]) * v1[3]};
            *(u32x2*)(acts + row * 256u + (col >> 1)) = pack4(a); ) } };
struct EpiOut {
    static constexpr bool PERM = true, AFTER_DRAIN = false; float* out; const float* x1; const float* adaf; const bf16_t* ybuf;
    __device__ __forceinline__ void operator()(const f32x4 (&acc)[2][2][4][2], const pg8::Unit& u, int wr, int wc, int fr, int fq) const { EPI_HEAD
        const float* g2 = adaf + (u.pm >> 3) * 6144 + 5 * 1024;
        EPI_LOOP( f32x4 s0 = v0, s1 = v1;
            f32x4 r0 = {0.f, 0.f, 0.f, 0.f}, r1 = {0.f, 0.f, 0.f, 0.f};
            _Pragma("unroll") for (int k = 0; k < 8; ++k) { const u32x2 y = *(const u32x2*)((const unsigned char*)ybuf + (row * 8u + k) * 1024u + col); r0 += unpack_fp8x4(y.x); r1 += unpack_fp8x4(y.y); }
            s0 += r0 * 0.0625f; s1 += r1 * 0.0625f;
            *(f32x4*)(out + row * 1024u + col) = *(const f32x4*)(x1 + row * 1024u + col) + *(const f32x4*)(g2 + col) * s0;
            *(f32x4*)(out + row * 1024u + col + 4) = *(const f32x4*)(x1 + row * 1024u + col + 4) + *(const f32x4*)(g2 + col + 4) * s1;
            if (m == 1 || m == 3) __builtin_amdgcn_sched_barrier(0); ) } };

template <class GET> __device__ __forceinline__ void conv_wt(const Ctx& F, bf16_t* dst, int K, int Nd, const GET& get) {
    const long gt = (long)F.vcu * NTHREADS + F.tid, gs = (long)F.G * NTHREADS; const long nchunk = (long)Nd * (K / 8);
    for (long c = gt; c < nchunk; c += gs) { const int n = (int)(c % Nd), k0 = (int)(c / Nd) * 8;
        u32x4 p; p.x = cvt_pk_bf16(get(k0, n), get(k0 + 1, n)); p.y = cvt_pk_bf16(get(k0 + 2, n), get(k0 + 3, n)); p.z = cvt_pk_bf16(get(k0 + 4, n), get(k0 + 5, n)); p.w = cvt_pk_bf16(get(k0 + 6, n), get(k0 + 7, n));
        *(u32x4*)(dst + (long)n * K + k0) = p; }
}

template <int K, int Nd, class GET4> __device__ __forceinline__ void conv4(bf16_t* dst, unsigned c, const GET4& get4) {
    constexpr unsigned NQ = Nd / 4; const unsigned n = (c % NQ) * 4u, k0 = (c / NQ) * 8u;
    f32x4 r[8];
#pragma unroll
    for (int i = 0; i < 8; ++i) r[i] = get4(k0 + i, n);
#pragma unroll
    for (int j = 0; j < 4; ++j) { u32x4 p; p.x = cvt_pk_bf16(r[0][j], r[1][j]); p.y = cvt_pk_bf16(r[2][j], r[3][j]); p.z = cvt_pk_bf16(r[4][j], r[5][j]); p.w = cvt_pk_bf16(r[6][j], r[7][j]);
        *(u32x4*)(dst + (size_t)(n + j) * K + k0) = p; }
}

__device__ __forceinline__ void p0_prep(const Ctx& F) {
    const float* c = F.a.in[1]; const float* w_ada = F.a.in[2];
    float* adap = (float*)(F.ws + WS_ADAP);
    float* sc = (float*)F.lds;
    float* red = sc + 512;
    for (int it = F.vcu; it < 256; it += F.G) {
        const int ks = it >> 4, chunk = it & 15;
        __syncthreads();
        { const int b = F.tid >> 6, k = F.tid & 63; sc[b * 64 + k] = siluf_(c[b * 1024 + ks * 64 + k]); }
        __syncthreads();
        const int cl = F.tid & 127, kq = F.tid >> 7;
        float acc[3][8];
#pragma unroll
        for (int j = 0; j < 3; ++j)
#pragma unroll
            for (int b = 0; b < 8; ++b) acc[j][b] = 0.f;
        const float* wp = w_ada + (long)(ks * 64 + kq * 16) * 6144 + chunk * 384 + cl;
#pragma unroll 8
        for (int k = 0; k < 16; ++k) {
            const float w0 = wp[k * 6144], w1 = wp[k * 6144 + 128], w2 = wp[k * 6144 + 256];
#pragma unroll
            for (int b = 0; b < 8; ++b) { const float sv = sc[b * 64 + kq * 16 + k]; acc[0][b] += sv * w0; acc[1][b] += sv * w1; acc[2][b] += sv * w2; }
        }
#pragma unroll
        for (int j = 0; j < 3; ++j)
#pragma unroll
            for (int b = 0; b < 8; ++b) red[(kq * 8 + b) * 384 + j * 128 + cl] = acc[j][b];
        __syncthreads();
        for (int o = F.tid; o < 8 * 384; o += NTHREADS) { const int b = o / 384, cc = o - b * 384;
            adap[((long)ks * 8 + b) * 6144 + chunk * 384 + cc] = (red[b * 384 + cc] + red[(8 + b) * 384 + cc]) + (red[(16 + b) * 384 + cc] + red[(24 + b) * 384 + cc]); }
    }
    const long gt = (long)F.vcu * NTHREADS + F.tid, gs = (long)F.G * NTHREADS;
    { float* rc = (float*)(F.ws + WS_ROPE); float* rs = rc + 2048 * 16;
      for (long i = gt; i < 2048 * 16; i += gs) { const int pos = (int)(i >> 4), j = (int)(i & 15);
          const float inv = powf(10000.0f, -(float)(2 * j) / 32.0f); const float ang = (float)pos * inv; rc[i] = cosf(ang); rs[i] = sinf(ang); } }
    { bf16_t* wd = (bf16_t*)(F.ws + WS_WDFT); const float nrm = 0.02209708691207961f;
      for (long g = gt; g < (long)2048 * 64; g += gs) { const int k = (int)(g >> 6), l = (int)(g & 63);
          const float cr = cospif((float)k * (1.0f / 1024.0f)), sr = sinpif((float)k * (1.0f / 1024.0f));
          const int idx0 = (k * (8 * l)) & 2047; const int q = k & 3;
          float c0 = cospif((float)idx0 * (1.0f / 1024.0f)) * nrm, s0 = sinpif((float)idx0 * (1.0f / 1024.0f)) * nrm;
#pragma unroll
          for (int i = 0; i < 4; ++i) {
              float cv[8], sv[8]; float cc = c0, ss = s0;
#pragma unroll
              for (int j = 0; j < 8; ++j) { cv[j] = cc; sv[j] = ss; const float cn = cc * cr - ss * sr; ss = ss * cr + cc * sr; cc = cn; }
              u32x4 pc, ps;
              pc.x = cvt_pk_bf16(cv[0], cv[1]); pc.y = cvt_pk_bf16(cv[2], cv[3]); pc.z = cvt_pk_bf16(cv[4], cv[5]); pc.w = cvt_pk_bf16(cv[6], cv[7]);
              ps.x = cvt_pk_bf16(sv[0], sv[1]); ps.y = cvt_pk_bf16(sv[2], sv[3]); ps.z = cvt_pk_bf16(sv[4], sv[5]); ps.w = cvt_pk_bf16(sv[6], sv[7]);
              *(u32x4*)(wd + (long)k * 4096 + 8 * l + 512 * i) = pc; *(u32x4*)(wd + (long)k * 4096 + 2048 + 8 * l + 512 * i) = ps;
              const float nc = (q == 0) ? c0 : (q == 1) ? -s0 : (q == 2) ? -c0 : s0;
              const float ns = (q == 0) ? s0 : (q == 1) ? c0 : (q == 2) ? -s0 : -c0;
              c0 = nc; s0 = ns;
          } } }
    { bf16_t* d6 = (bf16_t*)(F.ws + WS_D64T);
      for (long i = gt; i < 128 * 64; i += gs) { const int n = (int)(i >> 6), cc = (int)(i & 63), part = n >> 6, m = n & 63; const int idx = (m * cc) & 63;
          const float a = (float)idx * (1.0f / 32.0f); const float v = part ? -sinpif(a) : cospif(a); d6[i] = f2bf(v * 0.125f); } }
    { const float* w_in = F.a.in[5]; const float* w_pa = F.a.in[12]; const float* w_pf = F.a.in[13]; const float* w_o = F.a.in[14]; const float* w_r = F.a.in[16];
      const float* w_g = F.a.in[21]; const float* w_u = F.a.in[22]; const float* w_sd = F.a.in[23];
      const float* gq = F.a.in[6]; const float* wq = F.a.in[7]; const float* gkv = F.a.in[8]; const float* wk = F.a.in[9];
      constexpr unsigned C_IN = 768 * 128, C_OUT = 256 * 128, C_R = 64 * 384, C_PA = 256 * 64, C_SH = 128 * 128, C_SD = 256 * 32, C_UQ = 192 * 32, C_UKV = 256 * 16;
      constexpr unsigned C_TOT = C_IN + C_OUT + C_R + 2 * C_PA + C_SH + C_SD + C_UQ + C_UKV;
      for (unsigned c0 = (unsigned)gt; c0 < C_TOT; c0 += (unsigned)gs) {
          unsigned c = c0;
          if (c < C_IN) { conv4<1024, 3072>((bf16_t*)(F.ws + WS_WB_IN), c, [&](unsigned k, unsigned n) { const f32x4 z = {0.f, 0.f, 0.f, 0.f}; return (n < (unsigned)INW) ? *(const f32x4*)(w_in + k * (unsigned)INW + n) : z; }); continue; }
          c -= C_IN;
          if (c < C_OUT) { conv4<1024, 1024>((bf16_t*)(F.ws + WS_WB_OUT), c, [&](unsigned k, unsigned n) { return *(const f32x4*)(w_o + k * 1024u + n); }); continue; }
          c -= C_OUT;
          if (c < C_R) { conv4<3072, 256>((bf16_t*)(F.ws + WS_WB_R), c, [&](unsigned k3, unsigned n) { const unsigned rg = k3 >> 10, k = k3 & 1023u; const f32x4 wv = *(const f32x4*)(w_r + k * 256u + n);
                  f32x4 hi; hi[0] = bf2f(f2bf(wv[0])); hi[1] = bf2f(f2bf(wv[1])); hi[2] = bf2f(f2bf(wv[2])); hi[3] = bf2f(f2bf(wv[3])); return (rg == 2u) ? (wv - hi) : hi; }); continue; }
          c -= C_R;
          if (c < 2 * C_PA) { conv4<1024, 1024>((bf16_t*)(F.ws + WS_WB_PA), c, [&](unsigned k, unsigned n) { return (k < 512u) ? *(const f32x4*)(w_pa + k * 1024u + n) : *(const f32x4*)(w_pf + (k - 512u) * 1024u + n); }); continue; }
          c -= 2 * C_PA;
          if (c < C_SH) { conv4<1024, 512>((bf16_t*)(F.ws + WS_WB_SH), c, [&](unsigned k, unsigned n) { const unsigned j = (n >> 3) * 4u; return ((n >> 2) & 1u) ? *(const f32x4*)(w_u + k * 256u + j) : *(const f32x4*)(w_g + k * 256u + j); }); continue; }
          c -= C_SH;
          if (c < C_SD) { conv4<256, 1024>((bf16_t*)(F.ws + WS_WB_SD), c, [&](unsigned k, unsigned n) { return *(const f32x4*)(w_sd + k * 1024u + n); }); continue; }
          c -= C_SD;
          if (c < C_UQ) { conv4<256, 768>((bf16_t*)(F.ws + WS_WUQ), c, [&](unsigned k, unsigned n) { return *(const f32x4*)(wq + k * 768u + n) * gq[k]; }); continue; }
          c -= C_UQ;
          conv4<128, 1024>((bf16_t*)(F.ws + WS_WUKV), c, [&](unsigned k, unsigned n) { return *(const f32x4*)(wk + k * 1024u + n) * gkv[k]; });
      } }
}

__device__ __forceinline__ void p_norm_rows(const Ctx& F, int which) {
    const float* src = which ? (const float*)(F.ws + WS_X1) : F.a.in[0];
    const float* gain = which ? F.a.in[15] : F.a.in[4];
    const float* adap = (const float*)(F.ws + WS_ADAP); const float* b_ada = F.a.in[3];
    float* adaf = (float*)(F.ws + WS_ADAF);
    bf16_t* dhi = which ? (bf16_t*)(F.ws + WS_A3) : (bf16_t*)(F.ws + WS_H); const unsigned ldd = which ? 3072u : 1024u;
    float* smod = (float*)F.lds; float* sshift = smod + 1024;
    if (which == 0) {
        for (int idx = F.vcu * NTHREADS + F.tid; idx < 8 * 6144; idx += F.G * NTHREADS) { const int b = idx / 6144, j = idx - b * 6144; float s = b_ada[j];
#pragma unroll
            for (int ks = 0; ks < 16; ++ks) s += adap[((long)ks * 8 + b) * 6144 + j];
            adaf[idx] = s; }
    }
    for (int it = F.vcu; it < 256; it += F.G) {
        const int b = it >> 5;
        __syncthreads();
        for (int cidx = F.tid; cidx < 1024; cidx += NTHREADS) {
            float sh, scv;
            if (which == 0) { sh = b_ada[cidx]; scv = b_ada[1024 + cidx];
                for (int ks = 0; ks < 16; ++ks) { sh += adap[((long)ks * 8 + b) * 6144 + cidx]; scv += adap[((long)ks * 8 + b) * 6144 + 1024 + cidx]; } }
            else { sh = adaf[b * 6144 + 3 * 1024 + cidx]; scv = adaf[b * 6144 + 4 * 1024 + cidx]; }
            smod[cidx] = gain[cidx] * (1.f + scv); sshift[cidx] = sh;
        }
        __syncthreads();
#pragma unroll 1
        for (int jb = 0; jb < 8; jb += 4) {
        f32x4 va[4][4];
#pragma unroll
        for (int j = 0; j < 4; ++j)
#pragma unroll
            for (int i = 0; i < 4; ++i) va[j][i] = *(const f32x4*)(src + ((long)it * 64 + F.wave * 8 + jb + j) * 1024 + i * 256 + F.lane * 4);
#pragma unroll
        for (int j = 0; j < 4; ++j) {
            const long row = (long)it * 64 + F.wave * 8 + jb + j;
            f32x4 v[4]; float ss = 0.f;
#pragma unroll
            for (int i = 0; i < 4; ++i) { v[i] = va[j][i]; ss += v[i][0] * v[i][0] + v[i][1] * v[i][1] + v[i][2] * v[i][2] + v[i][3] * v[i][3]; }
            ss = wave_sum(ss);
            const float rstd = rsqrtf(ss * (1.0f / 1024.0f) + EPS);
#pragma unroll
            for (int i = 0; i < 4; ++i) {
                const int c0 = i * 256 + F.lane * 4; float hv[4];
#pragma unroll
                for (int e = 0; e < 4; ++e) hv[e] = v[i][e] * rstd * smod[c0 + e] + sshift[c0 + e];
                u32x2 pk; pk.x = cvt_pk_bf16(hv[0], hv[1]); pk.y = cvt_pk_bf16(hv[2], hv[3]);
                *(u32x2*)(dhi + row * ldd + c0) = pk;
                if (which) {
                    float lo[4];
                    lo[0] = hv[0] - __uint_as_float(pk.x << 16); lo[1] = hv[1] - __uint_as_float(pk.x & 0xffff0000u);
                    lo[2] = hv[2] - __uint_as_float(pk.y << 16); lo[3] = hv[3] - __uint_as_float(pk.y & 0xffff0000u);
                    u32x2 pl; pl.x = cvt_pk_bf16(lo[0], lo[1]); pl.y = cvt_pk_bf16(lo[2], lo[3]);
                    *(u32x2*)(dhi + row * ldd + 1024 + c0) = pl; *(u32x2*)(dhi + row * ldd + 2048 + c0) = pk;
                }
            }
        }
        }
    }
}

__device__ __forceinline__ void p2_win(const Ctx& F) {
    pg8::Gemm g{(const bf16_t*)(F.ws + WS_H), (const bf16_t*)(F.ws + WS_WB_IN), T, 3072, 1024};
    pg8::StaticOrder S; S.init(T, 3072, F.G, (int)blockIdx.x);
    EpiZ E{(bf16_t*)(F.ws + WS_ZQKV), (bf16_t*)(F.ws + WS_ZF), (bf16_t*)(F.ws + WS_SIG)};
    pg8::gemm_phase<EpiZ, pg8::StaticOrder, true, true>((LAS unsigned char*)F.lds, g, S, E);
}

struct BKNq { const float* b; static constexpr bool KN = true; int ldb;
    __device__ __forceinline__ const float* col(int c) const { return b + ((c < 192) ? c : 188); } };
__device__ __forceinline__ void p3_mixer_inputs(const Ctx& F) {
    const bf16_t* zqkv = (const bf16_t*)(F.ws + WS_ZQKV);
    const int lane = F.lane, w = F.wave;
    {
        const bf16_t* zf = (const bf16_t*)(F.ws + WS_ZF); const bf16_t* d6 = (const bf16_t*)(F.ws + WS_D64T); bf16_t* xt = (bf16_t*)(F.ws + WS_XT);
        for (int it = F.vcu; it < 8 * 64; it += F.G) {
            const int g = it & 7, tt = it >> 3; const int tok0 = tt * 256; const int b = tok0 >> 11, s0 = tok0 & 2047;
            f32x16 acc[2][2]; zero_acc<2>(acc);
            ARows af{d6, 64, 0}; BNK bf{zf + g * 64, 512, tok0};
            gemm_core<2, true>(acc, af, bf, 1, F.lds);
            stage_bf16<2>(acc, F.lds);
            __syncthreads();
#pragma unroll 4
            for (int rr = 0; rr < 16; ++rr) {
                const int n = w * 16 + rr; const int part = n >> 6, m = n & 63;
                *(u32x2*)(xt + (unsigned)(b * 512 + g * 64 + m) * 4096u + part * 2048 + s0 + 4 * lane) = *(const u32x2*)(F.lds + n * ST16 + lane * 8);
            }
        }
    }
    {
        constexpr int WQ_P = 528, WKV_P = 272, ST_P = 208;
        constexpr int L_WQ = 0, L_WKV = 96 * WQ_P, L_G = L_WKV + 128 * WKV_P, L_ST = L_G + 768;
        static_assert(L_ST + 8 * 32 * ST_P <= LDS_MISC, "head engine LDS");
        const float* rc = (const float*)(F.ws + WS_ROPE); const float* rsn = rc + 2048 * 16;
        bf16_t* Q = (bf16_t*)(F.ws + WS_Q); bf16_t* K = (bf16_t*)(F.ws + WS_K); bf16_t* vt = (bf16_t*)(F.ws + WS_VT);
        const int hd = F.vcu & 7; const int l31 = lane & 31, hh = lane >> 5;
        __syncthreads();
        { const u32x4* wq = (const u32x4*)((const bf16_t*)(F.ws + WS_WUQ) + (size_t)hd * 96 * 256); const u32x4* wk = (const u32x4*)((const bf16_t*)(F.ws + WS_WUKV) + (size_t)hd * 128 * 128);
          for (int c = F.tid; c < 96 * 32; c += NTHREADS) *(u32x4*)(F.lds + L_WQ + (c >> 5) * WQ_P + (c & 31) * 16) = wq[c];
          for (int c = F.tid; c < 128 * 16; c += NTHREADS) *(u32x4*)(F.lds + L_WKV + (c >> 4) * WKV_P + (c & 15) * 16) = wk[c];
          if (F.tid < 96) { ((float*)(F.lds + L_G))[F.tid] = F.a.in[10][F.tid]; ((float*)(F.lds + L_G))[96 + F.tid] = F.a.in[11][F.tid]; } }
        __syncthreads();
        const float* gq = (const float*)(F.lds + L_G); const float* gk = gq + 96;
        unsigned char* st = F.lds + L_ST + w * (32 * ST_P);
        const float qscale = 0.10206207261596577f * 1.4426950408889634f;
#pragma unroll 1
        for (int i2 = 0; i2 < 2; ++i2) {
            const int sb = (F.vcu >> 3) + 32 * i2; const unsigned tok = sb * 256 + w * 32 + l31; const int b = tok >> 11, s = tok & 2047; const unsigned bh = b * 8 + hd;
            const bf16_t* zrow = zqkv + tok * 416u;
            const f32x4 cs0 = *(const f32x4*)(rc + s * 16 + 4 * hh), cs1 = *(const f32x4*)(rc + s * 16 + 8 + 4 * hh), sn0 = *(const f32x4*)(rsn + s * 16 + 4 * hh), sn1 = *(const f32x4*)(rsn + s * 16 + 8 + 4 * hh);
            {
                bf16x8 zq[16];
#pragma unroll
                for (int k = 0; k < 16; ++k) zq[k] = *(const bf16x8*)(zrow + 16 * k + 8 * hh);
                f32x16 aq[3];
#pragma unroll
                for (int f = 0; f < 3; ++f) {
#pragma unroll
                    for (int r = 0; r < 16; ++r) aq[f][r] = 0.f;
#pragma unroll
                    for (int k = 0; k < 16; ++k) { const bf16x8 wf = *(const bf16x8*)(F.lds + L_WQ + (32 * f + l31) * WQ_P + (16 * k + 8 * hh) * 2); aq[f] = __builtin_amdgcn_mfma_f32_32x32x16_bf16(wf, zq[k], aq[f], 0, 0, 0);
                        if ((k & 7) == 7) __builtin_amdgcn_sched_barrier(0); }
                }
                float ss = 0.f;
#pragma unroll
                for (int f = 0; f < 3; ++f)
#pragma unroll
                    for (int r = 0; r < 16; ++r) ss += aq[f][r] * aq[f][r];
                ss += __shfl_xor(ss, 32);
                const float rstd = rsqrtf(ss * (1.0f / 96.0f) + EPS) * qscale;
#pragma unroll
                for (int f = 0; f < 3; ++f)
#pragma unroll
                    for (int r = 0; r < 16; ++r) aq[f][r] *= rstd * gq[32 * f + (r & 3) + 8 * (r >> 2) + 4 * hh];
#pragma unroll
                for (int r = 0; r < 8; ++r) { const float c = (r < 4) ? cs0[r & 3] : cs1[r & 3], sn = (r < 4) ? sn0[r & 3] : sn1[r & 3];
                    const float r1 = aq[2][r], r2 = aq[2][r + 8]; aq[2][r] = r1 * c - r2 * sn; aq[2][r + 8] = r2 * c + r1 * sn; }
#pragma unroll
                for (int f = 0; f < 3; ++f)
#pragma unroll
                    for (int q4 = 0; q4 < 4; ++q4) { const f32x4 v = {aq[f][4 * q4], aq[f][4 * q4 + 1], aq[f][4 * q4 + 2], aq[f][4 * q4 + 3]};
                        *(u32x2*)(st + l31 * ST_P + (32 * f + 8 * q4 + 4 * hh) * 2) = pack4(v); }
                u32x4* dst = (u32x4*)(Q + ((size_t)bh * 2048 + (s - l31)) * 96);
#pragma unroll
                for (int c6 = 0; c6 < 6; ++c6) { const int c = c6 * 64 + lane; dst[c] = *(const u32x4*)(st + (c / 12) * ST_P + (c % 12) * 16); }
            }
            {
                bf16x8 zk[8]; float sk = 0.f;
#pragma unroll
                for (int k = 0; k < 8; ++k) { zk[k] = *(const bf16x8*)(zrow + 256 + 16 * k + 8 * hh);
#pragma unroll
                    for (int e = 0; e < 8; ++e) { const float z = bf2f((bf16_t)zk[k][e]); sk += z * z; } }
                sk += __shfl_xor(sk, 32);
                const float rkv = rsqrtf(sk * (1.0f / 128.0f) + EPS);
                f32x16 ak[4];
#pragma unroll
                for (int f = 0; f < 4; ++f) {
#pragma unroll
                    for (int r = 0; r < 16; ++r) ak[f][r] = 0.f;
#pragma unroll
                    for (int k = 0; k < 8; ++k) { const bf16x8 wf = *(const bf16x8*)(F.lds + L_WKV + (32 * f + l31) * WKV_P + (16 * k + 8 * hh) * 2); ak[f] = __builtin_amdgcn_mfma_f32_32x32x16_bf16(wf, zk[k], ak[f], 0, 0, 0); }
                    __builtin_amdgcn_sched_barrier(0);
                }
#pragma unroll
                for (int f = 2; f < 4; ++f)
#pragma unroll
                    for (int r = 0; r < 16; ++r) { const int dv = 32 * (f - 2) + (r & 3) + 8 * (r >> 2) + 4 * hh; vt[((size_t)bh * 64 + dv) * 2048 + s] = f2bf(ak[f][r] * rkv); }
                float zr[16];
#pragma unroll
                for (int q4 = 0; q4 < 4; ++q4) { const f32x4 t4 = unpack4(*(const u32x2*)(zrow + 384 + 8 * q4 + 4 * hh)); zr[4 * q4] = t4[0]; zr[4 * q4 + 1] = t4[1]; zr[4 * q4 + 2] = t4[2]; zr[4 * q4 + 3] = t4[3]; }
                float ss = 0.f;
#pragma unroll
                for (int f = 0; f < 2; ++f)
#pragma unroll
                    for (int r = 0; r < 16; ++r) { ak[f][r] *= rkv; ss += ak[f][r] * ak[f][r]; }
#pragma unroll
                for (int r = 0; r < 16; ++r) ss += zr[r] * zr[r];
                ss += __shfl_xor(ss, 32);
                const float rstd = rsqrtf(ss * (1.0f / 96.0f) + EPS);
#pragma unroll
                for (int f = 0; f < 2; ++f)
#pragma unroll
                    for (int r = 0; r < 16; ++r) ak[f][r] *= rstd * gk[32 * f + (r & 3) + 8 * (r >> 2) + 4 * hh];
#pragma unroll
                for (int r = 0; r < 16; ++r) zr[r] *= rstd * gk[64 + (r & 3) + 8 * (r >> 2) + 4 * hh];
#pragma unroll
                for (int r = 0; r < 8; ++r) { const float c = (r < 4) ? cs0[r & 3] : cs1[r & 3], sn = (r < 4) ? sn0[r & 3] : sn1[r & 3];
                    const float r1 = zr[r], r2 = zr[r + 8]; zr[r] = r1 * c - r2 * sn; zr[r + 8] = r2 * c + r1 * sn; }
#pragma unroll
                for (int f = 0; f < 2; ++f)
#pragma unroll
                    for (int q4 = 0; q4 < 4; ++q4) { const f32x4 v = {ak[f][4 * q4], ak[f][4 * q4 + 1], ak[f][4 * q4 + 2], ak[f][4 * q4 + 3]};
                        *(u32x2*)(st + l31 * ST_P + (32 * f + 8 * q4 + 4 * hh) * 2) = pack4(v); }
#pragma unroll
                for (int q4 = 0; q4 < 4; ++q4) { const f32x4 v = {zr[4 * q4], zr[4 * q4 + 1], zr[4 * q4 + 2], zr[4 * q4 + 3]};
                    *(u32x2*)(st + l31 * ST_P + (64 + 8 * q4 + 4 * hh) * 2) = pack4(v); }
                u32x4* dst = (u32x4*)(K + ((size_t)bh * 2048 + (s - l31)) * 96);
#pragma unroll
                for (int c6 = 0; c6 < 6; ++c6) { const int c = c6 * 64 + lane; dst[c] = *(const u32x4*)(st + (c / 12) * ST_P + (c % 12) * 16); }
            }
        }
    }
}

constexpr int KROW = 208, VROW = 136, K_TILE = 64 * KROW, V_TILE = 64 * VROW, AT_STAGE = K_TILE + V_TILE;
__device__ __forceinline__ void attn_item(const Ctx& F, int item) {
    const int qb = item & 7, bh = item >> 3, b = bh >> 3, hd = bh & 7;
    const bf16_t* Q = (const bf16_t*)(F.ws + WS_Q) + (long)bh * 2048 * 96;
    const bf16_t* K = (const bf16_t*)(F.ws + WS_K) + (long)bh * 2048 * 96;
    const bf16_t* Vt = (const bf16_t*)(F.ws + WS_VT) + (long)bh * 64 * 2048;
    bf16_t* O = (bf16_t*)(F.ws + WS_O);
    const int t = F.tid, lane = F.lane, w = F.wave, l31 = lane & 31, hh = lane >> 5;
    bf16x8 qf[6];
    { const bf16_t* qp = Q + (long)(qb * 256 + w * 32 + l31) * 96 + hh * 8;
#pragma unroll
      for (int s = 0; s < 6; ++s) qf[s] = *(const bf16x8*)(qp + s * 16); }
    f32x16 oacc[2];
#pragma unroll
    for (int d = 0; d < 2; ++d)
#pragma unroll
        for (int r = 0; r < 16; ++r) oacc[d][r] = 0.f;
    float neg_m;
    { float qss = 0.f;
#pragma unroll
      for (int s = 0; s < 6; ++s)
#pragma unroll
          for (int e = 0; e < 8; ++e) { const float v = bf2f((bf16_t)qf[s][e]); qss += v * v; }
      qss += __shfl_xor(qss, 32);
      const float* kg = F.a.in[11];
      float gm = fmaxf(fabsf(kg[lane]), fabsf(kg[64 + (lane & 31)]));
#pragma unroll
      for (int o = 32; o > 0; o >>= 1) gm = fmaxf(gm, __shfl_xor(gm, o));
      neg_m = -(sqrtf(qss) * gm * 9.797958971132712f); }
    float l_run = 0.f;
    const int kq0 = t, kq1 = t + 512;
    const int k_l0 = (kq0 / 12) * KROW + (kq0 % 12) * 16, k_l1 = (kq1 / 12) * KROW + (kq1 % 12) * 16;
    const int v_dv = t >> 3, v_c = t & 7; const int v_l = v_dv * VROW + v_c * 16;
    u32x4 kr0, kr1, vr;
    auto gload = [&](int j) {
        const bf16_t* kp = K + (long)j * 64 * 96;
        kr0 = *(const u32x4*)(kp + kq0 * 8);
        if (t < 256) kr1 = *(const u32x4*)(kp + kq1 * 8);
        vr = *(const u32x4*)(Vt + (long)v_dv * 2048 + j * 64 + v_c * 8);
    };
    auto lstore = [&](int st) {
        unsigned char* base = F.lds + st * AT_STAGE;
        *(u32x4*)(base + k_l0) = kr0;
        if (t < 256) *(u32x4*)(base + k_l1) = kr1;
        *(u32x2*)(base + K_TILE + v_l) = (u32x2){vr.x, vr.y}; *(u32x2*)(base + K_TILE + v_l + 8) = (u32x2){vr.z, vr.w};
    };
    __syncthreads();
    gload(0); lstore(0);
    __syncthreads();
    for (int j = 0; j < 32; ++j) {
        const bool more = (j + 1 < 32);
        if (more) gload(j + 1);
        const unsigned char* kb = F.lds + (j & 1) * AT_STAGE; const unsigned char* vb = kb + K_TILE;
        f32x16 st[2];
        {
            bf16x8 kfr[2][6];
#pragma unroll
            for (int f = 0; f < 2; ++f)
#pragma unroll
                for (int s = 0; s < 6; ++s) kfr[f][s] = *(const bf16x8*)(kb + (32 * f + l31) * KROW + (16 * s + 8 * hh) * 2);
            __builtin_amdgcn_sched_barrier(0);
#pragma unroll
            for (int f = 0; f < 2; ++f) {
#pragma unroll
                for (int r = 0; r < 16; ++r) st[f][r] = neg_m;
#pragma unroll
                for (int s = 0; s < 6; ++s) st[f] = __builtin_amdgcn_mfma_f32_32x32x16_bf16(kfr[f][s], qf[s], st[f], 0, 0, 0);
            }
        }
        float ps = 0.f;
#pragma unroll
        for (int f = 0; f < 2; ++f)
#pragma unroll
            for (int r = 0; r < 16; ++r) { const float p = __builtin_amdgcn_exp2f(st[f][r]); st[f][r] = p; ps += p; }
        l_run += ps;
        {
            u32x4 vfr[2][2][2];
#pragma unroll
            for (int f = 0; f < 2; ++f)
#pragma unroll
                for (int s2 = 0; s2 < 2; ++s2)
#pragma unroll
                    for (int d = 0; d < 2; ++d) { const unsigned char* vp = vb + (32 * d + l31) * VROW + (32 * f + 16 * s2 + 4 * hh) * 2;
                        const u32x2 lo = *(const u32x2*)vp, hi = *(const u32x2*)(vp + 16); vfr[f][s2][d] = (u32x4){lo.x, lo.y, hi.x, hi.y}; }
#pragma unroll
            for (int f = 0; f < 2; ++f)
#pragma unroll
                for (int s2 = 0; s2 < 2; ++s2) {
                    u32x4 pw; pw.x = cvt_pk_bf16(st[f][8 * s2 + 0], st[f][8 * s2 + 1]); pw.y = cvt_pk_bf16(st[f][8 * s2 + 2], st[f][8 * s2 + 3]);
                    pw.z = cvt_pk_bf16(st[f][8 * s2 + 4], st[f][8 * s2 + 5]); pw.w = cvt_pk_bf16(st[f][8 * s2 + 6], st[f][8 * s2 + 7]);
                    const bf16x8 pf = *(const bf16x8*)&pw;
#pragma unroll
                    for (int d = 0; d < 2; ++d) oacc[d] = __builtin_amdgcn_mfma_f32_32x32x16_bf16(*(const bf16x8*)&vfr[f][s2][d], pf, oacc[d], 0, 0, 0);
                }
        }
        if (more) lstore((j + 1) & 1);
        __syncthreads();
    }
    l_run += __shfl_xor(l_run, 32);
    const float inv = 1.0f / l_run;
    const long tok = (long)b * 2048 + qb * 256 + w * 32 + l31;
#pragma unroll
    for (int d = 0; d < 2; ++d)
#pragma unroll
        for (int q4 = 0; q4 < 4; ++q4) {
            const int dv = 32 * d + 8 * q4 + 4 * hh;
            u32x2 pk; pk.x = cvt_pk_bf16(oacc[d][4 * q4 + 0] * inv, oacc[d][4 * q4 + 1] * inv); pk.y = cvt_pk_bf16(oacc[d][4 * q4 + 2] * inv, oacc[d][4 * q4 + 3] * inv);
            *(u32x2*)(O + tok * 1024 + hd * 64 + dv) = pk;
        }
}

__device__ __forceinline__ void p6_attn_dft(const Ctx& F) {
    {
        pg8::Gemm g{(const bf16_t*)(F.ws + WS_WDFT), (const bf16_t*)(F.ws + WS_XT), 2048, 4096, 4096};
        pg8::StaticOrder S; S.init(2048, 4096, F.G, (int)blockIdx.x);
        EpiF E{(bf16_t*)(F.ws + WS_O)};
        pg8::gemm_phase<EpiF, pg8::StaticOrder, true, true>((LAS unsigned char*)F.lds, g, S, E);
    }
    volatile LAS int* sitem = (volatile LAS int*)(F.lds + LDS_MISC);
    auto next_item = [&]() -> int {
        __syncthreads();
        if (F.tid == 0) sitem[0] = (int)xb_add(F.ctl + CW_QUEUE, 1u);
        __syncthreads();
        return sitem[0];
    };
    int it = next_item();
    while (it < 512) { attn_item(F, it); it = next_item(); }
}

__device__ __forceinline__ void p7_merge(const Ctx& F) {
    bf16_t* mg = (bf16_t*)(F.ws + WS_MERGED); const bf16_t* sig = (const bf16_t*)(F.ws + WS_SIG);
    pg8::StaticOrder S; S.init(T, 1024, F.G, (int)blockIdx.x);
    pg8::Gemm g{(const bf16_t*)(F.ws + WS_O), (const bf16_t*)(F.ws + WS_WB_PA), T, 1024, 1024}; EpiMg E{mg, sig};
    pg8::gemm_phase<EpiMg, pg8::StaticOrder, true, true, true>((LAS unsigned char*)F.lds, g, S, E);
}

__device__ __forceinline__ void p8_out(const Ctx& F) {
    pg8::Gemm g{(const bf16_t*)(F.ws + WS_MERGED), (const bf16_t*)(F.ws + WS_WB_OUT), T, 1024, 1024};
    pg8::StaticOrder S; S.init(T, 1024, F.G, (int)blockIdx.x);
    EpiX1 E{(float*)(F.ws + WS_X1), F.a.in[0], (const float*)(F.ws + WS_ADAF)};
    pg8::gemm_phase<EpiX1, pg8::StaticOrder, true, true>((LAS unsigned char*)F.lds, g, S, E);
}

template <int NT>
__device__ __forceinline__ void topk_tokens(const Ctx& F, int tok0, const float (&lg)[NT][4], const float (&bs)[4]) {
    int* ltok = (int*)(F.ws + WS_LTOK); float* lw = (float*)(F.ws + WS_LW); unsigned* cnt = F.ctl + CW_CNT;
    const int lane = F.lane;
    float sc[NT][4]; unsigned long long key[NT][4];
#pragma unroll
    for (int t = 0; t < NT; ++t)
#pragma unroll
        for (int i = 0; i < 4; ++i) {
            sc[t][i] = sigmoidf_(lg[t][i]);
            const unsigned ub = __float_as_uint(sc[t][i] + bs[i]);
            const unsigned ord = (ub & 0x80000000u) ? ~ub : (ub | 0x80000000u);
            key[t][i] = ((unsigned long long)ord << 32) | (unsigned long long)(255 - (lane + 64 * i));
        }
    float wsum[NT], myw[NT]; int mye[NT];
#pragma unroll
    for (int t = 0; t < NT; ++t) { wsum[t] = 0.f; myw[t] = 0.f; mye[t] = 0; }
    for (int k = 0; k < 8; ++k) {
        unsigned long long best[NT];
#pragma unroll
        for (int t = 0; t < NT; ++t) { best[t] = key[t][0];
#pragma unroll
            for (int i = 1; i < 4; ++i) best[t] = (key[t][i] > best[t]) ? key[t][i] : best[t]; }
#pragma unroll
        for (int o = 32; o > 0; o >>= 1) {
#pragma unroll
            for (int t = 0; t < NT; ++t) {
                const unsigned lo = __shfl_xor((unsigned)best[t], o), hi = __shfl_xor((unsigned)(best[t] >> 32), o);
                const unsigned long long ob = ((unsigned long long)hi << 32) | lo;
                best[t] = (ob > best[t]) ? ob : best[t];
            }
        }
#pragma unroll
        for (int t = 0; t < NT; ++t) {
            const int e = 255 - (int)(best[t] & 0xffull);
            float s_own = 0.f;
#pragma unroll
            for (int i = 0; i < 4; ++i) { const bool mine = (e == lane + 64 * i); s_own = mine ? sc[t][i] : s_own; key[t][i] = mine ? 0ull : key[t][i]; }
            const float s_k = __shfl(s_own, e & 63);
            wsum[t] += s_k;
            myw[t] = (lane == k) ? s_k : myw[t]; mye[t] = (lane == k) ? e : mye[t];
        }
    }
    if (lane < 8) {
        unsigned slot[NT];
#pragma unroll
        for (int t = 0; t < NT; ++t) slot[t] = atomicAdd(&cnt[mye[t] * 64], 1u);
#pragma unroll
        for (int t = 0; t < NT; ++t) { ltok[(long)mye[t] * LCAP + slot[t]] = (tok0 + t) * 8 + lane; lw[(long)mye[t] * LCAP + slot[t]] = myw[t] / wsum[t] * 2.5f; }
    }
}

struct EpiLog {
    static constexpr bool PERM = true, AFTER_DRAIN = false; float* dst;
    __device__ __forceinline__ void operator()(const f32x4 (&acc)[2][2][4][2], const pg8::Unit& u, int wr, int wc, int fr, int fq) const { EPI_HEAD
        EPI_LOOP( *(f32x4*)(dst + row * 256u + col) = v0; *(f32x4*)(dst + row * 256u + col + 4) = v1; ) } };
__device__ __forceinline__ void p10_router_shared(const Ctx& F) {
    const bf16_t* a3 = (const bf16_t*)(F.ws + WS_A3); const bf16_t* wr = (const bf16_t*)(F.ws + WS_WB_R); float* part = (float*)(F.ws + WS_QRAW);
    const unsigned bx = blockIdx.x, G = (unsigned)F.G;
    {
        pg8::Gemm g{a3, (const bf16_t*)(F.ws + WS_WB_SH), T, 512, 1024, 3072};
        pg8::StaticOrder S; S.init(T, 512, F.G, (int)bx);
        EpiSh E{(bf16_t*)(F.ws + WS_ACTS)};
        pg8::gemm_phase<EpiSh, pg8::StaticOrder, true, true>((LAS unsigned char*)F.lds, g, S, E);
    }
    {
        const int seg = (bx >= 192u) ? 1 : 0;
        const bool has = (bx >= 128u);
        pg8::Gemm g{a3 + seg * 1536, wr + seg * 1536, T, 256, 1536, 3072};
        g.ldb = 3072;
        pg8::StaticOrder S; S.init(T, 256, F.G, has ? (int)((bx - 128u) & 63u) : (int)(G - 1));
        EpiLog E{part + (size_t)seg * T * 256};
        pg8::gemm_phase<EpiLog, pg8::StaticOrder, true, true>((LAS unsigned char*)F.lds, g, S, E);
    }
}
__device__ __forceinline__ void p11_topk(const Ctx& F) {
    const float* part = (const float*)(F.ws + WS_QRAW);
    float bs[4];
#pragma unroll
    for (int i = 0; i < 4; ++i) bs[i] = F.a.in[17][F.lane + 64 * i];
    for (int tok0 = (F.vcu * 8 + F.wave) * 8; tok0 < T; tok0 += F.G * 8 * 8) {
        float lg[8][4];
#pragma unroll
        for (int t = 0; t < 8; ++t)
#pragma unroll
            for (int i = 0; i < 4; ++i) { const size_t o = (size_t)(tok0 + t) * 256 + F.lane + 64 * i; lg[t][i] = part[o] + part[o + (size_t)T * 256]; }
        topk_tokens<8>(F, tok0, lg, bs);
    }
}

__device__ __forceinline__ int build_expert_tables(const Ctx& F, int per_rt) {
    volatile LAS int* offs = (volatile LAS int*)(F.lds + LDS_MISC); volatile LAS int* istart = offs + 264; volatile LAS int* wtot = offs + 540;
    unsigned* cnt = F.ctl + CW_CNT;
    const int t = F.tid, lane = F.lane;
    const int c = (t < NE) ? (int)cnt[t * 64] : 0; const int ni = ((c + 255) >> 8) * per_rt;
    int x = c, y = ni;
#pragma unroll
    for (int d = 1; d < 64; d <<= 1) { const int x2 = __shfl_up(x, d), y2 = __shfl_up(y, d); x += (lane >= d) ? x2 : 0; y += (lane >= d) ? y2 : 0; }
    __syncthreads();
    if (t < NE && lane == 63) { wtot[t >> 6] = x; wtot[4 + (t >> 6)] = y; }
    __syncthreads();
    if (t < NE) { int bx = 0, by = 0; for (int k = 0; k < (t >> 6); ++k) { bx += wtot[k]; by += wtot[4 + k]; }
        offs[t] = bx + x - c; istart[t] = by + y - ni; if (t == NE - 1) { offs[NE] = bx + x; istart[NE] = by + y; } }
    __syncthreads();
    return istart[NE];
}
__device__ __forceinline__ int find_expert(const Ctx& F, int it) {
    volatile LAS int* istart = (volatile LAS int*)(F.lds + LDS_MISC) + 264;
    int lo = 0, hi = NE;
    while (hi - lo > 1) { const int mid = (lo + hi) >> 1; if (istart[mid] <= it) lo = mid; else hi = mid; }
    return lo;
}
struct AGather { const bf16_t* b; const int* list; int m0, mvalid; unsigned lda;
    __device__ __forceinline__ const bf16_t* base() const { return b; }
    __device__ __forceinline__ unsigned off(int r) const { int i = m0 + r; i = (i < mvalid) ? i : (mvalid - 1); return (unsigned)(list[i] >> 3) * lda; }
    __device__ __forceinline__ long koff(int kt) const { return (long)kt * 64; } };
struct ARowsV { const bf16_t* b; unsigned lda; int m0, mvalid;
    __device__ __forceinline__ const bf16_t* base() const { return b; }
    __device__ __forceinline__ unsigned off(int r) const { int i = m0 + r; i = (i < mvalid) ? i : (mvalid - 1); return (unsigned)i * lda; }
    __device__ __forceinline__ long koff(int kt) const { return (long)kt * 64; } };

__device__ __forceinline__ void p12_exp_up(const Ctx& F) {
    const int total = build_expert_tables(F, 2);
    volatile LAS int* offs = (volatile LAS int*)(F.lds + LDS_MISC);
    volatile LAS int* istart = offs + 264;
    const bf16_t* hhi = (const bf16_t*)(F.ws + WS_A3); const int* ltok = (const int*)(F.ws + WS_LTOK); bf16_t* act = (bf16_t*)(F.ws + WS_ACT);
    unsigned* cnt = F.ctl + CW_CNT;
    for (int it = F.vcu; it < total; it += F.G) {
        const int e = find_expert(F, it); const int li = it - istart[e]; const int rt = li >> 1, ct = li & 1;
        const int me = (int)cnt[e * 64], m0 = rt * 256, j0 = ct * 128; const int ro = offs[e];
        f32x16 acc[4][2]; zero_acc<4>(acc);
        AGather af{hhi, ltok + (long)e * LCAP, m0, me, 3072u};
        BKNPair bf{F.a.in[18] + (long)e * 262144 + j0, (long)(F.a.in[19] - F.a.in[18]), 256};
        gemm_core<4, true>(acc, af, bf, 16, F.lds);
        run_epilogue_tr<4>(acc, [&](int r, int c0, f32x4 v0, f32x4 v1) { const int i = m0 + r; if (i < me) { const int j = j0 + (c0 >> 6) * 32 + (c0 & 31);
            const f32x4 a = {siluf_(v0[0]) * v1[0], siluf_(v0[1]) * v1[1], siluf_(v0[2]) * v1[2], siluf_(v0[3]) * v1[3]};
            *(u32x2*)(act + (unsigned)(ro + i) * 256u + j) = pack4(a); } });
    }
}
__device__ __forceinline__ void p13_exp_down(const Ctx& F) {
    constexpr int W_P = 528, ST_P = 144;
    constexpr int L_W = 0, L_ST = 128 * W_P;
    static_assert(L_ST + 8 * 32 * ST_P <= LDS_MISC, "expert-down engine LDS");
    (void)build_expert_tables(F, 1);
    volatile LAS int* offs = (volatile LAS int*)(F.lds + LDS_MISC);
    const int* ltok = (const int*)(F.ws + WS_LTOK); const float* lw = (const float*)(F.ws + WS_LW); const bf16_t* act = (const bf16_t*)(F.ws + WS_ACT);
    unsigned char* ybuf8 = F.ws + WS_YBUF; unsigned* cnt = F.ctl + CW_CNT;
    const int lane = F.lane, w = F.wave, l31 = lane & 31, hh = lane >> 5;
    unsigned char* st = F.lds + L_ST + w * (32 * ST_P);
#pragma unroll 1
    for (int it = F.vcu; it < NE * 8; it += F.G) {
        const int e = it >> 3, n0 = (it & 7) * 128; const int me = (int)cnt[e * 64]; const int ro = offs[e];
        if (me == 0) continue;
        __syncthreads();
        { int tid_ = F.tid; asm volatile("" : "+v"(tid_));
#pragma unroll 1
          for (int b2 = tid_; b2 < 1024; b2 += NTHREADS) { const int kb = b2 >> 5, nq = b2 & 31;
            const float* src = F.a.in[20] + (size_t)e * 262144 + (size_t)(kb * 8) * 1024 + n0 + 4 * nq;
            f32x4 r[8];
#pragma unroll
            for (int i = 0; i < 8; ++i) r[i] = *(const f32x4*)(src + (size_t)i * 1024);
#pragma unroll
            for (int j = 0; j < 4; ++j) { u32x4 p; p.x = cvt_pk_bf16(r[0][j], r[1][j]); p.y = cvt_pk_bf16(r[2][j], r[3][j]); p.z = cvt_pk_bf16(r[4][j], r[5][j]); p.w = cvt_pk_bf16(r[6][j], r[7][j]);
                *(u32x4*)(F.lds + L_W + (4 * nq + j) * W_P + kb * 16) = p; } } }
        __syncthreads();
        const int* lt = ltok + (size_t)e * LCAP; const float* lwe = lw + (size_t)e * LCAP;
#pragma unroll 1
        for (int tb = w; tb * 32 < me; tb += 8) {
            const int idx = tb * 32 + l31; const int idc = (idx < me) ? idx : (me - 1);
            const bf16_t* arow = act + (size_t)(ro + idc) * 256 + 8 * hh;
            bf16x8 z[16];
#pragma unroll
            for (int k = 0; k < 16; ++k) z[k] = *(const bf16x8*)(arow + 16 * k);
            const int myent = lt[idc]; const float sc = lwe[idc] * 16.f;
            f32x16 acc[4];
#pragma unroll
            for (int f = 0; f < 4; ++f)
#pragma unroll
                for (int r = 0; r < 16; ++r) acc[f][r] = 0.f;
            bf16x8 wa[8], wb[8];
            const unsigned char* wbase = F.lds + L_W + l31 * W_P + 16 * hh;
#define WLOAD(dst, hs) _Pragma("unroll") for (int k = 0; k < 8; ++k) dst[k] = *(const bf16x8*)(wbase + (32 * ((hs) >> 1)) * W_P + (128 * ((hs) & 1) + 16 * k) * 2)
#define WMMA(src, hs) _Pragma("unroll") for (int k = 0; k < 8; ++k) acc[(hs) >> 1] = __builtin_amdgcn_mfma_f32_32x32x16_bf16(src[k], z[8 * ((hs) & 1) + k], acc[(hs) >> 1], 0, 0, 0)
            WLOAD(wa, 0);
#pragma unroll
            for (int hs = 0; hs < 8; hs += 2) {
                WLOAD(wb, hs + 1); __builtin_amdgcn_sched_barrier(0);
                WMMA(wa, hs); __builtin_amdgcn_sched_barrier(0);
                if (hs + 2 < 8) { WLOAD(wa, hs + 2); } __builtin_amdgcn_sched_barrier(0);
                WMMA(wb, hs + 1); __builtin_amdgcn_sched_barrier(0);
            }
#undef WLOAD
#undef WMMA
#pragma unroll
            for (int f = 0; f < 4; ++f)
#pragma unroll
                for (int q4 = 0; q4 < 4; ++q4) { const f32x4 v = {acc[f][4 * q4] * sc, acc[f][4 * q4 + 1] * sc, acc[f][4 * q4 + 2] * sc, acc[f][4 * q4 + 3] * sc};
                    *(unsigned*)(st + l31 * ST_P + 32 * f + 8 * q4 + 4 * hh) = pack_fp8x4(v); }
#pragma unroll
            for (int i = 0; i < 4; ++i) { const int row = (lane >> 3) + 8 * i, ch = lane & 7;
                const u32x4 v = *(const u32x4*)(st + row * ST_P + ch * 16); const unsigned ent = (unsigned)__shfl(myent, row);
                if (tb * 32 + row < me) *(u32x4*)(ybuf8 + (size_t)ent * 1024 + n0 + ch * 16) = v; }
        }
    }
}

__device__ __forceinline__ void p14_final(const Ctx& F) {
    pg8::Gemm g{(const bf16_t*)(F.ws + WS_ACTS), (const bf16_t*)(F.ws + WS_WB_SD), T, 1024, 256};
    pg8::StaticOrder S; S.init(T, 1024, F.G, (int)blockIdx.x);
    EpiOut E{F.out, (const float*)(F.ws + WS_X1), (const float*)(F.ws + WS_ADAF), (const bf16_t*)(F.ws + WS_YBUF)};
    pg8::gemm_phase<EpiOut, pg8::StaticOrder, true, true>((LAS unsigned char*)F.lds, g, S, E);
}

constexpr int NPHASE = 13;
__global__ void __launch_bounds__(NTHREADS, 2) mk_fwd(Args args) {
    extern __shared__ __attribute__((aligned(16))) unsigned char lds[];
    const int tid_ = threadIdx.x, G_ = gridDim.x, bx_ = blockIdx.x;
    Ctx F{args, args.out, args.ws, lds, (unsigned*)(args.ws + WS_CTL), tid_, tid_ & 63, __builtin_amdgcn_readfirstlane(tid_ >> 6), G_, (G_ % 8 == 0) ? (bx_ % 8) * (G_ / 8) + bx_ / 8 : bx_};
    const int lo = args.ph_lo, hi = args.ph_hi;
    volatile LAS unsigned* bst = (volatile LAS unsigned*)(lds + LDS_MISC + 4096);
    XcdBarrier bar; bar.bar = F.ctl + CW_BAR; bar.x = 0; bar.st = bst;
    if (hi - lo > 1) {
        if (F.tid == 0) { bst[0] = 0u; bst[1] = 0u; bst[2] = 0u; bst[3] = 0u; }
        __syncthreads();
        bar = xcd_barrier_post(F.ctl + CW_BAR, bst);
    }
#define PHASE(k, call) if (lo <= (k) && (k) < hi) { call; if ((k) + 1 < hi) xcd_barrier(bar); }
    PHASE(0, p0_prep(F))
    PHASE(1, p_norm_rows(F, 0))
    PHASE(2, p2_win(F))
    PHASE(3, p3_mixer_inputs(F))
    PHASE(4, p6_attn_dft(F))
    PHASE(5, p7_merge(F))
    PHASE(6, p8_out(F))
    PHASE(7, p_norm_rows(F, 1))
    PHASE(8, p10_router_shared(F))
    PHASE(9, p11_topk(F))
    PHASE(10, p12_exp_up(F))
    PHASE(11, p13_exp_down(F))
    PHASE(12, p14_final(F))
#undef PHASE
}

extern "C" void kernel_launch(void* const* d_in, const int* in_sizes, int n_in, void* d_out, int out_size, void* d_ws, size_t ws_size, hipStream_t stream) {
    static int grid = 0;
    if (grid == 0) {
        if (n_in != 24 || out_size != T * DM || ws_size < WS_END) {
            fprintf(stderr, "kernel_launch: unexpected shapes (n_in %d, out %d, ws %zu < %zu); nothing launched\n", n_in, out_size, ws_size, (size_t)WS_END); grid = -1; return; }
        int dev = 0, cus = 0, per_cu = 0;
        if (hipGetDevice(&dev) != hipSuccess || hipDeviceGetAttribute(&cus, hipDeviceAttributeMultiprocessorCount, dev) != hipSuccess) { grid = -1; return; }
        if (hipFuncSetAttribute((const void*)mk_fwd, hipFuncAttributeMaxDynamicSharedMemorySize, LDS_BYTES) != hipSuccess) { fprintf(stderr, "kernel_launch: hipFuncSetAttribute failed\n"); grid = -1; return; }
        if (hipOccupancyMaxActiveBlocksPerMultiprocessor(&per_cu, (const void*)mk_fwd, NTHREADS, LDS_BYTES) != hipSuccess || per_cu < 1)
            fprintf(stderr, "kernel_launch: occupancy query reports %d blocks per CU\n", per_cu);
        (void)hipGetLastError();
        if (cus < 256) { fprintf(stderr, "kernel_launch: this kernel is laid out for 256 CUs (device reports %d); nothing launched\n", cus); grid = -1; return; }
        grid = 256;
    }
    if (grid < 0) return;
    (void)hipMemsetAsync((char*)d_ws + WS_CTL, 0, CTL_BYTES, stream);
    Args a{};
    for (int i = 0; i < 24; ++i) a.in[i] = (const float*)d_in[i];
    a.out = (float*)d_out; a.ws = (unsigned char*)d_ws;
#if N_LAUNCH_MODE == 1
    a.ph_lo = 0; a.ph_hi = NPHASE;
    hipLaunchKernelGGL(mk_fwd, dim3(grid), dim3(NTHREADS), LDS_BYTES, stream, a);
#else
    for (int ph = 0; ph < NPHASE; ++ph) { a.ph_lo = ph; a.ph_hi = ph + 1; hipLaunchKernelGGL(mk_fwd, dim3(grid), dim3(NTHREADS), LDS_BYTES, stream, a); }
#endif
    const hipError_t le = hipPeekAtLastError();
    if (le != hipSuccess) fprintf(stderr, "kernel_launch: launch failed: %s\n", hipGetErrorName(le));
}
```

```cpp
#include <hip/hip_runtime.h>
#include <cstdio>
#include <cstdint>

typedef unsigned short bf16_t;
typedef short bf16x8 __attribute__((ext_vector_type(8)));
typedef float f32x16 __attribute__((ext_vector_type(16)));
typedef float f32x4 __attribute__((ext_vector_type(4)));
typedef unsigned u32x4 __attribute__((ext_vector_type(4)));
typedef unsigned u32x2 __attribute__((ext_vector_type(2)));

#define REPEAT_MASK 16384
#ifndef N_LAUNCH_MODE
#define N_LAUNCH_MODE 1
#endif
#ifndef NAIVE_MMA
#define NAIVE_MMA 0
#endif

constexpr int T = 16384, DM = 1024, NB = 8, SEQ = 2048;
constexpr int INW = 2976, NH = 8, DQK = 96, DV = 64;
constexpr int NE = 256, TOPK = 8, EH = 256;
constexpr float EPS = 1e-6f;
constexpr int NTHREADS = 512;
constexpr int LCAP = 16384;

constexpr size_t al256(size_t x) { return (x + 255) & ~(size_t)255; }
constexpr size_t WS_CTL   = 0;
constexpr size_t CTL_BYTES = 196608;
constexpr size_t WS_ADAP  = WS_CTL + CTL_BYTES;
constexpr size_t WS_ADAF  = WS_ADAP + al256((size_t)16 * 8 * 6144 * 4);
constexpr size_t WS_ROPE  = WS_ADAF + al256((size_t)8 * 6144 * 4);
constexpr size_t WS_WDFT  = WS_ROPE + al256((size_t)2 * 2048 * 16 * 4);
constexpr size_t WS_D64T  = WS_WDFT + al256((size_t)2048 * 4096 * 2);
constexpr size_t WS_WR3   = WS_D64T + al256((size_t)128 * 64 * 2);
constexpr size_t WS_WUQ   = WS_WR3 + al256((size_t)3072 * 256 * 4);
constexpr size_t WS_WUKV  = WS_WUQ + al256((size_t)256 * 768 * 4);
constexpr size_t WS_H     = WS_WUKV + al256((size_t)128 * 1024 * 4);
constexpr size_t WS_H2LO  = WS_H + al256((size_t)T * 1024 * 2);
constexpr size_t WS_ZQKV  = WS_H2LO + al256((size_t)T * 1024 * 2);
constexpr size_t WS_ZF    = WS_ZQKV + al256((size_t)T * 416 * 2);
constexpr size_t WS_SIG   = WS_ZF + al256((size_t)T * 512 * 2);
constexpr size_t WS_RSTD  = WS_SIG + al256((size_t)T * 2048 * 2);
constexpr size_t WS_XT    = WS_RSTD + al256((size_t)2 * T * 4);
constexpr size_t WS_QRAW  = WS_XT + al256((size_t)4096 * 4096 * 2);
constexpr size_t WS_KNRAW = WS_QRAW + al256((size_t)T * 768 * 4);
constexpr size_t WS_Q     = WS_KNRAW + al256((size_t)T * 512 * 4);
constexpr size_t WS_K     = WS_Q + al256((size_t)T * 768 * 2);
constexpr size_t WS_VT    = WS_K + al256((size_t)T * 768 * 2);
constexpr size_t WS_O     = WS_VT + al256((size_t)T * 512 * 2);
constexpr size_t WS_F     = WS_O + al256((size_t)T * 512 * 2);
constexpr size_t WS_MERGED= WS_F + al256((size_t)T * 512 * 2);
constexpr size_t WS_X1    = WS_MERGED + al256((size_t)T * 1024 * 2);
constexpr size_t WS_LOGIT = WS_X1 + al256((size_t)T * 1024 * 4);
constexpr size_t WS_ACTS  = WS_LOGIT + al256((size_t)T * 256 * 4);
constexpr size_t WS_LTOK  = WS_ACTS + al256((size_t)T * 256 * 2);
constexpr size_t WS_LW    = WS_LTOK + al256((size_t)NE * LCAP * 4);
constexpr size_t WS_ACT   = WS_LW + al256((size_t)NE * LCAP * 4);
constexpr size_t WS_YBUF  = WS_ACT + al256((size_t)T * 8 * 256 * 2);
constexpr size_t WS_WB_IN = WS_YBUF + al256((size_t)T * 8 * 1024 * 2);
constexpr size_t WS_WB_PA = WS_WB_IN + al256((size_t)3072 * 1024 * 2);
constexpr size_t WS_WB_PF = WS_WB_PA + al256((size_t)1024 * 512 * 2);
constexpr size_t WS_WB_OUT= WS_WB_PF + al256((size_t)1024 * 512 * 2);
constexpr size_t WS_WB_SH = WS_WB_OUT + al256((size_t)1024 * 1024 * 2);
constexpr size_t WS_WB_SD = WS_WB_SH + al256((size_t)512 * 1024 * 2);
constexpr size_t WS_WB_R  = WS_WB_SD + al256((size_t)1024 * 256 * 2);
constexpr size_t WS_A3    = WS_WB_R + al256((size_t)256 * 3072 * 2);
constexpr size_t WS_END   = WS_A3 + al256((size_t)T * 3072 * 2);

constexpr int CW_CNT = 16384;
constexpr int CW_QUEUE = 4400;
constexpr int CW_BAR = 0;

constexpr int LDS_GEMM = 2 * 65536;
constexpr int ST16 = 520, ST32 = 1040;
constexpr int LDS_STAGE = 256 * ST16;
constexpr int LDS_MISC = 140288;
constexpr int LDS_BYTES = LDS_MISC + 8192;

typedef __bf16 bf16x2_t __attribute__((ext_vector_type(2)));
typedef float f32x2_t __attribute__((ext_vector_type(2)));
__device__ __forceinline__ unsigned cvt_pk_bf16(float lo, float hi) { f32x2_t f = {lo, hi}; bf16x2_t h = __builtin_convertvector(f, bf16x2_t); return __builtin_bit_cast(unsigned, h); }
__device__ __forceinline__ bf16_t f2bf(float v) { __bf16 h = (__bf16)v; return __builtin_bit_cast(unsigned short, h); }
__device__ __forceinline__ float bf2f(bf16_t b) { return __uint_as_float(((unsigned)b) << 16); }
__device__ __forceinline__ float sigmoidf_(float v) { return 1.f / (1.f + __expf(-v)); }
__device__ __forceinline__ float siluf_(float v) { return v / (1.f + __expf(-v)); }
__device__ __forceinline__ float wave_sum(float v) {
#pragma unroll
    for (int o = 32; o > 0; o >>= 1) v += __shfl_xor(v, o);
    return v;
}
__device__ __forceinline__ int swz(int row) { return ((row >> 1) & 7) ^ ((row >> 4) & 1); }

#define XB_TMO      128
#define XB_XCNT(j)  (256  + 64 * (j))
#define XB_XSUB(j)  (1280 + 64 * (j))
#define XB_XGEN(j)  (2304 + 64 * (j))
#define XB_TOP      3328
#define XB_TOPGEN   3392
#define XCD_BAR_WORDS 3456
#define XB_SPIN_CAP (1u << 22)
#define LAS __attribute__((address_space(3)))
__device__ __forceinline__ unsigned xb_ld(unsigned* p)              { return __hip_atomic_load(p, __ATOMIC_RELAXED, __HIP_MEMORY_SCOPE_AGENT); }
__device__ __forceinline__ unsigned xb_add(unsigned* p, unsigned v) { return __hip_atomic_fetch_add(p, v, __ATOMIC_RELAXED, __HIP_MEMORY_SCOPE_AGENT); }
__device__ __forceinline__ unsigned xb_xcc_id() { return (unsigned)__builtin_amdgcn_s_getreg((3 << 11) | 20) & 0xFu; }
#define XB_SPIN(cond, bar) do { unsigned _sp = 0; while (cond) { __builtin_amdgcn_s_sleep(1); \
    if ((++_sp & 255u) == 0u) { if (xb_ld(&(bar)[XB_TMO])) break; if (_sp > XB_SPIN_CAP) { atomicAdd(&(bar)[XB_TMO], 1u); break; } } } } while (0)
struct XcdBarrier { unsigned* bar; unsigned x; volatile LAS unsigned* st; };
__device__ __forceinline__ XcdBarrier xcd_barrier_post(unsigned* bar, volatile LAS unsigned* st) {
    XcdBarrier b; b.bar = bar; b.x = xb_xcc_id(); b.st = st;
    if (threadIdx.x == 0) (void)xb_add(&bar[XB_XCNT(b.x)], 1u);
    return b;
}
__device__ __forceinline__ void xcd_barrier_complete(unsigned* bar, unsigned x, unsigned& nloc, unsigned& nx) {
    const unsigned G = gridDim.x * gridDim.y * gridDim.z;
    unsigned sum, cnt, mine, sp = 0u;
    for (;;) {
        sum = 0u; cnt = 0u; mine = 0u;
#pragma unroll
        for (unsigned j = 0; j < 16; ++j) { const unsigned c = xb_ld(&bar[XB_XCNT(j)]); sum += c; cnt += (c > 0u) ? 1u : 0u; mine = (j == x) ? c : mine; }
        if (sum == G) break;
        __builtin_amdgcn_s_sleep(1);
        if ((++sp & 255u) == 0u) { if (xb_ld(&bar[XB_TMO])) break; if (sp > XB_SPIN_CAP) { atomicAdd(&bar[XB_TMO], 1u); break; } }
    }
    nloc = mine > 0u ? mine : 1u; nx = cnt > 0u ? cnt : 1u;
}
__device__ __forceinline__ void xcd_barrier(const XcdBarrier& b) {
    asm volatile("s_waitcnt vmcnt(0)" ::: "memory");
    __syncthreads();
    if (threadIdx.x == 0) {
        unsigned* bar = b.bar;
        __builtin_amdgcn_s_waitcnt(0);
        unsigned nloc = b.st[0], nx = b.st[1];
        if (nloc == 0u) { xcd_barrier_complete(bar, b.x, nloc, nx); b.st[0] = nloc; b.st[1] = nx; }
        const unsigned old = xb_add(&bar[XB_XSUB(b.x)], 1u);
        const unsigned gen = old / nloc;
        if (old + 1u == (gen + 1u) * nloc) {
            __builtin_amdgcn_fence(__ATOMIC_RELEASE, "agent");
            asm volatile("s_waitcnt vmcnt(0)" ::: "memory");
            const unsigned og = xb_add(&bar[XB_TOP], 1u);
            const unsigned tg = og / nx;
            if (og + 1u == (tg + 1u) * nx) xb_add(&bar[XB_TOPGEN], 1u);
            else XB_SPIN(xb_ld(&bar[XB_TOPGEN]) == tg, bar);
            __builtin_amdgcn_fence(__ATOMIC_ACQUIRE, "agent");
            xb_add(&bar[XB_XGEN(b.x)], 1u);
            asm volatile("s_waitcnt vmcnt(0)" ::: "memory");
        } else {
            XB_SPIN(xb_ld(&bar[XB_XGEN(b.x)]) == gen, bar);
            __builtin_amdgcn_fence(__ATOMIC_ACQUIRE, "agent");
            asm volatile("s_waitcnt vmcnt(0)" ::: "memory");
        }
    }
    __syncthreads();
}

template <int MI, bool TR, class AF, class BF>
__device__ __forceinline__ void gemm_core(f32x16 (&acc)[MI][2], const AF& af, const BF& bf, const int nk, unsigned char* lds) {
    constexpr int BM = 64 * MI;
    constexpr int A_BYTES = BM * 128, STAGE = A_BYTES + 256 * 128;
    const int t = threadIdx.x, lane = t & 63, w = t >> 6, wm = w >> 2, wn = w & 3;
    const int l31 = lane & 31, hh = lane >> 5;
    const int ch = t & 7, r0 = t >> 3;
    const bf16_t* abase = af.base();
    unsigned aoff[MI];
#pragma unroll
    for (int i = 0; i < MI; ++i) aoff[i] = af.off(r0 + 64 * i);
    const int a_lds = r0 * 128 + ((ch ^ swz(r0)) << 4);
    u32x4 areg[MI];
    f32x4 bregf[8]; u32x4 bregh[4];
    unsigned boff[4];
    const float* bcolf = nullptr;
    if constexpr (BF::KN) { bcolf = bf.col(4 * lane); }
    else {
#pragma unroll
        for (int i = 0; i < 4; ++i) boff[i] = bf.off(r0 + 64 * i);
    }
    auto gload = [&](int kt) {
        const long ko = af.koff(kt) + ch * 8;
#pragma unroll
        for (int i = 0; i < MI; ++i) areg[i] = *(const u32x4*)(abase + aoff[i] + ko);
        if constexpr (BF::KN) {
            const float* bp = bcolf + (long)(kt * 64 + w * 8) * bf.ldb;
#pragma unroll
            for (int i = 0; i < 8; ++i) bregf[i] = *(const f32x4*)(bp + (long)i * bf.ldb);
        } else {
            const bf16_t* bp = bf.base() + bf.koff(kt) + ch * 8;
#pragma unroll
            for (int i = 0; i < 4; ++i) bregh[i] = *(const u32x4*)(bp + boff[i]);
        }
    };
    auto lstore = [&](int st) {
        unsigned char* base = lds + st * STAGE;
#pragma unroll
        for (int i = 0; i < MI; ++i) *(u32x4*)(base + a_lds + i * 64 * 128) = areg[i];
        unsigned char* bb = base + A_BYTES;
        if constexpr (BF::KN) {
#pragma unroll
            for (int cc = 0; cc < 4; ++cc) {
                const int col = 4 * lane + cc;
                u32x4 v; v.x = cvt_pk_bf16(bregf[0][cc], bregf[1][cc]); v.y = cvt_pk_bf16(bregf[2][cc], bregf[3][cc]);
                v.z = cvt_pk_bf16(bregf[4][cc], bregf[5][cc]); v.w = cvt_pk_bf16(bregf[6][cc], bregf[7][cc]);
                *(u32x4*)(bb + col * 128 + ((w ^ swz(col)) << 4)) = v;
            }
        } else {
#pragma unroll
            for (int i = 0; i < 4; ++i) *(u32x4*)(bb + a_lds + i * 64 * 128) = bregh[i];
        }
    };
    const int fsw = swz(l31);
    const int a_frag = (wm * 32 * MI + l31) * 128, b_frag = (wn * 64 + l31) * 128;
    auto compute = [&](int st) {
        const unsigned char* base = lds + st * STAGE;
        const unsigned char* bb = base + A_BYTES;
#if NAIVE_MMA
#pragma unroll
        for (int mi = 0; mi < MI; ++mi)
#pragma unroll
            for (int ni = 0; ni < 2; ++ni)
#pragma unroll
                for (int rg = 0; rg < 16; ++rg) {
                    const int row = TR ? (wm * 32 * MI + mi * 32 + l31) : (wm * 32 * MI + mi * 32 + (rg & 3) + 8 * (rg >> 2) + 4 * hh);
                    const int col = TR ? (wn * 64 + ni * 32 + (rg & 3) + 8 * (rg >> 2) + 4 * hh) : (wn * 64 + ni * 32 + l31);
                    float s = 0.f;
                    for (int k = 0; k < 64; ++k) {
                        const bf16_t av = *(const bf16_t*)(base + row * 128 + (((k >> 3) ^ swz(row)) << 4) + (k & 7) * 2);
                        const bf16_t bv = *(const bf16_t*)(bb + col * 128 + (((k >> 3) ^ swz(col)) << 4) + (k & 7) * 2);
                        s += bf2f(av) * bf2f(bv);
                    }
                    acc[mi][ni][rg] += s;
                }
#else
#pragma unroll 2
        for (int s = 0; s < 4; ++s) {
            const int pos = ((2 * s + hh) ^ fsw) << 4;
            bf16x8 bfr[2];
#pragma unroll
            for (int ni = 0; ni < 2; ++ni) bfr[ni] = *(const bf16x8*)(bb + b_frag + ni * 32 * 128 + pos);
#pragma unroll
            for (int mi = 0; mi < MI; ++mi) {
                const bf16x8 afr = *(const bf16x8*)(base + a_frag + mi * 32 * 128 + pos);
#pragma unroll
                for (int ni = 0; ni < 2; ++ni) acc[mi][ni] = TR ? __builtin_amdgcn_mfma_f32_32x32x16_bf16(bfr[ni], afr, acc[mi][ni], 0, 0, 0)
                                                               : __builtin_amdgcn_mfma_f32_32x32x16_bf16(afr, bfr[ni], acc[mi][ni], 0, 0, 0);
            }
        }
#endif
    };
    int nk_ = nk; asm volatile("" : "+s"(nk_));
    __syncthreads();
    gload(0);
    lstore(0);
    __syncthreads();
#pragma unroll 1
    for (int kt = 0; kt < nk_; ++kt) {
        const bool more = (kt + 1 < nk_);
        if (more) gload(kt + 1);
        compute(kt & 1);
        if (more) lstore((kt + 1) & 1);
        __syncthreads();
    }
}

template <int MI> __device__ __forceinline__ void zero_acc(f32x16 (&acc)[MI][2]) {
#pragma unroll
    for (int mi = 0; mi < MI; ++mi)
#pragma unroll
        for (int ni = 0; ni < 2; ++ni)
#pragma unroll
            for (int r = 0; r < 16; ++r) acc[mi][ni][r] = 0.f;
}
template <int MI, class EPI>
__device__ __forceinline__ void run_epilogue(const f32x16 (&acc)[MI][2], const EPI& epi) {
    const int t = threadIdx.x, lane = t & 63, w = t >> 6, wm = w >> 2, wn = w & 3, l31 = lane & 31, hh = lane >> 5;
#pragma unroll
    for (int mi = 0; mi < MI; ++mi)
#pragma unroll
        for (int rg = 0; rg < 16; ++rg) {
            const int r = wm * 32 * MI + mi * 32 + (rg & 3) + 8 * (rg >> 2) + 4 * hh;
            epi(r, wn * 64 + l31, acc[mi][0][rg], acc[mi][1][rg]);
            if ((rg & 7) == 7) __builtin_amdgcn_sched_barrier(0);
        }
}

template <int MI, class EPI>
__device__ __forceinline__ void run_epilogue_tr(const f32x16 (&acc)[MI][2], const EPI& epi) {
    const int t = threadIdx.x, lane = t & 63, w = t >> 6, wm = w >> 2, wn = w & 3, l31 = lane & 31, hh = lane >> 5;
#pragma unroll
    for (int mi = 0; mi < MI; ++mi) {
        const int r = wm * 32 * MI + mi * 32 + l31;
#pragma unroll
        for (int q4 = 0; q4 < 4; ++q4) {
            const f32x4 v0 = {acc[mi][0][4 * q4], acc[mi][0][4 * q4 + 1], acc[mi][0][4 * q4 + 2], acc[mi][0][4 * q4 + 3]};
            const f32x4 v1 = {acc[mi][1][4 * q4], acc[mi][1][4 * q4 + 1], acc[mi][1][4 * q4 + 2], acc[mi][1][4 * q4 + 3]};
            epi(r, wn * 64 + 8 * q4 + 4 * hh, v0, v1);
        }
        __builtin_amdgcn_sched_barrier(0);
    }
}
__device__ __forceinline__ u32x2 pack4(const f32x4 v) { u32x2 p; p.x = cvt_pk_bf16(v[0], v[1]); p.y = cvt_pk_bf16(v[2], v[3]); return p; }
__device__ __forceinline__ f32x4 unpack4(const u32x2 p) { f32x4 v = {__uint_as_float(p.x << 16), __uint_as_float(p.x & 0xffff0000u), __uint_as_float(p.y << 16), __uint_as_float(p.y & 0xffff0000u)}; return v; }

__device__ __forceinline__ unsigned pack_fp8x4(const f32x4 v) { int p = __builtin_amdgcn_cvt_pk_fp8_f32(v[0], v[1], 0, false); p = __builtin_amdgcn_cvt_pk_fp8_f32(v[2], v[3], p, true); return (unsigned)p; }
__device__ __forceinline__ f32x4 unpack_fp8x4(const unsigned p) { f32x4 v = {__builtin_amdgcn_cvt_f32_fp8((int)p, 0), __builtin_amdgcn_cvt_f32_fp8((int)p, 1), __builtin_amdgcn_cvt_f32_fp8((int)p, 2), __builtin_amdgcn_cvt_f32_fp8((int)p, 3)}; return v; }
template <int MI> __device__ __forceinline__ void stage_bf16(const f32x16 (&acc)[MI][2], unsigned char* lds) {
    const int t = threadIdx.x, lane = t & 63, w = t >> 6, wm = w >> 2, wn = w & 3, l31 = lane & 31, hh = lane >> 5;
#pragma unroll
    for (int mi = 0; mi < MI; ++mi) {
        unsigned char* rp = lds + (wm * 32 * MI + mi * 32 + l31) * ST16 + (wn * 64 + 4 * hh) * 2;
#pragma unroll
        for (int ni = 0; ni < 2; ++ni)
#pragma unroll
            for (int q4 = 0; q4 < 4; ++q4) {
                const f32x4 v = {acc[mi][ni][4 * q4], acc[mi][ni][4 * q4 + 1], acc[mi][ni][4 * q4 + 2], acc[mi][ni][4 * q4 + 3]};
                *(u32x2*)(rp + (ni * 32 + 8 * q4) * 2) = pack4(v);
            }
    }
}
__device__ __forceinline__ void stage_f32(const f32x16 (&acc)[2][2], unsigned char* lds) {
    const int t = threadIdx.x, lane = t & 63, w = t >> 6, wm = w >> 2, wn = w & 3, l31 = lane & 31, hh = lane >> 5;
#pragma unroll
    for (int mi = 0; mi < 2; ++mi) {
        unsigned char* rp = lds + (wm * 64 + mi * 32 + l31) * ST32 + (wn * 64 + 4 * hh) * 4;
#pragma unroll
        for (int ni = 0; ni < 2; ++ni)
#pragma unroll
            for (int q4 = 0; q4 < 4; ++q4) {
                const f32x4 v = {acc[mi][ni][4 * q4], acc[mi][ni][4 * q4 + 1], acc[mi][ni][4 * q4 + 2], acc[mi][ni][4 * q4 + 3]};
                *(f32x4*)(rp + (ni * 32 + 8 * q4) * 4) = v;
            }
    }
}

struct ARows { const bf16_t* b; unsigned lda; int m0;
    __device__ __forceinline__ const bf16_t* base() const { return b; }
    __device__ __forceinline__ unsigned off(int r) const { return (unsigned)(m0 + r) * lda; }
    __device__ __forceinline__ long koff(int kt) const { return (long)kt * 64; } };
struct BKN { const float* b; int ldb; int n0; int nvalid; static constexpr bool KN = true;
    __device__ __forceinline__ const float* col(int c) const { int cc = n0 + c; cc = (cc < nvalid) ? cc : (nvalid - 4); return b + cc; } };
struct BKNPair { const float* g; long u_minus_g; int ldb; static constexpr bool KN = true;
    __device__ __forceinline__ const float* col(int c) const { return g + (long)((c >> 5) & 1) * u_minus_g + (c >> 6) * 32 + (c & 31); } };
struct BNK { const bf16_t* b; unsigned ldb; int n0; static constexpr bool KN = false;
    __device__ __forceinline__ const bf16_t* base() const { return b; }
    __device__ __forceinline__ unsigned off(int c) const { return (unsigned)(n0 + c) * ldb; }
    __device__ __forceinline__ long koff(int kt) const { return (long)kt * 64; } };

namespace pg8 {
#define PG8_LAS __attribute__((address_space(3)))
typedef unsigned short bf16_t;
typedef short bf16x8 __attribute__((ext_vector_type(8)));
typedef float f32x4 __attribute__((ext_vector_type(4)));
typedef unsigned u32x4 __attribute__((ext_vector_type(4)));
constexpr int BM = 256, BK = 64, HALF = 128, HTB = HALF * BK * 2  , STAGE_BYTES = 8 * HTB, NXCD = 8, WGM = 8;

__host__ __device__ __forceinline__ int lds_byte(int r, int c) { const int st = (r >> 4) * 2 + (c >> 5), rr = r & 15, cc = c & 31, ob = rr * 64 + cc * 2; return st * 1024 + (ob ^ (((ob >> 9) & 1) << 5)); }
__host__ __device__ __forceinline__ void stage_rc(int b, int& R, int& C) { const int st = b / 1024, sb = b % 1024, swz = sb ^ (((sb >> 9) & 1) << 5); R = (st >> 1) * 16 + swz / 64; C = (st & 1) * 32 + (swz % 64) / 2; }
__host__ __device__ __forceinline__ int perm32(int rho) { const int n = rho >> 4, i = rho & 15; return 8 * (i >> 2) + 4 * n + (i & 3); }

struct Unit { int pm, pn; };
struct Gemm { const bf16_t* A; const bf16_t* Bt; int M, N, K; int lda; int ldb; };

struct StaticOrder {
    int nM, nN, nwg, G, c;
    __host__ __device__ void init(int M, int N, int G_, int c_) { nM = M / BM; nN = N / BM; nwg = nM * nN; G = G_; c = c_; }
    __host__ __device__ bool next(int i, Unit& u) const {
        const long L = (long)i * G + c; if (L >= nwg) return false;
        int wgid = (int)L; { const int q = nwg / NXCD, r = nwg % NXCD, xcd = wgid % NXCD, off = wgid / NXCD; wgid = (xcd < r ? xcd * (q + 1) : r * (q + 1) + (xcd - r) * q) + off; }
        const int nig = WGM * nN, gid = wgid / nig, fm = gid * WGM, gsz = (nM - fm) < WGM ? (nM - fm) : WGM;
        u.pm = fm + ((wgid % nig) % gsz); u.pn = (wgid % nig) / gsz; return true;
    }
    __device__ __forceinline__ void a_ready(const Unit&) const {}
    __device__ __forceinline__ void done(const Unit&) const {}
};
template <class Epi, class Sched, bool ALIGN_EPI = false, bool SP2 = false, bool MIDHOOK = false>
__device__ __forceinline__ void gemm_phase(PG8_LAS unsigned char* lds, const Gemm g, const Sched& S, const Epi& E) {
    const int tid = threadIdx.x, wid = __builtin_amdgcn_readfirstlane(tid >> 6), lane = tid & 63, wr = wid >> 2, wc = wid & 3, fr = lane & 15, fq = lane >> 4;
    const int K = g.K, nt = K / BK, LDA = g.lda ? g.lda : g.K, LDB = g.ldb ? g.ldb : g.K;
    unsigned voffA[2], voffB[2];
#pragma unroll
    for (int i = 0; i < 2; ++i) { int R, C; stage_rc(tid * 16 + i * 8192, R, C); const int Rb = Epi::PERM ? ((R & ~31) + perm32(R & 31)) : R;
        voffA[i] = (unsigned)(R * LDA + C) * 2u; voffB[i] = (unsigned)(Rb * LDB + C) * 2u; }
    const size_t kstep = (size_t)(BK * 2);
    const size_t hstep = (size_t)HALF * LDB * 2;
    const size_t tstep = 2 * hstep;
    const size_t hstepA = (size_t)HALF * LDA * 2, tstepA = 2 * hstepA;
    const unsigned ldsw = (unsigned)wid * 1024u;
    const int aoff = lds_byte(wr * 64 + fr, fq * 8), boff = lds_byte(wc * 32 + fr, fq * 8);
#define PG8_SA(b, h) (((b) * 2 + (h)) * HTB)
#define PG8_SB(b, h) ((4 + (b) * 2 + (h)) * HTB)
#define PG8_STAGE(bufoff, gbase, voff) do { _Pragma("unroll") for (int _i = 0; _i < 2; ++_i) \
        __builtin_amdgcn_global_load_lds((const unsigned*)((const char*)(gbase) + (voff)[_i]), (PG8_LAS unsigned*)(lds + (bufoff) + ldsw + _i * 8192), 16, 0, 0); } while (0)
#define PG8_LDA(dst, b, h) do { _Pragma("unroll") for (int m = 0; m < 4; ++m) _Pragma("unroll") for (int k = 0; k < 2; ++k) dst[m][k] = *(const PG8_LAS bf16x8*)(lds + PG8_SA(b, h) + aoff + m * 2048 + k * 1024); } while (0)
#define PG8_LDB(dst, b, h) do { _Pragma("unroll") for (int n = 0; n < 2; ++n) _Pragma("unroll") for (int k = 0; k < 2; ++k) dst[n][k] = *(const PG8_LAS bf16x8*)(lds + PG8_SB(b, h) + boff + n * 2048 + k * 1024); } while (0)
#define PG8_MMA(ai, bj, At, Bt) do { __builtin_amdgcn_s_setprio(1); _Pragma("unroll") for (int m = 0; m < 4; ++m) _Pragma("unroll") for (int n = 0; n < 2; ++n) _Pragma("unroll") for (int k = 0; k < 2; ++k) \
        acc[ai][bj][m][n] = __builtin_amdgcn_mfma_f32_16x16x32_bf16(Bt[n][k], At[m][k], acc[ai][bj][m][n], 0, 0, 0); __builtin_amdgcn_s_setprio(0); } while (0)
#define PG8_WAIT_V(n) asm volatile("s_waitcnt vmcnt(" #n ")" ::: "memory")
#define PG8_WAIT_L(n) asm volatile("s_waitcnt lgkmcnt(" #n ")" ::: "memory")
#define PG8_BAR __builtin_amdgcn_s_barrier()
#define PG8_SCHED __builtin_amdgcn_sched_barrier(0)
    Unit cur, nxt; int ui = 0;
    if (!S.next(0, cur)) return;
    f32x4 acc[2][2][4][2];
#pragma unroll
    for (int a = 0; a < 2; ++a)
#pragma unroll
        for (int b = 0; b < 2; ++b)
#pragma unroll
            for (int m = 0; m < 4; ++m)
#pragma unroll
                for (int n = 0; n < 2; ++n) acc[a][b][m][n] = (f32x4){0.f, 0.f, 0.f, 0.f};
    bf16x8 At[4][2], B0[2][2], B1[2][2];
    const char* cA = (const char*)g.A + (size_t)cur.pm * tstepA; const char* cB = (const char*)g.Bt + (size_t)cur.pn * tstep;
    S.a_ready(cur);
    if constexpr (SP2) {
        PG8_STAGE(PG8_SB(0, 0), cB, voffB); PG8_STAGE(PG8_SB(0, 1), cB + hstep, voffB); PG8_STAGE(PG8_SA(0, 0), cA, voffA); PG8_STAGE(PG8_SA(0, 1), cA + hstepA, voffA);
        if (wr == 1) PG8_BAR;
        PG8_WAIT_V(2); PG8_BAR;
        PG8_STAGE(PG8_SB(1, 0), cB + kstep, voffB); PG8_STAGE(PG8_SA(1, 0), cA + kstep, voffA); PG8_STAGE(PG8_SB(1, 1), cB + hstep + kstep, voffB);
        PG8_WAIT_V(6); PG8_BAR;
    } else {
        PG8_STAGE(PG8_SB(0, 0), cB, voffB); PG8_STAGE(PG8_SA(0, 0), cA, voffA); PG8_STAGE(PG8_SB(0, 1), cB + hstep, voffB); PG8_STAGE(PG8_SA(0, 1), cA + hstepA, voffA);
        if (wr == 1) PG8_BAR;
        PG8_WAIT_V(4); PG8_BAR;
        PG8_STAGE(PG8_SB(1, 0), cB + kstep, voffB); PG8_STAGE(PG8_SA(1, 0), cA + kstep, voffA); PG8_STAGE(PG8_SB(1, 1), cB + hstep + kstep, voffB);
        PG8_WAIT_V(6); PG8_BAR;
    }
    for (;;) {
        const bool has_next = S.next(ui + 1, nxt);
        const char* nA = has_next ? (const char*)g.A + (size_t)nxt.pm * tstepA : cA; const char* nB = has_next ? (const char*)g.Bt + (size_t)nxt.pn * tstep : cB;
        for (int t = 0; t < nt; t += 2) {
            if constexpr (MIDHOOK) { if (t == (nt >> 1)) E.mid(acc, cur, wr, wc, fr, fq); }
            const bool last = (t == nt - 2);
            const char* a1 = cA + (size_t)(t + 1) * kstep;
            const char* a2 = last ? nA : cA + (size_t)(t + 2) * kstep; const char* b2 = last ? nB : cB + (size_t)(t + 2) * kstep;
            const char* a3 = a2 + kstep; const char* b3 = b2 + kstep;
            if (last && has_next) S.a_ready(nxt);
            if constexpr (SP2) {
            PG8_LDB(B0, 0, 0); PG8_LDB(B1, 0, 1); PG8_SCHED; PG8_LDA(At, 0, 0); PG8_STAGE(PG8_SA(1, 1), a1 + hstepA, voffA);
            PG8_WAIT_V(8); PG8_WAIT_L(0); PG8_BAR; PG8_MMA(0, 0, At, B0); PG8_MMA(0, 1, At, B1); PG8_BAR; PG8_SCHED;
            PG8_LDA(At, 0, 1); PG8_STAGE(PG8_SB(0, 0), b2, voffB); PG8_STAGE(PG8_SB(0, 1), b2 + hstep, voffB); PG8_STAGE(PG8_SA(0, 0), a2, voffA);
            PG8_WAIT_V(8); PG8_WAIT_L(0); PG8_BAR; PG8_MMA(1, 0, At, B0); PG8_MMA(1, 1, At, B1); PG8_BAR; PG8_SCHED;
            PG8_LDB(B0, 1, 0); PG8_LDB(B1, 1, 1); PG8_SCHED; PG8_LDA(At, 1, 0); PG8_STAGE(PG8_SA(0, 1), a2 + hstepA, voffA);
            PG8_WAIT_V(8); PG8_WAIT_L(0); PG8_BAR; PG8_MMA(0, 0, At, B0); PG8_MMA(0, 1, At, B1); PG8_BAR; PG8_SCHED;
            PG8_LDA(At, 1, 1); PG8_STAGE(PG8_SB(1, 0), b3, voffB); PG8_STAGE(PG8_SB(1, 1), b3 + hstep, voffB); PG8_STAGE(PG8_SA(1, 0), a3, voffA);
            PG8_WAIT_V(8); PG8_WAIT_L(0); PG8_BAR; PG8_MMA(1, 0, At, B0); PG8_MMA(1, 1, At, B1); PG8_BAR; PG8_SCHED;
            } else {
            PG8_LDB(B0, 0, 0); PG8_SCHED; PG8_LDA(At, 0, 0); PG8_STAGE(PG8_SA(1, 1), a1 + hstepA, voffA);
            PG8_WAIT_L(8); PG8_BAR; PG8_WAIT_L(0); PG8_MMA(0, 0, At, B0); PG8_BAR; PG8_SCHED;
            PG8_LDB(B1, 0, 1); PG8_STAGE(PG8_SB(0, 0), b2, voffB);
            PG8_BAR; PG8_WAIT_L(0); PG8_MMA(0, 1, At, B1); PG8_BAR;
            PG8_LDA(At, 0, 1); PG8_STAGE(PG8_SA(0, 0), a2, voffA);
            PG8_BAR; PG8_WAIT_L(0); PG8_MMA(1, 0, At, B0); PG8_BAR; PG8_SCHED;
            PG8_STAGE(PG8_SB(0, 1), b2 + hstep, voffB);
            PG8_WAIT_V(6); PG8_BAR; PG8_MMA(1, 1, At, B1); PG8_BAR;
            PG8_LDB(B0, 1, 0); PG8_SCHED; PG8_LDA(At, 1, 0); PG8_STAGE(PG8_SA(0, 1), a2 + hstepA, voffA);
            PG8_WAIT_L(8); PG8_BAR; PG8_WAIT_L(0); PG8_MMA(0, 0, At, B0); PG8_BAR; PG8_SCHED;
            PG8_LDB(B1, 1, 1); PG8_STAGE(PG8_SB(1, 0), b3, voffB);
            PG8_BAR; PG8_WAIT_L(0); PG8_MMA(0, 1, At, B1); PG8_BAR;
            PG8_LDA(At, 1, 1); PG8_STAGE(PG8_SA(1, 0), a3, voffA);
            PG8_BAR; PG8_WAIT_L(0); PG8_MMA(1, 0, At, B0); PG8_BAR; PG8_SCHED;
            PG8_STAGE(PG8_SB(1, 1), b3 + hstep, voffB);
            PG8_WAIT_V(6); PG8_BAR; PG8_MMA(1, 1, At, B1); PG8_BAR;
            }
        }
        if constexpr (ALIGN_EPI) { if (wr == 0) PG8_BAR; }
        if constexpr (!Epi::AFTER_DRAIN) { E(acc, cur, wr, wc, fr, fq); S.done(cur); }
        if (!has_next) break;
#pragma unroll
        for (int a = 0; a < 2; ++a)
#pragma unroll
            for (int b = 0; b < 2; ++b)
#pragma unroll
                for (int m = 0; m < 4; ++m)
#pragma unroll
                    for (int n = 0; n < 2; ++n) acc[a][b][m][n] = (f32x4){0.f, 0.f, 0.f, 0.f};
        cur = nxt; cA = nA; cB = nB; ++ui;
        if constexpr (ALIGN_EPI) { if (wr == 1) PG8_BAR; }
    }
    PG8_WAIT_V(0);
    if constexpr (!ALIGN_EPI) { if (wr == 0) PG8_BAR; }
    PG8_BAR;
    if constexpr (Epi::AFTER_DRAIN) { E.fused(acc, cur, wr, wc, fr, fq, lds, wid, lane); S.done(cur); }
#undef PG8_SA
#undef PG8_SB
#undef PG8_STAGE
#undef PG8_LDA
#undef PG8_LDB
#undef PG8_MMA
#undef PG8_WAIT_V
#undef PG8_WAIT_L
#undef PG8_BAR
#undef PG8_SCHED
}
}


struct Args { const float* in[24]; float* out; unsigned char* ws; int ph_lo, ph_hi; };

struct Ctx {
    const Args& a; float* out; unsigned char* ws; unsigned char* lds; unsigned* ctl;
    int tid, lane, wave, G, vcu;
};

__device__ __forceinline__ u32x4 pack8(const f32x4 a, const f32x4 b) { u32x4 p; p.x = cvt_pk_bf16(a[0], a[1]); p.y = cvt_pk_bf16(a[2], a[3]); p.z = cvt_pk_bf16(b[0], b[1]); p.w = cvt_pk_bf16(b[2], b[3]); return p; }
__device__ __forceinline__ f32x4 unpack_lo(const u32x4 p) { f32x4 v = {__uint_as_float(p.x << 16), __uint_as_float(p.x & 0xffff0000u), __uint_as_float(p.y << 16), __uint_as_float(p.y & 0xffff0000u)}; return v; }
__device__ __forceinline__ f32x4 unpack_hi(const u32x4 p) { f32x4 v = {__uint_as_float(p.z << 16), __uint_as_float(p.z & 0xffff0000u), __uint_as_float(p.w << 16), __uint_as_float(p.w & 0xffff0000u)}; return v; }
#define EPI_LOOP(...) _Pragma("unroll") for (int ai = 0; ai < 2; ++ai) _Pragma("unroll") for (int m = 0; m < 4; ++m) { const unsigned row = row0 + ai * 128 + m * 16; \
    _Pragma("unroll") for (int bj = 0; bj < 2; ++bj) { const unsigned col = col0 + bj * 128; const f32x4 v0 = acc[ai][bj][m][0], v1 = acc[ai][bj][m][1]; __VA_ARGS__ } }
#define EPI_HEAD const unsigned row0 = u.pm * 256 + wr * 64 + fr; const unsigned col0 = u.pn * 256 + wc * 32 + 8 * fq;
struct EpiZ {
    static constexpr bool PERM = true, AFTER_DRAIN = false; bf16_t* zqkv; bf16_t* zf; bf16_t* sig;
    __device__ __forceinline__ void operator()(const f32x4 (&acc)[2][2][4][2], const pg8::Unit& u, int wr, int wc, int fr, int fq) const { EPI_HEAD
        EPI_LOOP(
            if (col < 416) *(u32x4*)(zqkv + row * 416u + col) = pack8(v0, v1);
            else if (col < 928) *(u32x4*)(zf + row * 512u + (col - 416)) = pack8(v0, v1);
            else if (col < INW) { const f32x4 s0 = {sigmoidf_(v0[0]), sigmoidf_(v0[1]), sigmoidf_(v0[2]), sigmoidf_(v0[3])}; const f32x4 s1 = {sigmoidf_(v1[0]), sigmoidf_(v1[1]), sigmoidf_(v1[2]), sigmoidf_(v1[3])};
                *(u32x4*)(sig + row * 2048u + (col - 928)) = pack8(s0, s1); } ) } };
struct EpiF {
    static constexpr bool PERM = true, AFTER_DRAIN = false; bf16_t* Fo;
    __device__ __forceinline__ void operator()(const f32x4 (&acc)[2][2][4][2], const pg8::Unit& u, int wr, int wc, int fr, int fq) const {
        const unsigned row0 = (u.pn >> 1) * 2048 + u.pm * 256 + wr * 64 + fr; const unsigned col0 = (u.pn & 1) * 256 + wc * 32 + 8 * fq;
        EPI_LOOP( *(u32x4*)(Fo + row * 1024u + 512u + col) = pack8(v0, v1); ) } };
struct EpiMg {
    static constexpr bool PERM = true, AFTER_DRAIN = false; bf16_t* mg; const bf16_t* sig;
    __device__ __forceinline__ void mid(f32x4 (&acc)[2][2][4][2], const pg8::Unit& u, int wr, int wc, int fr, int fq) const { EPI_HEAD
#pragma unroll
        for (int ai = 0; ai < 2; ++ai)
#pragma unroll
            for (int m = 0; m < 4; ++m) { const unsigned row = row0 + ai * 128 + m * 16;
#pragma unroll
                for (int bj = 0; bj < 2; ++bj) { const unsigned col = col0 + bj * 128;
                    const u32x4 ga = *(const u32x4*)(sig + row * 2048u + col), gf = *(const u32x4*)(sig + row * 2048u + 1024 + col);
                    const f32x4 al = unpack_lo(ga), ah = unpack_hi(ga), fl = unpack_lo(gf), fh = unpack_hi(gf);
#pragma unroll
                    for (int e = 0; e < 4; ++e) { acc[ai][bj][m][0][e] *= al[e] * __builtin_amdgcn_rcpf(fl[e]); acc[ai][bj][m][1][e] *= ah[e] * __builtin_amdgcn_rcpf(fh[e]); } }
                if (m == 1 || m == 3) __builtin_amdgcn_sched_barrier(0); } }
    __device__ __forceinline__ void operator()(const f32x4 (&acc)[2][2][4][2], const pg8::Unit& u, int wr, int wc, int fr, int fq) const { EPI_HEAD
        EPI_LOOP( const u32x4 g = *(const u32x4*)(sig + row * 2048u + 1024 + col); *(u32x4*)(mg + row * 1024u + col) = pack8(unpack_lo(g) * v0, unpack_hi(g) * v1); ) } };
struct EpiX1 {
    static constexpr bool PERM = true, AFTER_DRAIN = false; float* x1; const float* x; const float* adaf;
    __device__ __forceinline__ void operator()(const f32x4 (&acc)[2][2][4][2], const pg8::Unit& u, int wr, int wc, int fr, int fq) const { EPI_HEAD
        const float* g1 = adaf + (u.pm >> 3) * 6144 + 2 * 1024;
        EPI_LOOP( const f32x4 ga = *(const f32x4*)(g1 + col), gb = *(const f32x4*)(g1 + col + 4);
            *(f32x4*)(x1 + row * 1024u + col) = *(const f32x4*)(x + row * 1024u + col) + ga * v0; *(f32x4*)(x1 + row * 1024u + col + 4) = *(const f32x4*)(x + row * 1024u + col + 4) + gb * v1; ) } };
struct EpiSh {
    static constexpr bool PERM = true, AFTER_DRAIN = false; bf16_t* acts;
    __device__ __forceinline__ void operator()(const f32x4 (&acc)[2][2][4][2], const pg8::Unit& u, int wr, int wc, int fr, int fq) const { EPI_HEAD
        EPI_LOOP( const f32x4 a = {siluf_(v0[0]) * v1[0], siluf_(v0[1]) * v1[1], siluf_(v0[2]) * v1[2], siluf_(v0[3]) * v1[3]};
            *(u32x2*)(acts + row * 256u + (col >> 1)) = pack4(a); ) } };
struct EpiOut {
    static constexpr bool PERM = true, AFTER_DRAIN = false; float* out; const float* x1; const float* adaf; const bf16_t* ybuf;
    __device__ __forceinline__ void operator()(const f32x4 (&acc)[2][2][4][2], const pg8::Unit& u, int wr, int wc, int fr, int fq) const { EPI_HEAD
        const float* g2 = adaf + (u.pm >> 3) * 6144 + 5 * 1024;
        EPI_LOOP( f32x4 s0 = v0, s1 = v1;
            f32x4 r0 = {0.f, 0.f, 0.f, 0.f}, r1 = {0.f, 0.f, 0.f, 0.f};
            _Pragma("unroll") for (int k = 0; k < 8; ++k) { const u32x2 y = *(const u32x2*)((const unsigned char*)ybuf + (row * 8u + k) * 1024u + col); r0 += unpack_fp8x4(y.x); r1 += unpack_fp8x4(y.y); }
            s0 += r0 * 0.0625f; s1 += r1 * 0.0625f;
            *(f32x4*)(out + row * 1024u + col) = *(const f32x4*)(x1 + row * 1024u + col) + *(const f32x4*)(g2 + col) * s0;
            *(f32x4*)(out + row * 1024u + col + 4) = *(const f32x4*)(x1 + row * 1024u + col + 4) + *(const f32x4*)(g2 + col + 4) * s1;
            if (m == 1 || m == 3) __builtin_amdgcn_sched_barrier(0); ) } };

template <class GET> __device__ __forceinline__ void conv_wt(const Ctx& F, bf16_t* dst, int K, int Nd, const GET& get) {
    const long gt = (long)F.vcu * NTHREADS + F.tid, gs = (long)F.G * NTHREADS; const long nchunk = (long)Nd * (K / 8);
    for (long c = gt; c < nchunk; c += gs) { const int n = (int)(c % Nd), k0 = (int)(c / Nd) * 8;
        u32x4 p; p.x = cvt_pk_bf16(get(k0, n), get(k0 + 1, n)); p.y = cvt_pk_bf16(get(k0 + 2, n), get(k0 + 3, n)); p.z = cvt_pk_bf16(get(k0 + 4, n), get(k0 + 5, n)); p.w = cvt_pk_bf16(get(k0 + 6, n), get(k0 + 7, n));
        *(u32x4*)(dst + (long)n * K + k0) = p; }
}

template <int K, int Nd, class GET4> __device__ __forceinline__ void conv4(bf16_t* dst, unsigned c, const GET4& get4) {
    constexpr unsigned NQ = Nd / 4; const unsigned n = (c % NQ) * 4u, k0 = (c / NQ) * 8u;
    f32x4 r[8];
#pragma unroll
    for (int i = 0; i < 8; ++i) r[i] = get4(k0 + i, n);
#pragma unroll
    for (int j = 0; j < 4; ++j) { u32x4 p; p.x = cvt_pk_bf16(r[0][j], r[1][j]); p.y = cvt_pk_bf16(r[2][j], r[3][j]); p.z = cvt_pk_bf16(r[4][j], r[5][j]); p.w = cvt_pk_bf16(r[6][j], r[7][j]);
        *(u32x4*)(dst + (size_t)(n + j) * K + k0) = p; }
}

__device__ __forceinline__ void p0_prep(const Ctx& F) {
    const float* c = F.a.in[1]; const float* w_ada = F.a.in[2];
    float* adap = (float*)(F.ws + WS_ADAP);
    float* sc = (float*)F.lds;
    float* red = sc + 512;
    for (int it = F.vcu; it < 256; it += F.G) {
        const int ks = it >> 4, chunk = it & 15;
        __syncthreads();
        { const int b = F.tid >> 6, k = F.tid & 63; sc[b * 64 + k] = siluf_(c[b * 1024 + ks * 64 + k]); }
        __syncthreads();
        const int cl = F.tid & 127, kq = F.tid >> 7;
        float acc[3][8];
#pragma unroll
        for (int j = 0; j < 3; ++j)
#pragma unroll
            for (int b = 0; b < 8; ++b) acc[j][b] = 0.f;
        const float* wp = w_ada + (long)(ks * 64 + kq * 16) * 6144 + chunk * 384 + cl;
#pragma unroll 8
        for (int k = 0; k < 16; ++k) {
            const float w0 = wp[k * 6144], w1 = wp[k * 6144 + 128], w2 = wp[k * 6144 + 256];
#pragma unroll
            for (int b = 0; b < 8; ++b) { const float sv = sc[b * 64 + kq * 16 + k]; acc[0][b] += sv * w0; acc[1][b] += sv * w1; acc[2][b] += sv * w2; }
        }
#pragma unroll
        for (int j = 0; j < 3; ++j)
#pragma unroll
            for (int b = 0; b < 8; ++b) red[(kq * 8 + b) * 384 + j * 128 + cl] = acc[j][b];
        __syncthreads();
        for (int o = F.tid; o < 8 * 384; o += NTHREADS) { const int b = o / 384, cc = o - b * 384;
            adap[((long)ks * 8 + b) * 6144 + chunk * 384 + cc] = (red[b * 384 + cc] + red[(8 + b) * 384 + cc]) + (red[(16 + b) * 384 + cc] + red[(24 + b) * 384 + cc]); }
    }
    const long gt = (long)F.vcu * NTHREADS + F.tid, gs = (long)F.G * NTHREADS;
    { float* rc = (float*)(F.ws + WS_ROPE); float* rs = rc + 2048 * 16;
      for (long i = gt; i < 2048 * 16; i += gs) { const int pos = (int)(i >> 4), j = (int)(i & 15);
          const float inv = powf(10000.0f, -(float)(2 * j) / 32.0f); const float ang = (float)pos * inv; rc[i] = cosf(ang); rs[i] = sinf(ang); } }
    { bf16_t* wd = (bf16_t*)(F.ws + WS_WDFT); const float nrm = 0.02209708691207961f;
      for (long g = gt; g < (long)2048 * 64; g += gs) { const int k = (int)(g >> 6), l = (int)(g & 63);
          const float cr = cospif((float)k * (1.0f / 1024.0f)), sr = sinpif((float)k * (1.0f / 1024.0f));
          const int idx0 = (k * (8 * l)) & 2047; const int q = k & 3;
          float c0 = cospif((float)idx0 * (1.0f / 1024.0f)) * nrm, s0 = sinpif((float)idx0 * (1.0f / 1024.0f)) * nrm;
#pragma unroll
          for (int i = 0; i < 4; ++i) {
              float cv[8], sv[8]; float cc = c0, ss = s0;
#pragma unroll
              for (int j = 0; j < 8; ++j) { cv[j] = cc; sv[j] = ss; const float cn = cc * cr - ss * sr; ss = ss * cr + cc * sr; cc = cn; }
              u32x4 pc, ps;
              pc.x = cvt_pk_bf16(cv[0], cv[1]); pc.y = cvt_pk_bf16(cv[2], cv[3]); pc.z = cvt_pk_bf16(cv[4], cv[5]); pc.w = cvt_pk_bf16(cv[6], cv[7]);
              ps.x = cvt_pk_bf16(sv[0], sv[1]); ps.y = cvt_pk_bf16(sv[2], sv[3]); ps.z = cvt_pk_bf16(sv[4], sv[5]); ps.w = cvt_pk_bf16(sv[6], sv[7]);
              *(u32x4*)(wd + (long)k * 4096 + 8 * l + 512 * i) = pc; *(u32x4*)(wd + (long)k * 4096 + 2048 + 8 * l + 512 * i) = ps;
              const float nc = (q == 0) ? c0 : (q == 1) ? -s0 : (q == 2) ? -c0 : s0;
              const float ns = (q == 0) ? s0 : (q == 1) ? c0 : (q == 2) ? -s0 : -c0;
              c0 = nc; s0 = ns;
          } } }
    { bf16_t* d6 = (bf16_t*)(F.ws + WS_D64T);
      for (long i = gt; i < 128 * 64; i += gs) { const int n = (int)(i >> 6), cc = (int)(i & 63), part = n >> 6, m = n & 63; const int idx = (m * cc) & 63;
          const float a = (float)idx * (1.0f / 32.0f); const float v = part ? -sinpif(a) : cospif(a); d6[i] = f2bf(v * 0.125f); } }
    { const float* w_in = F.a.in[5]; const float* w_pa = F.a.in[12]; const float* w_pf = F.a.in[13]; const float* w_o = F.a.in[14]; const float* w_r = F.a.in[16];
      const float* w_g = F.a.in[21]; const float* w_u = F.a.in[22]; const float* w_sd = F.a.in[23];
      const float* gq = F.a.in[6]; const float* wq = F.a.in[7]; const float* gkv = F.a.in[8]; const float* wk = F.a.in[9];
      constexpr unsigned C_IN = 768 * 128, C_OUT = 256 * 128, C_R = 64 * 384, C_PA = 256 * 64, C_SH = 128 * 128, C_SD = 256 * 32, C_UQ = 192 * 32, C_UKV = 256 * 16;
      constexpr unsigned C_TOT = C_IN + C_OUT + C_R + 2 * C_PA + C_SH + C_SD + C_UQ + C_UKV;
      for (unsigned c0 = (unsigned)gt; c0 < C_TOT; c0 += (unsigned)gs) {
          unsigned c = c0;
          if (c < C_IN) { conv4<1024, 3072>((bf16_t*)(F.ws + WS_WB_IN), c, [&](unsigned k, unsigned n) { const f32x4 z = {0.f, 0.f, 0.f, 0.f}; return (n < (unsigned)INW) ? *(const f32x4*)(w_in + k * (unsigned)INW + n) : z; }); continue; }
          c -= C_IN;
          if (c < C_OUT) { conv4<1024, 1024>((bf16_t*)(F.ws + WS_WB_OUT), c, [&](unsigned k, unsigned n) { return *(const f32x4*)(w_o + k * 1024u + n); }); continue; }
          c -= C_OUT;
          if (c < C_R) { conv4<3072, 256>((bf16_t*)(F.ws + WS_WB_R), c, [&](unsigned k3, unsigned n) { const unsigned rg = k3 >> 10, k = k3 & 1023u; const f32x4 wv = *(const f32x4*)(w_r + k * 256u + n);
                  f32x4 hi; hi[0] = bf2f(f2bf(wv[0])); hi[1] = bf2f(f2bf(wv[1])); hi[2] = bf2f(f2bf(wv[2])); hi[3] = bf2f(f2bf(wv[3])); return (rg == 2u) ? (wv - hi) : hi; }); continue; }
          c -= C_R;
          if (c < 2 * C_PA) { conv4<1024, 1024>((bf16_t*)(F.ws + WS_WB_PA), c, [&](unsigned k, unsigned n) { return (k < 512u) ? *(const f32x4*)(w_pa + k * 1024u + n) : *(const f32x4*)(w_pf + (k - 512u) * 1024u + n); }); continue; }
          c -= 2 * C_PA;
          if (c < C_SH) { conv4<1024, 512>((bf16_t*)(F.ws + WS_WB_SH), c, [&](unsigned k, unsigned n) { const unsigned j = (n >> 3) * 4u; return ((n >> 2) & 1u) ? *(const f32x4*)(w_u + k * 256u + j) : *(const f32x4*)(w_g + k * 256u + j); }); continue; }
          c -= C_SH;
          if (c < C_SD) { conv4<256, 1024>((bf16_t*)(F.ws + WS_WB_SD), c, [&](unsigned k, unsigned n) { return *(const f32x4*)(w_sd + k * 1024u + n); }); continue; }
          c -= C_SD;
          if (c < C_UQ) { conv4<256, 768>((bf16_t*)(F.ws + WS_WUQ), c, [&](unsigned k, unsigned n) { return *(const f32x4*)(wq + k * 768u + n) * gq[k]; }); continue; }
          c -= C_UQ;
          conv4<128, 1024>((bf16_t*)(F.ws + WS_WUKV), c, [&](unsigned k, unsigned n) { return *(const f32x4*)(wk + k * 1024u + n) * gkv[k]; });
      } }
}

__device__ __forceinline__ void p_norm_rows(const Ctx& F, int which) {
    const float* src = which ? (const float*)(F.ws + WS_X1) : F.a.in[0];
    const float* gain = which ? F.a.in[15] : F.a.in[4];
    const float* adap = (const float*)(F.ws + WS_ADAP); const float* b_ada = F.a.in[3];
    float* adaf = (float*)(F.ws + WS_ADAF);
    bf16_t* dhi = which ? (bf16_t*)(F.ws + WS_A3) : (bf16_t*)(F.ws + WS_H); const unsigned ldd = which ? 3072u : 1024u;
    float* smod = (float*)F.lds; float* sshift = smod + 1024;
    if (which == 0) {
        for (int idx = F.vcu * NTHREADS + F.tid; idx < 8 * 6144; idx += F.G * NTHREADS) { const int b = idx / 6144, j = idx - b * 6144; float s = b_ada[j];
#pragma unroll
            for (int ks = 0; ks < 16; ++ks) s += adap[((long)ks * 8 + b) * 6144 + j];
            adaf[idx] = s; }
    }
    for (int it = F.vcu; it < 256; it += F.G) {
        const int b = it >> 5;
        __syncthreads();
        for (int cidx = F.tid; cidx < 1024; cidx += NTHREADS) {
            float sh, scv;
            if (which == 0) { sh = b_ada[cidx]; scv = b_ada[1024 + cidx];
                for (int ks = 0; ks < 16; ++ks) { sh += adap[((long)ks * 8 + b) * 6144 + cidx]; scv += adap[((long)ks * 8 + b) * 6144 + 1024 + cidx]; } }
            else { sh = adaf[b * 6144 + 3 * 1024 + cidx]; scv = adaf[b * 6144 + 4 * 1024 + cidx]; }
            smod[cidx] = gain[cidx] * (1.f + scv); sshift[cidx] = sh;
        }
        __syncthreads();
#pragma unroll 1
        for (int jb = 0; jb < 8; jb += 4) {
        f32x4 va[4][4];
#pragma unroll
        for (int j = 0; j < 4; ++j)
#pragma unroll
            for (int i = 0; i < 4; ++i) va[j][i] = *(const f32x4*)(src + ((long)it * 64 + F.wave * 8 + jb + j) * 1024 + i * 256 + F.lane * 4);
#pragma unroll
        for (int j = 0; j < 4; ++j) {
            const long row = (long)it * 64 + F.wave * 8 + jb + j;
            f32x4 v[4]; float ss = 0.f;
#pragma unroll
            for (int i = 0; i < 4; ++i) { v[i] = va[j][i]; ss += v[i][0] * v[i][0] + v[i][1] * v[i][1] + v[i][2] * v[i][2] + v[i][3] * v[i][3]; }
            ss = wave_sum(ss);
            const float rstd = rsqrtf(ss * (1.0f / 1024.0f) + EPS);
#pragma unroll
            for (int i = 0; i < 4; ++i) {
                const int c0 = i * 256 + F.lane * 4; float hv[4];
#pragma unroll
                for (int e = 0; e < 4; ++e) hv[e] = v[i][e] * rstd * smod[c0 + e] + sshift[c0 + e];
                u32x2 pk; pk.x = cvt_pk_bf16(hv[0], hv[1]); pk.y = cvt_pk_bf16(hv[2], hv[3]);
                *(u32x2*)(dhi + row * ldd + c0) = pk;
                if (which) {
                    float lo[4];
                    lo[0] = hv[0] - __uint_as_float(pk.x << 16); lo[1] = hv[1] - __uint_as_float(pk.x & 0xffff0000u);
                    lo[2] = hv[2] - __uint_as_float(pk.y << 16); lo[3] = hv[3] - __uint_as_float(pk.y & 0xffff0000u);
                    u32x2 pl; pl.x = cvt_pk_bf16(lo[0], lo[1]); pl.y = cvt_pk_bf16(lo[2], lo[3]);
                    *(u32x2*)(dhi + row * ldd + 1024 + c0) = pl; *(u32x2*)(dhi + row * ldd + 2048 + c0) = pk;
                }
            }
        }
        }
    }
}

__device__ __forceinline__ void p2_win(const Ctx& F) {
    pg8::Gemm g{(const bf16_t*)(F.ws + WS_H), (const bf16_t*)(F.ws + WS_WB_IN), T, 3072, 1024};
    pg8::StaticOrder S; S.init(T, 3072, F.G, (int)blockIdx.x);
    EpiZ E{(bf16_t*)(F.ws + WS_ZQKV), (bf16_t*)(F.ws + WS_ZF), (bf16_t*)(F.ws + WS_SIG)};
    pg8::gemm_phase<EpiZ, pg8::StaticOrder, true, true>((LAS unsigned char*)F.lds, g, S, E);
}

struct BKNq { const float* b; static constexpr bool KN = true; int ldb;
    __device__ __forceinline__ const float* col(int c) const { return b + ((c < 192) ? c : 188); } };
__device__ __forceinline__ void p3_mixer_inputs(const Ctx& F) {
    const bf16_t* zqkv = (const bf16_t*)(F.ws + WS_ZQKV);
    const int lane = F.lane, w = F.wave;
    {
        const bf16_t* zf = (const bf16_t*)(F.ws + WS_ZF); const bf16_t* d6 = (const bf16_t*)(F.ws + WS_D64T); bf16_t* xt = (bf16_t*)(F.ws + WS_XT);
        for (int it = F.vcu; it < 8 * 64; it += F.G) {
            const int g = it & 7, tt = it >> 3; const int tok0 = tt * 256; const int b = tok0 >> 11, s0 = tok0 & 2047;
            f32x16 acc[2][2]; zero_acc<2>(acc);
            ARows af{d6, 64, 0}; BNK bf{zf + g * 64, 512, tok0};
            gemm_core<2, true>(acc, af, bf, 1, F.lds);
            stage_bf16<2>(acc, F.lds);
            __syncthreads();
#pragma unroll 4
            for (int rr = 0; rr < 16; ++rr) {
                const int n = w * 16 + rr; const int part = n >> 6, m = n & 63;
                *(u32x2*)(xt + (unsigned)(b * 512 + g * 64 + m) * 4096u + part * 2048 + s0 + 4 * lane) = *(const u32x2*)(F.lds + n * ST16 + lane * 8);
            }
        }
    }
    {
        constexpr int WQ_P = 528, WKV_P = 272, ST_P = 208;
        constexpr int L_WQ = 0, L_WKV = 96 * WQ_P, L_G = L_WKV + 128 * WKV_P, L_ST = L_G + 768;
        static_assert(L_ST + 8 * 32 * ST_P <= LDS_MISC, "head engine LDS");
        const float* rc = (const float*)(F.ws + WS_ROPE); const float* rsn = rc + 2048 * 16;
        bf16_t* Q = (bf16_t*)(F.ws + WS_Q); bf16_t* K = (bf16_t*)(F.ws + WS_K); bf16_t* vt = (bf16_t*)(F.ws + WS_VT);
        const int hd = F.vcu & 7; const int l31 = lane & 31, hh = lane >> 5;
        __syncthreads();
        { const u32x4* wq = (const u32x4*)((const bf16_t*)(F.ws + WS_WUQ) + (size_t)hd * 96 * 256); const u32x4* wk = (const u32x4*)((const bf16_t*)(F.ws + WS_WUKV) + (size_t)hd * 128 * 128);
          for (int c = F.tid; c < 96 * 32; c += NTHREADS) *(u32x4*)(F.lds + L_WQ + (c >> 5) * WQ_P + (c & 31) * 16) = wq[c];
          for (int c = F.tid; c < 128 * 16; c += NTHREADS) *(u32x4*)(F.lds + L_WKV + (c >> 4) * WKV_P + (c & 15) * 16) = wk[c];
          if (F.tid < 96) { ((float*)(F.lds + L_G))[F.tid] = F.a.in[10][F.tid]; ((float*)(F.lds + L_G))[96 + F.tid] = F.a.in[11][F.tid]; } }
        __syncthreads();
        const float* gq = (const float*)(F.lds + L_G); const float* gk = gq + 96;
        unsigned char* st = F.lds + L_ST + w * (32 * ST_P);
        const float qscale = 0.10206207261596577f * 1.4426950408889634f;
#pragma unroll 1
        for (int i2 = 0; i2 < 2; ++i2) {
            const int sb = (F.vcu >> 3) + 32 * i2; const unsigned tok = sb * 256 + w * 32 + l31; const int b = tok >> 11, s = tok & 2047; const unsigned bh = b * 8 + hd;
            const bf16_t* zrow = zqkv + tok * 416u;
            const f32x4 cs0 = *(const f32x4*)(rc + s * 16 + 4 * hh), cs1 = *(const f32x4*)(rc + s * 16 + 8 + 4 * hh), sn0 = *(const f32x4*)(rsn + s * 16 + 4 * hh), sn1 = *(const f32x4*)(rsn + s * 16 + 8 + 4 * hh);
            {
                bf16x8 zq[16];
#pragma unroll
                for (int k = 0; k < 16; ++k) zq[k] = *(const bf16x8*)(zrow + 16 * k + 8 * hh);
                f32x16 aq[3];
#pragma unroll
                for (int f = 0; f < 3; ++f) {
#pragma unroll
                    for (int r = 0; r < 16; ++r) aq[f][r] = 0.f;
#pragma unroll
                    for (int k = 0; k < 16; ++k) { const bf16x8 wf = *(const bf16x8*)(F.lds + L_WQ + (32 * f + l31) * WQ_P + (16 * k + 8 * hh) * 2); aq[f] = __builtin_amdgcn_mfma_f32_32x32x16_bf16(wf, zq[k], aq[f], 0, 0, 0);
                        if ((k & 7) == 7) __builtin_amdgcn_sched_barrier(0); }
                }
                float ss = 0.f;
#pragma unroll
                for (int f = 0; f < 3; ++f)
#pragma unroll
                    for (int r = 0; r < 16; ++r) ss += aq[f][r] * aq[f][r];
                ss += __shfl_xor(ss, 32);
                const float rstd = rsqrtf(ss * (1.0f / 96.0f) + EPS) * qscale;
#pragma unroll
                for (int f = 0; f < 3; ++f)
#pragma unroll
                    for (int r = 0; r < 16; ++r) aq[f][r] *= rstd * gq[32 * f + (r & 3) + 8 * (r >> 2) + 4 * hh];
#pragma unroll
                for (int r = 0; r < 8; ++r) { const float c = (r < 4) ? cs0[r & 3] : cs1[r & 3], sn = (r < 4) ? sn0[r & 3] : sn1[r & 3];
                    const float r1 = aq[2][r], r2 = aq[2][r + 8]; aq[2][r] = r1 * c - r2 * sn; aq[2][r + 8] = r2 * c + r1 * sn; }
#pragma unroll
                for (int f = 0; f < 3; ++f)
#pragma unroll
                    for (int q4 = 0; q4 < 4; ++q4) { const f32x4 v = {aq[f][4 * q4], aq[f][4 * q4 + 1], aq[f][4 * q4 + 2], aq[f][4 * q4 + 3]};
                        *(u32x2*)(st + l31 * ST_P + (32 * f + 8 * q4 + 4 * hh) * 2) = pack4(v); }
                u32x4* dst = (u32x4*)(Q + ((size_t)bh * 2048 + (s - l31)) * 96);
#pragma unroll
                for (int c6 = 0; c6 < 6; ++c6) { const int c = c6 * 64 + lane; dst[c] = *(const u32x4*)(st + (c / 12) * ST_P + (c % 12) * 16); }
            }
            {
                bf16x8 zk[8]; float sk = 0.f;
#pragma unroll
                for (int k = 0; k < 8; ++k) { zk[k] = *(const bf16x8*)(zrow + 256 + 16 * k + 8 * hh);
#pragma unroll
                    for (int e = 0; e < 8; ++e) { const float z = bf2f((bf16_t)zk[k][e]); sk += z * z; } }
                sk += __shfl_xor(sk, 32);
                const float rkv = rsqrtf(sk * (1.0f / 128.0f) + EPS);
                f32x16 ak[4];
#pragma unroll
                for (int f = 0; f < 4; ++f) {
#pragma unroll
                    for (int r = 0; r < 16; ++r) ak[f][r] = 0.f;
#pragma unroll
                    for (int k = 0; k < 8; ++k) { const bf16x8 wf = *(const bf16x8*)(F.lds + L_WKV + (32 * f + l31) * WKV_P + (16 * k + 8 * hh) * 2); ak[f] = __builtin_amdgcn_mfma_f32_32x32x16_bf16(wf, zk[k], ak[f], 0, 0, 0); }
                    __builtin_amdgcn_sched_barrier(0);
                }
#pragma unroll
                for (int f = 2; f < 4; ++f)
#pragma unroll
                    for (int r = 0; r < 16; ++r) { const int dv = 32 * (f - 2) + (r & 3) + 8 * (r >> 2) + 4 * hh; vt[((size_t)bh * 64 + dv) * 2048 + s] = f2bf(ak[f][r] * rkv); }
                float zr[16];
#pragma unroll
                for (int q4 = 0; q4 < 4; ++q4) { const f32x4 t4 = unpack4(*(const u32x2*)(zrow + 384 + 8 * q4 + 4 * hh)); zr[4 * q4] = t4[0]; zr[4 * q4 + 1] = t4[1]; zr[4 * q4 + 2] = t4[2]; zr[4 * q4 + 3] = t4[3]; }
                float ss = 0.f;
#pragma unroll
                for (int f = 0; f < 2; ++f)
#pragma unroll
                    for (int r = 0; r < 16; ++r) { ak[f][r] *= rkv; ss += ak[f][r] * ak[f][r]; }
#pragma unroll
                for (int r = 0; r < 16; ++r) ss += zr[r] * zr[r];
                ss += __shfl_xor(ss, 32);
                const float rstd = rsqrtf(ss * (1.0f / 96.0f) + EPS);
#pragma unroll
                for (int f = 0; f < 2; ++f)
#pragma unroll
                    for (int r = 0; r < 16; ++r) ak[f][r] *= rstd * gk[32 * f + (r & 3) + 8 * (r >> 2) + 4 * hh];
#pragma unroll
                for (int r = 0; r < 16; ++r) zr[r] *= rstd * gk[64 + (r & 3) + 8 * (r >> 2) + 4 * hh];
#pragma unroll
                for (int r = 0; r < 8; ++r) { const float c = (r < 4) ? cs0[r & 3] : cs1[r & 3], sn = (r < 4) ? sn0[r & 3] : sn1[r & 3];
                    const float r1 = zr[r], r2 = zr[r + 8]; zr[r] = r1 * c - r2 * sn; zr[r + 8] = r2 * c + r1 * sn; }
#pragma unroll
                for (int f = 0; f < 2; ++f)
#pragma unroll
                    for (int q4 = 0; q4 < 4; ++q4) { const f32x4 v = {ak[f][4 * q4], ak[f][4 * q4 + 1], ak[f][4 * q4 + 2], ak[f][4 * q4 + 3]};
                        *(u32x2*)(st + l31 * ST_P + (32 * f + 8 * q4 + 4 * hh) * 2) = pack4(v); }
#pragma unroll
                for (int q4 = 0; q4 < 4; ++q4) { const f32x4 v = {zr[4 * q4], zr[4 * q4 + 1], zr[4 * q4 + 2], zr[4 * q4 + 3]};
                    *(u32x2*)(st + l31 * ST_P + (64 + 8 * q4 + 4 * hh) * 2) = pack4(v); }
                u32x4* dst = (u32x4*)(K + ((size_t)bh * 2048 + (s - l31)) * 96);
#pragma unroll
                for (int c6 = 0; c6 < 6; ++c6) { const int c = c6 * 64 + lane; dst[c] = *(const u32x4*)(st + (c / 12) * ST_P + (c % 12) * 16); }
            }
        }
    }
}

constexpr int KROW = 208, VROW = 136, K_TILE = 64 * KROW, V_TILE = 64 * VROW, AT_STAGE = K_TILE + V_TILE;
__device__ __forceinline__ void attn_item(const Ctx& F, int item) {
    const int qb = item & 7, bh = item >> 3, b = bh >> 3, hd = bh & 7;
    const bf16_t* Q = (const bf16_t*)(F.ws + WS_Q) + (long)bh * 2048 * 96;
    const bf16_t* K = (const bf16_t*)(F.ws + WS_K) + (long)bh * 2048 * 96;
    const bf16_t* Vt = (const bf16_t*)(F.ws + WS_VT) + (long)bh * 64 * 2048;
    bf16_t* O = (bf16_t*)(F.ws + WS_O);
    const int t = F.tid, lane = F.lane, w = F.wave, l31 = lane & 31, hh = lane >> 5;
    bf16x8 qf[6];
    { const bf16_t* qp = Q + (long)(qb * 256 + w * 32 + l31) * 96 + hh * 8;
#pragma unroll
      for (int s = 0; s < 6; ++s) qf[s] = *(const bf16x8*)(qp + s * 16); }
    f32x16 oacc[2];
#pragma unroll
    for (int d = 0; d < 2; ++d)
#pragma unroll
        for (int r = 0; r < 16; ++r) oacc[d][r] = 0.f;
    float neg_m;
    { float qss = 0.f;
#pragma unroll
      for (int s = 0; s < 6; ++s)
#pragma unroll
          for (int e = 0; e < 8; ++e) { const float v = bf2f((bf16_t)qf[s][e]); qss += v * v; }
      qss += __shfl_xor(qss, 32);
      const float* kg = F.a.in[11];
      float gm = fmaxf(fabsf(kg[lane]), fabsf(kg[64 + (lane & 31)]));
#pragma unroll
      for (int o = 32; o > 0; o >>= 1) gm = fmaxf(gm, __shfl_xor(gm, o));
      neg_m = -(sqrtf(qss) * gm * 9.797958971132712f); }
    f32x16 negm16;
#pragma unroll
    for (int r = 0; r < 16; ++r) negm16[r] = neg_m;
    float l_run = 0.f;
    const int kq0 = t, kq1 = t + 512;
    const int k_l0 = (kq0 / 12) * KROW + (kq0 % 12) * 16, k_l1 = (kq1 / 12) * KROW + (kq1 % 12) * 16;
    const int v_dv = t >> 3, v_c = t & 7; const int v_l = v_dv * VROW + v_c * 16;
    u32x4 kr0, kr1, vr;
    auto gload = [&](int j) {
        const bf16_t* kp = K + (long)j * 64 * 96;
        kr0 = *(const u32x4*)(kp + kq0 * 8);
        if (t < 256) kr1 = *(const u32x4*)(kp + kq1 * 8);
        vr = *(const u32x4*)(Vt + (long)v_dv * 2048 + j * 64 + v_c * 8);
    };
    auto lstore = [&](int st) {
        unsigned char* base = F.lds + st * AT_STAGE;
        *(u32x4*)(base + k_l0) = kr0;
        if (t < 256) *(u32x4*)(base + k_l1) = kr1;
        *(u32x2*)(base + K_TILE + v_l) = (u32x2){vr.x, vr.y}; *(u32x2*)(base + K_TILE + v_l + 8) = (u32x2){vr.z, vr.w};
    };
    __syncthreads();
    gload(0); lstore(0);
    __syncthreads();
    for (int j = 0; j < 32; ++j) {
        const bool more = (j + 1 < 32);
        if (more) gload(j + 1);
        const unsigned char* kb = F.lds + (j & 1) * AT_STAGE; const unsigned char* vb = kb + K_TILE;
        f32x16 st[2];
        {
            bf16x8 kfr[2][6];
#pragma unroll
            for (int f = 0; f < 2; ++f)
#pragma unroll
                for (int s = 0; s < 6; ++s) kfr[f][s] = *(const bf16x8*)(kb + (32 * f + l31) * KROW + (16 * s + 8 * hh) * 2);
            __builtin_amdgcn_sched_barrier(0);
#pragma unroll
            for (int f = 0; f < 2; ++f) {
#pragma unroll
                for (int s = 0; s < 6; ++s) st[f] = __builtin_amdgcn_mfma_f32_32x32x16_bf16(kfr[f][s], qf[s], s ? st[f] : negm16, 0, 0, 0);
            }
        }
        float ps = 0.f;
#pragma unroll
        for (int f = 0; f < 2; ++f)
#pragma unroll
            for (int r = 0; r < 16; ++r) { const float p = __builtin_amdgcn_exp2f(st[f][r]); st[f][r] = p; ps += p; }
        l_run += ps;
        {
            u32x4 vfr[2][2][2];
#pragma unroll
            for (int f = 0; f < 2; ++f)
#pragma unroll
                for (int s2 = 0; s2 < 2; ++s2)
#pragma unroll
                    for (int d = 0; d < 2; ++d) { const unsigned char* vp = vb + (32 * d + l31) * VROW + (32 * f + 16 * s2 + 4 * hh) * 2;
                        const u32x2 lo = *(const u32x2*)vp, hi = *(const u32x2*)(vp + 16); vfr[f][s2][d] = (u32x4){lo.x, lo.y, hi.x, hi.y}; }
#pragma unroll
            for (int f = 0; f < 2; ++f)
#pragma unroll
                for (int s2 = 0; s2 < 2; ++s2) {
                    u32x4 pw; pw.x = cvt_pk_bf16(st[f][8 * s2 + 0], st[f][8 * s2 + 1]); pw.y = cvt_pk_bf16(st[f][8 * s2 + 2], st[f][8 * s2 + 3]);
                    pw.z = cvt_pk_bf16(st[f][8 * s2 + 4], st[f][8 * s2 + 5]); pw.w = cvt_pk_bf16(st[f][8 * s2 + 6], st[f][8 * s2 + 7]);
                    const bf16x8 pf = *(const bf16x8*)&pw;
#pragma unroll
                    for (int d = 0; d < 2; ++d) oacc[d] = __builtin_amdgcn_mfma_f32_32x32x16_bf16(*(const bf16x8*)&vfr[f][s2][d], pf, oacc[d], 0, 0, 0);
                }
        }
        if (more) lstore((j + 1) & 1);
        __syncthreads();
    }
    l_run += __shfl_xor(l_run, 32);
    const float inv = 1.0f / l_run;
    const long tok = (long)b * 2048 + qb * 256 + w * 32 + l31;
#pragma unroll
    for (int d = 0; d < 2; ++d)
#pragma unroll
        for (int q4 = 0; q4 < 4; ++q4) {
            const int dv = 32 * d + 8 * q4 + 4 * hh;
            u32x2 pk; pk.x = cvt_pk_bf16(oacc[d][4 * q4 + 0] * inv, oacc[d][4 * q4 + 1] * inv); pk.y = cvt_pk_bf16(oacc[d][4 * q4 + 2] * inv, oacc[d][4 * q4 + 3] * inv);
            *(u32x2*)(O + tok * 1024 + hd * 64 + dv) = pk;
        }
}

__device__ __forceinline__ void p6_attn_dft(const Ctx& F) {
    {
        pg8::Gemm g{(const bf16_t*)(F.ws + WS_WDFT), (const bf16_t*)(F.ws + WS_XT), 2048, 4096, 4096};
        pg8::StaticOrder S; S.init(2048, 4096, F.G, (int)blockIdx.x);
        EpiF E{(bf16_t*)(F.ws + WS_O)};
        pg8::gemm_phase<EpiF, pg8::StaticOrder, true, true>((LAS unsigned char*)F.lds, g, S, E);
    }
    volatile LAS int* sitem = (volatile LAS int*)(F.lds + LDS_MISC);
    auto next_item = [&]() -> int {
        __syncthreads();
        if (F.tid == 0) sitem[0] = (int)xb_add(F.ctl + CW_QUEUE, 1u);
        __syncthreads();
        return sitem[0];
    };
    int it = next_item();
    while (it < 512) { attn_item(F, it); it = next_item(); }
}

__device__ __forceinline__ void p7_merge(const Ctx& F) {
    bf16_t* mg = (bf16_t*)(F.ws + WS_MERGED); const bf16_t* sig = (const bf16_t*)(F.ws + WS_SIG);
    pg8::StaticOrder S; S.init(T, 1024, F.G, (int)blockIdx.x);
    pg8::Gemm g{(const bf16_t*)(F.ws + WS_O), (const bf16_t*)(F.ws + WS_WB_PA), T, 1024, 1024}; EpiMg E{mg, sig};
    pg8::gemm_phase<EpiMg, pg8::StaticOrder, true, true, true>((LAS unsigned char*)F.lds, g, S, E);
}

__device__ __forceinline__ void p8_out(const Ctx& F) {
    pg8::Gemm g{(const bf16_t*)(F.ws + WS_MERGED), (const bf16_t*)(F.ws + WS_WB_OUT), T, 1024, 1024};
    pg8::StaticOrder S; S.init(T, 1024, F.G, (int)blockIdx.x);
    EpiX1 E{(float*)(F.ws + WS_X1), F.a.in[0], (const float*)(F.ws + WS_ADAF)};
    pg8::gemm_phase<EpiX1, pg8::StaticOrder, true, true>((LAS unsigned char*)F.lds, g, S, E);
}

template <int NT>
__device__ __forceinline__ void topk_tokens(const Ctx& F, int tok0, const float (&lg)[NT][4], const float (&bs)[4]) {
    int* ltok = (int*)(F.ws + WS_LTOK); float* lw = (float*)(F.ws + WS_LW); unsigned* cnt = F.ctl + CW_CNT;
    const int lane = F.lane;
    float sc[NT][4]; unsigned long long key[NT][4];
#pragma unroll
    for (int t = 0; t < NT; ++t)
#pragma unroll
        for (int i = 0; i < 4; ++i) {
            sc[t][i] = sigmoidf_(lg[t][i]);
            const unsigned ub = __float_as_uint(sc[t][i] + bs[i]);
            const unsigned ord = (ub & 0x80000000u) ? ~ub : (ub | 0x80000000u);
            key[t][i] = ((unsigned long long)ord << 32) | (unsigned long long)(255 - (lane + 64 * i));
        }
    float wsum[NT], myw[NT]; int mye[NT];
#pragma unroll
    for (int t = 0; t < NT; ++t) { wsum[t] = 0.f; myw[t] = 0.f; mye[t] = 0; }
    for (int k = 0; k < 8; ++k) {
        unsigned long long best[NT];
#pragma unroll
        for (int t = 0; t < NT; ++t) { best[t] = key[t][0];
#pragma unroll
            for (int i = 1; i < 4; ++i) best[t] = (key[t][i] > best[t]) ? key[t][i] : best[t]; }
#pragma unroll
        for (int o = 32; o > 0; o >>= 1) {
#pragma unroll
            for (int t = 0; t < NT; ++t) {
                const unsigned lo = __shfl_xor((unsigned)best[t], o), hi = __shfl_xor((unsigned)(best[t] >> 32), o);
                const unsigned long long ob = ((unsigned long long)hi << 32) | lo;
                best[t] = (ob > best[t]) ? ob : best[t];
            }
        }
#pragma unroll
        for (int t = 0; t < NT; ++t) {
            const int e = 255 - (int)(best[t] & 0xffull);
            float s_own = 0.f;
#pragma unroll
            for (int i = 0; i < 4; ++i) { const bool mine = (e == lane + 64 * i); s_own = mine ? sc[t][i] : s_own; key[t][i] = mine ? 0ull : key[t][i]; }
            const float s_k = __shfl(s_own, e & 63);
            wsum[t] += s_k;
            myw[t] = (lane == k) ? s_k : myw[t]; mye[t] = (lane == k) ? e : mye[t];
        }
    }
    if (lane < 8) {
        unsigned slot[NT];
#pragma unroll
        for (int t = 0; t < NT; ++t) slot[t] = atomicAdd(&cnt[mye[t] * 64], 1u);
#pragma unroll
        for (int t = 0; t < NT; ++t) { ltok[(long)mye[t] * LCAP + slot[t]] = (tok0 + t) * 8 + lane; lw[(long)mye[t] * LCAP + slot[t]] = myw[t] / wsum[t] * 2.5f; }
    }
}

struct EpiLog {
    static constexpr bool PERM = true, AFTER_DRAIN = false; float* dst;
    __device__ __forceinline__ void operator()(const f32x4 (&acc)[2][2][4][2], const pg8::Unit& u, int wr, int wc, int fr, int fq) const { EPI_HEAD
        EPI_LOOP( *(f32x4*)(dst + row * 256u + col) = v0; *(f32x4*)(dst + row * 256u + col + 4) = v1; ) } };
__device__ __forceinline__ void p10_router_shared(const Ctx& F) {
    const bf16_t* a3 = (const bf16_t*)(F.ws + WS_A3); const bf16_t* wr = (const bf16_t*)(F.ws + WS_WB_R); float* part = (float*)(F.ws + WS_QRAW);
    const unsigned bx = blockIdx.x, G = (unsigned)F.G;
    {
        pg8::Gemm g{a3, (const bf16_t*)(F.ws + WS_WB_SH), T, 512, 1024, 3072};
        pg8::StaticOrder S; S.init(T, 512, F.G, (int)bx);
        EpiSh E{(bf16_t*)(F.ws + WS_ACTS)};
        pg8::gemm_phase<EpiSh, pg8::StaticOrder, true, true>((LAS unsigned char*)F.lds, g, S, E);
    }
    {
        const int seg = (bx >= 192u) ? 1 : 0;
        const bool has = (bx >= 128u);
        pg8::Gemm g{a3 + seg * 1536, wr + seg * 1536, T, 256, 1536, 3072};
        g.ldb = 3072;
        pg8::StaticOrder S; S.init(T, 256, F.G, has ? (int)((bx - 128u) & 63u) : (int)(G - 1));
        EpiLog E{part + (size_t)seg * T * 256};
        pg8::gemm_phase<EpiLog, pg8::StaticOrder, true, true>((LAS unsigned char*)F.lds, g, S, E);
    }
}
__device__ __forceinline__ void p11_topk(const Ctx& F) {
    const float* part = (const float*)(F.ws + WS_QRAW);
    float bs[4];
#pragma unroll
    for (int i = 0; i < 4; ++i) bs[i] = F.a.in[17][F.lane + 64 * i];
    for (int tok0 = (F.vcu * 8 + F.wave) * 8; tok0 < T; tok0 += F.G * 8 * 8) {
        float lg[8][4];
#pragma unroll
        for (int t = 0; t < 8; ++t)
#pragma unroll
            for (int i = 0; i < 4; ++i) { const size_t o = (size_t)(tok0 + t) * 256 + F.lane + 64 * i; lg[t][i] = part[o] + part[o + (size_t)T * 256]; }
        topk_tokens<8>(F, tok0, lg, bs);
    }
}

__device__ __forceinline__ int build_expert_tables(const Ctx& F, int per_rt) {
    volatile LAS int* offs = (volatile LAS int*)(F.lds + LDS_MISC); volatile LAS int* istart = offs + 264; volatile LAS int* wtot = offs + 540;
    unsigned* cnt = F.ctl + CW_CNT;
    const int t = F.tid, lane = F.lane;
    const int c = (t < NE) ? (int)cnt[t * 64] : 0; const int ni = ((c + 255) >> 8) * per_rt;
    int x = c, y = ni;
#pragma unroll
    for (int d = 1; d < 64; d <<= 1) { const int x2 = __shfl_up(x, d), y2 = __shfl_up(y, d); x += (lane >= d) ? x2 : 0; y += (lane >= d) ? y2 : 0; }
    __syncthreads();
    if (t < NE && lane == 63) { wtot[t >> 6] = x; wtot[4 + (t >> 6)] = y; }
    __syncthreads();
    if (t < NE) { int bx = 0, by = 0; for (int k = 0; k < (t >> 6); ++k) { bx += wtot[k]; by += wtot[4 + k]; }
        offs[t] = bx + x - c; istart[t] = by + y - ni; if (t == NE - 1) { offs[NE] = bx + x; istart[NE] = by + y; } }
    __syncthreads();
    return istart[NE];
}
__device__ __forceinline__ int find_expert(const Ctx& F, int it) {
    volatile LAS int* istart = (volatile LAS int*)(F.lds + LDS_MISC) + 264;
    int lo = 0, hi = NE;
    while (hi - lo > 1) { const int mid = (lo + hi) >> 1; if (istart[mid] <= it) lo = mid; else hi = mid; }
    return lo;
}
struct AGather { const bf16_t* b; const int* list; int m0, mvalid; unsigned lda;
    __device__ __forceinline__ const bf16_t* base() const { return b; }
    __device__ __forceinline__ unsigned off(int r) const { int i = m0 + r; i = (i < mvalid) ? i : (mvalid - 1); return (unsigned)(list[i] >> 3) * lda; }
    __device__ __forceinline__ long koff(int kt) const { return (long)kt * 64; } };
struct ARowsV { const bf16_t* b; unsigned lda; int m0, mvalid;
    __device__ __forceinline__ const bf16_t* base() const { return b; }
    __device__ __forceinline__ unsigned off(int r) const { int i = m0 + r; i = (i < mvalid) ? i : (mvalid - 1); return (unsigned)i * lda; }
    __device__ __forceinline__ long koff(int kt) const { return (long)kt * 64; } };

__device__ __forceinline__ void p12_exp_up(const Ctx& F) {
    const int total = build_expert_tables(F, 2);
    volatile LAS int* offs = (volatile LAS int*)(F.lds + LDS_MISC);
    volatile LAS int* istart = offs + 264;
    const bf16_t* hhi = (const bf16_t*)(F.ws + WS_A3); const int* ltok = (const int*)(F.ws + WS_LTOK); bf16_t* act = (bf16_t*)(F.ws + WS_ACT);
    unsigned* cnt = F.ctl + CW_CNT;
    for (int it = F.vcu; it < total; it += F.G) {
        const int e = find_expert(F, it); const int li = it - istart[e]; const int rt = li >> 1, ct = li & 1;
        const int me = (int)cnt[e * 64], m0 = rt * 256, j0 = ct * 128; const int ro = offs[e];
        f32x16 acc[4][2]; zero_acc<4>(acc);
        AGather af{hhi, ltok + (long)e * LCAP, m0, me, 3072u};
        BKNPair bf{F.a.in[18] + (long)e * 262144 + j0, (long)(F.a.in[19] - F.a.in[18]), 256};
        gemm_core<4, true>(acc, af, bf, 16, F.lds);
        run_epilogue_tr<4>(acc, [&](int r, int c0, f32x4 v0, f32x4 v1) { const int i = m0 + r; if (i < me) { const int j = j0 + (c0 >> 6) * 32 + (c0 & 31);
            const f32x4 a = {siluf_(v0[0]) * v1[0], siluf_(v0[1]) * v1[1], siluf_(v0[2]) * v1[2], siluf_(v0[3]) * v1[3]};
            *(u32x2*)(act + (unsigned)(ro + i) * 256u + j) = pack4(a); } });
    }
}
__device__ __forceinline__ void p13_exp_down(const Ctx& F) {
    constexpr int W_P = 528, ST_P = 144;
    constexpr int L_W = 0, L_ST = 128 * W_P;
    static_assert(L_ST + 8 * 32 * ST_P <= LDS_MISC, "expert-down engine LDS");
    (void)build_expert_tables(F, 1);
    volatile LAS int* offs = (volatile LAS int*)(F.lds + LDS_MISC);
    const int* ltok = (const int*)(F.ws + WS_LTOK); const float* lw = (const float*)(F.ws + WS_LW); const bf16_t* act = (const bf16_t*)(F.ws + WS_ACT);
    unsigned char* ybuf8 = F.ws + WS_YBUF; unsigned* cnt = F.ctl + CW_CNT;
    const int lane = F.lane, w = F.wave, l31 = lane & 31, hh = lane >> 5;
    unsigned char* st = F.lds + L_ST + w * (32 * ST_P);
#pragma unroll 1
    for (int it = F.vcu; it < NE * 8; it += F.G) {
        const int e = it >> 3, n0 = (it & 7) * 128; const int me = (int)cnt[e * 64]; const int ro = offs[e];
        if (me == 0) continue;
        __syncthreads();
        { int tid_ = F.tid; asm volatile("" : "+v"(tid_));
#pragma unroll 1
          for (int b2 = tid_; b2 < 1024; b2 += NTHREADS) { const int kb = b2 >> 5, nq = b2 & 31;
            const float* src = F.a.in[20] + (size_t)e * 262144 + (size_t)(kb * 8) * 1024 + n0 + 4 * nq;
            f32x4 r[8];
#pragma unroll
            for (int i = 0; i < 8; ++i) r[i] = *(const f32x4*)(src + (size_t)i * 1024);
#pragma unroll
            for (int j = 0; j < 4; ++j) { u32x4 p; p.x = cvt_pk_bf16(r[0][j], r[1][j]); p.y = cvt_pk_bf16(r[2][j], r[3][j]); p.z = cvt_pk_bf16(r[4][j], r[5][j]); p.w = cvt_pk_bf16(r[6][j], r[7][j]);
                *(u32x4*)(F.lds + L_W + (4 * nq + j) * W_P + kb * 16) = p; } } }
        __syncthreads();
        const int* lt = ltok + (size_t)e * LCAP; const float* lwe = lw + (size_t)e * LCAP;
#pragma unroll 1
        for (int tb = w; tb * 32 < me; tb += 8) {
            const int idx = tb * 32 + l31; const int idc = (idx < me) ? idx : (me - 1);
            const bf16_t* arow = act + (size_t)(ro + idc) * 256 + 8 * hh;
            bf16x8 z[16];
#pragma unroll
            for (int k = 0; k < 16; ++k) z[k] = *(const bf16x8*)(arow + 16 * k);
            const int myent = lt[idc]; const float sc = lwe[idc] * 16.f;
            f32x16 acc[4];
#pragma unroll
            for (int f = 0; f < 4; ++f)
#pragma unroll
                for (int r = 0; r < 16; ++r) acc[f][r] = 0.f;
            bf16x8 wa[8], wb[8];
            const unsigned char* wbase = F.lds + L_W + l31 * W_P + 16 * hh;
#define WLOAD(dst, hs) _Pragma("unroll") for (int k = 0; k < 8; ++k) dst[k] = *(const bf16x8*)(wbase + (32 * ((hs) >> 1)) * W_P + (128 * ((hs) & 1) + 16 * k) * 2)
#define WMMA(src, hs) _Pragma("unroll") for (int k = 0; k < 8; ++k) acc[(hs) >> 1] = __builtin_amdgcn_mfma_f32_32x32x16_bf16(src[k], z[8 * ((hs) & 1) + k], acc[(hs) >> 1], 0, 0, 0)
            WLOAD(wa, 0);
#pragma unroll
            for (int hs = 0; hs < 8; hs += 2) {
                WLOAD(wb, hs + 1); __builtin_amdgcn_sched_barrier(0);
                WMMA(wa, hs); __builtin_amdgcn_sched_barrier(0);
                if (hs + 2 < 8) { WLOAD(wa, hs + 2); } __builtin_amdgcn_sched_barrier(0);
                WMMA(wb, hs + 1); __builtin_amdgcn_sched_barrier(0);
            }
#undef WLOAD
#undef WMMA
#pragma unroll
            for (int f = 0; f < 4; ++f)
#pragma unroll
                for (int q4 = 0; q4 < 4; ++q4) { const f32x4 v = {acc[f][4 * q4] * sc, acc[f][4 * q4 + 1] * sc, acc[f][4 * q4 + 2] * sc, acc[f][4 * q4 + 3] * sc};
                    *(unsigned*)(st + l31 * ST_P + 32 * f + 8 * q4 + 4 * hh) = pack_fp8x4(v); }
#pragma unroll
            for (int i = 0; i < 4; ++i) { const int row = (lane >> 3) + 8 * i, ch = lane & 7;
                const u32x4 v = *(const u32x4*)(st + row * ST_P + ch * 16); const unsigned ent = (unsigned)__shfl(myent, row);
                if (tb * 32 + row < me) *(u32x4*)(ybuf8 + (size_t)ent * 1024 + n0 + ch * 16) = v; }
        }
    }
}

__device__ __forceinline__ void p14_final(const Ctx& F) {
    pg8::Gemm g{(const bf16_t*)(F.ws + WS_ACTS), (const bf16_t*)(F.ws + WS_WB_SD), T, 1024, 256};
    pg8::StaticOrder S; S.init(T, 1024, F.G, (int)blockIdx.x);
    EpiOut E{F.out, (const float*)(F.ws + WS_X1), (const float*)(F.ws + WS_ADAF), (const bf16_t*)(F.ws + WS_YBUF)};
    pg8::gemm_phase<EpiOut, pg8::StaticOrder, true, true>((LAS unsigned char*)F.lds, g, S, E);
}

constexpr int NPHASE = 13;
__global__ void __launch_bounds__(NTHREADS, 2) mk_fwd(Args args) {
    extern __shared__ __attribute__((aligned(16))) unsigned char lds[];
    const int tid_ = threadIdx.x, G_ = gridDim.x, bx_ = blockIdx.x;
    Ctx F{args, args.out, args.ws, lds, (unsigned*)(args.ws + WS_CTL), tid_, tid_ & 63, __builtin_amdgcn_readfirstlane(tid_ >> 6), G_, (G_ % 8 == 0) ? (bx_ % 8) * (G_ / 8) + bx_ / 8 : bx_};
    const int lo = args.ph_lo, hi = args.ph_hi;
    volatile LAS unsigned* bst = (volatile LAS unsigned*)(lds + LDS_MISC + 4096);
    XcdBarrier bar; bar.bar = F.ctl + CW_BAR; bar.x = 0; bar.st = bst;
    if (hi - lo > 1) {
        if (F.tid == 0) { bst[0] = 0u; bst[1] = 0u; bst[2] = 0u; bst[3] = 0u; }
        __syncthreads();
        bar = xcd_barrier_post(F.ctl + CW_BAR, bst);
    }
#define PHASE(k, call) if (lo <= (k) && (k) < hi) { call; if ((k) + 1 < hi) xcd_barrier(bar); }
    PHASE(0, p0_prep(F))
    PHASE(1, p_norm_rows(F, 0))
    PHASE(2, p2_win(F))
    PHASE(3, p3_mixer_inputs(F))
    PHASE(4, p6_attn_dft(F))
    PHASE(5, p7_merge(F))
    PHASE(6, p8_out(F))
    PHASE(7, p_norm_rows(F, 1))
    PHASE(8, p10_router_shared(F))
    PHASE(9, p11_topk(F))
    PHASE(10, p12_exp_up(F))
    PHASE(11, p13_exp_down(F))
    PHASE(12, p14_final(F))
#undef PHASE
}

extern "C" void kernel_launch(void* const* d_in, const int* in_sizes, int n_in, void* d_out, int out_size, void* d_ws, size_t ws_size, hipStream_t stream) {
    static int grid = 0;
    if (grid == 0) {
        if (n_in != 24 || out_size != T * DM || ws_size < WS_END) {
            fprintf(stderr, "kernel_launch: unexpected shapes (n_in %d, out %d, ws %zu < %zu); nothing launched\n", n_in, out_size, ws_size, (size_t)WS_END); grid = -1; return; }
        int dev = 0, cus = 0, per_cu = 0;
        if (hipGetDevice(&dev) != hipSuccess || hipDeviceGetAttribute(&cus, hipDeviceAttributeMultiprocessorCount, dev) != hipSuccess) { grid = -1; return; }
        if (hipFuncSetAttribute((const void*)mk_fwd, hipFuncAttributeMaxDynamicSharedMemorySize, LDS_BYTES) != hipSuccess) { fprintf(stderr, "kernel_launch: hipFuncSetAttribute failed\n"); grid = -1; return; }
        if (hipOccupancyMaxActiveBlocksPerMultiprocessor(&per_cu, (const void*)mk_fwd, NTHREADS, LDS_BYTES) != hipSuccess || per_cu < 1)
            fprintf(stderr, "kernel_launch: occupancy query reports %d blocks per CU\n", per_cu);
        (void)hipGetLastError();
        if (cus < 256) { fprintf(stderr, "kernel_launch: this kernel is laid out for 256 CUs (device reports %d); nothing launched\n", cus); grid = -1; return; }
        grid = 256;
    }
    if (grid < 0) return;
    (void)hipMemsetAsync((char*)d_ws + WS_CTL, 0, CTL_BYTES, stream);
    Args a{};
    for (int i = 0; i < 24; ++i) a.in[i] = (const float*)d_in[i];
    a.out = (float*)d_out; a.ws = (unsigned char*)d_ws;
#if N_LAUNCH_MODE == 1
    a.ph_lo = 0; a.ph_hi = NPHASE;
    hipLaunchKernelGGL(mk_fwd, dim3(grid), dim3(NTHREADS), LDS_BYTES, stream, a);
#else
    for (int ph = 0; ph < NPHASE; ++ph) { a.ph_lo = ph; a.ph_hi = ph + 1; hipLaunchKernelGGL(mk_fwd, dim3(grid), dim3(NTHREADS), LDS_BYTES, stream, a); }
#endif
    const hipError_t le = hipPeekAtLastError();
    if (le != hipSuccess) fprintf(stderr, "kernel_launch: launch failed: %s\n", hipGetErrorName(le));
}
```
